# Optimizing an MI355X kernel written in HIP

```python
import math
import jax, jax.numpy as jnp
from jax import lax
import numpy as np

D_MODEL = 1024
BATCH = 4
SEQ = 4096
DEPTH = 2

MEM_LEN = 256
D_MIX = D_MODEL
GLA_WIDTH = 3 * D_MIX // 8
GLA_HEADS = 4
GLA_DV = GLA_WIDTH // GLA_HEADS
GLA_DK = GLA_DV // 2
GLA_RANK = 16
GLA_TAU = 16.0
GLA_CHUNK = 64
DSA_WIDTH = 3 * D_MIX // 8
DSA_DH = 64
DSA_HEADS = DSA_WIDTH // DSA_DH
IDX_HEADS = 8
IDX_DIM = 64
TOPK_MAX = 256
Q_BLOCK = 128
CONV_CH = D_MIX - GLA_WIDTH - DSA_WIDTH
CONV_WIDTH = 31
NUM_BUCKETS = 32
MAX_DISTANCE = 128
X_HEADS = 4
X_DH = 64
N_GROUPS = 4
EXPERTS_PER_GROUP = 4
N_EXPERTS = N_GROUPS * EXPERTS_PER_GROUP
TOPK_EXPERTS = 2
D_EXPERT = 512
NORM_EPS = 1e-6
IN_SIZES = (GLA_HEADS * GLA_DK, GLA_HEADS * GLA_DK, GLA_WIDTH, GLA_RANK, GLA_WIDTH,
            DSA_WIDTH, DSA_WIDTH, DSA_WIDTH, IDX_HEADS * IDX_DIM, IDX_DIM, IDX_HEADS,
            2 * CONV_CH)
D_IN = sum(IN_SIZES)

kernel_name = "hybrid_gla_dsa_conformer_hmoe"


def rms_norm(x, g):
    xf = x.astype(jnp.float32)
    y = xf * lax.rsqrt(jnp.mean(xf * xf, axis=-1, keepdims=True) + NORM_EPS)
    return (y * g.astype(jnp.float32)).astype(x.dtype)


def t5_bucket(dist):
    max_exact = NUM_BUCKETS // 2
    d = jnp.maximum(dist, 1).astype(jnp.float32)
    large = max_exact + (jnp.log(d / max_exact) / math.log(MAX_DISTANCE / max_exact)
                         * (NUM_BUCKETS - max_exact)).astype(jnp.int32)
    large = jnp.minimum(large, NUM_BUCKETS - 1)
    return jnp.where(dist < max_exact, dist, large)


def gla_chunked(q, k, v, log_a):
    B, S, H, DK = q.shape
    DV = v.shape[-1]
    n = S // GLA_CHUNK

    def to_chunks(t):
        return t.astype(jnp.float32).reshape(B, n, GLA_CHUNK, H, t.shape[-1]).transpose(1, 0, 3, 2, 4)

    qc, kc, vc, ac = to_chunks(q * (DK ** -0.5)), to_chunks(k), to_chunks(v), to_chunks(log_a)
    causal = jnp.tril(jnp.ones((GLA_CHUNK, GLA_CHUNK), dtype=bool))

    def step(state, inp):
        qi, ki, vi, ai = inp
        b = jnp.cumsum(ai, axis=-2)
        diff = b[:, :, :, None, :] - b[:, :, None, :, :]
        decay = jnp.exp(jnp.where(causal[:, :, None], diff, -jnp.inf))
        attn = jnp.einsum('bhtd,bhsd,bhtsd->bhts', qi, ki, decay)
        o = (jnp.einsum('bhts,bhsv->bhtv', attn, vi)
             + jnp.einsum('bhtd,bhdv->bhtv', qi * jnp.exp(b), state))
        b_last = b[:, :, -1:, :]
        state = (jnp.exp(b_last[:, :, 0, :])[..., None] * state
                 + jnp.einsum('bhsd,bhsv->bhdv', ki * jnp.exp(b_last - b), vi))
        return state, o

    state0 = jnp.zeros((B, H, DK, DV), jnp.float32)
    _, o = lax.scan(step, state0, (qc, kc, vc, ac))
    return o.transpose(1, 0, 3, 2, 4).reshape(B, S, H, DV)


def dsa_attention(q, k, v, q_idx, k_idx, w_idx, rel_bias, topk):
    B, S, H, DH = q.shape
    n_blk = S // Q_BLOCK
    kf = k.reshape(B, S, H * DH)
    vf = v.reshape(B, S, H * DH)
    key_pos = jnp.arange(S)
    k_idx_f = k_idx.astype(jnp.float32)

    def block(i):
        start = i * Q_BLOCK
        qi = lax.dynamic_slice_in_dim(q, start, Q_BLOCK, axis=1)
        qx = lax.dynamic_slice_in_dim(q_idx, start, Q_BLOCK, axis=1).astype(jnp.float32)
        wx = lax.dynamic_slice_in_dim(w_idx, start, Q_BLOCK, axis=1).astype(jnp.float32)
        tpos = start + jnp.arange(Q_BLOCK)
        dots = jnp.einsum('bthd,bsd->bths', qx, k_idx_f) * (IDX_DIM ** -0.5)
        score = jnp.einsum('bths,bth->bts', jax.nn.relu(dots), wx)
        score = jnp.where(key_pos[None, :] <= tpos[:, None], score, -jnp.inf)
        _, sel = lax.top_k(score, topk)
        valid = sel <= tpos[None, :, None]
        ksel = jax.vmap(lambda kb, ib: kb[ib])(kf, sel).reshape(B, Q_BLOCK, topk, H, DH)
        vsel = jax.vmap(lambda vb, ib: vb[ib])(vf, sel).reshape(B, Q_BLOCK, topk, H, DH)
        logits = jnp.einsum('bthd,btkhd->bhtk', qi, ksel).astype(jnp.float32) * (DH ** -0.5)
        bucket = t5_bucket(jnp.maximum(tpos[None, :, None] - sel, 0))
        logits = logits + rel_bias[bucket].astype(jnp.float32).transpose(0, 3, 1, 2)
        logits = jnp.where(valid[:, None], logits, -jnp.inf)
        p = jax.nn.softmax(logits, axis=-1)
        return jnp.einsum('bhtk,btkhd->bthd', p.astype(vsel.dtype), vsel)

    out = lax.map(block, jnp.arange(n_blk))
    return out.transpose(1, 0, 2, 3, 4).reshape(B, S, H, DH)


def conformer_conv(u, conv_w, conv_b, ln_g, ln_b):
    a, g = jnp.split(u, 2, axis=-1)
    h = a * jax.nn.sigmoid(g)
    h = lax.conv_general_dilated(h, conv_w[:, None, :].astype(h.dtype), window_strides=(1,),
                                 padding=[(CONV_WIDTH - 1, 0)],
                                 dimension_numbers=('NWC', 'WIO', 'NWC'),
                                 feature_group_count=CONV_CH) + conv_b
    hf = h.astype(jnp.float32)
    mu = jnp.mean(hf, axis=-1, keepdims=True)
    var = jnp.mean(jnp.square(hf - mu), axis=-1, keepdims=True)
    y = (hf - mu) * lax.rsqrt(var + NORM_EPS) * ln_g.astype(jnp.float32) + ln_b.astype(jnp.float32)
    return jax.nn.silu(y).astype(u.dtype)


def memory_cross_attention(h, m, w_cq, w_ckv, qn, kn, w_co):
    B, S, _ = h.shape
    M = m.shape[1]
    q = rms_norm((h @ w_cq).reshape(B, S, X_HEADS, X_DH), qn)
    kv = (m @ w_ckv).reshape(B, M, 2, X_HEADS, X_DH)
    k = rms_norm(kv[:, :, 0], kn)
    v = kv[:, :, 1]
    logits = jnp.einsum('bshd,bmhd->bhsm', q, k).astype(jnp.float32) * (X_DH ** -0.5)
    p = jax.nn.softmax(logits, axis=-1)
    o = jnp.einsum('bhsm,bmhd->bshd', p.astype(v.dtype), v).reshape(B, S, X_HEADS * X_DH)
    return o @ w_co


def hierarchical_moe(h, w_rg, b_rg, w_re, b_re, w_gate, w_up, w_down):
    B, S, D = h.shape
    t = h.reshape(B * S, D)
    g_logits = (t @ w_rg + b_rg).astype(jnp.float32)
    g_prob = jax.nn.softmax(g_logits, axis=-1)
    g_sel = jnp.argmax(g_logits, axis=-1)
    g_w = jnp.take_along_axis(g_prob, g_sel[:, None], axis=1)[:, 0]
    e_logits = (t @ w_re + b_re).astype(jnp.float32).reshape(-1, N_GROUPS, EXPERTS_PER_GROUP)
    e_logits = jnp.take_along_axis(e_logits, g_sel[:, None, None], axis=1)[:, 0]
    top_w, top_i = lax.top_k(jax.nn.softmax(e_logits, axis=-1), TOPK_EXPERTS)
    top_w = top_w / jnp.sum(top_w, axis=-1, keepdims=True)
    expert_id = g_sel[:, None] * EXPERTS_PER_GROUP + top_i
    gates = jnp.einsum('tk,tke->te', top_w, jax.nn.one_hot(expert_id, N_EXPERTS, dtype=jnp.float32))
    gates = (gates * g_w[:, None]).astype(t.dtype)
    y = jnp.zeros_like(t)
    for e in range(N_EXPERTS):
        he = jax.nn.silu(t @ w_gate[e]) * (t @ w_up[e])
        y = y + gates[:, e:e + 1] * (he @ w_down[e])
    return y.reshape(B, S, D)


def setup_inputs(seed: int = 0) -> dict:
    key = jax.random.key(seed)
    keys = jax.random.split(key, 32)
    counter = [0]

    def nrm(shape, scale):
        k = keys[counter[0]]
        counter[0] += 1
        return scale * jax.random.normal(k, shape, jnp.float32)

    L = DEPTH
    return {
        "x": nrm((BATCH, SEQ, D_MODEL), 1.0),
        "mem": nrm((BATCH, MEM_LEN, D_MODEL), 1.0),
        "rel_bias": nrm((NUM_BUCKETS, DSA_HEADS), 0.2),
        "norm_mix": 1.0 + nrm((L, D_MODEL), 0.02),
        "w_in": nrm((L, D_MODEL, D_IN), D_MODEL ** -0.5),
        "gla_wa2": nrm((L, GLA_RANK, GLA_HEADS * GLA_DK), GLA_RANK ** -0.5),
        "gla_ba": nrm((L, GLA_HEADS * GLA_DK), 0.1),
        "gla_onorm": 1.0 + nrm((L, GLA_DV), 0.02),
        "dsa_qnorm": 1.0 + nrm((L, DSA_DH), 0.02),
        "dsa_knorm": 1.0 + nrm((L, DSA_DH), 0.02),
        "conv_w": nrm((L, CONV_WIDTH, CONV_CH), CONV_WIDTH ** -0.5),
        "conv_b": nrm((L, CONV_CH), 0.02),
        "conv_ln_g": 1.0 + nrm((L, CONV_CH), 0.02),
        "conv_ln_b": nrm((L, CONV_CH), 0.02),
        "w_out": nrm((L, D_MIX, D_MODEL), D_MIX ** -0.5),
        "norm_x": 1.0 + nrm((L, D_MODEL), 0.02),
        "norm_mem": 1.0 + nrm((L, D_MODEL), 0.02),
        "w_cq": nrm((L, D_MODEL, X_HEADS * X_DH), D_MODEL ** -0.5),
        "w_ckv": nrm((L, D_MODEL, 2 * X_HEADS * X_DH), D_MODEL ** -0.5),
        "x_qnorm": 1.0 + nrm((L, X_DH), 0.02),
        "x_knorm": 1.0 + nrm((L, X_DH), 0.02),
        "w_co": nrm((L, X_HEADS * X_DH, D_MODEL), (X_HEADS * X_DH) ** -0.5),
        "norm_ffn": 1.0 + nrm((L, D_MODEL), 0.02),
        "w_rg": nrm((L, D_MODEL, N_GROUPS), D_MODEL ** -0.5),
        "b_rg": nrm((L, N_GROUPS), 0.01),
        "w_re": nrm((L, D_MODEL, N_EXPERTS), D_MODEL ** -0.5),
        "b_re": nrm((L, N_EXPERTS), 0.01),
        "w_gate": nrm((L, N_EXPERTS, D_MODEL, D_EXPERT), D_MODEL ** -0.5),
        "w_up": nrm((L, N_EXPERTS, D_MODEL, D_EXPERT), D_MODEL ** -0.5),
        "w_down": nrm((L, N_EXPERTS, D_EXPERT, D_MODEL), D_EXPERT ** -0.5),
    }


def reference(x, mem, rel_bias, norm_mix, w_in, gla_wa2, gla_ba, gla_onorm, dsa_qnorm, dsa_knorm,
              conv_w, conv_b, conv_ln_g, conv_ln_b, w_out, norm_x, norm_mem, w_cq, w_ckv,
              x_qnorm, x_knorm, w_co, norm_ffn, w_rg, b_rg, w_re, b_re, w_gate, w_up, w_down):
    B, S, _ = x.shape
    topk = min(TOPK_MAX, S // 4)
    split_at = [int(o) for o in np.cumsum(IN_SIZES)[:-1]]
    for l in range(DEPTH):
        h = rms_norm(x, norm_mix[l])
        z = h @ w_in[l]
        (g_q, g_k, g_v, g_lr, g_r, d_q, d_k, d_v, i_q, i_k, i_w, c_u) = jnp.split(z, split_at, axis=-1)
        log_a = jax.nn.log_sigmoid((g_lr @ gla_wa2[l] + gla_ba[l]).astype(jnp.float32)) / GLA_TAU
        o_gla = gla_chunked(g_q.reshape(B, S, GLA_HEADS, GLA_DK), g_k.reshape(B, S, GLA_HEADS, GLA_DK),
                            g_v.reshape(B, S, GLA_HEADS, GLA_DV), log_a.reshape(B, S, GLA_HEADS, GLA_DK))
        o_gla = rms_norm(o_gla.astype(x.dtype), gla_onorm[l]) * jax.nn.silu(g_r.reshape(B, S, GLA_HEADS, GLA_DV))
        dq = rms_norm(d_q.reshape(B, S, DSA_HEADS, DSA_DH), dsa_qnorm[l])
        dk = rms_norm(d_k.reshape(B, S, DSA_HEADS, DSA_DH), dsa_knorm[l])
        o_dsa = dsa_attention(dq, dk, d_v.reshape(B, S, DSA_HEADS, DSA_DH),
                              i_q.reshape(B, S, IDX_HEADS, IDX_DIM), i_k, i_w * (IDX_HEADS ** -0.5),
                              rel_bias, topk)
        o_conv = conformer_conv(c_u, conv_w[l], conv_b[l], conv_ln_g[l], conv_ln_b[l])
        mix = jnp.concatenate([o_gla.reshape(B, S, GLA_WIDTH), o_dsa.reshape(B, S, DSA_WIDTH), o_conv], axis=-1)
        x = x + mix @ w_out[l]
        x = x + memory_cross_attention(rms_norm(x, norm_x[l]), rms_norm(mem, norm_mem[l]),
                                       w_cq[l], w_ckv[l], x_qnorm[l], x_knorm[l], w_co[l])
        x = x + hierarchical_moe(rms_norm(x, norm_ffn[l]), w_rg[l], b_rg[l], w_re[l], b_re[l],
                                 w_gate[l], w_up[l], w_down[l])
    return x
```

```cpp
#include <hip/hip_runtime.h>
#include <cstdio>
#include <cstdint>

constexpr int D_MODEL = 1024, BATCH = 4, SEQ = 4096, DEPTH = 2, T = BATCH * SEQ;
constexpr int MEM_LEN = 256;
constexpr int GLA_HEADS = 4, GLA_DK = 48, GLA_DV = 96, GLA_RANK = 16;
constexpr int DSA_HEADS = 6, DSA_DH = 64, IDX_HEADS = 8, IDX_DIM = 64, TOPK = 256;
constexpr int CONV_CH = 256, CONV_W = 31;
constexpr int NUM_BUCKETS = 32;
constexpr int X_HEADS = 4, X_DH = 64, XW = X_HEADS * X_DH;
constexpr int N_GROUPS = 4, EPG = 4, N_EXPERTS = 16, D_EXPERT = 512;
constexpr float NORM_EPS = 1e-6f;
constexpr int D_IN = 3416;
constexpr int Z_GQ = 0, Z_GK = 192, Z_GV = 384, Z_GLR = 768, Z_GR = 784, Z_DQ = 1168, Z_DK = 1552, Z_DV = 1936, Z_IQ = 2320, Z_IK = 2832, Z_IW = 2896, Z_CU = 2904;
constexpr int ZLD = D_IN;
constexpr int MIX_GLA = 0, MIX_DSA = 384, MIX_CONV = 768;
constexpr int PADR = 256;
constexpr int MAXROWS = 2 * T + N_EXPERTS * PADR;

typedef unsigned short bf16_t;
typedef float f32x4 __attribute__((ext_vector_type(4)));

constexpr size_t MiB = 1u << 20;
constexpr size_t WS_CTL = 0, CTL_BYTES = 1 * MiB;
constexpr size_t WS_XN = 1 * MiB;
constexpr size_t WS_Z = 33 * MiB;
constexpr size_t WS_HRAW = WS_Z, WS_HB = WS_Z + 73 * MiB;
constexpr size_t WS_MIX = 151 * MiB;
constexpr size_t WS_QN = 183 * MiB, WS_KN = 196 * MiB;
constexpr size_t WS_DB = WS_MIX;
constexpr size_t WS_CQ = 227 * MiB, WS_COIN = 235 * MiB;
constexpr size_t WS_MEMN = 243 * MiB;
constexpr size_t WS_CKV = 247 * MiB;
constexpr size_t WS_CKN = 249 * MiB;
constexpr size_t WS_ROUTE = 250 * MiB;
constexpr size_t WS_END = 252 * MiB;
constexpr int CW_CNT = 1024;

constexpr int NTHREADS = 512, NWAVES = 8;
constexpr int LDS_BYTES = 147456;

__device__ __forceinline__ float bf2f(bf16_t u) { return __uint_as_float(((unsigned)u) << 16); }
__device__ __forceinline__ bf16_t f2bf(float f) { unsigned u = __float_as_uint(f); return (bf16_t)((u + 0x7fffu + ((u >> 16) & 1u)) >> 16); }
__device__ __forceinline__ unsigned pk2(float lo, float hi) { return (unsigned)f2bf(lo) | ((unsigned)f2bf(hi) << 16); }
__device__ __forceinline__ float wave_sum(float v) {
#pragma unroll
    for (int o = 1; o < 64; o <<= 1) v += __shfl_xor(v, o);
    return v;
}
__device__ __forceinline__ float siluf(float x) { return x / (1.f + __expf(-x)); }
__device__ __forceinline__ float sigmoidf(float x) { return 1.f / (1.f + __expf(-x)); }

struct Args {
    const float* in[30];
    float* out;
    unsigned char* ws;
    int ph_lo, ph_hi;
};

template <class Epi>
__device__ __forceinline__ void gemm_tile_v1(float* lds, const bf16_t* A, int lda, const int* rowidx, int row0,
                                             const float* B, int ldb, int col0, int ncols, int K, const Epi& epi) {
    float* As = lds;
    float* Bs = lds + 16 * 132;
    const int tid = threadIdx.x, ty = tid >> 4, tx = tid & 15;
    float acc[4][8];
#pragma unroll
    for (int i = 0; i < 4; ++i)
#pragma unroll
        for (int j = 0; j < 8; ++j) acc[i][j] = 0.f;
    const int ar = tid >> 2, ak = (tid & 3) * 4;
    const int grow = rowidx ? rowidx[row0 + ar] : (row0 + ar);
    const bf16_t* ap = A + (size_t)(grow >= 0 ? grow : 0) * lda + ak;
    const bool aval = grow >= 0;
    const int bk = tid >> 5, bn = (tid & 31) * 4;
    const bool bval = bn < ncols;
    const float* bp = B + (size_t)bk * ldb + col0 + bn;
    for (int k0 = 0; k0 < K; k0 += 16) {
        uint2 av = make_uint2(0u, 0u);
        if (aval) av = *(const uint2*)(ap + k0);
        f32x4 bv = (f32x4){0.f, 0.f, 0.f, 0.f};
        if (bval) bv = *(const f32x4*)(bp + (size_t)k0 * ldb);
        __syncthreads();
        As[(ak + 0) * 132 + ar] = __uint_as_float(av.x << 16);
        As[(ak + 1) * 132 + ar] = __uint_as_float(av.x & 0xffff0000u);
        As[(ak + 2) * 132 + ar] = __uint_as_float(av.y << 16);
        As[(ak + 3) * 132 + ar] = __uint_as_float(av.y & 0xffff0000u);
        *(f32x4*)&Bs[bk * 132 + bn] = bv;
        __syncthreads();
#pragma unroll
        for (int k = 0; k < 16; ++k) {
            const f32x4 a4 = *(const f32x4*)&As[k * 132 + ty * 4];
            const f32x4 b0 = *(const f32x4*)&Bs[k * 132 + tx * 8];
            const f32x4 b1 = *(const f32x4*)&Bs[k * 132 + tx * 8 + 4];
#pragma unroll
            for (int i = 0; i < 4; ++i) {
                acc[i][0] += a4[i] * b0[0]; acc[i][1] += a4[i] * b0[1]; acc[i][2] += a4[i] * b0[2]; acc[i][3] += a4[i] * b0[3];
                acc[i][4] += a4[i] * b1[0]; acc[i][5] += a4[i] * b1[1]; acc[i][6] += a4[i] * b1[2]; acc[i][7] += a4[i] * b1[3];
            }
        }
    }
    __syncthreads();
#pragma unroll
    for (int i = 0; i < 4; ++i)
        epi(row0 + ty * 4 + i, col0 + tx * 8, (f32x4){acc[i][0], acc[i][1], acc[i][2], acc[i][3]}, (f32x4){acc[i][4], acc[i][5], acc[i][6], acc[i][7]});
}

template <class Epi>
__device__ __forceinline__ void gemm_v1(float* lds, const bf16_t* A, int lda, int M, const float* B, int ldb, int N, int K, const Epi& epi) {
    const int nct = (N + 127) / 128, nrt = M / 128;
    for (int tile = blockIdx.x; tile < nrt * nct; tile += gridDim.x) {
        const int rt = tile / nct, ct = tile % nct;
        const int nc = (N - ct * 128) < 128 ? (N - ct * 128) : 128;
        gemm_tile_v1(lds, A, lda, nullptr, rt * 128, B, ldb, ct * 128, nc, K, epi);
    }
}

__device__ __forceinline__ void rmsnorm_row_bf16(const float* xrow, const float* g, bf16_t* orow, int lane) {
    f32x4 v[4]; float s = 0.f;
#pragma unroll
    for (int j = 0; j < 4; ++j) { v[j] = *(const f32x4*)(xrow + lane * 4 + 256 * j); s += v[j][0] * v[j][0] + v[j][1] * v[j][1] + v[j][2] * v[j][2] + v[j][3] * v[j][3]; }
    const float rinv = 1.0f / sqrtf(wave_sum(s) * (1.f / 1024.f) + NORM_EPS);
#pragma unroll
    for (int j = 0; j < 4; ++j) {
        const f32x4 gg = *(const f32x4*)(g + lane * 4 + 256 * j);
        uint2 o; o.x = pk2(v[j][0] * rinv * gg[0], v[j][1] * rinv * gg[1]); o.y = pk2(v[j][2] * rinv * gg[2], v[j][3] * rinv * gg[3]);
        *(uint2*)(orow + lane * 4 + 256 * j) = o;
    }
}

__device__ __forceinline__ int t5_bucket(int dist) {
    if (dist < 16) return dist;
    const float d = (float)dist;
    int large = 16 + (int)(__logf(d * (1.f / 16.f)) * (16.0f / 2.0794415416798357f));
    return large < 31 ? large : 31;
}
__device__ __forceinline__ unsigned fkey(float f) { const unsigned u = __float_as_uint(f + 0.0f); return (u & 0x80000000u) ? ~u : (u | 0x80000000u); }

constexpr int NP = 15;

template <int KSEL>
__global__ void __launch_bounds__(NTHREADS, 2) mk_fwd(Args args) {
    extern __shared__ __attribute__((aligned(16))) unsigned char lds_raw[];
    float* ldsf = (float*)lds_raw;
    const int tid = threadIdx.x, lane = tid & 63, wave = tid >> 6;
    const int G = gridDim.x, bid = blockIdx.x;
    const int gw = bid * NWAVES + wave, NGW = G * NWAVES;
    unsigned char* ws = args.ws;
    unsigned* ctl = (unsigned*)(ws + WS_CTL);
    bf16_t* XN = (bf16_t*)(ws + WS_XN);
    bf16_t* Z = (bf16_t*)(ws + WS_Z);
    bf16_t* HRAW = (bf16_t*)(ws + WS_HRAW);
    bf16_t* HB = (bf16_t*)(ws + WS_HB);
    bf16_t* MIX = (bf16_t*)(ws + WS_MIX);
    bf16_t* DB = (bf16_t*)(ws + WS_DB);
    bf16_t* QN = (bf16_t*)(ws + WS_QN);
    bf16_t* KN = (bf16_t*)(ws + WS_KN);
    bf16_t* CQ = (bf16_t*)(ws + WS_CQ);
    bf16_t* COIN = (bf16_t*)(ws + WS_COIN);
    bf16_t* MEMN = (bf16_t*)(ws + WS_MEMN);
    bf16_t* CKV = (bf16_t*)(ws + WS_CKV);
    bf16_t* CKN = (bf16_t*)(ws + WS_CKN);
    int* tok_e = (int*)(ws + WS_ROUTE);
    int* tok_r = tok_e + 2 * T;
    float* tok_g = (float*)(tok_r + 2 * T);
    int* rowtok = (int*)(tok_g + 2 * T);
    float* OUT = args.out;

    for (int ph = args.ph_lo; ph < args.ph_hi; ++ph) {
        const int l = ph / NP, k = (KSEL >= 0) ? KSEL : (ph % NP);
        const float* xin = (l == 0) ? args.in[0] : OUT;
        unsigned* cnt = ctl + CW_CNT + 64 * l;

        if (k == 0) {
            const float* g = args.in[3] + l * D_MODEL;
            for (int r = gw; r < T; r += NGW) rmsnorm_row_bf16(xin + (size_t)r * D_MODEL, g, XN + (size_t)r * D_MODEL, lane);
            if (l == 0)
                for (int r = gw; r < 2 * BATCH * MEM_LEN; r += NGW) {
                    const int ll = r / (BATCH * MEM_LEN), rr = r % (BATCH * MEM_LEN);
                    rmsnorm_row_bf16(args.in[1] + (size_t)rr * D_MODEL, args.in[16] + ll * D_MODEL, MEMN + (size_t)r * D_MODEL, lane);
                }
        } else if (k == 1) {
            {
                auto epi = [&](int row, int col, f32x4 v0, f32x4 v1) {
                    bf16_t* p = Z + (size_t)row * ZLD + col;
                    if (col + 8 <= D_IN) { uint2 a, b; a.x = pk2(v0[0], v0[1]); a.y = pk2(v0[2], v0[3]); b.x = pk2(v1[0], v1[1]); b.y = pk2(v1[2], v1[3]); *(uint2*)p = a; *(uint2*)(p + 4) = b; }
                };
                gemm_v1(ldsf, XN, D_MODEL, T, args.in[4] + (size_t)l * D_MODEL * D_IN, D_IN, D_IN, D_MODEL, epi);
            }
            if (l == 0)
                for (int ll = 0; ll < DEPTH; ++ll) {
                    bf16_t* dst = CKV + (size_t)ll * BATCH * MEM_LEN * 512;
                    auto epi = [&](int row, int col, f32x4 v0, f32x4 v1) {
                        bf16_t* p = dst + (size_t)row * 512 + col;
                        uint2 a, b; a.x = pk2(v0[0], v0[1]); a.y = pk2(v0[2], v0[3]); b.x = pk2(v1[0], v1[1]); b.y = pk2(v1[2], v1[3]); *(uint2*)p = a; *(uint2*)(p + 4) = b;
                    };
                    gemm_v1(ldsf, MEMN + (size_t)ll * BATCH * MEM_LEN * D_MODEL, D_MODEL, BATCH * MEM_LEN, args.in[18] + (size_t)ll * D_MODEL * 512, 512, 512, D_MODEL, epi);
                }
        } else if (k == 2) {
            if (wave == 0 && bid < BATCH * GLA_HEADS) {
                const int b = bid / GLA_HEADS, h = bid % GLA_HEADS;
                float* sh = ldsf;
                float S0[GLA_DK], S1[GLA_DK];
#pragma unroll
                for (int d = 0; d < GLA_DK; ++d) { S0[d] = 0.f; S1[d] = 0.f; }
                const float* wa2 = args.in[5] + (size_t)l * GLA_RANK * 192;
                const float* ba = args.in[6] + l * 192;
                const float* gon = args.in[7] + l * GLA_DV;
                float wcol[GLA_RANK]; float bad = 0.f;
                if (lane < GLA_DK) {
#pragma unroll
                    for (int r = 0; r < GLA_RANK; ++r) wcol[r] = wa2[r * 192 + h * GLA_DK + lane];
                    bad = ba[h * GLA_DK + lane];
                } else {
#pragma unroll
                    for (int r = 0; r < GLA_RANK; ++r) wcol[r] = 0.f;
                }
                const float g0 = gon[lane], g1 = (lane < 32) ? gon[64 + lane] : 0.f;
                const float qscale = 0.14433756729740643f;
                for (int t = 0; t < SEQ; ++t) {
                    const bf16_t* zr = Z + (size_t)(b * SEQ + t) * ZLD;
                    if (lane < GLA_DK) {
                        float x = bad;
#pragma unroll
                        for (int r = 0; r < GLA_RANK; ++r) x += bf2f(zr[Z_GLR + r]) * wcol[r];
                        const float ls = fminf(x, 0.f) - log1pf(__expf(-fabsf(x)));
                        sh[lane] = __expf(ls * (1.f / 16.f));
                        sh[48 + lane] = bf2f(zr[Z_GQ + h * GLA_DK + lane]) * qscale;
                        sh[96 + lane] = bf2f(zr[Z_GK + h * GLA_DK + lane]);
                    }
                    const float v0 = bf2f(zr[Z_GV + h * GLA_DV + lane]);
                    const float v1 = (lane < 32) ? bf2f(zr[Z_GV + h * GLA_DV + 64 + lane]) : 0.f;
                    __builtin_amdgcn_s_waitcnt(0xc07f); __builtin_amdgcn_wave_barrier();
                    float o0 = 0.f, o1 = 0.f;
#pragma unroll
                    for (int d4 = 0; d4 < GLA_DK; d4 += 4) {
                        const f32x4 a = *(const f32x4*)&sh[d4], q = *(const f32x4*)&sh[48 + d4], kk = *(const f32x4*)&sh[96 + d4];
#pragma unroll
                        for (int j = 0; j < 4; ++j) {
                            S0[d4 + j] = a[j] * S0[d4 + j] + kk[j] * v0; o0 += q[j] * S0[d4 + j];
                            S1[d4 + j] = a[j] * S1[d4 + j] + kk[j] * v1; o1 += q[j] * S1[d4 + j];
                        }
                    }
                    __builtin_amdgcn_wave_barrier();
                    const float ss = wave_sum(o0 * o0 + ((lane < 32) ? o1 * o1 : 0.f));
                    const float rinv = 1.0f / sqrtf(ss * (1.f / 96.f) + NORM_EPS);
                    const float r0 = bf2f(zr[Z_GR + h * GLA_DV + lane]);
                    bf16_t* mo = MIX + (size_t)(b * SEQ + t) * D_MODEL + MIX_GLA + h * GLA_DV;
                    mo[lane] = f2bf(o0 * rinv * g0 * siluf(r0));
                    if (lane < 32) { const float r1 = bf2f(zr[Z_GR + h * GLA_DV + 64 + lane]); mo[64 + lane] = f2bf(o1 * rinv * g1 * siluf(r1)); }
                }
            }
            {
                const float* gq = args.in[8] + l * DSA_DH; const float* gk = args.in[9] + l * DSA_DH;
                const float gql = gq[lane], gkl = gk[lane];
                for (int r = gw; r < T; r += NGW) {
                    const bf16_t* zr = Z + (size_t)r * ZLD;
#pragma unroll
                    for (int h = 0; h < DSA_HEADS; ++h) {
                        const float q = bf2f(zr[Z_DQ + h * 64 + lane]), kk = bf2f(zr[Z_DK + h * 64 + lane]);
                        const float rq = 1.0f / sqrtf(wave_sum(q * q) * (1.f / 64.f) + NORM_EPS), rk = 1.0f / sqrtf(wave_sum(kk * kk) * (1.f / 64.f) + NORM_EPS);
                        QN[(size_t)r * 384 + h * 64 + lane] = f2bf(q * rq * gql * 0.125f);
                        KN[(size_t)r * 384 + h * 64 + lane] = f2bf(kk * rk * gkl);
                    }
                }
            }
            if (l == 0) {
                for (int r = gw; r < DEPTH * BATCH * MEM_LEN; r += NGW) {
                    const int ll = r / (BATCH * MEM_LEN);
                    const float gkl = args.in[20][ll * X_DH + lane];
#pragma unroll
                    for (int h = 0; h < X_HEADS; ++h) {
                        const float kk = bf2f(CKV[(size_t)r * 512 + h * 64 + lane]);
                        const float rk = 1.0f / sqrtf(wave_sum(kk * kk) * (1.f / 64.f) + NORM_EPS);
                        CKN[(size_t)r * 256 + h * 64 + lane] = f2bf(kk * rk * gkl);
                    }
                }
            }
            {
                const float* cw = args.in[10] + (size_t)l * CONV_W * CONV_CH;
                const float* cb = args.in[11] + l * CONV_CH; const float* lg = args.in[12] + l * CONV_CH; const float* lb = args.in[13] + l * CONV_CH;
                float* ct = ldsf + 1024;
                const int c = tid & 255, half = tid >> 8;
                float wreg[CONV_W];
#pragma unroll
                for (int j = 0; j < CONV_W; ++j) wreg[j] = cw[j * CONV_CH + c];
                const float cbias = cb[c];
                for (int item = bid; item < T / 32; item += G) {
                    const int tok0 = item * 32;
                    const int tb = tok0 % SEQ;
                    const int t0 = tb + half * 16;
                    float hwin[46];
#pragma unroll
                    for (int i = 0; i < 46; ++i) {
                        const int tp = t0 - 30 + i;
                        float hv = 0.f;
                        if (tp >= 0) { const bf16_t* zr = Z + (size_t)(tok0 - tb + tp) * ZLD + Z_CU; hv = bf2f(zr[c]) * sigmoidf(bf2f(zr[256 + c])); }
                        hwin[i] = hv;
                    }
                    __syncthreads();
#pragma unroll
                    for (int o = 0; o < 16; ++o) {
                        float a = cbias;
#pragma unroll
                        for (int j = 0; j < CONV_W; ++j) a += hwin[o + j] * wreg[j];
                        ct[(half * 16 + o) * 256 + c] = a;
                    }
                    __syncthreads();
#pragma unroll
                    for (int i = 0; i < 4; ++i) {
                        const int tt = wave * 4 + i;
                        const f32x4 v = *(const f32x4*)&ct[tt * 256 + lane * 4];
                        const float mu = wave_sum(v[0] + v[1] + v[2] + v[3]) * (1.f / 256.f);
                        const f32x4 dv = v - mu;
                        const float var = wave_sum(dv[0] * dv[0] + dv[1] * dv[1] + dv[2] * dv[2] + dv[3] * dv[3]) * (1.f / 256.f);
                        const float rstd = 1.0f / sqrtf(var + NORM_EPS);
                        const f32x4 gg = *(const f32x4*)(lg + lane * 4), bb = *(const f32x4*)(lb + lane * 4);
                        f32x4 y = dv * rstd * gg + bb;
                        uint2 o; o.x = pk2(siluf(y[0]), siluf(y[1])); o.y = pk2(siluf(y[2]), siluf(y[3]));
                        *(uint2*)(MIX + (size_t)(tok0 + tt) * D_MODEL + MIX_CONV + lane * 4) = o;
                    }
                }
            }
        } else if (k == 3) {
            float* sc = ldsf;
            float* qi = ldsf + 4096;
            float* wh = ldsf + 4608;
            unsigned* hist = (unsigned*)(ldsf + 4624);
            unsigned* misc = (unsigned*)(ldsf + 4880);
            int* sel = (int*)(ldsf + 4896);
            float* P = ldsf + 5152;
            float* lsum = ldsf + 6688;
            unsigned* wcnt = (unsigned*)(ldsf + 6696);
            const float* relb = args.in[2];
            for (int row = bid; row < T; row += G) {
                const int b = row / SEQ, t = row % SEQ, n = t + 1;
                const bf16_t* zr = Z + (size_t)row * ZLD;
                __syncthreads();
                qi[tid] = bf2f(zr[Z_IQ + tid]);
                if (tid < 8) wh[tid] = bf2f(zr[Z_IW + tid]) * 0.35355339059327373f;
                __syncthreads();
                for (int s = tid; s < n; s += NTHREADS) {
                    const bf16_t* kr = Z + (size_t)(b * SEQ + s) * ZLD + Z_IK;
                    float kv[64];
#pragma unroll
                    for (int j = 0; j < 8; ++j) { const uint4 u = *(const uint4*)(kr + j * 8);
                        kv[j * 8 + 0] = __uint_as_float(u.x << 16); kv[j * 8 + 1] = __uint_as_float(u.x & 0xffff0000u); kv[j * 8 + 2] = __uint_as_float(u.y << 16); kv[j * 8 + 3] = __uint_as_float(u.y & 0xffff0000u);
                        kv[j * 8 + 4] = __uint_as_float(u.z << 16); kv[j * 8 + 5] = __uint_as_float(u.z & 0xffff0000u); kv[j * 8 + 6] = __uint_as_float(u.w << 16); kv[j * 8 + 7] = __uint_as_float(u.w & 0xffff0000u); }
                    float score = 0.f;
#pragma unroll
                    for (int h = 0; h < 8; ++h) {
                        float dot = 0.f;
#pragma unroll
                        for (int d4 = 0; d4 < 64; d4 += 4) { const f32x4 q = *(const f32x4*)&qi[h * 64 + d4]; dot += q[0] * kv[d4] + q[1] * kv[d4 + 1] + q[2] * kv[d4 + 2] + q[3] * kv[d4 + 3]; }
                        score += wh[h] * fmaxf(dot * 0.125f, 0.f);
                    }
                    sc[s] = score;
                }
                __syncthreads();
                unsigned tau = 0u, krem = 0u, meq = 0u;
                if (n > TOPK) {
                    unsigned prefix = 0u; krem = TOPK;
                    for (int pass = 0; pass < 4; ++pass) {
                        const int shift = 24 - 8 * pass;
                        if (tid < 256) hist[tid] = 0u;
                        __syncthreads();
                        for (int s = tid; s < n; s += NTHREADS) {
                            const unsigned key = fkey(sc[s]);
                            if (pass == 0 || (key >> (shift + 8)) == prefix) atomicAdd(&hist[(key >> shift) & 255u], 1u);
                        }
                        __syncthreads();
                        if (tid == 0) {
                            unsigned cum = 0u; int bsel = 0;
                            for (int bb = 255; bb >= 0; --bb) { const unsigned hb = hist[bb]; if (cum + hb >= krem) { bsel = bb; break; } cum += hb; }
                            misc[0] = (prefix << 8) | (unsigned)bsel; misc[1] = krem - cum; misc[2] = hist[bsel];
                        }
                        __syncthreads();
                        prefix = misc[0]; krem = misc[1]; meq = misc[2];
                        __syncthreads();
                    }
                    tau = prefix;
                }
                unsigned flags = 0u; int myc = 0;
                const bool tie_order = (n > TOPK) && (meq > krem);
                if (tie_order) {
                    if (tid == 0) { unsigned left = krem; for (int s = 0; s < n; ++s) { if (fkey(sc[s]) == tau) { if (left > 0u) { --left; } else { sc[s] = -INFINITY; } } } }
                    __syncthreads();
                }
#pragma unroll
                for (int j = 0; j < 8; ++j) {
                    const int s = tid * 8 + j;
                    bool on = false;
                    if (s < n) on = (n <= TOPK) ? true : (fkey(sc[s]) >= tau);
                    if (on) { flags |= 1u << j; ++myc; }
                }
                int incl = myc;
#pragma unroll
                for (int o = 1; o < 64; o <<= 1) { const int v = __shfl_up(incl, o); if (lane >= o) incl += v; }
                if (lane == 63) wcnt[wave] = (unsigned)incl;
                __syncthreads();
                int base = 0;
                for (int w = 0; w < wave; ++w) base += (int)wcnt[w];
                int total = 0;
                for (int w = 0; w < NWAVES; ++w) total += (int)wcnt[w];
                int pos = base + incl - myc;
#pragma unroll
                for (int j = 0; j < 8; ++j) if (flags & (1u << j)) { if (pos < TOPK) sel[pos] = tid * 8 + j; ++pos; }
                __syncthreads();
                const int nsel = total < TOPK ? total : TOPK;
                for (int p = tid; p < nsel * DSA_HEADS; p += NTHREADS) {
                    const int j = p / DSA_HEADS, h = p % DSA_HEADS;
                    const int s = sel[j];
                    const bf16_t* qr = QN + (size_t)row * 384 + h * 64;
                    const bf16_t* kr = KN + (size_t)(b * SEQ + s) * 384 + h * 64;
                    float dot = 0.f;
#pragma unroll
                    for (int d8 = 0; d8 < 64; d8 += 8) {
                        const uint4 qa = *(const uint4*)(qr + d8), ka = *(const uint4*)(kr + d8);
                        dot += __uint_as_float(qa.x << 16) * __uint_as_float(ka.x << 16) + __uint_as_float(qa.x & 0xffff0000u) * __uint_as_float(ka.x & 0xffff0000u)
                             + __uint_as_float(qa.y << 16) * __uint_as_float(ka.y << 16) + __uint_as_float(qa.y & 0xffff0000u) * __uint_as_float(ka.y & 0xffff0000u)
                             + __uint_as_float(qa.z << 16) * __uint_as_float(ka.z << 16) + __uint_as_float(qa.z & 0xffff0000u) * __uint_as_float(ka.z & 0xffff0000u)
                             + __uint_as_float(qa.w << 16) * __uint_as_float(ka.w << 16) + __uint_as_float(qa.w & 0xffff0000u) * __uint_as_float(ka.w & 0xffff0000u);
                    }
                    const float logit = dot + relb[t5_bucket(t - s) * DSA_HEADS + h];
                    P[h * 256 + j] = __expf(logit);
                }
                __syncthreads();
                if (wave < DSA_HEADS) {
                    float s4 = 0.f;
                    for (int j = lane; j < nsel; j += 64) s4 += P[wave * 256 + j];
                    s4 = wave_sum(s4);
                    if (lane == 0) lsum[wave] = s4;
                }
                __syncthreads();
                if (tid < 384) {
                    const int h = tid >> 6;
                    float o = 0.f;
                    for (int j = 0; j < nsel; ++j) o += P[h * 256 + j] * bf2f(Z[(size_t)(b * SEQ + sel[j]) * ZLD + Z_DV + tid]);
                    MIX[(size_t)row * D_MODEL + MIX_DSA + tid] = f2bf(o / lsum[h]);
                }
            }
        } else if (k == 4) {
            auto epi = [&](int row, int col, f32x4 v0, f32x4 v1) {
                const float* xp = xin + (size_t)row * D_MODEL + col; float* op = OUT + (size_t)row * D_MODEL + col;
                const f32x4 a = *(const f32x4*)xp, b2 = *(const f32x4*)(xp + 4);
                *(f32x4*)op = a + v0; *(f32x4*)(op + 4) = b2 + v1;
            };
            gemm_v1(ldsf, MIX, D_MODEL, T, args.in[14] + (size_t)l * D_MODEL * D_MODEL, D_MODEL, D_MODEL, D_MODEL, epi);
        } else if (k == 5) {
            const float* g = args.in[15] + l * D_MODEL;
            for (int r = gw; r < T; r += NGW) rmsnorm_row_bf16(OUT + (size_t)r * D_MODEL, g, XN + (size_t)r * D_MODEL, lane);
            for (int i = bid * NTHREADS + tid; i < MAXROWS; i += G * NTHREADS) rowtok[i] = -1;
        } else if (k == 6) {
            auto epi = [&](int row, int col, f32x4 v0, f32x4 v1) {
                bf16_t* p = CQ + (size_t)row * XW + col;
                uint2 a, b; a.x = pk2(v0[0], v0[1]); a.y = pk2(v0[2], v0[3]); b.x = pk2(v1[0], v1[1]); b.y = pk2(v1[2], v1[3]); *(uint2*)p = a; *(uint2*)(p + 4) = b;
            };
            gemm_v1(ldsf, XN, D_MODEL, T, args.in[17] + (size_t)l * D_MODEL * XW, XW, XW, D_MODEL, epi);
        } else if (k == 7) {
            const float* gq = args.in[19] + l * X_DH;
            for (int item = gw; item < (T / 64) * X_HEADS; item += NGW) {
                const int tg = item / X_HEADS, h = item % X_HEADS;
                const int tok = tg * 64 + lane, b = (tg * 64) / SEQ;
                float q[64], o[64];
                const bf16_t* qr = CQ + (size_t)tok * XW + h * 64;
                float ss = 0.f;
#pragma unroll
                for (int d = 0; d < 64; ++d) { q[d] = bf2f(qr[d]); ss += q[d] * q[d]; o[d] = 0.f; }
                const float rq = 0.125f / sqrtf(ss * (1.f / 64.f) + NORM_EPS);
#pragma unroll
                for (int d = 0; d < 64; ++d) q[d] *= rq * gq[d];
                float lsm = 0.f;
                const bf16_t* kb = CKN + ((size_t)l * BATCH * MEM_LEN + (size_t)b * MEM_LEN) * 256 + h * 64;
                const bf16_t* vb = CKV + ((size_t)l * BATCH * MEM_LEN + (size_t)b * MEM_LEN) * 512 + 256 + h * 64;
                for (int m = 0; m < MEM_LEN; ++m) {
                    float dot = 0.f;
#pragma unroll
                    for (int d = 0; d < 64; ++d) dot += q[d] * bf2f(kb[(size_t)m * 256 + d]);
                    const float p = __expf(dot);
                    lsm += p;
#pragma unroll
                    for (int d = 0; d < 64; ++d) o[d] += p * bf2f(vb[(size_t)m * 512 + d]);
                }
                const float inv = 1.f / lsm;
                bf16_t* op = COIN + (size_t)tok * XW + h * 64;
#pragma unroll
                for (int d = 0; d < 64; d += 2) *(unsigned*)(op + d) = pk2(o[d] * inv, o[d + 1] * inv);
            }
        } else if (k == 8) {
            auto epi = [&](int row, int col, f32x4 v0, f32x4 v1) {
                float* op = OUT + (size_t)row * D_MODEL + col;
                const f32x4 a = *(const f32x4*)op, b2 = *(const f32x4*)(op + 4);
                *(f32x4*)op = a + v0; *(f32x4*)(op + 4) = b2 + v1;
            };
            gemm_v1(ldsf, COIN, XW, T, args.in[21] + (size_t)l * XW * D_MODEL, D_MODEL, D_MODEL, XW, epi);
        } else if (k == 9) {
            const float* g = args.in[22] + l * D_MODEL;
            const float* wrg = args.in[23] + (size_t)l * D_MODEL * N_GROUPS; const float* brg = args.in[24] + l * N_GROUPS;
            const float* wre = args.in[25] + (size_t)l * D_MODEL * N_EXPERTS; const float* bre = args.in[26] + l * N_EXPERTS;
            for (int r = gw; r < T; r += NGW) {
                const float* xrow = OUT + (size_t)r * D_MODEL;
                f32x4 v[4]; float s = 0.f;
#pragma unroll
                for (int j = 0; j < 4; ++j) { v[j] = *(const f32x4*)(xrow + lane * 4 + 256 * j); s += v[j][0] * v[j][0] + v[j][1] * v[j][1] + v[j][2] * v[j][2] + v[j][3] * v[j][3]; }
                const float rinv = 1.0f / sqrtf(wave_sum(s) * (1.f / 1024.f) + NORM_EPS);
                float acc[20];
#pragma unroll
                for (int j = 0; j < 20; ++j) acc[j] = 0.f;
#pragma unroll
                for (int j = 0; j < 4; ++j) {
                    const f32x4 gg = *(const f32x4*)(g + lane * 4 + 256 * j);
                    const f32x4 xn = v[j] * rinv * gg;
                    uint2 o; o.x = pk2(xn[0], xn[1]); o.y = pk2(xn[2], xn[3]);
                    *(uint2*)(XN + (size_t)r * D_MODEL + lane * 4 + 256 * j) = o;
#pragma unroll
                    for (int e = 0; e < 4; ++e) {
                        const int kk = lane * 4 + 256 * j + e;
                        const f32x4 wg = *(const f32x4*)(wrg + (size_t)kk * 4);
                        acc[0] += xn[e] * wg[0]; acc[1] += xn[e] * wg[1]; acc[2] += xn[e] * wg[2]; acc[3] += xn[e] * wg[3];
#pragma unroll
                        for (int q4 = 0; q4 < 4; ++q4) { const f32x4 we = *(const f32x4*)(wre + (size_t)kk * 16 + q4 * 4);
                            acc[4 + q4 * 4 + 0] += xn[e] * we[0]; acc[4 + q4 * 4 + 1] += xn[e] * we[1]; acc[4 + q4 * 4 + 2] += xn[e] * we[2]; acc[4 + q4 * 4 + 3] += xn[e] * we[3]; }
                    }
                }
#pragma unroll
                for (int j = 0; j < 20; ++j) acc[j] = wave_sum(acc[j]);
                if (lane == 0) {
                    float gl[4]; int gs = 0;
#pragma unroll
                    for (int j = 0; j < 4; ++j) gl[j] = acc[j] + brg[j];
                    float gmax = gl[0];
#pragma unroll
                    for (int j = 1; j < 4; ++j) if (gl[j] > gmax) { gmax = gl[j]; gs = j; }
                    float den = 0.f;
#pragma unroll
                    for (int j = 0; j < 4; ++j) den += __expf(gl[j] - gmax);
                    const float gwt = 1.f / den;
                    float el[4];
#pragma unroll
                    for (int j = 0; j < 4; ++j) { float vsel = 0.f;
#pragma unroll
                        for (int gg2 = 0; gg2 < 4; ++gg2) vsel = (gg2 == gs) ? (acc[4 + gg2 * 4 + j] + bre[gg2 * 4 + j]) : vsel;
                        el[j] = vsel; }
                    int i1 = 0; float e1v = el[0];
#pragma unroll
                    for (int j = 1; j < 4; ++j) if (el[j] > e1v) { e1v = el[j]; i1 = j; }
                    int i2 = -1; float e2v = -INFINITY;
#pragma unroll
                    for (int j = 0; j < 4; ++j) if (j != i1 && el[j] > e2v) { e2v = el[j]; i2 = j; }
                    const float e2 = __expf(e2v - e1v);
                    const float w1 = 1.f / (1.f + e2), w2 = e2 / (1.f + e2);
                    const int ex1 = gs * 4 + i1, ex2 = gs * 4 + i2;
                    tok_e[r * 2] = ex1; tok_e[r * 2 + 1] = ex2;
                    tok_g[r * 2] = w1 * gwt; tok_g[r * 2 + 1] = w2 * gwt;
                    tok_r[r * 2] = (int)atomicAdd(&cnt[ex1], 1u); tok_r[r * 2 + 1] = (int)atomicAdd(&cnt[ex2], 1u);
                }
            }
        } else if (k >= 10 && k <= 14) {
            int off[N_EXPERTS + 1];
            off[0] = 0;
#pragma unroll
            for (int e = 0; e < N_EXPERTS; ++e) { const int c = (int)__hip_atomic_load(&cnt[e], __ATOMIC_RELAXED, __HIP_MEMORY_SCOPE_AGENT); off[e + 1] = off[e] + ((c + PADR - 1) / PADR) * PADR; }
            const int total_rows = off[N_EXPERTS];
            if (k == 10) {
                for (int i = bid * NTHREADS + tid; i < 2 * T; i += G * NTHREADS) {
                    const int e = tok_e[i]; int o = 0;
#pragma unroll
                    for (int q = 0; q < N_EXPERTS; ++q) o = (q == e) ? off[q] : o;
                    rowtok[o + tok_r[i]] = i >> 1;
                }
            } else if (k == 11) {
                const int nrt = total_rows / 128;
                auto epi = [&](int row, int col, f32x4 v0, f32x4 v1) {
                    bf16_t* p = HRAW + (size_t)row * 1024 + col;
                    uint2 a, b; a.x = pk2(v0[0], v0[1]); a.y = pk2(v0[2], v0[3]); b.x = pk2(v1[0], v1[1]); b.y = pk2(v1[2], v1[3]); *(uint2*)p = a; *(uint2*)(p + 4) = b;
                };
                for (int tile = bid; tile < nrt * 8; tile += G) {
                    const int rt = tile / 8, ct = tile % 8; int e = 0;
#pragma unroll
                    for (int q = 1; q < N_EXPERTS; ++q) if (rt * 128 >= off[q]) e = q;
                    const float* Bw = (ct < 4 ? args.in[27] : args.in[28]) + ((size_t)l * N_EXPERTS + e) * D_MODEL * D_EXPERT;
                    const float* Bsh = Bw - (ct >= 4 ? 512 : 0);
                    gemm_tile_v1(ldsf, XN, D_MODEL, rowtok, rt * 128, Bsh, D_EXPERT, ct * 128, 128, D_MODEL, epi);
                }
            } else if (k == 12) {
                for (size_t i = (size_t)bid * NTHREADS + tid; i < (size_t)total_rows * 128; i += (size_t)G * NTHREADS) {
                    const size_t row = i / 128; const int c4 = (int)(i % 128) * 4;
                    const uint2 gv = *(const uint2*)(HRAW + row * 1024 + c4), uv = *(const uint2*)(HRAW + row * 1024 + 512 + c4);
                    const float g0 = __uint_as_float(gv.x << 16), g1 = __uint_as_float(gv.x & 0xffff0000u), g2 = __uint_as_float(gv.y << 16), g3 = __uint_as_float(gv.y & 0xffff0000u);
                    const float u0 = __uint_as_float(uv.x << 16), u1 = __uint_as_float(uv.x & 0xffff0000u), u2 = __uint_as_float(uv.y << 16), u3 = __uint_as_float(uv.y & 0xffff0000u);
                    uint2 o; o.x = pk2(siluf(g0) * u0, siluf(g1) * u1); o.y = pk2(siluf(g2) * u2, siluf(g3) * u3);
                    *(uint2*)(HB + row * 512 + c4) = o;
                }
            } else if (k == 13) {
                const int nrt = total_rows / 128;
                auto epi = [&](int row, int col, f32x4 v0, f32x4 v1) {
                    bf16_t* p = DB + (size_t)row * 1024 + col;
                    uint2 a, b; a.x = pk2(v0[0], v0[1]); a.y = pk2(v0[2], v0[3]); b.x = pk2(v1[0], v1[1]); b.y = pk2(v1[2], v1[3]); *(uint2*)p = a; *(uint2*)(p + 4) = b;
                };
                for (int tile = bid; tile < nrt * 8; tile += G) {
                    const int rt = tile / 8, ct = tile % 8; int e = 0;
#pragma unroll
                    for (int q = 1; q < N_EXPERTS; ++q) if (rt * 128 >= off[q]) e = q;
                    const float* Bw = args.in[29] + ((size_t)l * N_EXPERTS + e) * D_EXPERT * D_MODEL;
                    gemm_tile_v1(ldsf, HB, D_EXPERT, nullptr, rt * 128, Bw, D_MODEL, ct * 128, 128, D_EXPERT, epi);
                }
            } else {
                for (int r = gw; r < T; r += NGW) {
                    const int e0 = tok_e[r * 2], e1 = tok_e[r * 2 + 1]; int o0 = 0, o1 = 0;
#pragma unroll
                    for (int q = 0; q < N_EXPERTS; ++q) { o0 = (q == e0) ? off[q] : o0; o1 = (q == e1) ? off[q] : o1; }
                    const size_t r0 = (size_t)(o0 + tok_r[r * 2]), r1 = (size_t)(o1 + tok_r[r * 2 + 1]);
                    const float g0 = tok_g[r * 2], g1 = tok_g[r * 2 + 1];
#pragma unroll
                    for (int j = 0; j < 4; ++j) {
                        const int c = lane * 4 + 256 * j;
                        const uint2 a = *(const uint2*)(DB + r0 * 1024 + c), bq = *(const uint2*)(DB + r1 * 1024 + c);
                        f32x4 x = *(const f32x4*)(OUT + (size_t)r * D_MODEL + c);
                        x[0] += g0 * __uint_as_float(a.x << 16) + g1 * __uint_as_float(bq.x << 16);
                        x[1] += g0 * __uint_as_float(a.x & 0xffff0000u) + g1 * __uint_as_float(bq.x & 0xffff0000u);
                        x[2] += g0 * __uint_as_float(a.y << 16) + g1 * __uint_as_float(bq.y << 16);
                        x[3] += g0 * __uint_as_float(a.y & 0xffff0000u) + g1 * __uint_as_float(bq.y & 0xffff0000u);
                        *(f32x4*)(OUT + (size_t)r * D_MODEL + c) = x;
                    }
                }
            }
        }
    }
}

extern "C" void kernel_launch(void* const* d_in, const int* in_sizes, int n_in, void* d_out, int out_size, void* d_ws, size_t ws_size, hipStream_t stream) {
    static int grid = 0;
    if (grid == 0) {
        if (n_in != 30 || out_size != T * D_MODEL || ws_size < WS_END) { fprintf(stderr, "kernel_launch: unexpected sizes n_in %d out %d ws %zu (need %zu)\n", n_in, out_size, ws_size, (size_t)WS_END); grid = -1; return; }
        int dev = 0, cus = 0;
        if (hipGetDevice(&dev) != hipSuccess || hipDeviceGetAttribute(&cus, hipDeviceAttributeMultiprocessorCount, dev) != hipSuccess) { grid = -1; return; }
        bool okattr = true;
#define SETATTR(K) okattr = okattr && (hipFuncSetAttribute((const void*)mk_fwd<K>, hipFuncAttributeMaxDynamicSharedMemorySize, LDS_BYTES) == hipSuccess)
        SETATTR(0); SETATTR(1); SETATTR(2); SETATTR(3); SETATTR(4); SETATTR(5); SETATTR(6); SETATTR(7); SETATTR(8); SETATTR(9); SETATTR(10); SETATTR(11); SETATTR(12); SETATTR(13); SETATTR(14);
        if (!okattr) { fprintf(stderr, "kernel_launch: hipFuncSetAttribute failed\n"); grid = -1; return; }
        (void)hipGetLastError();
        grid = cus > 0 ? cus : 256;
    }
    if (grid < 0) return;
    (void)hipMemsetAsync((char*)d_ws + WS_CTL, 0, CTL_BYTES, stream);
    Args a{};
    for (int i = 0; i < 30; ++i) a.in[i] = (const float*)d_in[i];
    a.out = (float*)d_out; a.ws = (unsigned char*)d_ws;
    for (int ph = 0; ph < DEPTH * NP; ++ph) {
        a.ph_lo = ph; a.ph_hi = ph + 1;
        switch (ph % NP) {
#define LCASE(K) case K: hipLaunchKernelGGL(mk_fwd<K>, dim3(grid), dim3(NTHREADS), LDS_BYTES, stream, a); break
            LCASE(0); LCASE(1); LCASE(2); LCASE(3); LCASE(4); LCASE(5); LCASE(6); LCASE(7); LCASE(8); LCASE(9); LCASE(10); LCASE(11); LCASE(12); LCASE(13); LCASE(14);
        }
    }
}
```

```cpp
#include <hip/hip_runtime.h>
#include <cstdio>
#include <cstdint>

constexpr int D_MODEL = 1024, BATCH = 4, SEQ = 4096, DEPTH = 2, T = BATCH * SEQ;
constexpr int MEM_LEN = 256;
constexpr int GLA_HEADS = 4, GLA_DK = 48, GLA_DV = 96, GLA_RANK = 16;
constexpr int DSA_HEADS = 6, DSA_DH = 64, IDX_HEADS = 8, IDX_DIM = 64, TOPK = 256;
constexpr int CONV_CH = 256, CONV_W = 31;
constexpr int NUM_BUCKETS = 32;
constexpr int X_HEADS = 4, X_DH = 64, XW = X_HEADS * X_DH;
constexpr int N_GROUPS = 4, EPG = 4, N_EXPERTS = 16, D_EXPERT = 512;
constexpr float NORM_EPS = 1e-6f;
constexpr int D_IN = 3416;
constexpr int Z_GQ = 0, Z_GK = 192, Z_GV = 384, Z_GLR = 768, Z_GR = 784, Z_DQ = 1168, Z_DK = 1552, Z_DV = 1936, Z_IQ = 2320, Z_IK = 2832, Z_IW = 2896, Z_CU = 2904;
constexpr int ZLD = D_IN;
constexpr int MIX_GLA = 0, MIX_DSA = 384, MIX_CONV = 768;
constexpr int PADR = 256;
constexpr int MAXROWS = 2 * T + N_EXPERTS * PADR;

typedef unsigned short bf16_t;
typedef float f32x4 __attribute__((ext_vector_type(4)));

constexpr size_t MiB = 1u << 20;
constexpr size_t WS_CTL = 0, CTL_BYTES = 1 * MiB;
constexpr size_t WS_XN = 1 * MiB;
constexpr size_t WS_Z = 33 * MiB;
constexpr size_t WS_HRAW = WS_Z, WS_HB = WS_Z + 73 * MiB;
constexpr size_t WS_MIX = 151 * MiB;
constexpr size_t WS_QN = 183 * MiB, WS_KN = 196 * MiB;
constexpr size_t WS_DB = WS_MIX;
constexpr size_t WS_CQ = 227 * MiB, WS_COIN = 235 * MiB;
constexpr size_t WS_MEMN = 243 * MiB;
constexpr size_t WS_CKV = 247 * MiB;
constexpr size_t WS_CKN = 249 * MiB;
constexpr size_t WS_ROUTE = 250 * MiB;
constexpr size_t WS_END = 252 * MiB;
constexpr int CW_CNT = 1024;

constexpr int NTHREADS = 512, NWAVES = 8;
constexpr int LDS_BYTES = 147456;

__device__ __forceinline__ float bf2f(bf16_t u) { return __uint_as_float(((unsigned)u) << 16); }
__device__ __forceinline__ bf16_t f2bf(float f) { unsigned u = __float_as_uint(f); return (bf16_t)((u + 0x7fffu + ((u >> 16) & 1u)) >> 16); }
__device__ __forceinline__ unsigned pk2(float lo, float hi) { return (unsigned)f2bf(lo) | ((unsigned)f2bf(hi) << 16); }
__device__ __forceinline__ float wave_sum(float v) {
#pragma unroll
    for (int o = 1; o < 64; o <<= 1) v += __shfl_xor(v, o);
    return v;
}
__device__ __forceinline__ float siluf(float x) { return x / (1.f + __expf(-x)); }
__device__ __forceinline__ float sigmoidf(float x) { return 1.f / (1.f + __expf(-x)); }

struct Args {
    const float* in[30];
    float* out;
    unsigned char* ws;
    int ph_lo, ph_hi;
};

template <class Epi>
__device__ __forceinline__ void gemm_tile_v1(const int tid, float* lds, const bf16_t* A, int lda, const int* rowidx, int row0,
                                             const float* B, int ldb, int col0, int ncols, int K, const Epi& epi) {
    float* As = lds;
    float* Bs = lds + 16 * 132;
    const int ty = tid >> 4, tx = tid & 15;
    float acc[4][8];
#pragma unroll
    for (int i = 0; i < 4; ++i)
#pragma unroll
        for (int j = 0; j < 8; ++j) acc[i][j] = 0.f;
    const int ar = tid >> 2, ak = (tid & 3) * 4;
    const int grow = rowidx ? rowidx[row0 + ar] : (row0 + ar);
    const bf16_t* ap = A + (size_t)(grow >= 0 ? grow : 0) * lda + ak;
    const bool aval = grow >= 0;
    const int bk = tid >> 5, bn = (tid & 31) * 4;
    const bool bval = bn < ncols;
    const float* bp = B + (size_t)bk * ldb + col0 + bn;
    for (int k0 = 0; k0 < K; k0 += 16) {
        uint2 av = make_uint2(0u, 0u);
        if (aval) av = *(const uint2*)(ap + k0);
        f32x4 bv = (f32x4){0.f, 0.f, 0.f, 0.f};
        if (bval) bv = *(const f32x4*)(bp + (size_t)k0 * ldb);
        __syncthreads();
        As[(ak + 0) * 132 + ar] = __uint_as_float(av.x << 16);
        As[(ak + 1) * 132 + ar] = __uint_as_float(av.x & 0xffff0000u);
        As[(ak + 2) * 132 + ar] = __uint_as_float(av.y << 16);
        As[(ak + 3) * 132 + ar] = __uint_as_float(av.y & 0xffff0000u);
        *(f32x4*)&Bs[bk * 132 + bn] = bv;
        __syncthreads();
#pragma unroll
        for (int k = 0; k < 16; ++k) {
            const f32x4 a4 = *(const f32x4*)&As[k * 132 + ty * 4];
            const f32x4 b0 = *(const f32x4*)&Bs[k * 132 + tx * 8];
            const f32x4 b1 = *(const f32x4*)&Bs[k * 132 + tx * 8 + 4];
#pragma unroll
            for (int i = 0; i < 4; ++i) {
                acc[i][0] += a4[i] * b0[0]; acc[i][1] += a4[i] * b0[1]; acc[i][2] += a4[i] * b0[2]; acc[i][3] += a4[i] * b0[3];
                acc[i][4] += a4[i] * b1[0]; acc[i][5] += a4[i] * b1[1]; acc[i][6] += a4[i] * b1[2]; acc[i][7] += a4[i] * b1[3];
            }
        }
    }
    __syncthreads();
#pragma unroll
    for (int i = 0; i < 4; ++i)
        epi(row0 + ty * 4 + i, col0 + tx * 8, (f32x4){acc[i][0], acc[i][1], acc[i][2], acc[i][3]}, (f32x4){acc[i][4], acc[i][5], acc[i][6], acc[i][7]});
}

template <class Epi>
__device__ __forceinline__ void gemm_v1(const int tid, float* lds, const bf16_t* A, int lda, int M, const float* B, int ldb, int N, int K, const Epi& epi) {
    const int nct = (N + 127) / 128, nrt = M / 128;
    for (int tile = blockIdx.x; tile < nrt * nct; tile += gridDim.x) {
        const int rt = tile / nct, ct = tile % nct;
        const int nc = (N - ct * 128) < 128 ? (N - ct * 128) : 128;
        gemm_tile_v1(tid, lds, A, lda, nullptr, rt * 128, B, ldb, ct * 128, nc, K, epi);
    }
}

__device__ __forceinline__ void rmsnorm_row_bf16(const float* xrow, const float* g, bf16_t* orow, int lane) {
    f32x4 v[4]; float s = 0.f;
#pragma unroll
    for (int j = 0; j < 4; ++j) { v[j] = *(const f32x4*)(xrow + lane * 4 + 256 * j); s += v[j][0] * v[j][0] + v[j][1] * v[j][1] + v[j][2] * v[j][2] + v[j][3] * v[j][3]; }
    const float rinv = 1.0f / sqrtf(wave_sum(s) * (1.f / 1024.f) + NORM_EPS);
#pragma unroll
    for (int j = 0; j < 4; ++j) {
        const f32x4 gg = *(const f32x4*)(g + lane * 4 + 256 * j);
        uint2 o; o.x = pk2(v[j][0] * rinv * gg[0], v[j][1] * rinv * gg[1]); o.y = pk2(v[j][2] * rinv * gg[2], v[j][3] * rinv * gg[3]);
        *(uint2*)(orow + lane * 4 + 256 * j) = o;
    }
}

__device__ __forceinline__ int t5_bucket(int dist) {
    if (dist < 16) return dist;
    const float d = (float)dist;
    int large = 16 + (int)(__logf(d * (1.f / 16.f)) * (16.0f / 2.0794415416798357f));
    return large < 31 ? large : 31;
}
__device__ __forceinline__ unsigned fkey(float f) { const unsigned u = __float_as_uint(f + 0.0f); return (u & 0x80000000u) ? ~u : (u | 0x80000000u); }


#define LAS __attribute__((address_space(3)))
#define XB_TMO      128
#define XB_XCNT(j)  (256  + 64 * (j))
#define XB_XSUB(j)  (1280 + 64 * (j))
#define XB_XGEN(j)  (2304 + 64 * (j))
#define XB_TOP      3328
#define XB_TOPGEN   3392
#define XCD_BAR_WORDS 3456
#define XB_SPIN_CAP (1u << 24)
__device__ __forceinline__ unsigned xb_ld(unsigned* p)              { return __hip_atomic_load(p, __ATOMIC_RELAXED, __HIP_MEMORY_SCOPE_AGENT); }
__device__ __forceinline__ unsigned xb_add(unsigned* p, unsigned v) { return __hip_atomic_fetch_add(p, v, __ATOMIC_RELAXED, __HIP_MEMORY_SCOPE_AGENT); }
__device__ __forceinline__ unsigned xb_xcc_id() { return (unsigned)__builtin_amdgcn_s_getreg((3 << 11) | 20) & 0xFu; }
#define XB_SPIN(cond, bar) do { unsigned _sp = 0; while (cond) { __builtin_amdgcn_s_sleep(1); \
    if ((++_sp & 255u) == 0u) { if (xb_ld(&(bar)[XB_TMO])) break; if (_sp > XB_SPIN_CAP) { atomicAdd(&(bar)[XB_TMO], 1u); break; } } } } while (0)
struct XcdBarrier { unsigned* bar; unsigned x; volatile LAS unsigned* st; };
__device__ __forceinline__ XcdBarrier xcd_barrier_post(unsigned* bar, volatile LAS unsigned* st) {
    XcdBarrier b; b.bar = bar; b.x = xb_xcc_id(); b.st = st;
    if (threadIdx.x == 0) (void)xb_add(&bar[XB_XCNT(b.x)], 1u);
    return b;
}
__device__ __forceinline__ void xcd_barrier_complete(unsigned* bar, unsigned x, unsigned& nloc, unsigned& nx) {
    const unsigned G = gridDim.x * gridDim.y * gridDim.z;
    unsigned sum, cnt, mine, sp = 0u;
    for (;;) {
        sum = 0u; cnt = 0u; mine = 0u;
#pragma unroll
        for (unsigned j = 0; j < 16; ++j) { const unsigned c = xb_ld(&bar[XB_XCNT(j)]); sum += c; cnt += (c > 0u) ? 1u : 0u; mine = (j == x) ? c : mine; }
        if (sum == G) break;
        __builtin_amdgcn_s_sleep(1);
        if ((++sp & 255u) == 0u) { if (xb_ld(&bar[XB_TMO])) break; if (sp > XB_SPIN_CAP) { atomicAdd(&bar[XB_TMO], 1u); break; } }
    }
    nloc = mine > 0u ? mine : 1u; nx = cnt > 0u ? cnt : 1u;
}
__device__ __forceinline__ void xcd_barrier(const XcdBarrier& b) {
    asm volatile("s_waitcnt vmcnt(0)" ::: "memory");
    __syncthreads();
    if (threadIdx.x == 0) {
        unsigned* bar = b.bar;
        __builtin_amdgcn_s_waitcnt(0);
        unsigned nloc = b.st[0], nx = b.st[1];
        if (nloc == 0u) { xcd_barrier_complete(bar, b.x, nloc, nx); b.st[0] = nloc; b.st[1] = nx; }
        const unsigned old = xb_add(&bar[XB_XSUB(b.x)], 1u);
        const unsigned gen = old / nloc;
        if (old + 1u == (gen + 1u) * nloc) {
            __builtin_amdgcn_fence(__ATOMIC_RELEASE, "agent");
            asm volatile("s_waitcnt vmcnt(0)" ::: "memory");
            const unsigned og = xb_add(&bar[XB_TOP], 1u);
            const unsigned tg = og / nx;
            if (og + 1u == (tg + 1u) * nx) xb_add(&bar[XB_TOPGEN], 1u);
            else XB_SPIN(xb_ld(&bar[XB_TOPGEN]) == tg, bar);
            __builtin_amdgcn_fence(__ATOMIC_ACQUIRE, "agent");
            xb_add(&bar[XB_XGEN(b.x)], 1u);
            asm volatile("s_waitcnt vmcnt(0)" ::: "memory");
        } else {
            XB_SPIN(xb_ld(&bar[XB_XGEN(b.x)]) == gen, bar);
            __builtin_amdgcn_fence(__ATOMIC_ACQUIRE, "agent");
            asm volatile("s_waitcnt vmcnt(0)" ::: "memory");
        }
    }
    __syncthreads();
}
constexpr int CW_BAR = 4096;
constexpr int LDSCTL_OFF = LDS_BYTES - 256;

constexpr int NP = 15;
#ifndef MK_PHMASK
#define MK_PHMASK 0x7fff
#endif
#define PH_ON(x) (((MK_PHMASK) >> (x)) & 1)

template <int KSEL>
__global__ void __launch_bounds__(NTHREADS, 2) mk_fwd(Args args) {
    extern __shared__ __attribute__((aligned(16))) unsigned char lds_raw[];
    float* ldsf = (float*)lds_raw;
    const int G = gridDim.x, bid = blockIdx.x, NGW = G * NWAVES;
    unsigned char* ws = args.ws;
    unsigned* ctl = (unsigned*)(ws + WS_CTL);
    bf16_t* XN = (bf16_t*)(ws + WS_XN);
    bf16_t* Z = (bf16_t*)(ws + WS_Z);
    bf16_t* HRAW = (bf16_t*)(ws + WS_HRAW);
    bf16_t* HB = (bf16_t*)(ws + WS_HB);
    bf16_t* MIX = (bf16_t*)(ws + WS_MIX);
    bf16_t* DB = (bf16_t*)(ws + WS_DB);
    bf16_t* QN = (bf16_t*)(ws + WS_QN);
    bf16_t* KN = (bf16_t*)(ws + WS_KN);
    bf16_t* CQ = (bf16_t*)(ws + WS_CQ);
    bf16_t* COIN = (bf16_t*)(ws + WS_COIN);
    bf16_t* MEMN = (bf16_t*)(ws + WS_MEMN);
    bf16_t* CKV = (bf16_t*)(ws + WS_CKV);
    bf16_t* CKN = (bf16_t*)(ws + WS_CKN);
    int* tok_e = (int*)(ws + WS_ROUTE);
    int* tok_r = tok_e + 2 * T;
    float* tok_g = (float*)(tok_r + 2 * T);
    int* rowtok = (int*)(tok_g + 2 * T);
    float* OUT = args.out;
    XcdBarrier bar; bar.bar = ctl + CW_BAR; bar.x = 0; bar.st = nullptr;
    if (KSEL < 0) {
        volatile LAS unsigned* st = (volatile LAS unsigned*)((LAS unsigned char*)lds_raw + LDSCTL_OFF);
        if (threadIdx.x < 64) st[threadIdx.x] = 0u;
        __syncthreads();
        bar = xcd_barrier_post(ctl + CW_BAR, st);
    }

    for (int ph = args.ph_lo; ph < args.ph_hi; ++ph) {
        if (KSEL < 0 && ph > args.ph_lo) xcd_barrier(bar);
        int tid_op = threadIdx.x; asm volatile("" : "+v"(tid_op));
        const int tid = tid_op, lane = tid & 63, wave = __builtin_amdgcn_readfirstlane(tid >> 6), gw = bid * NWAVES + wave;
        const int l = ph / NP, k = (KSEL >= 0) ? KSEL : (ph % NP);
        const float* xin = (l == 0) ? args.in[0] : OUT;
        unsigned* cnt = ctl + CW_CNT + 64 * l;

        if (k == 0 && PH_ON(0)) {
            const float* g = args.in[3] + l * D_MODEL;
            for (int r = gw; r < T; r += NGW) rmsnorm_row_bf16(xin + (size_t)r * D_MODEL, g, XN + (size_t)r * D_MODEL, lane);
            if (l == 0)
                for (int r = gw; r < 2 * BATCH * MEM_LEN; r += NGW) {
                    const int ll = r / (BATCH * MEM_LEN), rr = r % (BATCH * MEM_LEN);
                    rmsnorm_row_bf16(args.in[1] + (size_t)rr * D_MODEL, args.in[16] + ll * D_MODEL, MEMN + (size_t)r * D_MODEL, lane);
                }
        } else if (k == 1 && PH_ON(1)) {
            {
                auto epi = [&](int row, int col, f32x4 v0, f32x4 v1) {
                    bf16_t* p = Z + (size_t)row * ZLD + col;
                    if (col + 8 <= D_IN) { uint2 a, b; a.x = pk2(v0[0], v0[1]); a.y = pk2(v0[2], v0[3]); b.x = pk2(v1[0], v1[1]); b.y = pk2(v1[2], v1[3]); *(uint2*)p = a; *(uint2*)(p + 4) = b; }
                };
                gemm_v1(tid, ldsf, XN, D_MODEL, T, args.in[4] + (size_t)l * D_MODEL * D_IN, D_IN, D_IN, D_MODEL, epi);
            }
            if (l == 0)
                for (int ll = 0; ll < DEPTH; ++ll) {
                    bf16_t* dst = CKV + (size_t)ll * BATCH * MEM_LEN * 512;
                    auto epi = [&](int row, int col, f32x4 v0, f32x4 v1) {
                        bf16_t* p = dst + (size_t)row * 512 + col;
                        uint2 a, b; a.x = pk2(v0[0], v0[1]); a.y = pk2(v0[2], v0[3]); b.x = pk2(v1[0], v1[1]); b.y = pk2(v1[2], v1[3]); *(uint2*)p = a; *(uint2*)(p + 4) = b;
                    };
                    gemm_v1(tid, ldsf, MEMN + (size_t)ll * BATCH * MEM_LEN * D_MODEL, D_MODEL, BATCH * MEM_LEN, args.in[18] + (size_t)ll * D_MODEL * 512, 512, 512, D_MODEL, epi);
                }
        } else if (k == 2 && PH_ON(2)) {
            if (wave == 0 && bid < BATCH * GLA_HEADS) {
                const int b = bid / GLA_HEADS, h = bid % GLA_HEADS;
                float* sh = ldsf;
                float S0[GLA_DK], S1[GLA_DK];
#pragma unroll
                for (int d = 0; d < GLA_DK; ++d) { S0[d] = 0.f; S1[d] = 0.f; }
                const float* wa2 = args.in[5] + (size_t)l * GLA_RANK * 192;
                const float* ba = args.in[6] + l * 192;
                const float* gon = args.in[7] + l * GLA_DV;
                float wcol[GLA_RANK]; float bad = 0.f;
                if (lane < GLA_DK) {
#pragma unroll
                    for (int r = 0; r < GLA_RANK; ++r) wcol[r] = wa2[r * 192 + h * GLA_DK + lane];
                    bad = ba[h * GLA_DK + lane];
                } else {
#pragma unroll
                    for (int r = 0; r < GLA_RANK; ++r) wcol[r] = 0.f;
                }
                const float g0 = gon[lane], g1 = (lane < 32) ? gon[64 + lane] : 0.f;
                const float qscale = 0.14433756729740643f;
                for (int t = 0; t < SEQ; ++t) {
                    const bf16_t* zr = Z + (size_t)(b * SEQ + t) * ZLD;
                    if (lane < GLA_DK) {
                        float x = bad;
#pragma unroll
                        for (int r = 0; r < GLA_RANK; ++r) x += bf2f(zr[Z_GLR + r]) * wcol[r];
                        const float ls = fminf(x, 0.f) - log1pf(__expf(-fabsf(x)));
                        sh[lane] = __expf(ls * (1.f / 16.f));
                        sh[48 + lane] = bf2f(zr[Z_GQ + h * GLA_DK + lane]) * qscale;
                        sh[96 + lane] = bf2f(zr[Z_GK + h * GLA_DK + lane]);
                    }
                    const float v0 = bf2f(zr[Z_GV + h * GLA_DV + lane]);
                    const float v1 = (lane < 32) ? bf2f(zr[Z_GV + h * GLA_DV + 64 + lane]) : 0.f;
                    __builtin_amdgcn_s_waitcnt(0xc07f); __builtin_amdgcn_wave_barrier();
                    float o0 = 0.f, o1 = 0.f;
#pragma unroll
                    for (int d4 = 0; d4 < GLA_DK; d4 += 4) {
                        const f32x4 a = *(const f32x4*)&sh[d4], q = *(const f32x4*)&sh[48 + d4], kk = *(const f32x4*)&sh[96 + d4];
#pragma unroll
                        for (int j = 0; j < 4; ++j) {
                            S0[d4 + j] = a[j] * S0[d4 + j] + kk[j] * v0; o0 += q[j] * S0[d4 + j];
                            S1[d4 + j] = a[j] * S1[d4 + j] + kk[j] * v1; o1 += q[j] * S1[d4 + j];
                        }
                    }
                    __builtin_amdgcn_wave_barrier();
                    const float ss = wave_sum(o0 * o0 + ((lane < 32) ? o1 * o1 : 0.f));
                    const float rinv = 1.0f / sqrtf(ss * (1.f / 96.f) + NORM_EPS);
                    const float r0 = bf2f(zr[Z_GR + h * GLA_DV + lane]);
                    bf16_t* mo = MIX + (size_t)(b * SEQ + t) * D_MODEL + MIX_GLA + h * GLA_DV;
                    mo[lane] = f2bf(o0 * rinv * g0 * siluf(r0));
                    if (lane < 32) { const float r1 = bf2f(zr[Z_GR + h * GLA_DV + 64 + lane]); mo[64 + lane] = f2bf(o1 * rinv * g1 * siluf(r1)); }
                }
            }
            {
                const float* gq = args.in[8] + l * DSA_DH; const float* gk = args.in[9] + l * DSA_DH;
                const float gql = gq[lane], gkl = gk[lane];
                for (int r = gw; r < T; r += NGW) {
                    const bf16_t* zr = Z + (size_t)r * ZLD;
#pragma unroll
                    for (int h = 0; h < DSA_HEADS; ++h) {
                        const float q = bf2f(zr[Z_DQ + h * 64 + lane]), kk = bf2f(zr[Z_DK + h * 64 + lane]);
                        const float rq = 1.0f / sqrtf(wave_sum(q * q) * (1.f / 64.f) + NORM_EPS), rk = 1.0f / sqrtf(wave_sum(kk * kk) * (1.f / 64.f) + NORM_EPS);
                        QN[(size_t)r * 384 + h * 64 + lane] = f2bf(q * rq * gql * 0.125f);
                        KN[(size_t)r * 384 + h * 64 + lane] = f2bf(kk * rk * gkl);
                    }
                }
            }
            if (l == 0) {
                for (int r = gw; r < DEPTH * BATCH * MEM_LEN; r += NGW) {
                    const int ll = r / (BATCH * MEM_LEN);
                    const float gkl = args.in[20][ll * X_DH + lane];
#pragma unroll
                    for (int h = 0; h < X_HEADS; ++h) {
                        const float kk = bf2f(CKV[(size_t)r * 512 + h * 64 + lane]);
                        const float rk = 1.0f / sqrtf(wave_sum(kk * kk) * (1.f / 64.f) + NORM_EPS);
                        CKN[(size_t)r * 256 + h * 64 + lane] = f2bf(kk * rk * gkl);
                    }
                }
            }
            {
                const float* cw = args.in[10] + (size_t)l * CONV_W * CONV_CH;
                const float* cb = args.in[11] + l * CONV_CH; const float* lg = args.in[12] + l * CONV_CH; const float* lb = args.in[13] + l * CONV_CH;
                float* ct = ldsf + 1024;
                const int c = tid & 255, half = tid >> 8;
                float wreg[CONV_W];
#pragma unroll
                for (int j = 0; j < CONV_W; ++j) wreg[j] = cw[j * CONV_CH + c];
                const float cbias = cb[c];
                for (int item = bid; item < T / 32; item += G) {
                    const int tok0 = item * 32;
                    const int tb = tok0 % SEQ;
                    const int t0 = tb + half * 16;
                    float hwin[46];
#pragma unroll
                    for (int i = 0; i < 46; ++i) {
                        const int tp = t0 - 30 + i;
                        float hv = 0.f;
                        if (tp >= 0) { const bf16_t* zr = Z + (size_t)(tok0 - tb + tp) * ZLD + Z_CU; hv = bf2f(zr[c]) * sigmoidf(bf2f(zr[256 + c])); }
                        hwin[i] = hv;
                    }
                    __syncthreads();
#pragma unroll
                    for (int o = 0; o < 16; ++o) {
                        float a = cbias;
#pragma unroll
                        for (int j = 0; j < CONV_W; ++j) a += hwin[o + j] * wreg[j];
                        ct[(half * 16 + o) * 256 + c] = a;
                    }
                    __syncthreads();
#pragma unroll
                    for (int i = 0; i < 4; ++i) {
                        const int tt = wave * 4 + i;
                        const f32x4 v = *(const f32x4*)&ct[tt * 256 + lane * 4];
                        const float mu = wave_sum(v[0] + v[1] + v[2] + v[3]) * (1.f / 256.f);
                        const f32x4 dv = v - mu;
                        const float var = wave_sum(dv[0] * dv[0] + dv[1] * dv[1] + dv[2] * dv[2] + dv[3] * dv[3]) * (1.f / 256.f);
                        const float rstd = 1.0f / sqrtf(var + NORM_EPS);
                        const f32x4 gg = *(const f32x4*)(lg + lane * 4), bb = *(const f32x4*)(lb + lane * 4);
                        f32x4 y = dv * rstd * gg + bb;
                        uint2 o; o.x = pk2(siluf(y[0]), siluf(y[1])); o.y = pk2(siluf(y[2]), siluf(y[3]));
                        *(uint2*)(MIX + (size_t)(tok0 + tt) * D_MODEL + MIX_CONV + lane * 4) = o;
                    }
                }
            }
        } else if (k == 3 && PH_ON(3)) {
            float* sc = ldsf;
            float* qi = ldsf + 4096;
            float* wh = ldsf + 4608;
            unsigned* hist = (unsigned*)(ldsf + 4624);
            unsigned* misc = (unsigned*)(ldsf + 4880);
            int* sel = (int*)(ldsf + 4896);
            float* P = ldsf + 5152;
            float* lsum = ldsf + 6688;
            unsigned* wcnt = (unsigned*)(ldsf + 6696);
            const float* relb = args.in[2];
            for (int row = bid; row < T; row += G) {
                const int b = row / SEQ, t = row % SEQ, n = t + 1;
                const bf16_t* zr = Z + (size_t)row * ZLD;
                __syncthreads();
                qi[tid] = bf2f(zr[Z_IQ + tid]);
                if (tid < 8) wh[tid] = bf2f(zr[Z_IW + tid]) * 0.35355339059327373f;
                __syncthreads();
                for (int s = tid; s < n; s += NTHREADS) {
                    const bf16_t* kr = Z + (size_t)(b * SEQ + s) * ZLD + Z_IK;
                    float kv[64];
#pragma unroll
                    for (int j = 0; j < 8; ++j) { const uint4 u = *(const uint4*)(kr + j * 8);
                        kv[j * 8 + 0] = __uint_as_float(u.x << 16); kv[j * 8 + 1] = __uint_as_float(u.x & 0xffff0000u); kv[j * 8 + 2] = __uint_as_float(u.y << 16); kv[j * 8 + 3] = __uint_as_float(u.y & 0xffff0000u);
                        kv[j * 8 + 4] = __uint_as_float(u.z << 16); kv[j * 8 + 5] = __uint_as_float(u.z & 0xffff0000u); kv[j * 8 + 6] = __uint_as_float(u.w << 16); kv[j * 8 + 7] = __uint_as_float(u.w & 0xffff0000u); }
                    float score = 0.f;
#pragma unroll 1
                    for (int h = 0; h < 8; ++h) {
                        float dot = 0.f;
#pragma unroll
                        for (int d4 = 0; d4 < 64; d4 += 4) { const f32x4 q = *(const f32x4*)&qi[h * 64 + d4]; dot += q[0] * kv[d4] + q[1] * kv[d4 + 1] + q[2] * kv[d4 + 2] + q[3] * kv[d4 + 3]; }
                        score += wh[h] * fmaxf(dot * 0.125f, 0.f);
                    }
                    sc[s] = score;
                }
                __syncthreads();
                unsigned tau = 0u, krem = 0u, meq = 0u;
                if (n > TOPK) {
                    unsigned prefix = 0u; krem = TOPK;
                    for (int pass = 0; pass < 4; ++pass) {
                        const int shift = 24 - 8 * pass;
                        if (tid < 256) hist[tid] = 0u;
                        __syncthreads();
                        for (int s = tid; s < n; s += NTHREADS) {
                            const unsigned key = fkey(sc[s]);
                            if (pass == 0 || (key >> (shift + 8)) == prefix) atomicAdd(&hist[(key >> shift) & 255u], 1u);
                        }
                        __syncthreads();
                        if (tid == 0) {
                            unsigned cum = 0u; int bsel = 0;
                            for (int bb = 255; bb >= 0; --bb) { const unsigned hb = hist[bb]; if (cum + hb >= krem) { bsel = bb; break; } cum += hb; }
                            misc[0] = (prefix << 8) | (unsigned)bsel; misc[1] = krem - cum; misc[2] = hist[bsel];
                        }
                        __syncthreads();
                        prefix = misc[0]; krem = misc[1]; meq = misc[2];
                        __syncthreads();
                    }
                    tau = prefix;
                }
                unsigned flags = 0u; int myc = 0;
                const bool tie_order = (n > TOPK) && (meq > krem);
                if (tie_order) {
                    if (tid == 0) { unsigned left = krem; for (int s = 0; s < n; ++s) { if (fkey(sc[s]) == tau) { if (left > 0u) { --left; } else { sc[s] = -INFINITY; } } } }
                    __syncthreads();
                }
#pragma unroll
                for (int j = 0; j < 8; ++j) {
                    const int s = tid * 8 + j;
                    bool on = false;
                    if (s < n) on = (n <= TOPK) ? true : (fkey(sc[s]) >= tau);
                    if (on) { flags |= 1u << j; ++myc; }
                }
                int incl = myc;
#pragma unroll
                for (int o = 1; o < 64; o <<= 1) { const int v = __shfl_up(incl, o); if (lane >= o) incl += v; }
                if (lane == 63) wcnt[wave] = (unsigned)incl;
                __syncthreads();
                int base = 0;
                for (int w = 0; w < wave; ++w) base += (int)wcnt[w];
                int total = 0;
                for (int w = 0; w < NWAVES; ++w) total += (int)wcnt[w];
                int pos = base + incl - myc;
#pragma unroll
                for (int j = 0; j < 8; ++j) if (flags & (1u << j)) { if (pos < TOPK) sel[pos] = tid * 8 + j; ++pos; }
                __syncthreads();
                const int nsel = total < TOPK ? total : TOPK;
                for (int p = tid; p < nsel * DSA_HEADS; p += NTHREADS) {
                    const int j = p / DSA_HEADS, h = p % DSA_HEADS;
                    const int s = sel[j];
                    const bf16_t* qr = QN + (size_t)row * 384 + h * 64;
                    const bf16_t* kr = KN + (size_t)(b * SEQ + s) * 384 + h * 64;
                    float dot = 0.f;
#pragma unroll
                    for (int d8 = 0; d8 < 64; d8 += 8) {
                        const uint4 qa = *(const uint4*)(qr + d8), ka = *(const uint4*)(kr + d8);
                        dot += __uint_as_float(qa.x << 16) * __uint_as_float(ka.x << 16) + __uint_as_float(qa.x & 0xffff0000u) * __uint_as_float(ka.x & 0xffff0000u)
                             + __uint_as_float(qa.y << 16) * __uint_as_float(ka.y << 16) + __uint_as_float(qa.y & 0xffff0000u) * __uint_as_float(ka.y & 0xffff0000u)
                             + __uint_as_float(qa.z << 16) * __uint_as_float(ka.z << 16) + __uint_as_float(qa.z & 0xffff0000u) * __uint_as_float(ka.z & 0xffff0000u)
                             + __uint_as_float(qa.w << 16) * __uint_as_float(ka.w << 16) + __uint_as_float(qa.w & 0xffff0000u) * __uint_as_float(ka.w & 0xffff0000u);
                    }
                    const float logit = dot + relb[t5_bucket(t - s) * DSA_HEADS + h];
                    P[h * 256 + j] = __expf(logit);
                }
                __syncthreads();
                if (wave < DSA_HEADS) {
                    float s4 = 0.f;
                    for (int j = lane; j < nsel; j += 64) s4 += P[wave * 256 + j];
                    s4 = wave_sum(s4);
                    if (lane == 0) lsum[wave] = s4;
                }
                __syncthreads();
                if (tid < 384) {
                    const int h = tid >> 6;
                    float o = 0.f;
                    for (int j = 0; j < nsel; ++j) o += P[h * 256 + j] * bf2f(Z[(size_t)(b * SEQ + sel[j]) * ZLD + Z_DV + tid]);
                    MIX[(size_t)row * D_MODEL + MIX_DSA + tid] = f2bf(o / lsum[h]);
                }
            }
        } else if (k == 4 && PH_ON(4)) {
            auto epi = [&](int row, int col, f32x4 v0, f32x4 v1) {
                const float* xp = xin + (size_t)row * D_MODEL + col; float* op = OUT + (size_t)row * D_MODEL + col;
                const f32x4 a = *(const f32x4*)xp, b2 = *(const f32x4*)(xp + 4);
                *(f32x4*)op = a + v0; *(f32x4*)(op + 4) = b2 + v1;
            };
            gemm_v1(tid, ldsf, MIX, D_MODEL, T, args.in[14] + (size_t)l * D_MODEL * D_MODEL, D_MODEL, D_MODEL, D_MODEL, epi);
        } else if (k == 5 && PH_ON(5)) {
            const float* g = args.in[15] + l * D_MODEL;
            for (int r = gw; r < T; r += NGW) rmsnorm_row_bf16(OUT + (size_t)r * D_MODEL, g, XN + (size_t)r * D_MODEL, lane);
            for (int i = bid * NTHREADS + tid; i < MAXROWS; i += G * NTHREADS) rowtok[i] = -1;
        } else if (k == 6 && PH_ON(6)) {
            auto epi = [&](int row, int col, f32x4 v0, f32x4 v1) {
                bf16_t* p = CQ + (size_t)row * XW + col;
                uint2 a, b; a.x = pk2(v0[0], v0[1]); a.y = pk2(v0[2], v0[3]); b.x = pk2(v1[0], v1[1]); b.y = pk2(v1[2], v1[3]); *(uint2*)p = a; *(uint2*)(p + 4) = b;
            };
            gemm_v1(tid, ldsf, XN, D_MODEL, T, args.in[17] + (size_t)l * D_MODEL * XW, XW, XW, D_MODEL, epi);
        } else if (k == 7 && PH_ON(7)) {
            const float* gq = args.in[19] + l * X_DH;
            for (int item = gw; item < (T / 64) * X_HEADS; item += NGW) {
                const int tg = item / X_HEADS, h = item % X_HEADS;
                const int tok = tg * 64 + lane, b = (tg * 64) / SEQ;
                float q[64], o[64];
                const bf16_t* qr = CQ + (size_t)tok * XW + h * 64;
                float ss = 0.f;
#pragma unroll
                for (int d = 0; d < 64; ++d) { q[d] = bf2f(qr[d]); ss += q[d] * q[d]; o[d] = 0.f; }
                const float rq = 0.125f / sqrtf(ss * (1.f / 64.f) + NORM_EPS);
#pragma unroll
                for (int d = 0; d < 64; ++d) q[d] *= rq * gq[d];
                float lsm = 0.f;
                const bf16_t* kb = CKN + ((size_t)l * BATCH * MEM_LEN + (size_t)b * MEM_LEN) * 256 + h * 64;
                const bf16_t* vb = CKV + ((size_t)l * BATCH * MEM_LEN + (size_t)b * MEM_LEN) * 512 + 256 + h * 64;
                for (int m = 0; m < MEM_LEN; ++m) {
                    float dot = 0.f;
#pragma unroll
                    for (int d = 0; d < 64; ++d) dot += q[d] * bf2f(kb[(size_t)m * 256 + d]);
                    const float p = __expf(dot);
                    lsm += p;
#pragma unroll
                    for (int d = 0; d < 64; ++d) o[d] += p * bf2f(vb[(size_t)m * 512 + d]);
                }
                const float inv = 1.f / lsm;
                bf16_t* op = COIN + (size_t)tok * XW + h * 64;
#pragma unroll
                for (int d = 0; d < 64; d += 2) *(unsigned*)(op + d) = pk2(o[d] * inv, o[d + 1] * inv);
            }
        } else if (k == 8 && PH_ON(8)) {
            auto epi = [&](int row, int col, f32x4 v0, f32x4 v1) {
                float* op = OUT + (size_t)row * D_MODEL + col;
                const f32x4 a = *(const f32x4*)op, b2 = *(const f32x4*)(op + 4);
                *(f32x4*)op = a + v0; *(f32x4*)(op + 4) = b2 + v1;
            };
            gemm_v1(tid, ldsf, COIN, XW, T, args.in[21] + (size_t)l * XW * D_MODEL, D_MODEL, D_MODEL, XW, epi);
        } else if (k == 9 && PH_ON(9)) {
            const float* g = args.in[22] + l * D_MODEL;
            const float* wrg = args.in[23] + (size_t)l * D_MODEL * N_GROUPS; const float* brg = args.in[24] + l * N_GROUPS;
            const float* wre = args.in[25] + (size_t)l * D_MODEL * N_EXPERTS; const float* bre = args.in[26] + l * N_EXPERTS;
            for (int r = gw; r < T; r += NGW) {
                const float* xrow = OUT + (size_t)r * D_MODEL;
                float s = 0.f;
#pragma unroll 4
                for (int i = 0; i < 16; ++i) { const float xv = xrow[lane + 64 * i]; s += xv * xv; }
                const float rinv = 1.0f / sqrtf(wave_sum(s) * (1.f / 1024.f) + NORM_EPS);
                float acc[20];
#pragma unroll
                for (int j = 0; j < 20; ++j) acc[j] = 0.f;
#pragma unroll 2
                for (int i = 0; i < 16; ++i) {
                    const int kk = lane + 64 * i;
                    const float xn = xrow[kk] * rinv * g[kk];
                    XN[(size_t)r * D_MODEL + kk] = f2bf(xn);
                    const f32x4 wg = *(const f32x4*)(wrg + (size_t)kk * 4);
                    acc[0] += xn * wg[0]; acc[1] += xn * wg[1]; acc[2] += xn * wg[2]; acc[3] += xn * wg[3];
#pragma unroll
                    for (int q4 = 0; q4 < 4; ++q4) { const f32x4 we = *(const f32x4*)(wre + (size_t)kk * 16 + q4 * 4);
                        acc[4 + q4 * 4 + 0] += xn * we[0]; acc[4 + q4 * 4 + 1] += xn * we[1]; acc[4 + q4 * 4 + 2] += xn * we[2]; acc[4 + q4 * 4 + 3] += xn * we[3]; }
                }
#pragma unroll
                for (int j = 0; j < 20; ++j) acc[j] = wave_sum(acc[j]);
                if (lane == 0) {
                    float gl[4]; int gs = 0;
#pragma unroll
                    for (int j = 0; j < 4; ++j) gl[j] = acc[j] + brg[j];
                    float gmax = gl[0];
#pragma unroll
                    for (int j = 1; j < 4; ++j) if (gl[j] > gmax) { gmax = gl[j]; gs = j; }
                    float den = 0.f;
#pragma unroll
                    for (int j = 0; j < 4; ++j) den += __expf(gl[j] - gmax);
                    const float gwt = 1.f / den;
                    float el[4];
#pragma unroll
                    for (int j = 0; j < 4; ++j) { float vsel = 0.f;
#pragma unroll
                        for (int gg2 = 0; gg2 < 4; ++gg2) vsel = (gg2 == gs) ? (acc[4 + gg2 * 4 + j] + bre[gg2 * 4 + j]) : vsel;
                        el[j] = vsel; }
                    int i1 = 0; float e1v = el[0];
#pragma unroll
                    for (int j = 1; j < 4; ++j) if (el[j] > e1v) { e1v = el[j]; i1 = j; }
                    int i2 = -1; float e2v = -INFINITY;
#pragma unroll
                    for (int j = 0; j < 4; ++j) if (j != i1 && el[j] > e2v) { e2v = el[j]; i2 = j; }
                    const float e2 = __expf(e2v - e1v);
                    const float w1 = 1.f / (1.f + e2), w2 = e2 / (1.f + e2);
                    const int ex1 = gs * 4 + i1, ex2 = gs * 4 + i2;
                    tok_e[r * 2] = ex1; tok_e[r * 2 + 1] = ex2;
                    tok_g[r * 2] = w1 * gwt; tok_g[r * 2 + 1] = w2 * gwt;
                    tok_r[r * 2] = (int)atomicAdd(&cnt[ex1], 1u); tok_r[r * 2 + 1] = (int)atomicAdd(&cnt[ex2], 1u);
                }
            }
        } else if (k >= 10 && k <= 14 && PH_ON(10)) {
            int off[N_EXPERTS + 1];
            off[0] = 0;
#pragma unroll
            for (int e = 0; e < N_EXPERTS; ++e) { const int c = (int)__hip_atomic_load(&cnt[e], __ATOMIC_RELAXED, __HIP_MEMORY_SCOPE_AGENT); off[e + 1] = off[e] + ((c + PADR - 1) / PADR) * PADR; }
            const int total_rows = off[N_EXPERTS];
            if (k == 10) {
                for (int i = bid * NTHREADS + tid; i < 2 * T; i += G * NTHREADS) {
                    const int e = tok_e[i]; int o = 0;
#pragma unroll
                    for (int q = 0; q < N_EXPERTS; ++q) o = (q == e) ? off[q] : o;
                    rowtok[o + tok_r[i]] = i >> 1;
                }
            } else if (k == 11) {
                const int nrt = total_rows / 128;
                auto epi = [&](int row, int col, f32x4 v0, f32x4 v1) {
                    bf16_t* p = HRAW + (size_t)row * 1024 + col;
                    uint2 a, b; a.x = pk2(v0[0], v0[1]); a.y = pk2(v0[2], v0[3]); b.x = pk2(v1[0], v1[1]); b.y = pk2(v1[2], v1[3]); *(uint2*)p = a; *(uint2*)(p + 4) = b;
                };
                for (int tile = bid; tile < nrt * 8; tile += G) {
                    const int rt = tile / 8, ct = tile % 8; int e = 0;
#pragma unroll
                    for (int q = 1; q < N_EXPERTS; ++q) if (rt * 128 >= off[q]) e = q;
                    const float* Bw = (ct < 4 ? args.in[27] : args.in[28]) + ((size_t)l * N_EXPERTS + e) * D_MODEL * D_EXPERT;
                    const float* Bsh = Bw - (ct >= 4 ? 512 : 0);
                    gemm_tile_v1(tid, ldsf, XN, D_MODEL, rowtok, rt * 128, Bsh, D_EXPERT, ct * 128, 128, D_MODEL, epi);
                }
            } else if (k == 12) {
                for (size_t i = (size_t)bid * NTHREADS + tid; i < (size_t)total_rows * 128; i += (size_t)G * NTHREADS) {
                    const size_t row = i / 128; const int c4 = (int)(i % 128) * 4;
                    const uint2 gv = *(const uint2*)(HRAW + row * 1024 + c4), uv = *(const uint2*)(HRAW + row * 1024 + 512 + c4);
                    const float g0 = __uint_as_float(gv.x << 16), g1 = __uint_as_float(gv.x & 0xffff0000u), g2 = __uint_as_float(gv.y << 16), g3 = __uint_as_float(gv.y & 0xffff0000u);
                    const float u0 = __uint_as_float(uv.x << 16), u1 = __uint_as_float(uv.x & 0xffff0000u), u2 = __uint_as_float(uv.y << 16), u3 = __uint_as_float(uv.y & 0xffff0000u);
                    uint2 o; o.x = pk2(siluf(g0) * u0, siluf(g1) * u1); o.y = pk2(siluf(g2) * u2, siluf(g3) * u3);
                    *(uint2*)(HB + row * 512 + c4) = o;
                }
            } else if (k == 13) {
                const int nrt = total_rows / 128;
                auto epi = [&](int row, int col, f32x4 v0, f32x4 v1) {
                    bf16_t* p = DB + (size_t)row * 1024 + col;
                    uint2 a, b; a.x = pk2(v0[0], v0[1]); a.y = pk2(v0[2], v0[3]); b.x = pk2(v1[0], v1[1]); b.y = pk2(v1[2], v1[3]); *(uint2*)p = a; *(uint2*)(p + 4) = b;
                };
                for (int tile = bid; tile < nrt * 8; tile += G) {
                    const int rt = tile / 8, ct = tile % 8; int e = 0;
#pragma unroll
                    for (int q = 1; q < N_EXPERTS; ++q) if (rt * 128 >= off[q]) e = q;
                    const float* Bw = args.in[29] + ((size_t)l * N_EXPERTS + e) * D_EXPERT * D_MODEL;
                    gemm_tile_v1(tid, ldsf, HB, D_EXPERT, nullptr, rt * 128, Bw, D_MODEL, ct * 128, 128, D_EXPERT, epi);
                }
            } else {
                for (int r = gw; r < T; r += NGW) {
                    const int e0 = tok_e[r * 2], e1 = tok_e[r * 2 + 1]; int o0 = 0, o1 = 0;
#pragma unroll
                    for (int q = 0; q < N_EXPERTS; ++q) { o0 = (q == e0) ? off[q] : o0; o1 = (q == e1) ? off[q] : o1; }
                    const size_t r0 = (size_t)(o0 + tok_r[r * 2]), r1 = (size_t)(o1 + tok_r[r * 2 + 1]);
                    const float g0 = tok_g[r * 2], g1 = tok_g[r * 2 + 1];
#pragma unroll
                    for (int j = 0; j < 4; ++j) {
                        const int c = lane * 4 + 256 * j;
                        const uint2 a = *(const uint2*)(DB + r0 * 1024 + c), bq = *(const uint2*)(DB + r1 * 1024 + c);
                        f32x4 x = *(const f32x4*)(OUT + (size_t)r * D_MODEL + c);
                        x[0] += g0 * __uint_as_float(a.x << 16) + g1 * __uint_as_float(bq.x << 16);
                        x[1] += g0 * __uint_as_float(a.x & 0xffff0000u) + g1 * __uint_as_float(bq.x & 0xffff0000u);
                        x[2] += g0 * __uint_as_float(a.y << 16) + g1 * __uint_as_float(bq.y << 16);
                        x[3] += g0 * __uint_as_float(a.y & 0xffff0000u) + g1 * __uint_as_float(bq.y & 0xffff0000u);
                        *(f32x4*)(OUT + (size_t)r * D_MODEL + c) = x;
                    }
                }
            }
        }
    }
}

#ifndef MK_SINGLE
#define MK_SINGLE 1
#endif
extern "C" void kernel_launch(void* const* d_in, const int* in_sizes, int n_in, void* d_out, int out_size, void* d_ws, size_t ws_size, hipStream_t stream) {
    static int grid = 0;
    if (grid == 0) {
        if (n_in != 30 || out_size != T * D_MODEL || ws_size < WS_END) { fprintf(stderr, "kernel_launch: unexpected sizes n_in %d out %d ws %zu (need %zu)\n", n_in, out_size, ws_size, (size_t)WS_END); grid = -1; return; }
        int dev = 0, cus = 0;
        if (hipGetDevice(&dev) != hipSuccess || hipDeviceGetAttribute(&cus, hipDeviceAttributeMultiprocessorCount, dev) != hipSuccess) { grid = -1; return; }
        bool okattr = true;
#define SETATTR(K) okattr = okattr && (hipFuncSetAttribute((const void*)mk_fwd<K>, hipFuncAttributeMaxDynamicSharedMemorySize, LDS_BYTES) == hipSuccess)
#if MK_SINGLE
        SETATTR(-1);
#else
        SETATTR(0); SETATTR(1); SETATTR(2); SETATTR(3); SETATTR(4); SETATTR(5); SETATTR(6); SETATTR(7); SETATTR(8); SETATTR(9); SETATTR(10); SETATTR(11); SETATTR(12); SETATTR(13); SETATTR(14);
#endif
        if (!okattr) { fprintf(stderr, "kernel_launch: hipFuncSetAttribute failed\n"); grid = -1; return; }
        (void)hipGetLastError();
        grid = cus > 0 ? cus : 256;
    }
    if (grid < 0) return;
    (void)hipMemsetAsync((char*)d_ws + WS_CTL, 0, CTL_BYTES, stream);
    Args a{};
    for (int i = 0; i < 30; ++i) a.in[i] = (const float*)d_in[i];
    a.out = (float*)d_out; a.ws = (unsigned char*)d_ws;
#if MK_SINGLE
    a.ph_lo = 0; a.ph_hi = DEPTH * NP;
    hipLaunchKernelGGL(mk_fwd<-1>, dim3(grid), dim3(NTHREADS), LDS_BYTES, stream, a);
#else
    for (int ph = 0; ph < DEPTH * NP; ++ph) {
        a.ph_lo = ph; a.ph_hi = ph + 1;
        switch (ph % NP) {
#define LCASE(K) case K: hipLaunchKernelGGL(mk_fwd<K>, dim3(grid), dim3(NTHREADS), LDS_BYTES, stream, a); break
            LCASE(0); LCASE(1); LCASE(2); LCASE(3); LCASE(4); LCASE(5); LCASE(6); LCASE(7); LCASE(8); LCASE(9); LCASE(10); LCASE(11); LCASE(12); LCASE(13); LCASE(14);
        }
    }
#endif
}
```

```cpp
#include <hip/hip_runtime.h>
#include <cstdio>
#include <cstdint>

constexpr int D_MODEL = 1024, BATCH = 4, SEQ = 4096, DEPTH = 2, T = BATCH * SEQ;
constexpr int MEM_LEN = 256;
constexpr int GLA_HEADS = 4, GLA_DK = 48, GLA_DV = 96, GLA_RANK = 16;
constexpr int DSA_HEADS = 6, DSA_DH = 64, IDX_HEADS = 8, IDX_DIM = 64, TOPK = 256;
constexpr int CONV_CH = 256, CONV_W = 31;
constexpr int NUM_BUCKETS = 32;
constexpr int X_HEADS = 4, X_DH = 64, XW = X_HEADS * X_DH;
constexpr int N_GROUPS = 4, EPG = 4, N_EXPERTS = 16, D_EXPERT = 512;
constexpr float NORM_EPS = 1e-6f;
constexpr int D_IN = 3416;
constexpr int Z_GQ = 0, Z_GK = 192, Z_GV = 384, Z_GLR = 768, Z_GR = 784, Z_DQ = 1168, Z_DK = 1552, Z_DV = 1936, Z_IQ = 2320, Z_IK = 2832, Z_IW = 2896, Z_CU = 2904;
constexpr int ZLD = 3584;
constexpr int MIX_GLA = 0, MIX_DSA = 384, MIX_CONV = 768;
constexpr int PADR = 256;
constexpr int MAXROWS = 2 * T + N_EXPERTS * PADR;

typedef unsigned short bf16_t;
typedef float f32x4 __attribute__((ext_vector_type(4)));

constexpr size_t MiB = 1u << 20;
constexpr size_t WS_CTL = 0, CTL_BYTES = 1 * MiB;
constexpr size_t WS_WIN = 1 * MiB, WS_WOUT = 15 * MiB, WS_WCQ = 19 * MiB, WS_WCKV = 20 * MiB, WS_WCO = 22 * MiB;
constexpr size_t WS_XN = 24 * MiB;
constexpr size_t WS_Z = 56 * MiB;
constexpr size_t WS_WGU = WS_Z, WS_WDN = WS_Z + 32 * MiB, WS_HB = WS_Z + 48 * MiB;
constexpr size_t WS_MIX = 168 * MiB;
constexpr size_t WS_QN = 200 * MiB, WS_KN = 212 * MiB;
constexpr size_t WS_VT = 224 * MiB;
constexpr size_t WS_MASK = 236 * MiB;
constexpr size_t WS_IK = 244 * MiB, WS_QL = 246 * MiB, WS_CH = 248 * MiB;
constexpr size_t WS_XG = WS_MIX, WS_DB = WS_MIX;
constexpr size_t WS_CQ = 252 * MiB, WS_COIN = 260 * MiB;
constexpr size_t WS_BCUM = 252 * MiB, WS_SLOC = 264 * MiB, WS_DEC = 282 * MiB;
constexpr size_t WS_MEMN = 284 * MiB;
constexpr size_t WS_CKV = 288 * MiB;
constexpr size_t WS_CKN = 290 * MiB;
constexpr size_t WS_ROUTE = 291 * MiB;
constexpr size_t WS_END = 293 * MiB;
constexpr int CW_CNT = 1024;
constexpr int CW_Q3 = 2048, CW_Q4 = 2304;

constexpr int NTHREADS = 512, NWAVES = 8;
constexpr int LDS_BYTES = 147456;

__device__ __forceinline__ float bf2f(bf16_t u) { return __uint_as_float(((unsigned)u) << 16); }
__device__ __forceinline__ bf16_t f2bf(float f) { unsigned u = __float_as_uint(f); return (bf16_t)((u + 0x7fffu + ((u >> 16) & 1u)) >> 16); }
__device__ __forceinline__ unsigned pk2(float lo, float hi) { return (unsigned)f2bf(lo) | ((unsigned)f2bf(hi) << 16); }
__device__ __forceinline__ float wave_sum(float v) {
#pragma unroll
    for (int o = 1; o < 64; o <<= 1) v += __shfl_xor(v, o);
    return v;
}
__device__ __forceinline__ float siluf(float x) { return x / (1.f + __expf(-x)); }
__device__ __forceinline__ float sigmoidf(float x) { return 1.f / (1.f + __expf(-x)); }


typedef short bf16x8 __attribute__((ext_vector_type(8)));
typedef float f32x16 __attribute__((ext_vector_type(16)));
typedef unsigned u32x4v __attribute__((ext_vector_type(4)));
typedef __bf16 bf16x2_t __attribute__((ext_vector_type(2)));
typedef float f32x2_t __attribute__((ext_vector_type(2)));
#define LDSAS __attribute__((address_space(3)))
#define MFMA32(a, b, c) __builtin_amdgcn_mfma_f32_32x32x16_bf16((a), (b), (c), 0, 0, 0)
__device__ __forceinline__ int crow(int reg, int hh) { return (reg & 3) + 8 * (reg >> 2) + 4 * hh; }
__device__ __forceinline__ unsigned pkbf(float a, float b) { f32x2_t v = {a, b}; bf16x2_t r = __builtin_convertvector(v, bf16x2_t); return __builtin_bit_cast(unsigned, r); }

struct Args {
    const float* in[30];
    float* out;
    unsigned char* ws;
    int ph_lo, ph_hi;
};

template <class Epi>
__device__ __forceinline__ void gemm_tile_v1(const int tid, float* lds, const bf16_t* A, int lda, const int* rowidx, int row0,
                                             const float* B, int ldb, int col0, int ncols, int K, const Epi& epi) {
    float* As = lds;
    float* Bs = lds + 16 * 132;
    const int ty = tid >> 4, tx = tid & 15;
    float acc[4][8];
#pragma unroll
    for (int i = 0; i < 4; ++i)
#pragma unroll
        for (int j = 0; j < 8; ++j) acc[i][j] = 0.f;
    const int ar = tid >> 2, ak = (tid & 3) * 4;
    const int grow = rowidx ? rowidx[row0 + ar] : (row0 + ar);
    const bf16_t* ap = A + (size_t)(grow >= 0 ? grow : 0) * lda + ak;
    const bool aval = grow >= 0;
    const int bk = tid >> 5, bn = (tid & 31) * 4;
    const bool bval = bn < ncols;
    const float* bp = B + (size_t)bk * ldb + col0 + bn;
    for (int k0 = 0; k0 < K; k0 += 16) {
        uint2 av = make_uint2(0u, 0u);
        if (aval) av = *(const uint2*)(ap + k0);
        f32x4 bv = (f32x4){0.f, 0.f, 0.f, 0.f};
        if (bval) bv = *(const f32x4*)(bp + (size_t)k0 * ldb);
        __syncthreads();
        As[(ak + 0) * 132 + ar] = __uint_as_float(av.x << 16);
        As[(ak + 1) * 132 + ar] = __uint_as_float(av.x & 0xffff0000u);
        As[(ak + 2) * 132 + ar] = __uint_as_float(av.y << 16);
        As[(ak + 3) * 132 + ar] = __uint_as_float(av.y & 0xffff0000u);
        *(f32x4*)&Bs[bk * 132 + bn] = bv;
        __syncthreads();
#pragma unroll
        for (int k = 0; k < 16; ++k) {
            const f32x4 a4 = *(const f32x4*)&As[k * 132 + ty * 4];
            const f32x4 b0 = *(const f32x4*)&Bs[k * 132 + tx * 8];
            const f32x4 b1 = *(const f32x4*)&Bs[k * 132 + tx * 8 + 4];
#pragma unroll
            for (int i = 0; i < 4; ++i) {
                acc[i][0] += a4[i] * b0[0]; acc[i][1] += a4[i] * b0[1]; acc[i][2] += a4[i] * b0[2]; acc[i][3] += a4[i] * b0[3];
                acc[i][4] += a4[i] * b1[0]; acc[i][5] += a4[i] * b1[1]; acc[i][6] += a4[i] * b1[2]; acc[i][7] += a4[i] * b1[3];
            }
        }
    }
    __syncthreads();
#pragma unroll
    for (int i = 0; i < 4; ++i)
        epi(row0 + ty * 4 + i, col0 + tx * 8, (f32x4){acc[i][0], acc[i][1], acc[i][2], acc[i][3]}, (f32x4){acc[i][4], acc[i][5], acc[i][6], acc[i][7]});
}

template <class Epi>
__device__ __forceinline__ void gemm_v1(const int tid, float* lds, const bf16_t* A, int lda, int M, const float* B, int ldb, int N, int K, const Epi& epi) {
    const int nct = (N + 127) / 128, nrt = M / 128;
    for (int tile = blockIdx.x; tile < nrt * nct; tile += gridDim.x) {
        const int rt = tile / nct, ct = tile % nct;
        const int nc = (N - ct * 128) < 128 ? (N - ct * 128) : 128;
        gemm_tile_v1(tid, lds, A, lda, nullptr, rt * 128, B, ldb, ct * 128, nc, K, epi);
    }
}

namespace pg8 {
#define PG8_LAS __attribute__((address_space(3)))
typedef PG8_LAS unsigned char* PG8_LAS_T;
typedef short bf16x8 __attribute__((ext_vector_type(8)));
typedef unsigned u32x4 __attribute__((ext_vector_type(4)));
constexpr int BM = 256, BK = 64, HALF = 128, HTB = HALF * BK * 2  , STAGE_BYTES = 8 * HTB, NXCD = 8, WGM = 8;

__host__ __device__ __forceinline__ int lds_byte(int r, int c) { const int st = (r >> 4) * 2 + (c >> 5), rr = r & 15, cc = c & 31, ob = rr * 64 + cc * 2; return st * 1024 + (ob ^ (((ob >> 9) & 1) << 5)); }
__host__ __device__ __forceinline__ void stage_rc(int b, int& R, int& C) { const int st = b / 1024, sb = b % 1024, swz = sb ^ (((sb >> 9) & 1) << 5); R = (st >> 1) * 16 + swz / 64; C = (st & 1) * 32 + (swz % 64) / 2; }
__host__ __device__ __forceinline__ int perm32(int rho) { const int n = rho >> 4, i = rho & 15; return 8 * (i >> 2) + 4 * n + (i & 3); }

struct Unit { int pm, pn; };
struct Gemm { const bf16_t* A; const bf16_t* Bt; int M, N, K; };

struct StaticOrder {
    int nM, nN, nwg, G, c;
    __host__ __device__ void init(int M, int N, int G_, int c_) { nM = M / BM; nN = N / BM; nwg = nM * nN; G = G_; c = c_; }
    __host__ __device__ bool next(int i, Unit& u) const {
        const long L = (long)i * G + c; if (L >= nwg) return false;
        int wgid = (int)L; { const int q = nwg / NXCD, r = nwg % NXCD, xcd = wgid % NXCD, off = wgid / NXCD; wgid = (xcd < r ? xcd * (q + 1) : r * (q + 1) + (xcd - r) * q) + off; }
        const int nig = WGM * nN, gid = wgid / nig, fm = gid * WGM, gsz = (nM - fm) < WGM ? (nM - fm) : WGM;
        u.pm = fm + ((wgid % nig) % gsz); u.pn = (wgid % nig) / gsz; return true;
    }
    __device__ __forceinline__ void a_ready(const Unit&) const {}
    __device__ __forceinline__ void done(const Unit&) const {}
};

__device__ __forceinline__ unsigned cvt_pk_bf16(float lo, float hi) { unsigned r; asm volatile("v_cvt_pk_bf16_f32 %0, %1, %2" : "=v"(r) : "v"(lo), "v"(hi)); return r; }
typedef float f32x2 __attribute__((ext_vector_type(2)));
template <class Epi, class Sched, bool ALIGN_EPI = false, bool SP2 = false>
__device__ __forceinline__ void gemm_phase(const int tid, PG8_LAS unsigned char* lds, const Gemm g, const Sched& S, const Epi& E) {
    const int wid = __builtin_amdgcn_readfirstlane(tid >> 6), lane = tid & 63, wr = wid >> 2, wc = wid & 3, fr = lane & 15, fq = lane >> 4;
    const int K = g.K, nt = K / BK;
    unsigned voffA[2], voffB[2];
#pragma unroll
    for (int i = 0; i < 2; ++i) { int R, C; stage_rc(tid * 16 + i * 8192, R, C); const int Rb = Epi::PERM ? ((R & ~31) + perm32(R & 31)) : R;
        voffA[i] = (unsigned)(R * K + C) * 2u; voffB[i] = (unsigned)(Rb * K + C) * 2u; }
    const size_t kstep = (size_t)(BK * 2);
    const size_t hstep = (size_t)HALF * K * 2;
    const size_t tstep = 2 * hstep;
    const unsigned ldsw = (unsigned)wid * 1024u;
    const int aoff = lds_byte(wr * 64 + fr, fq * 8), boff = lds_byte(wc * 32 + fr, fq * 8);
#define PG8_SA(b, h) (((b) * 2 + (h)) * HTB)
#define PG8_SB(b, h) ((4 + (b) * 2 + (h)) * HTB)
#define PG8_STAGE(bufoff, gbase, voff) do { _Pragma("unroll") for (int _i = 0; _i < 2; ++_i) \
        __builtin_amdgcn_global_load_lds((const unsigned*)((const char*)(gbase) + (voff)[_i]), (PG8_LAS unsigned*)(lds + (bufoff) + ldsw + _i * 8192), 16, 0, 0); } while (0)
#define PG8_LDA(dst, b, h) do { _Pragma("unroll") for (int m = 0; m < 4; ++m) _Pragma("unroll") for (int k = 0; k < 2; ++k) dst[m][k] = *(const PG8_LAS bf16x8*)(lds + PG8_SA(b, h) + aoff + m * 2048 + k * 1024); } while (0)
#define PG8_LDB(dst, b, h) do { _Pragma("unroll") for (int n = 0; n < 2; ++n) _Pragma("unroll") for (int k = 0; k < 2; ++k) dst[n][k] = *(const PG8_LAS bf16x8*)(lds + PG8_SB(b, h) + boff + n * 2048 + k * 1024); } while (0)
#define PG8_MMA(ai, bj, At, Bt) do { __builtin_amdgcn_s_setprio(1); _Pragma("unroll") for (int m = 0; m < 4; ++m) _Pragma("unroll") for (int n = 0; n < 2; ++n) _Pragma("unroll") for (int k = 0; k < 2; ++k) \
        acc[ai][bj][m][n] = __builtin_amdgcn_mfma_f32_16x16x32_bf16(Bt[n][k], At[m][k], acc[ai][bj][m][n], 0, 0, 0); __builtin_amdgcn_s_setprio(0); } while (0)
#define PG8_WAIT_V(n) asm volatile("s_waitcnt vmcnt(" #n ")" ::: "memory")
#define PG8_WAIT_L(n) asm volatile("s_waitcnt lgkmcnt(" #n ")" ::: "memory")
#define PG8_BAR __builtin_amdgcn_s_barrier()
#define PG8_SCHED __builtin_amdgcn_sched_barrier(0)
    Unit cur, nxt; int ui = 0;
    if (!S.next(0, cur)) return;
    f32x4 acc[2][2][4][2];
#pragma unroll
    for (int a = 0; a < 2; ++a)
#pragma unroll
        for (int b = 0; b < 2; ++b)
#pragma unroll
            for (int m = 0; m < 4; ++m)
#pragma unroll
                for (int n = 0; n < 2; ++n) acc[a][b][m][n] = (f32x4){0.f, 0.f, 0.f, 0.f};
    bf16x8 At[4][2], B0[2][2], B1[2][2];
    const char* cA = (const char*)g.A + (size_t)cur.pm * tstep; const char* cB = (const char*)g.Bt + (size_t)cur.pn * tstep;
    S.a_ready(cur);
    if constexpr (SP2) {
        PG8_STAGE(PG8_SB(0, 0), cB, voffB); PG8_STAGE(PG8_SB(0, 1), cB + hstep, voffB); PG8_STAGE(PG8_SA(0, 0), cA, voffA); PG8_STAGE(PG8_SA(0, 1), cA + hstep, voffA);
        if (wr == 1) PG8_BAR;
        PG8_WAIT_V(2); PG8_BAR;
        PG8_STAGE(PG8_SB(1, 0), cB + kstep, voffB); PG8_STAGE(PG8_SA(1, 0), cA + kstep, voffA); PG8_STAGE(PG8_SB(1, 1), cB + hstep + kstep, voffB);
        PG8_WAIT_V(6); PG8_BAR;
    } else {
        PG8_STAGE(PG8_SB(0, 0), cB, voffB); PG8_STAGE(PG8_SA(0, 0), cA, voffA); PG8_STAGE(PG8_SB(0, 1), cB + hstep, voffB); PG8_STAGE(PG8_SA(0, 1), cA + hstep, voffA);
        if (wr == 1) PG8_BAR;
        PG8_WAIT_V(4); PG8_BAR;
        PG8_STAGE(PG8_SB(1, 0), cB + kstep, voffB); PG8_STAGE(PG8_SA(1, 0), cA + kstep, voffA); PG8_STAGE(PG8_SB(1, 1), cB + hstep + kstep, voffB);
        PG8_WAIT_V(6); PG8_BAR;
    }
    for (;;) {
        const bool has_next = S.next(ui + 1, nxt);
        const char* nA = has_next ? (const char*)g.A + (size_t)nxt.pm * tstep : cA; const char* nB = has_next ? (const char*)g.Bt + (size_t)nxt.pn * tstep : cB;
        for (int t = 0; t < nt; t += 2) {
            const bool last = (t == nt - 2);
            const char* a1 = cA + (size_t)(t + 1) * kstep;
            const char* a2 = last ? nA : cA + (size_t)(t + 2) * kstep; const char* b2 = last ? nB : cB + (size_t)(t + 2) * kstep;
            const char* a3 = a2 + kstep; const char* b3 = b2 + kstep;
            if (last && has_next) S.a_ready(nxt);
            if constexpr (SP2) {
            PG8_LDB(B0, 0, 0); PG8_LDB(B1, 0, 1); PG8_SCHED; PG8_LDA(At, 0, 0); PG8_STAGE(PG8_SA(1, 1), a1 + hstep, voffA);
            PG8_WAIT_V(8); PG8_WAIT_L(0); PG8_BAR; PG8_MMA(0, 0, At, B0); PG8_MMA(0, 1, At, B1); PG8_BAR; PG8_SCHED;
            PG8_LDA(At, 0, 1); PG8_STAGE(PG8_SB(0, 0), b2, voffB); PG8_STAGE(PG8_SB(0, 1), b2 + hstep, voffB); PG8_STAGE(PG8_SA(0, 0), a2, voffA);
            PG8_WAIT_V(8); PG8_WAIT_L(0); PG8_BAR; PG8_MMA(1, 0, At, B0); PG8_MMA(1, 1, At, B1); PG8_BAR; PG8_SCHED;
            PG8_LDB(B0, 1, 0); PG8_LDB(B1, 1, 1); PG8_SCHED; PG8_LDA(At, 1, 0); PG8_STAGE(PG8_SA(0, 1), a2 + hstep, voffA);
            PG8_WAIT_V(8); PG8_WAIT_L(0); PG8_BAR; PG8_MMA(0, 0, At, B0); PG8_MMA(0, 1, At, B1); PG8_BAR; PG8_SCHED;
            PG8_LDA(At, 1, 1); PG8_STAGE(PG8_SB(1, 0), b3, voffB); PG8_STAGE(PG8_SB(1, 1), b3 + hstep, voffB); PG8_STAGE(PG8_SA(1, 0), a3, voffA);
            PG8_WAIT_V(8); PG8_WAIT_L(0); PG8_BAR; PG8_MMA(1, 0, At, B0); PG8_MMA(1, 1, At, B1); PG8_BAR; PG8_SCHED;
            } else {
            PG8_LDB(B0, 0, 0); PG8_SCHED; PG8_LDA(At, 0, 0); PG8_STAGE(PG8_SA(1, 1), a1 + hstep, voffA);
            PG8_WAIT_L(8); PG8_BAR; PG8_WAIT_L(0); PG8_MMA(0, 0, At, B0); PG8_BAR; PG8_SCHED;
            PG8_LDB(B1, 0, 1); PG8_STAGE(PG8_SB(0, 0), b2, voffB);
            PG8_BAR; PG8_WAIT_L(0); PG8_MMA(0, 1, At, B1); PG8_BAR;
            PG8_LDA(At, 0, 1); PG8_STAGE(PG8_SA(0, 0), a2, voffA);
            PG8_BAR; PG8_WAIT_L(0); PG8_MMA(1, 0, At, B0); PG8_BAR; PG8_SCHED;
            PG8_STAGE(PG8_SB(0, 1), b2 + hstep, voffB);
            PG8_WAIT_V(6); PG8_BAR; PG8_MMA(1, 1, At, B1); PG8_BAR;
            PG8_LDB(B0, 1, 0); PG8_SCHED; PG8_LDA(At, 1, 0); PG8_STAGE(PG8_SA(0, 1), a2 + hstep, voffA);
            PG8_WAIT_L(8); PG8_BAR; PG8_WAIT_L(0); PG8_MMA(0, 0, At, B0); PG8_BAR; PG8_SCHED;
            PG8_LDB(B1, 1, 1); PG8_STAGE(PG8_SB(1, 0), b3, voffB);
            PG8_BAR; PG8_WAIT_L(0); PG8_MMA(0, 1, At, B1); PG8_BAR;
            PG8_LDA(At, 1, 1); PG8_STAGE(PG8_SA(1, 0), a3, voffA);
            PG8_BAR; PG8_WAIT_L(0); PG8_MMA(1, 0, At, B0); PG8_BAR; PG8_SCHED;
            PG8_STAGE(PG8_SB(1, 1), b3 + hstep, voffB);
            PG8_WAIT_V(6); PG8_BAR; PG8_MMA(1, 1, At, B1); PG8_BAR;
            }
        }
        if constexpr (ALIGN_EPI) { if (wr == 0) PG8_BAR; }
        if constexpr (!Epi::AFTER_DRAIN) { E(acc, cur, wr, wc, fr, fq); S.done(cur); }
        if (!has_next) break;
#pragma unroll
        for (int a = 0; a < 2; ++a)
#pragma unroll
            for (int b = 0; b < 2; ++b)
#pragma unroll
                for (int m = 0; m < 4; ++m)
#pragma unroll
                    for (int n = 0; n < 2; ++n) acc[a][b][m][n] = (f32x4){0.f, 0.f, 0.f, 0.f};
        cur = nxt; cA = nA; cB = nB; ++ui;
        if constexpr (ALIGN_EPI) { if (wr == 1) PG8_BAR; }
    }
    PG8_WAIT_V(0);
    if constexpr (!ALIGN_EPI) { if (wr == 0) PG8_BAR; }
    PG8_BAR;
    if constexpr (Epi::AFTER_DRAIN) { E.fused(acc, cur, wr, wc, fr, fq, lds, wid, lane); S.done(cur); }
#undef PG8_SA
#undef PG8_SB
#undef PG8_STAGE
#undef PG8_LDA
#undef PG8_LDB
#undef PG8_MMA
#undef PG8_WAIT_V
#undef PG8_WAIT_L
#undef PG8_BAR
#undef PG8_SCHED
}

struct EpiStoreBf16 {
    static constexpr bool PERM = true, AFTER_DRAIN = false;
    bf16_t* O; int ldc; int pnmask;
    __device__ __forceinline__ void operator()(const f32x4 (&acc)[2][2][4][2], const Unit& u, int wr, int wc, int fr, int fq) const {
        const int row0 = u.pm * BM + wr * 64 + fr; const int col0 = (u.pn & pnmask) * BM + wc * 32 + 8 * fq;
#pragma unroll
        for (int ai = 0; ai < 2; ++ai)
#pragma unroll
            for (int m = 0; m < 4; ++m) { bf16_t* rowp = O + (size_t)(row0 + ai * HALF + m * 16) * ldc + col0;
#pragma unroll
                for (int bj = 0; bj < 2; ++bj) { const f32x4 v0 = acc[ai][bj][m][0], v1 = acc[ai][bj][m][1];
                    u32x4 w; w.x = cvt_pk_bf16(v0[0], v0[1]); w.y = cvt_pk_bf16(v0[2], v0[3]); w.z = cvt_pk_bf16(v1[0], v1[1]); w.w = cvt_pk_bf16(v1[2], v1[3]);
                    *(u32x4*)(rowp + bj * HALF) = w; } }
    }
};
struct EpiRes {
    static constexpr bool PERM = false, AFTER_DRAIN = false;
    const float* base; float* out; int ldc;
    __device__ __forceinline__ void operator()(const f32x4 (&acc)[2][2][4][2], const Unit& u, int wr, int wc, int fr, int fq) const {
        const int row0 = u.pm * BM + wr * 64 + fr; const int col0 = u.pn * BM + wc * 32 + 4 * fq;
#pragma unroll
        for (int ai = 0; ai < 2; ++ai)
#pragma unroll
            for (int m = 0; m < 4; ++m) { const size_t off = (size_t)(row0 + ai * HALF + m * 16) * ldc + col0;
#pragma unroll
                for (int bj = 0; bj < 2; ++bj)
#pragma unroll
                    for (int n = 0; n < 2; ++n) { const f32x4 b = *(const f32x4*)(base + off + bj * HALF + n * 16); *(f32x4*)(out + off + bj * HALF + n * 16) = b + acc[ai][bj][m][n]; } }
    }
};
struct EpiGateUp {
    static constexpr bool PERM = true, AFTER_DRAIN = false;
    bf16_t* O; int ldc;
    __device__ __forceinline__ static float silu(float x) { return x / (1.f + __expf(-x)); }
    __device__ __forceinline__ void operator()(const f32x4 (&acc)[2][2][4][2], const Unit& u, int wr, int wc, int fr, int fq) const {
        const int row0 = u.pm * BM + wr * 64 + fr; const int col0 = ((u.pn & 3) * BM + wc * 32 + 8 * fq) >> 1;
#pragma unroll
        for (int ai = 0; ai < 2; ++ai)
#pragma unroll
            for (int m = 0; m < 4; ++m) { bf16_t* rowp = O + (size_t)(row0 + ai * HALF + m * 16) * ldc + col0;
#pragma unroll
                for (int bj = 0; bj < 2; ++bj) { const f32x4 v0 = acc[ai][bj][m][0], v1 = acc[ai][bj][m][1];
                    uint2 w; w.x = cvt_pk_bf16(silu(v0[0]) * v0[1], silu(v0[2]) * v0[3]); w.y = cvt_pk_bf16(silu(v1[0]) * v1[1], silu(v1[2]) * v1[3]);
                    *(uint2*)(rowp + bj * (HALF / 2)) = w; } }
    }
};
struct GroupSched {
    int off[17]; int nunits, G, c;
    __device__ __forceinline__ bool next(int i, Unit& u) const {
        const int L = i * G + c; if (L >= nunits) return false;
        const int rt = L >> 2, pn = L & 3, row0 = rt * BM; int e = 0;
#pragma unroll
        for (int q = 1; q < 16; ++q) e = (row0 >= off[q]) ? q : e;
        u.pm = rt; u.pn = e * 4 + pn; return true;
    }
    __device__ __forceinline__ void a_ready(const Unit&) const {}
    __device__ __forceinline__ void done(const Unit&) const {}
};
}

__device__ __forceinline__ void rmsnorm_row_bf16(const float* xrow, const float* g, bf16_t* orow, int lane) {
    f32x4 v[4]; float s = 0.f;
#pragma unroll
    for (int j = 0; j < 4; ++j) { v[j] = *(const f32x4*)(xrow + lane * 4 + 256 * j); s += v[j][0] * v[j][0] + v[j][1] * v[j][1] + v[j][2] * v[j][2] + v[j][3] * v[j][3]; }
    const float rinv = 1.0f / sqrtf(wave_sum(s) * (1.f / 1024.f) + NORM_EPS);
#pragma unroll
    for (int j = 0; j < 4; ++j) {
        const f32x4 gg = *(const f32x4*)(g + lane * 4 + 256 * j);
        uint2 o; o.x = pk2(v[j][0] * rinv * gg[0], v[j][1] * rinv * gg[1]); o.y = pk2(v[j][2] * rinv * gg[2], v[j][3] * rinv * gg[3]);
        *(uint2*)(orow + lane * 4 + 256 * j) = o;
    }
}

__device__ __forceinline__ void transpose_item(const float* W, int K, int N, int nblk, bf16_t* WT, int row_off, int rmul, int radd, float* scr, int item, int lane) {
    const int kb = item / nblk, nb = item % nblk, k0 = 64 * kb, n0 = 32 * nb;
    const bool nv = (n0 + (lane & 31)) < N;
#pragma unroll 8
    for (int i = 0; i < 32; ++i) { const int kk = 2 * i + (lane >> 5); scr[kk * 33 + (lane & 31)] = nv ? W[(size_t)(k0 + kk) * N + n0 + (lane & 31)] : 0.f; }
    __builtin_amdgcn_s_waitcnt(0xc07f); __builtin_amdgcn_wave_barrier();
    const int c = lane & 7;
#pragma unroll
    for (int j = 0; j < 4; ++j) { const int n = (lane >> 3) + 8 * j; const float* sp = scr + (8 * c) * 33 + n;
        uint4 o; o.x = pk2(sp[0 * 33], sp[1 * 33]); o.y = pk2(sp[2 * 33], sp[3 * 33]); o.z = pk2(sp[4 * 33], sp[5 * 33]); o.w = pk2(sp[6 * 33], sp[7 * 33]);
        *(uint4*)(WT + (size_t)(row_off + (n0 + n) * rmul + radd) * K + k0 + 8 * c) = o; }
    __builtin_amdgcn_s_waitcnt(0xc07f); __builtin_amdgcn_wave_barrier();
}

__device__ __forceinline__ int t5_bucket(int dist) {
    if (dist < 16) return dist;
    const float d = (float)dist;
    int large = 16 + (int)(__logf(d * (1.f / 16.f)) * (16.0f / 2.0794415416798357f));
    return large < 31 ? large : 31;
}
__device__ __forceinline__ unsigned fkey(float f) { const unsigned u = __float_as_uint(f + 0.0f); return (u & 0x80000000u) ? ~u : (u | 0x80000000u); }


#define LAS __attribute__((address_space(3)))
#define XB_TMO      128
#define XB_XCNT(j)  (256  + 64 * (j))
#define XB_XSUB(j)  (1280 + 64 * (j))
#define XB_XGEN(j)  (2304 + 64 * (j))
#define XB_TOP      3328
#define XB_TOPGEN   3392
#define XCD_BAR_WORDS 3456
#define XB_SPIN_CAP (1u << 24)
__device__ __forceinline__ unsigned xb_ld(unsigned* p)              { return __hip_atomic_load(p, __ATOMIC_RELAXED, __HIP_MEMORY_SCOPE_AGENT); }
__device__ __forceinline__ unsigned xb_add(unsigned* p, unsigned v) { return __hip_atomic_fetch_add(p, v, __ATOMIC_RELAXED, __HIP_MEMORY_SCOPE_AGENT); }
__device__ __forceinline__ unsigned xb_xcc_id() { return (unsigned)__builtin_amdgcn_s_getreg((3 << 11) | 20) & 0xFu; }
#define XB_SPIN(cond, bar) do { unsigned _sp = 0; while (cond) { __builtin_amdgcn_s_sleep(1); \
    if ((++_sp & 255u) == 0u) { if (xb_ld(&(bar)[XB_TMO])) break; if (_sp > XB_SPIN_CAP) { atomicAdd(&(bar)[XB_TMO], 1u); break; } } } } while (0)
struct XcdBarrier { unsigned* bar; unsigned x; volatile LAS unsigned* st; };
__device__ __forceinline__ XcdBarrier xcd_barrier_post(unsigned* bar, volatile LAS unsigned* st) {
    XcdBarrier b; b.bar = bar; b.x = xb_xcc_id(); b.st = st;
    if (threadIdx.x == 0) (void)xb_add(&bar[XB_XCNT(b.x)], 1u);
    return b;
}
__device__ __forceinline__ void xcd_barrier_complete(unsigned* bar, unsigned x, unsigned& nloc, unsigned& nx) {
    const unsigned G = gridDim.x * gridDim.y * gridDim.z;
    unsigned sum, cnt, mine, sp = 0u;
    for (;;) {
        sum = 0u; cnt = 0u; mine = 0u;
#pragma unroll
        for (unsigned j = 0; j < 16; ++j) { const unsigned c = xb_ld(&bar[XB_XCNT(j)]); sum += c; cnt += (c > 0u) ? 1u : 0u; mine = (j == x) ? c : mine; }
        if (sum == G) break;
        __builtin_amdgcn_s_sleep(1);
        if ((++sp & 255u) == 0u) { if (xb_ld(&bar[XB_TMO])) break; if (sp > XB_SPIN_CAP) { atomicAdd(&bar[XB_TMO], 1u); break; } }
    }
    nloc = mine > 0u ? mine : 1u; nx = cnt > 0u ? cnt : 1u;
}
__device__ __forceinline__ void xcd_barrier(const XcdBarrier& b) {
    asm volatile("s_waitcnt vmcnt(0)" ::: "memory");
    __syncthreads();
    if (threadIdx.x == 0) {
        unsigned* bar = b.bar;
        __builtin_amdgcn_s_waitcnt(0);
        unsigned nloc = b.st[0], nx = b.st[1];
        if (nloc == 0u) { xcd_barrier_complete(bar, b.x, nloc, nx); b.st[0] = nloc; b.st[1] = nx; }
        const unsigned old = xb_add(&bar[XB_XSUB(b.x)], 1u);
        const unsigned gen = old / nloc;
        if (old + 1u == (gen + 1u) * nloc) {
            __builtin_amdgcn_fence(__ATOMIC_RELEASE, "agent");
            asm volatile("s_waitcnt vmcnt(0)" ::: "memory");
            const unsigned og = xb_add(&bar[XB_TOP], 1u);
            const unsigned tg = og / nx;
            if (og + 1u == (tg + 1u) * nx) xb_add(&bar[XB_TOPGEN], 1u);
            else XB_SPIN(xb_ld(&bar[XB_TOPGEN]) == tg, bar);
            __builtin_amdgcn_fence(__ATOMIC_ACQUIRE, "agent");
            xb_add(&bar[XB_XGEN(b.x)], 1u);
            asm volatile("s_waitcnt vmcnt(0)" ::: "memory");
        } else {
            XB_SPIN(xb_ld(&bar[XB_XGEN(b.x)]) == gen, bar);
            __builtin_amdgcn_fence(__ATOMIC_ACQUIRE, "agent");
            asm volatile("s_waitcnt vmcnt(0)" ::: "memory");
        }
    }
    __syncthreads();
}
constexpr int CW_BAR = 4096;
constexpr int LDSCTL_OFF = LDS_BYTES - 256;

constexpr int NP = 15;
#ifndef MK_PHMASK
#define MK_PHMASK 0x7fff
#endif
#define PH_ON(x) (((MK_PHMASK) >> (x)) & 1)

template <int KSEL>
__global__ void __launch_bounds__(NTHREADS, 2) mk_fwd(Args args) {
    extern __shared__ __attribute__((aligned(16))) unsigned char lds_raw[];
    float* ldsf = (float*)lds_raw;
    const int G = gridDim.x, bid = blockIdx.x, NGW = G * NWAVES;
    unsigned char* ws = args.ws;
    unsigned* ctl = (unsigned*)(ws + WS_CTL);
    bf16_t* XN = (bf16_t*)(ws + WS_XN);
    bf16_t* Z = (bf16_t*)(ws + WS_Z);
    bf16_t* XG = (bf16_t*)(ws + WS_XG);
    bf16_t* VT = (bf16_t*)(ws + WS_VT); unsigned* MASK = (unsigned*)(ws + WS_MASK); bf16_t* IK = (bf16_t*)(ws + WS_IK); bf16_t* QL = (bf16_t*)(ws + WS_QL); float* CH = (float*)(ws + WS_CH);
    float* BCUM = (float*)(ws + WS_BCUM); float* SLOC = (float*)(ws + WS_SLOC); float* DEC = (float*)(ws + WS_DEC);
    bf16_t* WIN = (bf16_t*)(ws + WS_WIN); bf16_t* WOUT = (bf16_t*)(ws + WS_WOUT); bf16_t* WCQ = (bf16_t*)(ws + WS_WCQ); bf16_t* WCKV = (bf16_t*)(ws + WS_WCKV); bf16_t* WCO = (bf16_t*)(ws + WS_WCO);
    bf16_t* WGU = (bf16_t*)(ws + WS_WGU); bf16_t* WDN = (bf16_t*)(ws + WS_WDN);
    pg8::PG8_LAS_T ldsq = (pg8::PG8_LAS_T)lds_raw;
    bf16_t* HB = (bf16_t*)(ws + WS_HB);
    bf16_t* MIX = (bf16_t*)(ws + WS_MIX);
    bf16_t* DB = (bf16_t*)(ws + WS_DB);
    bf16_t* QN = (bf16_t*)(ws + WS_QN);
    bf16_t* KN = (bf16_t*)(ws + WS_KN);
    bf16_t* CQ = (bf16_t*)(ws + WS_CQ);
    bf16_t* COIN = (bf16_t*)(ws + WS_COIN);
    bf16_t* MEMN = (bf16_t*)(ws + WS_MEMN);
    bf16_t* CKV = (bf16_t*)(ws + WS_CKV);
    bf16_t* CKN = (bf16_t*)(ws + WS_CKN);
    int* tok_e = (int*)(ws + WS_ROUTE);
    int* tok_r = tok_e + 2 * T;
    float* tok_g = (float*)(tok_r + 2 * T);
    float* OUT = args.out;
    XcdBarrier bar; bar.bar = ctl + CW_BAR; bar.x = 0; bar.st = nullptr;
    if (KSEL < 0) {
        volatile LAS unsigned* st = (volatile LAS unsigned*)((LAS unsigned char*)lds_raw + LDSCTL_OFF);
        if (threadIdx.x < 64) st[threadIdx.x] = 0u;
        __syncthreads();
        bar = xcd_barrier_post(ctl + CW_BAR, st);
    }

    for (int ph = args.ph_lo; ph < args.ph_hi; ++ph) {
        if (KSEL < 0 && ph > args.ph_lo) xcd_barrier(bar);
        int tid_op = threadIdx.x; asm volatile("" : "+v"(tid_op));
        const int tid = tid_op, lane = tid & 63, wave = __builtin_amdgcn_readfirstlane(tid >> 6), gw = bid * NWAVES + wave;
        const int l = ph / NP, k = (KSEL >= 0) ? KSEL : (ph % NP);
        const float* xin = (l == 0) ? args.in[0] : OUT;
        unsigned* cnt = ctl + CW_CNT + 64 * l;

        if (k == 0 && PH_ON(0)) {
            const float* g = args.in[3] + l * D_MODEL;
            for (int r = gw; r < T; r += NGW) rmsnorm_row_bf16(xin + (size_t)r * D_MODEL, g, XN + (size_t)r * D_MODEL, lane);
            if (l == 0) {
                float* scr = ldsf + wave * (64 * 33);
                constexpr int I_IN = 16 * 112, I_OUT = 16 * 32, I_CQ = 16 * 8, I_CKV = 16 * 16, I_CO = 4 * 32, I_L = I_IN + I_OUT + I_CQ + I_CKV + I_CO;
                for (int it = gw; it < DEPTH * I_L; it += NGW) {
                    const int ll = it / I_L; int r = it % I_L;
                    if (r < I_IN) { transpose_item(args.in[4] + (size_t)ll * D_MODEL * D_IN, D_MODEL, D_IN, 112, WIN + (size_t)ll * ZLD * D_MODEL, 0, 1, 0, scr, r, lane); continue; } r -= I_IN;
                    if (r < I_OUT) { transpose_item(args.in[14] + (size_t)ll * D_MODEL * D_MODEL, D_MODEL, D_MODEL, 32, WOUT + (size_t)ll * D_MODEL * D_MODEL, 0, 1, 0, scr, r, lane); continue; } r -= I_OUT;
                    if (r < I_CQ) { transpose_item(args.in[17] + (size_t)ll * D_MODEL * XW, D_MODEL, XW, 8, WCQ + (size_t)ll * XW * D_MODEL, 0, 1, 0, scr, r, lane); continue; } r -= I_CQ;
                    if (r < I_CKV) { transpose_item(args.in[18] + (size_t)ll * D_MODEL * 512, D_MODEL, 512, 16, WCKV + (size_t)ll * 512 * D_MODEL, 0, 1, 0, scr, r, lane); continue; } r -= I_CKV;
                    transpose_item(args.in[21] + (size_t)ll * XW * D_MODEL, XW, D_MODEL, 32, WCO + (size_t)ll * D_MODEL * XW, 0, 1, 0, scr, r, lane);
                }
            }
            if (l == 0)
                for (int r = gw; r < 2 * BATCH * MEM_LEN; r += NGW) {
                    const int ll = r / (BATCH * MEM_LEN), rr = r % (BATCH * MEM_LEN);
                    rmsnorm_row_bf16(args.in[1] + (size_t)rr * D_MODEL, args.in[16] + ll * D_MODEL, MEMN + (size_t)r * D_MODEL, lane);
                }
        } else if (k == 1 && PH_ON(1)) {
            {
                pg8::Gemm g{XN, WIN + (size_t)l * ZLD * D_MODEL, T, ZLD, D_MODEL}; pg8::StaticOrder S; S.init(T, ZLD, G, bid);
                pg8::EpiStoreBf16 E{Z, ZLD, 0xffff};
                pg8::gemm_phase<pg8::EpiStoreBf16, pg8::StaticOrder, true, true>(tid, ldsq, g, S, E);
            }
            if (l == 0)
                for (int ll = 0; ll < DEPTH; ++ll) {
                    pg8::Gemm g{MEMN + (size_t)ll * BATCH * MEM_LEN * D_MODEL, WCKV + (size_t)ll * 512 * D_MODEL, BATCH * MEM_LEN, 512, D_MODEL}; pg8::StaticOrder S; S.init(BATCH * MEM_LEN, 512, G, bid);
                    pg8::EpiStoreBf16 E{CKV + (size_t)ll * BATCH * MEM_LEN * 512, 512, 0xffff};
                    pg8::gemm_phase<pg8::EpiStoreBf16, pg8::StaticOrder, true, true>(tid, ldsq, g, S, E);
                }
        } else if (k == 2 && PH_ON(2)) {
            {
                float* lr = ldsf;
                float* la = ldsf + 1024;
                float* ks = la + 64 * 49;
                float* vs = ks + 64 * 49;
                float* seg = vs + 64 * 97;
                const float* wa2 = args.in[5] + (size_t)l * GLA_RANK * 192;
                const float* ba = args.in[6] + l * 192;
                for (int item = bid; item < BATCH * GLA_HEADS * 64; item += G) {
                    const int bh = item >> 6, c = item & 63, b = bh >> 2, h = bh & 3, tok0 = b * SEQ + c * 64;
                    __syncthreads();
                    for (int i = tid; i < 64 * 16; i += NTHREADS) lr[i] = bf2f(Z[(size_t)(tok0 + (i >> 4)) * ZLD + Z_GLR + (i & 15)]);
                    for (int i = tid; i < 64 * 48; i += NTHREADS) { const int t = i / 48, d = i % 48; ks[t * 49 + d] = bf2f(Z[(size_t)(tok0 + t) * ZLD + Z_GK + h * 48 + d]); }
                    for (int i = tid; i < 64 * 96; i += NTHREADS) { const int t = i / 96, v = i % 96; vs[t * 97 + v] = bf2f(Z[(size_t)(tok0 + t) * ZLD + Z_GV + h * 96 + v]); }
                    __syncthreads();
                    for (int i = tid; i < 64 * 48; i += NTHREADS) { const int t = i / 48, d = i % 48;
                        float x = ba[h * 48 + d];
#pragma unroll
                        for (int r = 0; r < GLA_RANK; ++r) x += lr[t * 16 + r] * wa2[r * 192 + h * 48 + d];
                        la[t * 49 + d] = (fminf(x, 0.f) - log1pf(__expf(-fabsf(x)))) * (1.f / 16.f); }
                    __syncthreads();
                    const int cd = tid % 48, cs = tid / 48;
                    if (tid < 384) { float run = 0.f;
#pragma unroll
                        for (int j2 = 0; j2 < 8; ++j2) { run += la[(cs * 8 + j2) * 49 + cd]; la[(cs * 8 + j2) * 49 + cd] = run; }
                        seg[cs * 48 + cd] = run; }
                    __syncthreads();
                    if (tid < 384) { float base = 0.f;
                        for (int q = 0; q < cs; ++q) base += seg[q * 48 + cd];
#pragma unroll
                        for (int j2 = 0; j2 < 8; ++j2) { const float v = la[(cs * 8 + j2) * 49 + cd] + base; la[(cs * 8 + j2) * 49 + cd] = v; BCUM[(size_t)(tok0 + cs * 8 + j2) * 192 + h * 48 + cd] = v; } }
                    __syncthreads();
                    for (int i = tid; i < 64 * 48; i += NTHREADS) { const int t = i / 48, d = i % 48; ks[t * 49 + d] *= __expf(la[63 * 49 + d] - la[t * 49 + d]); }
                    if (tid < 48) DEC[(size_t)item * 48 + tid] = __expf(la[63 * 49 + tid]);
                    __syncthreads();
                    const int dg = tid >> 5, vg = tid & 31;
                    float acc[3][3];
#pragma unroll
                    for (int a = 0; a < 3; ++a)
#pragma unroll
                        for (int q = 0; q < 3; ++q) acc[a][q] = 0.f;
                    for (int sidx = 0; sidx < 64; ++sidx) {
                        const float k0 = ks[sidx * 49 + dg * 3], k1 = ks[sidx * 49 + dg * 3 + 1], k2 = ks[sidx * 49 + dg * 3 + 2];
                        const float v0 = vs[sidx * 97 + vg * 3], v1 = vs[sidx * 97 + vg * 3 + 1], v2 = vs[sidx * 97 + vg * 3 + 2];
                        acc[0][0] += k0 * v0; acc[0][1] += k0 * v1; acc[0][2] += k0 * v2;
                        acc[1][0] += k1 * v0; acc[1][1] += k1 * v1; acc[1][2] += k1 * v2;
                        acc[2][0] += k2 * v0; acc[2][1] += k2 * v1; acc[2][2] += k2 * v2; }
#pragma unroll
                    for (int a = 0; a < 3; ++a)
#pragma unroll
                        for (int q = 0; q < 3; ++q) SLOC[(size_t)item * 4608 + (dg * 3 + a) * 96 + vg * 3 + q] = acc[a][q];
                }
                __syncthreads();
            }
            {
                const float* gq = args.in[8] + l * DSA_DH; const float* gk = args.in[9] + l * DSA_DH;
                const float gql = gq[lane], gkl = gk[lane];
                for (int r = gw; r < T; r += NGW) {
                    const bf16_t* zr = Z + (size_t)r * ZLD;
#pragma unroll
                    for (int h = 0; h < DSA_HEADS; ++h) {
                        const float q = bf2f(zr[Z_DQ + h * 64 + lane]), kk = bf2f(zr[Z_DK + h * 64 + lane]);
                        const float rq = 1.0f / sqrtf(wave_sum(q * q) * (1.f / 64.f) + NORM_EPS), rk = 1.0f / sqrtf(wave_sum(kk * kk) * (1.f / 64.f) + NORM_EPS);
                        QN[(size_t)r * 384 + h * 64 + lane] = f2bf(q * rq * gql * (0.125f * 1.4426950408889634f));
                        KN[(size_t)r * 384 + h * 64 + lane] = f2bf(kk * rk * gkl);
                    }
                    float qlv = 0.f, myc = 0.f;
#pragma unroll
                    for (int h = 0; h < IDX_HEADS; ++h) { const float c = bf2f(zr[Z_IW + h]) * (0.35355339059327373f * 0.0625f); qlv += c * bf2f(zr[Z_IQ + h * 64 + lane]); myc = (lane == h) ? c : myc; }
                    QL[(size_t)r * 64 + lane] = f2bf(qlv);
                    if (lane < 8) CH[(size_t)r * 8 + lane] = myc;
                    IK[(size_t)r * 64 + lane] = zr[Z_IK + lane];
                }
            }
            for (int tile = bid; tile < BATCH * 128; tile += G) {
                if (tid < 384) {
                    const bf16_t* zb = Z + (size_t)(tile * 32) * ZLD + Z_DV + tid;
                    unsigned w[16];
#pragma unroll
                    for (int p2 = 0; p2 < 16; ++p2) {
                        const int p = 2 * p2, sst = p >> 4, hh2 = (p >> 3) & 1, j = p & 7;
                        const int key0 = 16 * sst + 8 * (j >> 2) + 4 * hh2 + (j & 3);
                        w[p2] = (unsigned)zb[(size_t)key0 * ZLD] | ((unsigned)zb[(size_t)(key0 + 1) * ZLD] << 16);
                    }
                    uint4* dst = (uint4*)(VT + ((size_t)tile * 384 + tid) * 32);
                    dst[0] = make_uint4(w[0], w[1], w[2], w[3]); dst[1] = make_uint4(w[4], w[5], w[6], w[7]); dst[2] = make_uint4(w[8], w[9], w[10], w[11]); dst[3] = make_uint4(w[12], w[13], w[14], w[15]);
                }
            }
            if (l == 0) {
                for (int r = gw; r < DEPTH * BATCH * MEM_LEN; r += NGW) {
                    const int ll = r / (BATCH * MEM_LEN);
                    const float gkl = args.in[20][ll * X_DH + lane];
#pragma unroll
                    for (int h = 0; h < X_HEADS; ++h) {
                        const float kk = bf2f(CKV[(size_t)r * 512 + h * 64 + lane]);
                        const float rk = 1.0f / sqrtf(wave_sum(kk * kk) * (1.f / 64.f) + NORM_EPS);
                        CKN[(size_t)r * 256 + h * 64 + lane] = f2bf(kk * rk * gkl);
                    }
                }
            }
            {
                const float* cw = args.in[10] + (size_t)l * CONV_W * CONV_CH;
                const float* cb = args.in[11] + l * CONV_CH; const float* lg = args.in[12] + l * CONV_CH; const float* lb = args.in[13] + l * CONV_CH;
                float* ct = ldsf + 1024;
                const int c = tid & 255, half = tid >> 8;
                float wreg[CONV_W];
#pragma unroll
                for (int j = 0; j < CONV_W; ++j) wreg[j] = cw[j * CONV_CH + c];
                const float cbias = cb[c];
                for (int item = bid; item < T / 32; item += G) {
                    const int tok0 = item * 32;
                    const int tb = tok0 % SEQ;
                    const int t0 = tb + half * 16;
                    float hwin[46];
#pragma unroll
                    for (int i = 0; i < 46; ++i) {
                        const int tp = t0 - 30 + i;
                        float hv = 0.f;
                        if (tp >= 0) { const bf16_t* zr = Z + (size_t)(tok0 - tb + tp) * ZLD + Z_CU; hv = bf2f(zr[c]) * sigmoidf(bf2f(zr[256 + c])); }
                        hwin[i] = hv;
                    }
                    __syncthreads();
#pragma unroll
                    for (int o = 0; o < 16; ++o) {
                        float a = cbias;
#pragma unroll
                        for (int j = 0; j < CONV_W; ++j) a += hwin[o + j] * wreg[j];
                        ct[(half * 16 + o) * 256 + c] = a;
                    }
                    __syncthreads();
#pragma unroll
                    for (int i = 0; i < 4; ++i) {
                        const int tt = wave * 4 + i;
                        const f32x4 v = *(const f32x4*)&ct[tt * 256 + lane * 4];
                        const float mu = wave_sum(v[0] + v[1] + v[2] + v[3]) * (1.f / 256.f);
                        const f32x4 dv = v - mu;
                        const float var = wave_sum(dv[0] * dv[0] + dv[1] * dv[1] + dv[2] * dv[2] + dv[3] * dv[3]) * (1.f / 256.f);
                        const float rstd = 1.0f / sqrtf(var + NORM_EPS);
                        const f32x4 gg = *(const f32x4*)(lg + lane * 4), bb = *(const f32x4*)(lb + lane * 4);
                        f32x4 y = dv * rstd * gg + bb;
                        uint2 o; o.x = pk2(siluf(y[0]), siluf(y[1])); o.y = pk2(siluf(y[2]), siluf(y[3]));
                        *(uint2*)(MIX + (size_t)(tok0 + tt) * D_MODEL + MIX_CONV + lane * 4) = o;
                    }
                }
            }
        } else if (k == 3 && PH_ON(3)) {
            for (int e = bid * NTHREADS + tid; e < BATCH * GLA_HEADS * 4608; e += G * NTHREADS) {
                const int bh = e / 4608, idx = e % 4608, d = idx / 96;
                float state = 0.f;
#pragma unroll 16
                for (int c = 0; c < 64; ++c) {
                    const size_t it = (size_t)bh * 64 + c;
                    const float tmp = SLOC[it * 4608 + idx], dec = DEC[it * 48 + d];
                    SLOC[it * 4608 + idx] = state; state = dec * state + tmp; }
            }
            {
                unsigned* hist32 = (unsigned*)lds_raw;
                unsigned* rs = (unsigned*)(lds_raw + 131072);
                volatile unsigned* qsh = (volatile unsigned*)(lds_raw + LDSCTL_OFF + 64);
                unsigned* qhead = ctl + CW_Q3 + 64 * l;
                const int qc = lane & 15, g4 = lane >> 4, qh = wave >> 2, kg = wave & 3;
                const int row = 16 * qh + qc;
                for (;;) {
                    __syncthreads();
                    if (tid == 0) qsh[0] = atomicAdd(qhead, 1u);
                    __syncthreads();
                    const int it = (int)qsh[0];
                    if (it >= BATCH * 128) break;
                    const int b = it & 3, qt = 127 - (it >> 2);
                    const int tokb = b * SEQ, q0 = qt * 32, tq = q0 + row;
                    unsigned* mrow = MASK + (size_t)(tokb + tq) * 128;
                    if (qt < 8) {
                        if (kg == 0 && g4 == 0) for (int kt = 0; kt <= qt; ++kt) mrow[kt] = (kt < qt || row == 31) ? 0xffffffffu : ((1u << (row + 1)) - 1u);
                        continue;
                    }
                    bf16x8 qf[9][2];
                    {
                        const bf16_t* zq = Z + (size_t)(tokb + tq) * ZLD + Z_IQ + g4 * 8;
#pragma unroll
                        for (int h = 0; h < 8; ++h)
#pragma unroll
                            for (int ks = 0; ks < 2; ++ks) qf[h][ks] = *(const bf16x8*)(zq + h * 64 + ks * 32);
                        const bf16_t* ql = QL + (size_t)(tokb + tq) * 64 + g4 * 8;
#pragma unroll
                        for (int ks = 0; ks < 2; ++ks) qf[8][ks] = *(const bf16x8*)(ql + ks * 32);
                    }
                    float ch[8];
                    { const f32x4 c0 = *(const f32x4*)(CH + (size_t)(tokb + tq) * 8), c1 = *(const f32x4*)(CH + (size_t)(tokb + tq) * 8 + 4);
                      ch[0] = c0[0]; ch[1] = c0[1]; ch[2] = c0[2]; ch[3] = c0[3]; ch[4] = c1[0]; ch[5] = c1[1]; ch[6] = c1[2]; ch[7] = c1[3]; }
#pragma unroll
                    for (int i = 0; i < 16; ++i) ((uint4*)hist32)[tid + 512 * i] = make_uint4(0u, 0u, 0u, 0u);
                    if (tid < 32) { rs[tid] = 0u; rs[32 + tid] = TOPK; rs[64 + tid] = 0u; rs[96 + tid] = 0u; }
                    __syncthreads();
#define DSA_SCORE(kt_) \
                        f32x4 sc[2]; \
                        { const bf16_t* kp = IK + (size_t)(tokb + (kt_) * 32 + qc) * 64 + g4 * 8; \
                          bf16x8 kf[2][2]; \
                          _Pragma("unroll") for (int u = 0; u < 2; ++u) _Pragma("unroll") for (int ks = 0; ks < 2; ++ks) kf[u][ks] = *(const bf16x8*)(kp + u * 16 * 64 + ks * 32); \
                          _Pragma("unroll") for (int u = 0; u < 2; ++u) { sc[u] = (f32x4){0.f, 0.f, 0.f, 0.f}; \
                              _Pragma("unroll") for (int ks = 0; ks < 2; ++ks) sc[u] = __builtin_amdgcn_mfma_f32_16x16x32_bf16(kf[u][ks], qf[8][ks], sc[u], 0, 0, 0); } \
                          _Pragma("unroll") for (int h = 0; h < 8; ++h) _Pragma("unroll") for (int u = 0; u < 2; ++u) { f32x4 a = (f32x4){0.f, 0.f, 0.f, 0.f}; \
                              _Pragma("unroll") for (int ks = 0; ks < 2; ++ks) a = __builtin_amdgcn_mfma_f32_16x16x32_bf16(kf[u][ks], qf[h][ks], a, 0, 0, 0); \
                              _Pragma("unroll") for (int i = 0; i < 4; ++i) sc[u][i] = __builtin_fmaf(fabsf(a[i]), ch[h], sc[u][i]); } }
                    for (int pass = 0; pass < 3; ++pass) {
                        const unsigned mmask = (pass == 0) ? 0u : ((pass == 1) ? 0xFFE00000u : 0xFFFFFC00u);
                        const int bshift = (pass == 0) ? 21 : ((pass == 1) ? 10 : 0);
                        const unsigned bmask = (pass == 2) ? 1023u : 2047u;
                        const unsigned prefm = rs[row];
                        for (int kt = kg; kt <= qt; kt += 4) {
                            DSA_SCORE(kt)
#pragma unroll
                            for (int u = 0; u < 2; ++u)
#pragma unroll
                                for (int i = 0; i < 4; ++i) {
                                    const int sidx = kt * 32 + 16 * u + 4 * g4 + i;
                                    const unsigned key = fkey(sc[u][i]);
                                    if (sidx <= tq && (key & mmask) == prefm) { const unsigned bin = (key >> bshift) & bmask; atomicAdd(&hist32[row * 1024 + (bin >> 1)], 1u << ((bin & 1u) * 16u)); }
                                }
                        }
                        __syncthreads();
                        for (int rr = 0; rr < 4; ++rr) {
                            const int R = wave * 4 + rr;
                            const unsigned kremR = rs[32 + R];
                            const uint4* hw = (const uint4*)(hist32 + R * 1024 + lane * 16);
                            const uint4 w0 = hw[0], w1 = hw[1], w2 = hw[2], w3 = hw[3];
                            const unsigned wv[16] = {w0.x, w0.y, w0.z, w0.w, w1.x, w1.y, w1.z, w1.w, w2.x, w2.y, w2.z, w2.w, w3.x, w3.y, w3.z, w3.w};
                            unsigned cntl = 0u;
#pragma unroll
                            for (int i = 0; i < 16; ++i) cntl += (wv[i] & 0xffffu) + (wv[i] >> 16);
                            unsigned suf = cntl;
#pragma unroll
                            for (int o = 1; o < 64; o <<= 1) { const unsigned tv = __shfl_down(suf, o); if (lane + o < 64) suf += tv; }
                            const unsigned excl = suf - cntl;
                            if (excl < kremR && kremR <= suf) {
                                unsigned above = excl, eq = 0u; int bin = 0; bool found = false;
#pragma unroll
                                for (int i = 15; i >= 0; --i) { const unsigned hi = wv[i] >> 16, lo = wv[i] & 0xffffu;
                                    if (!found) { if (above + hi >= kremR) { bin = 2 * (lane * 16 + i) + 1; eq = hi; found = true; } else above += hi; }
                                    if (!found) { if (above + lo >= kremR) { bin = 2 * (lane * 16 + i); eq = lo; found = true; } else above += lo; } }
                                rs[R] = rs[R] | ((unsigned)bin << bshift); rs[32 + R] = kremR - above; rs[64 + R] = eq;
                            }
                        }
                        __syncthreads();
#pragma unroll
                        for (int i = 0; i < 16; ++i) ((uint4*)hist32)[tid + 512 * i] = make_uint4(0u, 0u, 0u, 0u);
                        __syncthreads();
                    }
                    {
                        const unsigned tau = rs[row]; const bool tiecrit = rs[64 + row] > rs[32 + row];
                        for (int kt = kg; kt <= qt; kt += 4) {
                            DSA_SCORE(kt)
                            unsigned bits = 0u;
#pragma unroll
                            for (int u = 0; u < 2; ++u)
#pragma unroll
                                for (int i = 0; i < 4; ++i) {
                                    const int sidx = kt * 32 + 16 * u + 4 * g4 + i;
                                    const unsigned key = fkey(sc[u][i]);
                                    const bool valid = sidx <= tq;
                                    if (valid && (key > tau || (key == tau && !tiecrit))) bits |= 1u << (16 * u + 4 * g4 + i);
                                    if (valid && key == tau && tiecrit) { const unsigned idx = atomicAdd(&rs[96 + row], 1u); if (idx < 1023u) hist32[row * 1024 + idx] = (unsigned)sidx; }
                                }
                            bits |= (unsigned)__shfl_xor((int)bits, 16);
                            bits |= (unsigned)__shfl_xor((int)bits, 32);
                            if (g4 == 0) mrow[kt] = bits;
                        }
                        asm volatile("s_waitcnt vmcnt(0)" ::: "memory");
                        __syncthreads();
                        if (tid < 32 && rs[64 + tid] > rs[32 + tid]) {
                            unsigned nl = rs[96 + tid]; if (nl > 1023u) nl = 1023u;
                            const unsigned need = rs[32 + tid];
                            unsigned* lst = hist32 + tid * 1024;
                            for (unsigned q = 0; q < need && q < nl; ++q) {
                                unsigned best = 0xffffffffu, bi = 0u;
                                for (unsigned e2 = 0; e2 < nl; ++e2) { const unsigned v = lst[e2]; if (v < best) { best = v; bi = e2; } }
                                lst[bi] = 0xffffffffu;
                                atomicOr(MASK + (size_t)(tokb + q0 + tid) * 128 + (best >> 5), 1u << (best & 31u));
                            }
                        }
                    }
#undef DSA_SCORE
                }
            }
        } else if (k == 4 && PH_ON(4)) {
            float* qt = ldsf;
            float* kt = qt + 64 * 49;
            float* vs = kt + 64 * 49;
            float* Am = vs + 64 * 97;
            float* Sin = Am + 64 * 65;
            const float* gon = args.in[7] + l * GLA_DV;
            volatile unsigned* qsh = (volatile unsigned*)(lds_raw + LDSCTL_OFF + 64);
            unsigned* qhead = ctl + CW_Q4 + 64 * l;
            float* biasd = (float*)(lds_raw + 111616);
            for (int i = tid; i < 6 * 224; i += NTHREADS) { const int h = i / 224, d = i % 224 - 32; biasd[i] = d < 0 ? 0.f : args.in[2][t5_bucket(d) * DSA_HEADS + h] * 1.4426950408889634f; }
            for (;;) {
                __syncthreads();
                if (tid == 0) qsh[0] = atomicAdd(qhead, 1u);
                __syncthreads();
                const int qit = (int)qsh[0];
                if (qit >= BATCH * 64 + BATCH * GLA_HEADS * 64) break;
                if (qit < BATCH * 64) {
                    const int b = qit & 3, qt = 63 - (qit >> 2);
                    const int tokb = b * SEQ, q0 = qt * 64, nkt = 2 * (qt + 1);
                    int tid_a = tid; asm volatile("" : "+v"(tid_a));
                    const int r = tid_a & 31, hh = (tid_a >> 5) & 1;
                    const int qg = wave & 1, hp = wave >> 1;
                    const int tq = q0 + 32 * qg + r;
                    LDSAS unsigned char* lb = (LDSAS unsigned char*)lds_raw;
                    bf16x8 qf[2][4];
                    f32x16 oacc[2][2];
                    float lsum[2] = {0.f, 0.f};
#ifdef MK_CHECK_MASK
                    int pcnt = 0;
#endif
                    {
                        const int hpl = (wave < 6) ? hp : 0;
#pragma unroll
                        for (int hd = 0; hd < 2; ++hd)
#pragma unroll
                            for (int ks = 0; ks < 4; ++ks) qf[hd][ks] = *(const bf16x8*)(QN + (size_t)(tokb + tq) * 384 + (2 * hpl + hd) * 64 + ks * 16 + hh * 8);
                    }
#pragma unroll
                    for (int hd = 0; hd < 2; ++hd)
#pragma unroll
                        for (int dt = 0; dt < 2; ++dt)
#pragma unroll
                            for (int i = 0; i < 16; ++i) oacc[hd][dt][i] = 0.f;
                    const unsigned* mrow = MASK + (size_t)(tokb + tq) * 128;
                    u32x4v stk[3], stv[3];
                    const u32x4v* kg = (const u32x4v*)(KN + (size_t)tokb * 384);
                    const u32x4v* vg = (const u32x4v*)(VT + (size_t)(b * 128) * 384 * 32);
#pragma unroll
                    for (int i = 0; i < 3; ++i) { stk[i] = kg[tid_a + 512 * i]; stv[i] = vg[tid_a + 512 * i]; }
#pragma unroll
                    for (int i = 0; i < 3; ++i) { const int c = tid_a + 512 * i;
                        *(LDSAS u32x4v*)(lb + (c / 48) * 784 + (c % 48) * 16) = stk[i];
                        *(LDSAS u32x4v*)(lb + 50176 + (c >> 2) * 80 + (c & 3) * 16) = stv[i]; }
                    __syncthreads();
                    for (int kt = 0; kt < nkt; ++kt) {
                        const int cur = kt & 1;
                        if (kt + 1 < nkt) {
#pragma unroll
                            for (int i = 0; i < 3; ++i) { stk[i] = kg[(size_t)(kt + 1) * 1536 + tid_a + 512 * i]; stv[i] = vg[(size_t)(kt + 1) * 1536 + tid_a + 512 * i]; }
                        }
                        if (wave < 6 && kt * 32 <= q0 + 32 * qg + 31) {
                            const unsigned mw = mrow[kt];
#ifdef MK_CHECK_MASK
                            pcnt += __builtin_popcount(mw);
#endif
                            const int mind = (q0 + 32 * qg) - (kt * 32 + 31);
                            LDSAS unsigned char* Kb = lb + cur * 25088;
                            LDSAS unsigned char* Vb = lb + 50176 + cur * 30720;
#pragma unroll
                            for (int hd = 0; hd < 2; ++hd) {
                                const int h = 2 * hp + hd;
                                f32x16 S;
#pragma unroll
                                for (int i = 0; i < 16; ++i) S[i] = 0.f;
#pragma unroll
                                for (int ks = 0; ks < 4; ++ks) { const bf16x8 a = *(const LDSAS bf16x8*)(Kb + r * 784 + (h * 64 + ks * 16 + hh * 8) * 2); S = MFMA32(a, qf[hd][ks], S); }
                                float p[16];
                                if (mind >= 113) {
                                    const float bu = biasd[h * 224 + 223];
#pragma unroll
                                    for (int i = 0; i < 16; ++i) p[i] = ((mw >> crow(i, hh)) & 1u) ? __builtin_amdgcn_exp2f(S[i] + bu) : 0.f;
                                } else {
                                    const float* bp = biasd + h * 224 + (tq - kt * 32 - 4 * hh + 5);
#pragma unroll
                                    for (int i = 0; i < 16; ++i) p[i] = ((mw >> crow(i, hh)) & 1u) ? __builtin_amdgcn_exp2f(S[i] + bp[27 - (i & 3) - 8 * (i >> 2)]) : 0.f;
                                }
                                float ps = 0.f;
#pragma unroll
                                for (int i = 0; i < 16; ++i) ps += p[i];
                                lsum[hd] += ps;
                                uint4 u0, u1;
                                u0.x = pkbf(p[0], p[1]); u0.y = pkbf(p[2], p[3]); u0.z = pkbf(p[4], p[5]); u0.w = pkbf(p[6], p[7]);
                                u1.x = pkbf(p[8], p[9]); u1.y = pkbf(p[10], p[11]); u1.z = pkbf(p[12], p[13]); u1.w = pkbf(p[14], p[15]);
                                const bf16x8 pf0 = __builtin_bit_cast(bf16x8, u0), pf1 = __builtin_bit_cast(bf16x8, u1);
#pragma unroll
                                for (int dt = 0; dt < 2; ++dt) {
                                    const bf16x8 a0 = *(const LDSAS bf16x8*)(Vb + (h * 64 + dt * 32 + r) * 80 + hh * 16);
                                    const bf16x8 a1 = *(const LDSAS bf16x8*)(Vb + (h * 64 + dt * 32 + r) * 80 + 32 + hh * 16);
                                    oacc[hd][dt] = MFMA32(a0, pf0, oacc[hd][dt]);
                                    oacc[hd][dt] = MFMA32(a1, pf1, oacc[hd][dt]);
                                }
                                __builtin_amdgcn_sched_barrier(0);
                            }
                        }
                        if (kt + 1 < nkt) {
#pragma unroll
                            for (int i = 0; i < 3; ++i) { const int c = tid_a + 512 * i;
                                *(LDSAS u32x4v*)(lb + (cur ^ 1) * 25088 + (c / 48) * 784 + (c % 48) * 16) = stk[i];
                                *(LDSAS u32x4v*)(lb + 50176 + (cur ^ 1) * 30720 + (c >> 2) * 80 + (c & 3) * 16) = stv[i]; }
                        }
                        __syncthreads();
                    }
                    if (wave < 6) {
#pragma unroll
                        for (int hd = 0; hd < 2; ++hd) {
                            const float lt = lsum[hd] + __shfl_xor(lsum[hd], 32);
                            float inv = 1.f / lt;
#ifdef MK_CHECK_MASK
                            if (pcnt != ((tq + 1) < TOPK ? (tq + 1) : TOPK)) inv = __builtin_nanf("");
#endif
                            bf16_t* mo = MIX + (size_t)(tokb + tq) * D_MODEL + MIX_DSA + (2 * hp + hd) * 64;
#pragma unroll
                            for (int dt = 0; dt < 2; ++dt)
#pragma unroll
                                for (int g4 = 0; g4 < 4; ++g4) {
                                    uint2 o; o.x = pkbf(oacc[hd][dt][4 * g4] * inv, oacc[hd][dt][4 * g4 + 1] * inv); o.y = pkbf(oacc[hd][dt][4 * g4 + 2] * inv, oacc[hd][dt][4 * g4 + 3] * inv);
                                    *(uint2*)(mo + dt * 32 + 8 * g4 + 4 * hh) = o;
                                }
                        }
                    }
                    continue;
                }
                const int item = qit - BATCH * 64;
                const int bh = item >> 6, c = item & 63, b = bh >> 2, h = bh & 3, tok0 = b * SEQ + c * 64;
                int tid_g = tid; asm volatile("" : "+v"(tid_g));
                __syncthreads();
                for (int i = tid_g; i < 64 * 48; i += NTHREADS) { const int t = i / 48, d = i % 48;
                    const float bc = BCUM[(size_t)(tok0 + t) * 192 + h * 48 + d];
                    const bf16_t* zr = Z + (size_t)(tok0 + t) * ZLD;
                    qt[t * 49 + d] = bf2f(zr[Z_GQ + h * 48 + d]) * 0.14433756729740643f * __expf(bc);
                    kt[t * 49 + d] = bf2f(zr[Z_GK + h * 48 + d]) * __expf(-bc); }
                for (int i = tid_g; i < 64 * 96; i += NTHREADS) { const int t = i / 96, v = i % 96; vs[t * 97 + v] = bf2f(Z[(size_t)(tok0 + t) * ZLD + Z_GV + h * 96 + v]); }
                for (int i = tid_g; i < 48 * 96; i += NTHREADS) { const int d = i / 96, v = i % 96; Sin[d * 97 + v] = SLOC[(size_t)item * 4608 + i]; }
                __syncthreads();
                const int t = tid_g >> 3, sg = tid_g & 7;
#pragma unroll
                for (int j = 0; j < 8; ++j) { const int sidx = sg * 8 + j; float a = 0.f;
                    if (sidx <= t) {
#pragma unroll 8
                        for (int d = 0; d < 48; ++d) a += qt[t * 49 + d] * kt[sidx * 49 + d]; }
                    Am[t * 65 + sidx] = a; }
                __syncthreads();
                float o[12];
#pragma unroll
                for (int i = 0; i < 12; ++i) o[i] = 0.f;
                for (int sidx = 0; sidx <= t; ++sidx) { const float a = Am[t * 65 + sidx];
#pragma unroll
                    for (int i = 0; i < 12; ++i) o[i] += a * vs[sidx * 97 + sg * 12 + i]; }
                for (int d = 0; d < 48; ++d) { const float qv = qt[t * 49 + d];
#pragma unroll
                    for (int i = 0; i < 12; ++i) o[i] += qv * Sin[d * 97 + sg * 12 + i]; }
                float ss = 0.f;
#pragma unroll
                for (int i = 0; i < 12; ++i) ss += o[i] * o[i];
                ss += __shfl_xor(ss, 1); ss += __shfl_xor(ss, 2); ss += __shfl_xor(ss, 4);
                const float rinv = 1.0f / sqrtf(ss * (1.f / 96.f) + NORM_EPS);
                const bf16_t* zr = Z + (size_t)(tok0 + t) * ZLD + Z_GR + h * 96 + sg * 12;
                bf16_t* mo = MIX + (size_t)(tok0 + t) * D_MODEL + MIX_GLA + h * 96 + sg * 12;
#pragma unroll
                for (int i = 0; i < 12; i += 2) *(unsigned*)(mo + i) = pk2(o[i] * rinv * gon[sg * 12 + i] * siluf(bf2f(zr[i])), o[i + 1] * rinv * gon[sg * 12 + i + 1] * siluf(bf2f(zr[i + 1])));
            }
        } else if (k == 5 && PH_ON(5)) {
            pg8::Gemm g{MIX, WOUT + (size_t)l * D_MODEL * D_MODEL, T, D_MODEL, D_MODEL}; pg8::StaticOrder S; S.init(T, D_MODEL, G, bid);
            pg8::EpiRes E{xin, OUT, D_MODEL};
            pg8::gemm_phase<pg8::EpiRes, pg8::StaticOrder, true, true>(tid, ldsq, g, S, E);
        } else if (k == 6 && PH_ON(6)) {
            const float* g = args.in[15] + l * D_MODEL;
            for (int r = gw; r < T; r += NGW) rmsnorm_row_bf16(OUT + (size_t)r * D_MODEL, g, XN + (size_t)r * D_MODEL, lane);
            {
                float* scr = ldsf + wave * (64 * 33);
                constexpr int I_G = 16 * 16, I_D = 8 * 32, I_E = 2 * I_G + I_D;
                for (int it = gw; it < N_EXPERTS * I_E; it += NGW) {
                    const int e = it / I_E; int r = it % I_E;
                    const size_t we = (size_t)l * N_EXPERTS + e;
                    if (r < I_G) { transpose_item(args.in[27] + we * D_MODEL * D_EXPERT, D_MODEL, D_EXPERT, 16, WGU + (size_t)e * 1024 * D_MODEL, 0, 2, 0, scr, r, lane); continue; } r -= I_G;
                    if (r < I_G) { transpose_item(args.in[28] + we * D_MODEL * D_EXPERT, D_MODEL, D_EXPERT, 16, WGU + (size_t)e * 1024 * D_MODEL, 0, 2, 1, scr, r, lane); continue; } r -= I_G;
                    transpose_item(args.in[29] + we * D_EXPERT * D_MODEL, D_EXPERT, D_MODEL, 32, WDN + (size_t)e * D_MODEL * D_EXPERT, 0, 1, 0, scr, r, lane);
                }
            }
        } else if (k == 7 && PH_ON(7)) {
            pg8::Gemm g{XN, WCQ + (size_t)l * XW * D_MODEL, T, XW, D_MODEL}; pg8::StaticOrder S; S.init(T, XW, G, bid);
            pg8::EpiStoreBf16 E{CQ, XW, 0xffff};
            pg8::gemm_phase<pg8::EpiStoreBf16, pg8::StaticOrder, true, true>(tid, ldsq, g, S, E);
        } else if (k == 8 && PH_ON(8)) {
            const float* gq = args.in[19] + l * X_DH;
            for (int item = gw; item < (T / 64) * X_HEADS; item += NGW) {
                const int tg = item / X_HEADS, h = item % X_HEADS;
                const int tok = tg * 64 + lane, b = (tg * 64) / SEQ;
                float q[64], o[64];
                const bf16_t* qr = CQ + (size_t)tok * XW + h * 64;
                float ss = 0.f;
#pragma unroll
                for (int d = 0; d < 64; ++d) { q[d] = bf2f(qr[d]); ss += q[d] * q[d]; o[d] = 0.f; }
                const float rq = 0.125f / sqrtf(ss * (1.f / 64.f) + NORM_EPS);
#pragma unroll
                for (int d = 0; d < 64; ++d) q[d] *= rq * gq[d];
                float lsm = 0.f;
                const bf16_t* kb = CKN + ((size_t)l * BATCH * MEM_LEN + (size_t)b * MEM_LEN) * 256 + h * 64;
                const bf16_t* vb = CKV + ((size_t)l * BATCH * MEM_LEN + (size_t)b * MEM_LEN) * 512 + 256 + h * 64;
                for (int m = 0; m < MEM_LEN; ++m) {
                    float dot = 0.f;
#pragma unroll
                    for (int d = 0; d < 64; ++d) dot += q[d] * bf2f(kb[(size_t)m * 256 + d]);
                    const float p = __expf(dot);
                    lsm += p;
#pragma unroll
                    for (int d = 0; d < 64; ++d) o[d] += p * bf2f(vb[(size_t)m * 512 + d]);
                }
                const float inv = 1.f / lsm;
                bf16_t* op = COIN + (size_t)tok * XW + h * 64;
#pragma unroll
                for (int d = 0; d < 64; d += 2) *(unsigned*)(op + d) = pk2(o[d] * inv, o[d + 1] * inv);
            }
        } else if (k == 9 && PH_ON(9)) {
            pg8::Gemm g{COIN, WCO + (size_t)l * D_MODEL * XW, T, D_MODEL, XW}; pg8::StaticOrder S; S.init(T, D_MODEL, G, bid);
            pg8::EpiRes E{OUT, OUT, D_MODEL};
            pg8::gemm_phase<pg8::EpiRes, pg8::StaticOrder, true, true>(tid, ldsq, g, S, E);
        } else if (k == 10 && PH_ON(10)) {
            const float* g = args.in[22] + l * D_MODEL;
            const float* wrg = args.in[23] + (size_t)l * D_MODEL * N_GROUPS; const float* brg = args.in[24] + l * N_GROUPS;
            const float* wre = args.in[25] + (size_t)l * D_MODEL * N_EXPERTS; const float* bre = args.in[26] + l * N_EXPERTS;
            for (int r = gw; r < T; r += NGW) {
                const float* xrow = OUT + (size_t)r * D_MODEL;
                float s = 0.f;
#pragma unroll 4
                for (int i = 0; i < 16; ++i) { const float xv = xrow[lane + 64 * i]; s += xv * xv; }
                const float rinv = 1.0f / sqrtf(wave_sum(s) * (1.f / 1024.f) + NORM_EPS);
                float acc[20];
#pragma unroll
                for (int j = 0; j < 20; ++j) acc[j] = 0.f;
#pragma unroll 2
                for (int i = 0; i < 16; ++i) {
                    const int kk = lane + 64 * i;
                    const float xn = xrow[kk] * rinv * g[kk];
                    XN[(size_t)r * D_MODEL + kk] = f2bf(xn);
                    const f32x4 wg = *(const f32x4*)(wrg + (size_t)kk * 4);
                    acc[0] += xn * wg[0]; acc[1] += xn * wg[1]; acc[2] += xn * wg[2]; acc[3] += xn * wg[3];
#pragma unroll
                    for (int q4 = 0; q4 < 4; ++q4) { const f32x4 we = *(const f32x4*)(wre + (size_t)kk * 16 + q4 * 4);
                        acc[4 + q4 * 4 + 0] += xn * we[0]; acc[4 + q4 * 4 + 1] += xn * we[1]; acc[4 + q4 * 4 + 2] += xn * we[2]; acc[4 + q4 * 4 + 3] += xn * we[3]; }
                }
#pragma unroll
                for (int j = 0; j < 20; ++j) acc[j] = wave_sum(acc[j]);
                if (lane == 0) {
                    float gl[4]; int gs = 0;
#pragma unroll
                    for (int j = 0; j < 4; ++j) gl[j] = acc[j] + brg[j];
                    float gmax = gl[0];
#pragma unroll
                    for (int j = 1; j < 4; ++j) if (gl[j] > gmax) { gmax = gl[j]; gs = j; }
                    float den = 0.f;
#pragma unroll
                    for (int j = 0; j < 4; ++j) den += __expf(gl[j] - gmax);
                    const float gwt = 1.f / den;
                    float el[4];
#pragma unroll
                    for (int j = 0; j < 4; ++j) { float vsel = 0.f;
#pragma unroll
                        for (int gg2 = 0; gg2 < 4; ++gg2) vsel = (gg2 == gs) ? (acc[4 + gg2 * 4 + j] + bre[gg2 * 4 + j]) : vsel;
                        el[j] = vsel; }
                    int i1 = 0; float e1v = el[0];
#pragma unroll
                    for (int j = 1; j < 4; ++j) if (el[j] > e1v) { e1v = el[j]; i1 = j; }
                    int i2 = -1; float e2v = -INFINITY;
#pragma unroll
                    for (int j = 0; j < 4; ++j) if (j != i1 && el[j] > e2v) { e2v = el[j]; i2 = j; }
                    const float e2 = __expf(e2v - e1v);
                    const float w1 = 1.f / (1.f + e2), w2 = e2 / (1.f + e2);
                    const int ex1 = gs * 4 + i1, ex2 = gs * 4 + i2;
                    tok_e[r * 2] = ex1; tok_e[r * 2 + 1] = ex2;
                    tok_g[r * 2] = w1 * gwt; tok_g[r * 2 + 1] = w2 * gwt;
                    tok_r[r * 2] = (int)atomicAdd(&cnt[ex1], 1u); tok_r[r * 2 + 1] = (int)atomicAdd(&cnt[ex2], 1u);
                }
            }
        } else if (k >= 11 && k <= 14 && PH_ON(11)) {
            int off[N_EXPERTS + 1];
            off[0] = 0;
#pragma unroll
            for (int e = 0; e < N_EXPERTS; ++e) { const int c = (int)__hip_atomic_load(&cnt[e], __ATOMIC_RELAXED, __HIP_MEMORY_SCOPE_AGENT); off[e + 1] = off[e] + ((c + PADR - 1) / PADR) * PADR; }
            const int total_rows = off[N_EXPERTS];
            if (k == 11) {
                for (int i = gw; i < 2 * T; i += NGW) {
                    const int e = tok_e[i]; int o = 0;
#pragma unroll
                    for (int q = 0; q < N_EXPERTS; ++q) o = (q == e) ? off[q] : o;
                    const uint4* src = (const uint4*)(XN + (size_t)(i >> 1) * D_MODEL); uint4* dst = (uint4*)(XG + (size_t)(o + tok_r[i]) * D_MODEL);
                    dst[lane] = src[lane]; dst[lane + 64] = src[lane + 64];
                }
                for (int e = 0; e < N_EXPERTS; ++e) {
                    int oe = 0, oe1 = 0;
#pragma unroll
                    for (int q = 0; q < N_EXPERTS; ++q) { oe = (q == e) ? off[q] : oe; oe1 = (q == e) ? off[q + 1] : oe1; }
                    const int c = (int)__hip_atomic_load(&cnt[e], __ATOMIC_RELAXED, __HIP_MEMORY_SCOPE_AGENT);
                    for (int r = oe + c + gw; r < oe1; r += NGW) { uint4* dst = (uint4*)(XG + (size_t)r * D_MODEL); dst[lane] = make_uint4(0u, 0u, 0u, 0u); dst[lane + 64] = make_uint4(0u, 0u, 0u, 0u); }
                }
            } else if (k == 12) {
                pg8::Gemm g{XG, WGU, total_rows, 1024, D_MODEL};
                pg8::GroupSched S;
#pragma unroll
                for (int q = 0; q < 17; ++q) S.off[q] = off[q];
                S.nunits = (total_rows / 256) * 4; S.G = G; S.c = bid;
                pg8::EpiGateUp E{HB, D_EXPERT};
                pg8::gemm_phase<pg8::EpiGateUp, pg8::GroupSched, true, true>(tid, ldsq, g, S, E);
            } else if (k == 13) {
                pg8::Gemm g{HB, WDN, total_rows, 1024, D_EXPERT};
                pg8::GroupSched S;
#pragma unroll
                for (int q = 0; q < 17; ++q) S.off[q] = off[q];
                S.nunits = (total_rows / 256) * 4; S.G = G; S.c = bid;
                pg8::EpiStoreBf16 E{DB, D_MODEL, 3};
                pg8::gemm_phase<pg8::EpiStoreBf16, pg8::GroupSched, true, true>(tid, ldsq, g, S, E);
            } else {
                for (int r = gw; r < T; r += NGW) {
                    const int e0 = tok_e[r * 2], e1 = tok_e[r * 2 + 1]; int o0 = 0, o1 = 0;
#pragma unroll
                    for (int q = 0; q < N_EXPERTS; ++q) { o0 = (q == e0) ? off[q] : o0; o1 = (q == e1) ? off[q] : o1; }
                    const size_t r0 = (size_t)(o0 + tok_r[r * 2]), r1 = (size_t)(o1 + tok_r[r * 2 + 1]);
                    const float g0 = tok_g[r * 2], g1 = tok_g[r * 2 + 1];
#pragma unroll
                    for (int j = 0; j < 4; ++j) {
                        const int c = lane * 4 + 256 * j;
                        const uint2 a = *(const uint2*)(DB + r0 * 1024 + c), bq = *(const uint2*)(DB + r1 * 1024 + c);
                        f32x4 x = *(const f32x4*)(OUT + (size_t)r * D_MODEL + c);
                        x[0] += g0 * __uint_as_float(a.x << 16) + g1 * __uint_as_float(bq.x << 16);
                        x[1] += g0 * __uint_as_float(a.x & 0xffff0000u) + g1 * __uint_as_float(bq.x & 0xffff0000u);
                        x[2] += g0 * __uint_as_float(a.y << 16) + g1 * __uint_as_float(bq.y << 16);
                        x[3] += g0 * __uint_as_float(a.y & 0xffff0000u) + g1 * __uint_as_float(bq.y & 0xffff0000u);
                        *(f32x4*)(OUT + (size_t)r * D_MODEL + c) = x;
                    }
                }
            }
        }
    }
}

#ifndef MK_SINGLE
#define MK_SINGLE 1
#endif
extern "C" void kernel_launch(void* const* d_in, const int* in_sizes, int n_in, void* d_out, int out_size, void* d_ws, size_t ws_size, hipStream_t stream) {
    static int grid = 0;
    if (grid == 0) {
        if (n_in != 30 || out_size != T * D_MODEL || ws_size < WS_END) { fprintf(stderr, "kernel_launch: unexpected sizes n_in %d out %d ws %zu (need %zu)\n", n_in, out_size, ws_size, (size_t)WS_END); grid = -1; return; }
        int dev = 0, cus = 0;
        if (hipGetDevice(&dev) != hipSuccess || hipDeviceGetAttribute(&cus, hipDeviceAttributeMultiprocessorCount, dev) != hipSuccess) { grid = -1; return; }
        bool okattr = true;
#define SETATTR(K) okattr = okattr && (hipFuncSetAttribute((const void*)mk_fwd<K>, hipFuncAttributeMaxDynamicSharedMemorySize, LDS_BYTES) == hipSuccess)
#if MK_SINGLE
        SETATTR(-1);
#else
        SETATTR(0); SETATTR(1); SETATTR(2); SETATTR(3); SETATTR(4); SETATTR(5); SETATTR(6); SETATTR(7); SETATTR(8); SETATTR(9); SETATTR(10); SETATTR(11); SETATTR(12); SETATTR(13); SETATTR(14);
#endif
        if (!okattr) { fprintf(stderr, "kernel_launch: hipFuncSetAttribute failed\n"); grid = -1; return; }
        (void)hipGetLastError();
        grid = cus > 0 ? cus : 256;
    }
    if (grid < 0) return;
    (void)hipMemsetAsync((char*)d_ws + WS_CTL, 0, CTL_BYTES, stream);
    Args a{};
    for (int i = 0; i < 30; ++i) a.in[i] = (const float*)d_in[i];
    a.out = (float*)d_out; a.ws = (unsigned char*)d_ws;
#if MK_SINGLE
    a.ph_lo = 0; a.ph_hi = DEPTH * NP;
    hipLaunchKernelGGL(mk_fwd<-1>, dim3(grid), dim3(NTHREADS), LDS_BYTES, stream, a);
#else
    for (int ph = 0; ph < DEPTH * NP; ++ph) {
        a.ph_lo = ph; a.ph_hi = ph + 1;
        switch (ph % NP) {
#define LCASE(K) case K: hipLaunchKernelGGL(mk_fwd<K>, dim3(grid), dim3(NTHREADS), LDS_BYTES, stream, a); break
            LCASE(0); LCASE(1); LCASE(2); LCASE(3); LCASE(4); LCASE(5); LCASE(6); LCASE(7); LCASE(8); LCASE(9); LCASE(10); LCASE(11); LCASE(12); LCASE(13); LCASE(14);
        }
    }
#endif
}
```

```cpp
#include <hip/hip_runtime.h>
#include <cstdio>
#include <cstdint>

constexpr int D_MODEL = 1024, BATCH = 4, SEQ = 4096, DEPTH = 2, T = BATCH * SEQ;
constexpr int MEM_LEN = 256;
constexpr int GLA_HEADS = 4, GLA_DK = 48, GLA_DV = 96, GLA_RANK = 16;
constexpr int DSA_HEADS = 6, DSA_DH = 64, IDX_HEADS = 8, IDX_DIM = 64, TOPK = 256;
constexpr int CONV_CH = 256, CONV_W = 31;
constexpr int NUM_BUCKETS = 32;
constexpr int X_HEADS = 4, X_DH = 64, XW = X_HEADS * X_DH;
constexpr int N_GROUPS = 4, EPG = 4, N_EXPERTS = 16, D_EXPERT = 512;
constexpr float NORM_EPS = 1e-6f;
constexpr int D_IN = 3416;
constexpr int Z_GQ = 0, Z_GK = 192, Z_GV = 384, Z_GLR = 768, Z_GR = 784, Z_DQ = 1168, Z_DK = 1552, Z_DV = 1936, Z_IQ = 2320, Z_IK = 2832, Z_IW = 2896, Z_CU = 2904;
constexpr int ZLD = 3584;
constexpr int MIX_GLA = 0, MIX_DSA = 384, MIX_CONV = 768;
constexpr int PADR = 256;
constexpr int MAXROWS = 2 * T + N_EXPERTS * PADR;

typedef unsigned short bf16_t;
typedef float f32x4 __attribute__((ext_vector_type(4)));

constexpr size_t MiB = 1u << 20;
constexpr size_t WS_CTL = 0, CTL_BYTES = 1 * MiB;
constexpr size_t WS_WIN = 1 * MiB, WS_WOUT = 15 * MiB, WS_WCQ = 19 * MiB, WS_WCKV = 20 * MiB, WS_WCO = 22 * MiB;
constexpr size_t WS_XN = 24 * MiB;
constexpr size_t WS_Z = 56 * MiB;
constexpr size_t WS_WGU = WS_Z, WS_WDN = WS_Z + 32 * MiB, WS_HB = WS_Z + 48 * MiB;
constexpr size_t WS_MIX = 168 * MiB;
constexpr size_t WS_QN = 200 * MiB, WS_KN = 212 * MiB;
constexpr size_t WS_VT = 224 * MiB;
constexpr size_t WS_MASK = 236 * MiB;
constexpr size_t WS_IK = 244 * MiB, WS_QL = 246 * MiB, WS_CH = 248 * MiB;
constexpr size_t WS_XG = WS_MIX, WS_DB = WS_MIX;
constexpr size_t WS_CQ = 252 * MiB, WS_COIN = 260 * MiB;
constexpr size_t WS_BCUM = 252 * MiB, WS_SLOC = 264 * MiB, WS_DEC = 282 * MiB;
constexpr size_t WS_MEMN = 284 * MiB;
constexpr size_t WS_CKV = 288 * MiB;
constexpr size_t WS_CKN = 290 * MiB;
constexpr size_t WS_CVT = 292 * MiB;
constexpr size_t WS_ROUTE = 291 * MiB;
constexpr size_t WS_END = 293 * MiB;
constexpr int CW_CNT = 1024;
constexpr int CW_Q3 = 2048, CW_Q4 = 2304;

constexpr int NTHREADS = 512, NWAVES = 8;
constexpr int LDS_BYTES = 147456;

__device__ __forceinline__ float bf2f(bf16_t u) { return __uint_as_float(((unsigned)u) << 16); }
__device__ __forceinline__ bf16_t f2bf(float f) { unsigned u = __float_as_uint(f); return (bf16_t)((u + 0x7fffu + ((u >> 16) & 1u)) >> 16); }
__device__ __forceinline__ unsigned pk2(float lo, float hi) { return (unsigned)f2bf(lo) | ((unsigned)f2bf(hi) << 16); }
__device__ __forceinline__ float wave_sum(float v) {
#pragma unroll
    for (int o = 1; o < 64; o <<= 1) v += __shfl_xor(v, o);
    return v;
}
__device__ __forceinline__ float siluf(float x) { return x / (1.f + __expf(-x)); }
__device__ __forceinline__ float sigmoidf(float x) { return 1.f / (1.f + __expf(-x)); }


typedef short bf16x8 __attribute__((ext_vector_type(8)));
typedef float f32x16 __attribute__((ext_vector_type(16)));
typedef unsigned u32x4v __attribute__((ext_vector_type(4)));
typedef __bf16 bf16x2_t __attribute__((ext_vector_type(2)));
typedef float f32x2_t __attribute__((ext_vector_type(2)));
#define LDSAS __attribute__((address_space(3)))
#define MFMA32(a, b, c) __builtin_amdgcn_mfma_f32_32x32x16_bf16((a), (b), (c), 0, 0, 0)
__device__ __forceinline__ int crow(int reg, int hh) { return (reg & 3) + 8 * (reg >> 2) + 4 * hh; }
__device__ __forceinline__ unsigned pkbf(float a, float b) { f32x2_t v = {a, b}; bf16x2_t r = __builtin_convertvector(v, bf16x2_t); return __builtin_bit_cast(unsigned, r); }

struct Args {
    const float* in[30];
    float* out;
    unsigned char* ws;
    int ph_lo, ph_hi;
};

template <class Epi>
__device__ __forceinline__ void gemm_tile_v1(const int tid, float* lds, const bf16_t* A, int lda, const int* rowidx, int row0,
                                             const float* B, int ldb, int col0, int ncols, int K, const Epi& epi) {
    float* As = lds;
    float* Bs = lds + 16 * 132;
    const int ty = tid >> 4, tx = tid & 15;
    float acc[4][8];
#pragma unroll
    for (int i = 0; i < 4; ++i)
#pragma unroll
        for (int j = 0; j < 8; ++j) acc[i][j] = 0.f;
    const int ar = tid >> 2, ak = (tid & 3) * 4;
    const int grow = rowidx ? rowidx[row0 + ar] : (row0 + ar);
    const bf16_t* ap = A + (size_t)(grow >= 0 ? grow : 0) * lda + ak;
    const bool aval = grow >= 0;
    const int bk = tid >> 5, bn = (tid & 31) * 4;
    const bool bval = bn < ncols;
    const float* bp = B + (size_t)bk * ldb + col0 + bn;
    for (int k0 = 0; k0 < K; k0 += 16) {
        uint2 av = make_uint2(0u, 0u);
        if (aval) av = *(const uint2*)(ap + k0);
        f32x4 bv = (f32x4){0.f, 0.f, 0.f, 0.f};
        if (bval) bv = *(const f32x4*)(bp + (size_t)k0 * ldb);
        __syncthreads();
        As[(ak + 0) * 132 + ar] = __uint_as_float(av.x << 16);
        As[(ak + 1) * 132 + ar] = __uint_as_float(av.x & 0xffff0000u);
        As[(ak + 2) * 132 + ar] = __uint_as_float(av.y << 16);
        As[(ak + 3) * 132 + ar] = __uint_as_float(av.y & 0xffff0000u);
        *(f32x4*)&Bs[bk * 132 + bn] = bv;
        __syncthreads();
#pragma unroll
        for (int k = 0; k < 16; ++k) {
            const f32x4 a4 = *(const f32x4*)&As[k * 132 + ty * 4];
            const f32x4 b0 = *(const f32x4*)&Bs[k * 132 + tx * 8];
            const f32x4 b1 = *(const f32x4*)&Bs[k * 132 + tx * 8 + 4];
#pragma unroll
            for (int i = 0; i < 4; ++i) {
                acc[i][0] += a4[i] * b0[0]; acc[i][1] += a4[i] * b0[1]; acc[i][2] += a4[i] * b0[2]; acc[i][3] += a4[i] * b0[3];
                acc[i][4] += a4[i] * b1[0]; acc[i][5] += a4[i] * b1[1]; acc[i][6] += a4[i] * b1[2]; acc[i][7] += a4[i] * b1[3];
            }
        }
    }
    __syncthreads();
#pragma unroll
    for (int i = 0; i < 4; ++i)
        epi(row0 + ty * 4 + i, col0 + tx * 8, (f32x4){acc[i][0], acc[i][1], acc[i][2], acc[i][3]}, (f32x4){acc[i][4], acc[i][5], acc[i][6], acc[i][7]});
}

template <class Epi>
__device__ __forceinline__ void gemm_v1(const int tid, float* lds, const bf16_t* A, int lda, int M, const float* B, int ldb, int N, int K, const Epi& epi) {
    const int nct = (N + 127) / 128, nrt = M / 128;
    for (int tile = blockIdx.x; tile < nrt * nct; tile += gridDim.x) {
        const int rt = tile / nct, ct = tile % nct;
        const int nc = (N - ct * 128) < 128 ? (N - ct * 128) : 128;
        gemm_tile_v1(tid, lds, A, lda, nullptr, rt * 128, B, ldb, ct * 128, nc, K, epi);
    }
}

namespace pg8 {
#define PG8_LAS __attribute__((address_space(3)))
typedef PG8_LAS unsigned char* PG8_LAS_T;
typedef short bf16x8 __attribute__((ext_vector_type(8)));
typedef unsigned u32x4 __attribute__((ext_vector_type(4)));
constexpr int BM = 256, BK = 64, HALF = 128, HTB = HALF * BK * 2  , STAGE_BYTES = 8 * HTB, NXCD = 8, WGM = 8;

__host__ __device__ __forceinline__ int lds_byte(int r, int c) { const int st = (r >> 4) * 2 + (c >> 5), rr = r & 15, cc = c & 31, ob = rr * 64 + cc * 2; return st * 1024 + (ob ^ (((ob >> 9) & 1) << 5)); }
__host__ __device__ __forceinline__ void stage_rc(int b, int& R, int& C) { const int st = b / 1024, sb = b % 1024, swz = sb ^ (((sb >> 9) & 1) << 5); R = (st >> 1) * 16 + swz / 64; C = (st & 1) * 32 + (swz % 64) / 2; }
__host__ __device__ __forceinline__ int perm32(int rho) { const int n = rho >> 4, i = rho & 15; return 8 * (i >> 2) + 4 * n + (i & 3); }

struct Unit { int pm, pn; };
struct Gemm { const bf16_t* A; const bf16_t* Bt; int M, N, K; };

struct StaticOrder {
    int nM, nN, nwg, G, c;
    __host__ __device__ void init(int M, int N, int G_, int c_) { nM = M / BM; nN = N / BM; nwg = nM * nN; G = G_; c = c_; }
    __host__ __device__ bool next(int i, Unit& u) const {
        const long L = (long)i * G + c; if (L >= nwg) return false;
        int wgid = (int)L; { const int q = nwg / NXCD, r = nwg % NXCD, xcd = wgid % NXCD, off = wgid / NXCD; wgid = (xcd < r ? xcd * (q + 1) : r * (q + 1) + (xcd - r) * q) + off; }
        const int nig = WGM * nN, gid = wgid / nig, fm = gid * WGM, gsz = (nM - fm) < WGM ? (nM - fm) : WGM;
        u.pm = fm + ((wgid % nig) % gsz); u.pn = (wgid % nig) / gsz; return true;
    }
    __device__ __forceinline__ void a_ready(const Unit&) const {}
    __device__ __forceinline__ void done(const Unit&) const {}
};

__device__ __forceinline__ unsigned cvt_pk_bf16(float lo, float hi) { unsigned r; asm volatile("v_cvt_pk_bf16_f32 %0, %1, %2" : "=v"(r) : "v"(lo), "v"(hi)); return r; }
typedef float f32x2 __attribute__((ext_vector_type(2)));
template <class Epi, class Sched, bool ALIGN_EPI = false, bool SP2 = false>
__device__ __forceinline__ void gemm_phase(const int tid, PG8_LAS unsigned char* lds, const Gemm g, const Sched& S, const Epi& E) {
    const int wid = __builtin_amdgcn_readfirstlane(tid >> 6), lane = tid & 63, wr = wid >> 2, wc = wid & 3, fr = lane & 15, fq = lane >> 4;
    const int K = g.K, nt = K / BK;
    unsigned voffA[2], voffB[2];
#pragma unroll
    for (int i = 0; i < 2; ++i) { int R, C; stage_rc(tid * 16 + i * 8192, R, C); const int Rb = Epi::PERM ? ((R & ~31) + perm32(R & 31)) : R;
        voffA[i] = (unsigned)(R * K + C) * 2u; voffB[i] = (unsigned)(Rb * K + C) * 2u; }
    const size_t kstep = (size_t)(BK * 2);
    const size_t hstep = (size_t)HALF * K * 2;
    const size_t tstep = 2 * hstep;
    const unsigned ldsw = (unsigned)wid * 1024u;
    const int aoff = lds_byte(wr * 64 + fr, fq * 8), boff = lds_byte(wc * 32 + fr, fq * 8);
#define PG8_SA(b, h) (((b) * 2 + (h)) * HTB)
#define PG8_SB(b, h) ((4 + (b) * 2 + (h)) * HTB)
#define PG8_STAGE(bufoff, gbase, voff) do { _Pragma("unroll") for (int _i = 0; _i < 2; ++_i) \
        __builtin_amdgcn_global_load_lds((const unsigned*)((const char*)(gbase) + (voff)[_i]), (PG8_LAS unsigned*)(lds + (bufoff) + ldsw + _i * 8192), 16, 0, 0); } while (0)
#define PG8_LDA(dst, b, h) do { _Pragma("unroll") for (int m = 0; m < 4; ++m) _Pragma("unroll") for (int k = 0; k < 2; ++k) dst[m][k] = *(const PG8_LAS bf16x8*)(lds + PG8_SA(b, h) + aoff + m * 2048 + k * 1024); } while (0)
#define PG8_LDB(dst, b, h) do { _Pragma("unroll") for (int n = 0; n < 2; ++n) _Pragma("unroll") for (int k = 0; k < 2; ++k) dst[n][k] = *(const PG8_LAS bf16x8*)(lds + PG8_SB(b, h) + boff + n * 2048 + k * 1024); } while (0)
#define PG8_MMA(ai, bj, At, Bt) do { __builtin_amdgcn_s_setprio(1); _Pragma("unroll") for (int m = 0; m < 4; ++m) _Pragma("unroll") for (int n = 0; n < 2; ++n) _Pragma("unroll") for (int k = 0; k < 2; ++k) \
        acc[ai][bj][m][n] = __builtin_amdgcn_mfma_f32_16x16x32_bf16(Bt[n][k], At[m][k], acc[ai][bj][m][n], 0, 0, 0); __builtin_amdgcn_s_setprio(0); } while (0)
#define PG8_WAIT_V(n) asm volatile("s_waitcnt vmcnt(" #n ")" ::: "memory")
#define PG8_WAIT_L(n) asm volatile("s_waitcnt lgkmcnt(" #n ")" ::: "memory")
#define PG8_BAR __builtin_amdgcn_s_barrier()
#define PG8_SCHED __builtin_amdgcn_sched_barrier(0)
    Unit cur, nxt; int ui = 0;
    if (!S.next(0, cur)) return;
    f32x4 acc[2][2][4][2];
#pragma unroll
    for (int a = 0; a < 2; ++a)
#pragma unroll
        for (int b = 0; b < 2; ++b)
#pragma unroll
            for (int m = 0; m < 4; ++m)
#pragma unroll
                for (int n = 0; n < 2; ++n) acc[a][b][m][n] = (f32x4){0.f, 0.f, 0.f, 0.f};
    bf16x8 At[4][2], B0[2][2], B1[2][2];
    const char* cA = (const char*)g.A + (size_t)cur.pm * tstep; const char* cB = (const char*)g.Bt + (size_t)cur.pn * tstep;
    S.a_ready(cur);
    if constexpr (SP2) {
        PG8_STAGE(PG8_SB(0, 0), cB, voffB); PG8_STAGE(PG8_SB(0, 1), cB + hstep, voffB); PG8_STAGE(PG8_SA(0, 0), cA, voffA); PG8_STAGE(PG8_SA(0, 1), cA + hstep, voffA);
        if (wr == 1) PG8_BAR;
        PG8_WAIT_V(2); PG8_BAR;
        PG8_STAGE(PG8_SB(1, 0), cB + kstep, voffB); PG8_STAGE(PG8_SA(1, 0), cA + kstep, voffA); PG8_STAGE(PG8_SB(1, 1), cB + hstep + kstep, voffB);
        PG8_WAIT_V(6); PG8_BAR;
    } else {
        PG8_STAGE(PG8_SB(0, 0), cB, voffB); PG8_STAGE(PG8_SA(0, 0), cA, voffA); PG8_STAGE(PG8_SB(0, 1), cB + hstep, voffB); PG8_STAGE(PG8_SA(0, 1), cA + hstep, voffA);
        if (wr == 1) PG8_BAR;
        PG8_WAIT_V(4); PG8_BAR;
        PG8_STAGE(PG8_SB(1, 0), cB + kstep, voffB); PG8_STAGE(PG8_SA(1, 0), cA + kstep, voffA); PG8_STAGE(PG8_SB(1, 1), cB + hstep + kstep, voffB);
        PG8_WAIT_V(6); PG8_BAR;
    }
    for (;;) {
        const bool has_next = S.next(ui + 1, nxt);
        const char* nA = has_next ? (const char*)g.A + (size_t)nxt.pm * tstep : cA; const char* nB = has_next ? (const char*)g.Bt + (size_t)nxt.pn * tstep : cB;
        for (int t = 0; t < nt; t += 2) {
            const bool last = (t == nt - 2);
            const char* a1 = cA + (size_t)(t + 1) * kstep;
            const char* a2 = last ? nA : cA + (size_t)(t + 2) * kstep; const char* b2 = last ? nB : cB + (size_t)(t + 2) * kstep;
            const char* a3 = a2 + kstep; const char* b3 = b2 + kstep;
            if (last && has_next) S.a_ready(nxt);
            if constexpr (SP2) {
            PG8_LDB(B0, 0, 0); PG8_LDB(B1, 0, 1); PG8_SCHED; PG8_LDA(At, 0, 0); PG8_STAGE(PG8_SA(1, 1), a1 + hstep, voffA);
            PG8_WAIT_V(8); PG8_WAIT_L(0); PG8_BAR; PG8_MMA(0, 0, At, B0); PG8_MMA(0, 1, At, B1); PG8_BAR; PG8_SCHED;
            PG8_LDA(At, 0, 1); PG8_STAGE(PG8_SB(0, 0), b2, voffB); PG8_STAGE(PG8_SB(0, 1), b2 + hstep, voffB); PG8_STAGE(PG8_SA(0, 0), a2, voffA);
            PG8_WAIT_V(8); PG8_WAIT_L(0); PG8_BAR; PG8_MMA(1, 0, At, B0); PG8_MMA(1, 1, At, B1); PG8_BAR; PG8_SCHED;
            PG8_LDB(B0, 1, 0); PG8_LDB(B1, 1, 1); PG8_SCHED; PG8_LDA(At, 1, 0); PG8_STAGE(PG8_SA(0, 1), a2 + hstep, voffA);
            PG8_WAIT_V(8); PG8_WAIT_L(0); PG8_BAR; PG8_MMA(0, 0, At, B0); PG8_MMA(0, 1, At, B1); PG8_BAR; PG8_SCHED;
            PG8_LDA(At, 1, 1); PG8_STAGE(PG8_SB(1, 0), b3, voffB); PG8_STAGE(PG8_SB(1, 1), b3 + hstep, voffB); PG8_STAGE(PG8_SA(1, 0), a3, voffA);
            PG8_WAIT_V(8); PG8_WAIT_L(0); PG8_BAR; PG8_MMA(1, 0, At, B0); PG8_MMA(1, 1, At, B1); PG8_BAR; PG8_SCHED;
            } else {
            PG8_LDB(B0, 0, 0); PG8_SCHED; PG8_LDA(At, 0, 0); PG8_STAGE(PG8_SA(1, 1), a1 + hstep, voffA);
            PG8_WAIT_L(8); PG8_BAR; PG8_WAIT_L(0); PG8_MMA(0, 0, At, B0); PG8_BAR; PG8_SCHED;
            PG8_LDB(B1, 0, 1); PG8_STAGE(PG8_SB(0, 0), b2, voffB);
            PG8_BAR; PG8_WAIT_L(0); PG8_MMA(0, 1, At, B1); PG8_BAR;
            PG8_LDA(At, 0, 1); PG8_STAGE(PG8_SA(0, 0), a2, voffA);
            PG8_BAR; PG8_WAIT_L(0); PG8_MMA(1, 0, At, B0); PG8_BAR; PG8_SCHED;
            PG8_STAGE(PG8_SB(0, 1), b2 + hstep, voffB);
            PG8_WAIT_V(6); PG8_BAR; PG8_MMA(1, 1, At, B1); PG8_BAR;
            PG8_LDB(B0, 1, 0); PG8_SCHED; PG8_LDA(At, 1, 0); PG8_STAGE(PG8_SA(0, 1), a2 + hstep, voffA);
            PG8_WAIT_L(8); PG8_BAR; PG8_WAIT_L(0); PG8_MMA(0, 0, At, B0); PG8_BAR; PG8_SCHED;
            PG8_LDB(B1, 1, 1); PG8_STAGE(PG8_SB(1, 0), b3, voffB);
            PG8_BAR; PG8_WAIT_L(0); PG8_MMA(0, 1, At, B1); PG8_BAR;
            PG8_LDA(At, 1, 1); PG8_STAGE(PG8_SA(1, 0), a3, voffA);
            PG8_BAR; PG8_WAIT_L(0); PG8_MMA(1, 0, At, B0); PG8_BAR; PG8_SCHED;
            PG8_STAGE(PG8_SB(1, 1), b3 + hstep, voffB);
            PG8_WAIT_V(6); PG8_BAR; PG8_MMA(1, 1, At, B1); PG8_BAR;
            }
        }
        if constexpr (ALIGN_EPI) { if (wr == 0) PG8_BAR; }
        if constexpr (!Epi::AFTER_DRAIN) { E(acc, cur, wr, wc, fr, fq); S.done(cur); }
        if (!has_next) break;
#pragma unroll
        for (int a = 0; a < 2; ++a)
#pragma unroll
            for (int b = 0; b < 2; ++b)
#pragma unroll
                for (int m = 0; m < 4; ++m)
#pragma unroll
                    for (int n = 0; n < 2; ++n) acc[a][b][m][n] = (f32x4){0.f, 0.f, 0.f, 0.f};
        cur = nxt; cA = nA; cB = nB; ++ui;
        if constexpr (ALIGN_EPI) { if (wr == 1) PG8_BAR; }
    }
    PG8_WAIT_V(0);
    if constexpr (!ALIGN_EPI) { if (wr == 0) PG8_BAR; }
    PG8_BAR;
    if constexpr (Epi::AFTER_DRAIN) { E.fused(acc, cur, wr, wc, fr, fq, lds, wid, lane); S.done(cur); }
#undef PG8_SA
#undef PG8_SB
#undef PG8_STAGE
#undef PG8_LDA
#undef PG8_LDB
#undef PG8_MMA
#undef PG8_WAIT_V
#undef PG8_WAIT_L
#undef PG8_BAR
#undef PG8_SCHED
}

struct EpiStoreBf16 {
    static constexpr bool PERM = true, AFTER_DRAIN = false;
    bf16_t* O; int ldc; int pnmask;
    __device__ __forceinline__ void operator()(const f32x4 (&acc)[2][2][4][2], const Unit& u, int wr, int wc, int fr, int fq) const {
        const int row0 = u.pm * BM + wr * 64 + fr; const int col0 = (u.pn & pnmask) * BM + wc * 32 + 8 * fq;
#pragma unroll
        for (int ai = 0; ai < 2; ++ai)
#pragma unroll
            for (int m = 0; m < 4; ++m) { bf16_t* rowp = O + (size_t)(row0 + ai * HALF + m * 16) * ldc + col0;
#pragma unroll
                for (int bj = 0; bj < 2; ++bj) { const f32x4 v0 = acc[ai][bj][m][0], v1 = acc[ai][bj][m][1];
                    u32x4 w; w.x = cvt_pk_bf16(v0[0], v0[1]); w.y = cvt_pk_bf16(v0[2], v0[3]); w.z = cvt_pk_bf16(v1[0], v1[1]); w.w = cvt_pk_bf16(v1[2], v1[3]);
                    *(u32x4*)(rowp + bj * HALF) = w; } }
    }
};
struct EpiRes {
    static constexpr bool PERM = false, AFTER_DRAIN = false;
    const float* base; float* out; int ldc;
    __device__ __forceinline__ void operator()(const f32x4 (&acc)[2][2][4][2], const Unit& u, int wr, int wc, int fr, int fq) const {
        const int row0 = u.pm * BM + wr * 64 + fr; const int col0 = u.pn * BM + wc * 32 + 4 * fq;
#pragma unroll
        for (int ai = 0; ai < 2; ++ai)
#pragma unroll
            for (int m = 0; m < 4; ++m) { const size_t off = (size_t)(row0 + ai * HALF + m * 16) * ldc + col0;
#pragma unroll
                for (int bj = 0; bj < 2; ++bj)
#pragma unroll
                    for (int n = 0; n < 2; ++n) { const f32x4 b = *(const f32x4*)(base + off + bj * HALF + n * 16); *(f32x4*)(out + off + bj * HALF + n * 16) = b + acc[ai][bj][m][n]; } }
    }
};
struct EpiGateUp {
    static constexpr bool PERM = true, AFTER_DRAIN = false;
    bf16_t* O; int ldc;
    __device__ __forceinline__ static float silu(float x) { return x / (1.f + __expf(-x)); }
    __device__ __forceinline__ void operator()(const f32x4 (&acc)[2][2][4][2], const Unit& u, int wr, int wc, int fr, int fq) const {
        const int row0 = u.pm * BM + wr * 64 + fr; const int col0 = ((u.pn & 3) * BM + wc * 32 + 8 * fq) >> 1;
#pragma unroll
        for (int ai = 0; ai < 2; ++ai)
#pragma unroll
            for (int m = 0; m < 4; ++m) { bf16_t* rowp = O + (size_t)(row0 + ai * HALF + m * 16) * ldc + col0;
#pragma unroll
                for (int bj = 0; bj < 2; ++bj) { const f32x4 v0 = acc[ai][bj][m][0], v1 = acc[ai][bj][m][1];
                    uint2 w; w.x = cvt_pk_bf16(silu(v0[0]) * v0[1], silu(v0[2]) * v0[3]); w.y = cvt_pk_bf16(silu(v1[0]) * v1[1], silu(v1[2]) * v1[3]);
                    *(uint2*)(rowp + bj * (HALF / 2)) = w; } }
    }
};
struct GroupSched {
    int off[17]; int nunits, G, c;
    __device__ __forceinline__ bool next(int i, Unit& u) const {
        const int L = i * G + c; if (L >= nunits) return false;
        const int rt = L >> 2, pn = L & 3, row0 = rt * BM; int e = 0;
#pragma unroll
        for (int q = 1; q < 16; ++q) e = (row0 >= off[q]) ? q : e;
        u.pm = rt; u.pn = e * 4 + pn; return true;
    }
    __device__ __forceinline__ void a_ready(const Unit&) const {}
    __device__ __forceinline__ void done(const Unit&) const {}
};
}

__device__ __forceinline__ void rmsnorm_row_bf16(const float* xrow, const float* g, bf16_t* orow, int lane) {
    f32x4 v[4]; float s = 0.f;
#pragma unroll
    for (int j = 0; j < 4; ++j) { v[j] = *(const f32x4*)(xrow + lane * 4 + 256 * j); s += v[j][0] * v[j][0] + v[j][1] * v[j][1] + v[j][2] * v[j][2] + v[j][3] * v[j][3]; }
    const float rinv = 1.0f / sqrtf(wave_sum(s) * (1.f / 1024.f) + NORM_EPS);
#pragma unroll
    for (int j = 0; j < 4; ++j) {
        const f32x4 gg = *(const f32x4*)(g + lane * 4 + 256 * j);
        uint2 o; o.x = pk2(v[j][0] * rinv * gg[0], v[j][1] * rinv * gg[1]); o.y = pk2(v[j][2] * rinv * gg[2], v[j][3] * rinv * gg[3]);
        *(uint2*)(orow + lane * 4 + 256 * j) = o;
    }
}

__device__ __forceinline__ void transpose_item(const float* W, int K, int N, int nblk, bf16_t* WT, int row_off, int rmul, int radd, float* scr, int item, int lane) {
    const int kb = item / nblk, nb = item % nblk, k0 = 64 * kb, n0 = 32 * nb;
    const bool nv = (n0 + (lane & 31)) < N;
#pragma unroll 8
    for (int i = 0; i < 32; ++i) { const int kk = 2 * i + (lane >> 5); scr[kk * 33 + (lane & 31)] = nv ? W[(size_t)(k0 + kk) * N + n0 + (lane & 31)] : 0.f; }
    __builtin_amdgcn_s_waitcnt(0xc07f); __builtin_amdgcn_wave_barrier();
    const int c = lane & 7;
#pragma unroll
    for (int j = 0; j < 4; ++j) { const int n = (lane >> 3) + 8 * j; const float* sp = scr + (8 * c) * 33 + n;
        uint4 o; o.x = pk2(sp[0 * 33], sp[1 * 33]); o.y = pk2(sp[2 * 33], sp[3 * 33]); o.z = pk2(sp[4 * 33], sp[5 * 33]); o.w = pk2(sp[6 * 33], sp[7 * 33]);
        *(uint4*)(WT + (size_t)(row_off + (n0 + n) * rmul + radd) * K + k0 + 8 * c) = o; }
    __builtin_amdgcn_s_waitcnt(0xc07f); __builtin_amdgcn_wave_barrier();
}

__device__ __forceinline__ int t5_bucket(int dist) {
    if (dist < 16) return dist;
    const float d = (float)dist;
    int large = 16 + (int)(__logf(d * (1.f / 16.f)) * (16.0f / 2.0794415416798357f));
    return large < 31 ? large : 31;
}
__device__ __forceinline__ unsigned fkey(float f) { const unsigned u = __float_as_uint(f + 0.0f); return (u & 0x80000000u) ? ~u : (u | 0x80000000u); }


#define LAS __attribute__((address_space(3)))
#define XB_TMO      128
#define XB_XCNT(j)  (256  + 64 * (j))
#define XB_XSUB(j)  (1280 + 64 * (j))
#define XB_XGEN(j)  (2304 + 64 * (j))
#define XB_TOP      3328
#define XB_TOPGEN   3392
#define XCD_BAR_WORDS 3456
#define XB_SPIN_CAP (1u << 24)
__device__ __forceinline__ unsigned xb_ld(unsigned* p)              { return __hip_atomic_load(p, __ATOMIC_RELAXED, __HIP_MEMORY_SCOPE_AGENT); }
__device__ __forceinline__ unsigned xb_add(unsigned* p, unsigned v) { return __hip_atomic_fetch_add(p, v, __ATOMIC_RELAXED, __HIP_MEMORY_SCOPE_AGENT); }
__device__ __forceinline__ unsigned xb_xcc_id() { return (unsigned)__builtin_amdgcn_s_getreg((3 << 11) | 20) & 0xFu; }
#define XB_SPIN(cond, bar) do { unsigned _sp = 0; while (cond) { __builtin_amdgcn_s_sleep(1); \
    if ((++_sp & 255u) == 0u) { if (xb_ld(&(bar)[XB_TMO])) break; if (_sp > XB_SPIN_CAP) { atomicAdd(&(bar)[XB_TMO], 1u); break; } } } } while (0)
struct XcdBarrier { unsigned* bar; unsigned x; volatile LAS unsigned* st; };
__device__ __forceinline__ XcdBarrier xcd_barrier_post(unsigned* bar, volatile LAS unsigned* st) {
    XcdBarrier b; b.bar = bar; b.x = xb_xcc_id(); b.st = st;
    if (threadIdx.x == 0) (void)xb_add(&bar[XB_XCNT(b.x)], 1u);
    return b;
}
__device__ __forceinline__ void xcd_barrier_complete(unsigned* bar, unsigned x, unsigned& nloc, unsigned& nx) {
    const unsigned G = gridDim.x * gridDim.y * gridDim.z;
    unsigned sum, cnt, mine, sp = 0u;
    for (;;) {
        sum = 0u; cnt = 0u; mine = 0u;
#pragma unroll
        for (unsigned j = 0; j < 16; ++j) { const unsigned c = xb_ld(&bar[XB_XCNT(j)]); sum += c; cnt += (c > 0u) ? 1u : 0u; mine = (j == x) ? c : mine; }
        if (sum == G) break;
        __builtin_amdgcn_s_sleep(1);
        if ((++sp & 255u) == 0u) { if (xb_ld(&bar[XB_TMO])) break; if (sp > XB_SPIN_CAP) { atomicAdd(&bar[XB_TMO], 1u); break; } }
    }
    nloc = mine > 0u ? mine : 1u; nx = cnt > 0u ? cnt : 1u;
}
__device__ __forceinline__ void xcd_barrier(const XcdBarrier& b) {
    asm volatile("s_waitcnt vmcnt(0)" ::: "memory");
    __syncthreads();
    if (threadIdx.x == 0) {
        unsigned* bar = b.bar;
        __builtin_amdgcn_s_waitcnt(0);
        unsigned nloc = b.st[0], nx = b.st[1];
        if (nloc == 0u) { xcd_barrier_complete(bar, b.x, nloc, nx); b.st[0] = nloc; b.st[1] = nx; }
        const unsigned old = xb_add(&bar[XB_XSUB(b.x)], 1u);
        const unsigned gen = old / nloc;
        if (old + 1u == (gen + 1u) * nloc) {
            __builtin_amdgcn_fence(__ATOMIC_RELEASE, "agent");
            asm volatile("s_waitcnt vmcnt(0)" ::: "memory");
            const unsigned og = xb_add(&bar[XB_TOP], 1u);
            const unsigned tg = og / nx;
            if (og + 1u == (tg + 1u) * nx) xb_add(&bar[XB_TOPGEN], 1u);
            else XB_SPIN(xb_ld(&bar[XB_TOPGEN]) == tg, bar);
            __builtin_amdgcn_fence(__ATOMIC_ACQUIRE, "agent");
            xb_add(&bar[XB_XGEN(b.x)], 1u);
            asm volatile("s_waitcnt vmcnt(0)" ::: "memory");
        } else {
            XB_SPIN(xb_ld(&bar[XB_XGEN(b.x)]) == gen, bar);
            __builtin_amdgcn_fence(__ATOMIC_ACQUIRE, "agent");
            asm volatile("s_waitcnt vmcnt(0)" ::: "memory");
        }
    }
    __syncthreads();
}
constexpr int CW_BAR = 4096;
constexpr int LDSCTL_OFF = LDS_BYTES - 256;

constexpr int NP = 15;
#ifndef MK_PHMASK
#define MK_PHMASK 0x7fff
#endif
#define PH_ON(x) (((MK_PHMASK) >> (x)) & 1)

template <int KSEL>
__global__ void __launch_bounds__(NTHREADS, 2) mk_fwd(Args args) {
    extern __shared__ __attribute__((aligned(16))) unsigned char lds_raw[];
    float* ldsf = (float*)lds_raw;
    const int G = gridDim.x, bid = blockIdx.x, NGW = G * NWAVES;
    unsigned char* ws = args.ws;
    unsigned* ctl = (unsigned*)(ws + WS_CTL);
    bf16_t* XN = (bf16_t*)(ws + WS_XN);
    bf16_t* Z = (bf16_t*)(ws + WS_Z);
    bf16_t* XG = (bf16_t*)(ws + WS_XG);
    bf16_t* VT = (bf16_t*)(ws + WS_VT); unsigned* MASK = (unsigned*)(ws + WS_MASK); bf16_t* IK = (bf16_t*)(ws + WS_IK); bf16_t* QL = (bf16_t*)(ws + WS_QL); float* CH = (float*)(ws + WS_CH);
    float* BCUM = (float*)(ws + WS_BCUM); float* SLOC = (float*)(ws + WS_SLOC); float* DEC = (float*)(ws + WS_DEC);
    bf16_t* WIN = (bf16_t*)(ws + WS_WIN); bf16_t* WOUT = (bf16_t*)(ws + WS_WOUT); bf16_t* WCQ = (bf16_t*)(ws + WS_WCQ); bf16_t* WCKV = (bf16_t*)(ws + WS_WCKV); bf16_t* WCO = (bf16_t*)(ws + WS_WCO);
    bf16_t* WGU = (bf16_t*)(ws + WS_WGU); bf16_t* WDN = (bf16_t*)(ws + WS_WDN);
    pg8::PG8_LAS_T ldsq = (pg8::PG8_LAS_T)lds_raw;
    bf16_t* HB = (bf16_t*)(ws + WS_HB);
    bf16_t* MIX = (bf16_t*)(ws + WS_MIX);
    bf16_t* DB = (bf16_t*)(ws + WS_DB);
    bf16_t* QN = (bf16_t*)(ws + WS_QN);
    bf16_t* KN = (bf16_t*)(ws + WS_KN);
    bf16_t* CQ = (bf16_t*)(ws + WS_CQ);
    bf16_t* COIN = (bf16_t*)(ws + WS_COIN);
    bf16_t* MEMN = (bf16_t*)(ws + WS_MEMN);
    bf16_t* CKV = (bf16_t*)(ws + WS_CKV);
    bf16_t* CKN = (bf16_t*)(ws + WS_CKN);
    bf16_t* CVT = (bf16_t*)(ws + WS_CVT);
    int* tok_e = (int*)(ws + WS_ROUTE);
    int* tok_r = tok_e + 2 * T;
    float* tok_g = (float*)(tok_r + 2 * T);
    float* OUT = args.out;
    XcdBarrier bar; bar.bar = ctl + CW_BAR; bar.x = 0; bar.st = nullptr;
    if (KSEL < 0) {
        volatile LAS unsigned* st = (volatile LAS unsigned*)((LAS unsigned char*)lds_raw + LDSCTL_OFF);
        if (threadIdx.x < 64) st[threadIdx.x] = 0u;
        __syncthreads();
        bar = xcd_barrier_post(ctl + CW_BAR, st);
    }

#ifndef MK_REPEAT_PH
#define MK_REPEAT_PH (-1)
#define MK_REPEAT_N 0
#endif
    const int nvirt = (args.ph_hi - args.ph_lo) + ((MK_REPEAT_PH >= 0) ? MK_REPEAT_N : 0);
    for (int vi = 0; vi < nvirt; ++vi) {
        const int ph = (MK_REPEAT_PH < 0 || vi <= MK_REPEAT_PH) ? args.ph_lo + vi : ((vi <= MK_REPEAT_PH + MK_REPEAT_N) ? MK_REPEAT_PH : args.ph_lo + vi - MK_REPEAT_N);
        const int rep = (MK_REPEAT_PH >= 0 && vi > MK_REPEAT_PH && vi <= MK_REPEAT_PH + MK_REPEAT_N) ? vi - MK_REPEAT_PH : 0;
        if (KSEL < 0 && vi > 0) xcd_barrier(bar);
        int tid_op = threadIdx.x; asm volatile("" : "+v"(tid_op));
        const int tid = tid_op, lane = tid & 63, wave = __builtin_amdgcn_readfirstlane(tid >> 6), gw = bid * NWAVES + wave;
#ifdef MK_PROF_A
        if (bid == 0 && tid == 0) ctl[8192 + ph] = (unsigned)__builtin_amdgcn_s_memrealtime();
#endif
        const int l = ph / NP, k = (KSEL >= 0) ? KSEL : (ph % NP);
        const float* xin = (l == 0) ? args.in[0] : OUT;
        unsigned* cnt = ctl + CW_CNT + 64 * l;

        if (k == 0 && PH_ON(0)) {
            const float* g = args.in[3] + l * D_MODEL;
            for (int r = gw; r < T; r += NGW) rmsnorm_row_bf16(xin + (size_t)r * D_MODEL, g, XN + (size_t)r * D_MODEL, lane);
            if (l == 0) {
                float* scr = ldsf + wave * (64 * 33);
                constexpr int I_IN = 16 * 112, I_OUT = 16 * 32, I_CQ = 16 * 8, I_CKV = 16 * 16, I_CO = 4 * 32, I_L = I_IN + I_OUT + I_CQ + I_CKV + I_CO;
                for (int it = gw; it < DEPTH * I_L; it += NGW) {
                    const int ll = it / I_L; int r = it % I_L;
                    if (r < I_IN) { transpose_item(args.in[4] + (size_t)ll * D_MODEL * D_IN, D_MODEL, D_IN, 112, WIN + (size_t)ll * ZLD * D_MODEL, 0, 1, 0, scr, r, lane); continue; } r -= I_IN;
                    if (r < I_OUT) { transpose_item(args.in[14] + (size_t)ll * D_MODEL * D_MODEL, D_MODEL, D_MODEL, 32, WOUT + (size_t)ll * D_MODEL * D_MODEL, 0, 1, 0, scr, r, lane); continue; } r -= I_OUT;
                    if (r < I_CQ) { transpose_item(args.in[17] + (size_t)ll * D_MODEL * XW, D_MODEL, XW, 8, WCQ + (size_t)ll * XW * D_MODEL, 0, 1, 0, scr, r, lane); continue; } r -= I_CQ;
                    if (r < I_CKV) { transpose_item(args.in[18] + (size_t)ll * D_MODEL * 512, D_MODEL, 512, 16, WCKV + (size_t)ll * 512 * D_MODEL, 0, 1, 0, scr, r, lane); continue; } r -= I_CKV;
                    transpose_item(args.in[21] + (size_t)ll * XW * D_MODEL, XW, D_MODEL, 32, WCO + (size_t)ll * D_MODEL * XW, 0, 1, 0, scr, r, lane);
                }
            }
            if (l == 0)
                for (int r = gw; r < 2 * BATCH * MEM_LEN; r += NGW) {
                    const int ll = r / (BATCH * MEM_LEN), rr = r % (BATCH * MEM_LEN);
                    rmsnorm_row_bf16(args.in[1] + (size_t)rr * D_MODEL, args.in[16] + ll * D_MODEL, MEMN + (size_t)r * D_MODEL, lane);
                }
        } else if (k == 1 && PH_ON(1)) {
            {
                pg8::Gemm g{XN, WIN + (size_t)l * ZLD * D_MODEL, T, ZLD, D_MODEL}; pg8::StaticOrder S; S.init(T, ZLD, G, bid);
                pg8::EpiStoreBf16 E{Z, ZLD, 0xffff};
                pg8::gemm_phase<pg8::EpiStoreBf16, pg8::StaticOrder, true, true>(tid, ldsq, g, S, E);
            }
            if (l == 0)
                for (int ll = 0; ll < DEPTH; ++ll) {
                    pg8::Gemm g{MEMN + (size_t)ll * BATCH * MEM_LEN * D_MODEL, WCKV + (size_t)ll * 512 * D_MODEL, BATCH * MEM_LEN, 512, D_MODEL}; pg8::StaticOrder S; S.init(BATCH * MEM_LEN, 512, G, bid);
                    pg8::EpiStoreBf16 E{CKV + (size_t)ll * BATCH * MEM_LEN * 512, 512, 0xffff};
                    pg8::gemm_phase<pg8::EpiStoreBf16, pg8::StaticOrder, true, true>(tid, ldsq, g, S, E);
                }
        } else if (k == 2 && PH_ON(2)) {
            {
                float* lr = ldsf;
                float* la = ldsf + 1024;
                float* ks = ldsf + 4160;
                float* vs = ldsf + 7488;
                float* seg = ldsf + 13888;
                const float* wa2 = args.in[5] + (size_t)l * GLA_RANK * 192;
                const float* ba = args.in[6] + l * 192;
                for (int item = bid; item < BATCH * GLA_HEADS * 64; item += G) {
                    const int bh = item >> 6, c = item & 63, b = bh >> 2, h = bh & 3, tok0 = b * SEQ + c * 64;
                    __syncthreads();
                    if (tid < 128) { const int t = tid >> 1, c8 = (tid & 1) * 8; const uint4 u = *(const uint4*)(Z + (size_t)(tok0 + t) * ZLD + Z_GLR + c8);
                        *(f32x4*)&lr[t * 16 + c8] = (f32x4){__uint_as_float(u.x << 16), __uint_as_float(u.x & 0xffff0000u), __uint_as_float(u.y << 16), __uint_as_float(u.y & 0xffff0000u)};
                        *(f32x4*)&lr[t * 16 + c8 + 4] = (f32x4){__uint_as_float(u.z << 16), __uint_as_float(u.z & 0xffff0000u), __uint_as_float(u.w << 16), __uint_as_float(u.w & 0xffff0000u)}; }
                    if (tid < 384) { const int t = tid / 6, c8 = (tid % 6) * 8; const uint4 u = *(const uint4*)(Z + (size_t)(tok0 + t) * ZLD + Z_GK + h * 48 + c8);
                        *(f32x4*)&ks[t * 52 + c8] = (f32x4){__uint_as_float(u.x << 16), __uint_as_float(u.x & 0xffff0000u), __uint_as_float(u.y << 16), __uint_as_float(u.y & 0xffff0000u)};
                        *(f32x4*)&ks[t * 52 + c8 + 4] = (f32x4){__uint_as_float(u.z << 16), __uint_as_float(u.z & 0xffff0000u), __uint_as_float(u.w << 16), __uint_as_float(u.w & 0xffff0000u)}; }
                    for (int i = tid; i < 64 * 12; i += NTHREADS) { const int t = i / 12, c8 = (i % 12) * 8; const uint4 u = *(const uint4*)(Z + (size_t)(tok0 + t) * ZLD + Z_GV + h * 96 + c8);
                        *(f32x4*)&vs[t * 100 + c8] = (f32x4){__uint_as_float(u.x << 16), __uint_as_float(u.x & 0xffff0000u), __uint_as_float(u.y << 16), __uint_as_float(u.y & 0xffff0000u)};
                        *(f32x4*)&vs[t * 100 + c8 + 4] = (f32x4){__uint_as_float(u.z << 16), __uint_as_float(u.z & 0xffff0000u), __uint_as_float(u.w << 16), __uint_as_float(u.w & 0xffff0000u)}; }
                    __syncthreads();
                    for (int i = tid; i < 64 * 48; i += NTHREADS) { const int t = i / 48, d = i % 48;
                        float x = ba[h * 48 + d];
#pragma unroll
                        for (int r = 0; r < GLA_RANK; ++r) x += lr[t * 16 + r] * wa2[r * 192 + h * 48 + d];
                        la[t * 49 + d] = (fminf(x, 0.f) - log1pf(__expf(-fabsf(x)))) * (1.f / 16.f); }
                    __syncthreads();
                    const int cd = tid % 48, cs = tid / 48;
                    if (tid < 384) { float run = 0.f;
#pragma unroll
                        for (int j2 = 0; j2 < 8; ++j2) { run += la[(cs * 8 + j2) * 49 + cd]; la[(cs * 8 + j2) * 49 + cd] = run; }
                        seg[cs * 48 + cd] = run; }
                    __syncthreads();
                    if (tid < 384) { float base = 0.f;
                        for (int q = 0; q < cs; ++q) base += seg[q * 48 + cd];
#pragma unroll
                        for (int j2 = 0; j2 < 8; ++j2) { const float v = la[(cs * 8 + j2) * 49 + cd] + base; la[(cs * 8 + j2) * 49 + cd] = v; BCUM[(size_t)(tok0 + cs * 8 + j2) * 192 + h * 48 + cd] = v; } }
                    __syncthreads();
                    for (int i = tid; i < 64 * 48; i += NTHREADS) { const int t = i / 48, d = i % 48; ks[t * 52 + d] *= __expf(la[63 * 49 + d] - la[t * 49 + d]); }
                    if (tid < 48) DEC[(size_t)item * 48 + tid] = __expf(la[63 * 49 + tid]);
                    __syncthreads();
                    if (tid < 288) {
                        const int d0 = (tid / 24) * 4, v0 = (tid % 24) * 4;
                        float acc[4][4];
#pragma unroll
                        for (int x = 0; x < 4; ++x)
#pragma unroll
                            for (int y = 0; y < 4; ++y) acc[x][y] = 0.f;
#pragma unroll 4
                        for (int sidx = 0; sidx < 64; ++sidx) { const f32x4 kv = *(const f32x4*)&ks[sidx * 52 + d0], vv = *(const f32x4*)&vs[sidx * 100 + v0];
#pragma unroll
                            for (int x = 0; x < 4; ++x)
#pragma unroll
                                for (int y = 0; y < 4; ++y) acc[x][y] += kv[x] * vv[y]; }
#pragma unroll
                        for (int x = 0; x < 4; ++x) *(f32x4*)(SLOC + (size_t)item * 4608 + (d0 + x) * 96 + v0) = (f32x4){acc[x][0], acc[x][1], acc[x][2], acc[x][3]};
                    }
                }
                __syncthreads();
            }
            {
                const float* gq = args.in[8] + l * DSA_DH; const float* gk = args.in[9] + l * DSA_DH;
                const float gql = gq[lane], gkl = gk[lane];
                for (int r = gw; r < T; r += NGW) {
                    const bf16_t* zr = Z + (size_t)r * ZLD;
#pragma unroll
                    for (int h = 0; h < DSA_HEADS; ++h) {
                        const float q = bf2f(zr[Z_DQ + h * 64 + lane]), kk = bf2f(zr[Z_DK + h * 64 + lane]);
                        const float rq = 1.0f / sqrtf(wave_sum(q * q) * (1.f / 64.f) + NORM_EPS), rk = 1.0f / sqrtf(wave_sum(kk * kk) * (1.f / 64.f) + NORM_EPS);
                        QN[(size_t)r * 384 + h * 64 + lane] = f2bf(q * rq * gql * (0.125f * 1.4426950408889634f));
                        KN[(size_t)r * 384 + h * 64 + lane] = f2bf(kk * rk * gkl);
                    }
                    float qlv = 0.f, myc = 0.f;
#pragma unroll
                    for (int h = 0; h < IDX_HEADS; ++h) { const float c = bf2f(zr[Z_IW + h]) * (0.35355339059327373f * 0.0625f); qlv += c * bf2f(zr[Z_IQ + h * 64 + lane]); myc = (lane == h) ? c : myc; }
                    QL[(size_t)r * 64 + lane] = f2bf(qlv);
                    if (lane < 8) CH[(size_t)r * 8 + lane] = myc;
                    IK[(size_t)r * 64 + lane] = zr[Z_IK + lane];
                }
            }
            for (int tile = bid; tile < BATCH * 128; tile += G) {
                if (tid < 384) {
                    const bf16_t* zb = Z + (size_t)(tile * 32) * ZLD + Z_DV + tid;
                    unsigned w[16];
#pragma unroll
                    for (int p2 = 0; p2 < 16; ++p2) {
                        const int p = 2 * p2, sst = p >> 4, hh2 = (p >> 3) & 1, j = p & 7;
                        const int key0 = 16 * sst + 8 * (j >> 2) + 4 * hh2 + (j & 3);
                        w[p2] = (unsigned)zb[(size_t)key0 * ZLD] | ((unsigned)zb[(size_t)(key0 + 1) * ZLD] << 16);
                    }
                    uint4* dst = (uint4*)(VT + ((size_t)tile * 384 + tid) * 32);
                    dst[0] = make_uint4(w[0], w[1], w[2], w[3]); dst[1] = make_uint4(w[4], w[5], w[6], w[7]); dst[2] = make_uint4(w[8], w[9], w[10], w[11]); dst[3] = make_uint4(w[12], w[13], w[14], w[15]);
                }
            }
            if (l == 0) {
                for (int i = bid * NTHREADS + tid; i < DEPTH * BATCH * X_HEADS * 64 * MEM_LEN; i += G * NTHREADS) {
                    const int p = i & 255, d = (i >> 8) & 63, h = (i >> 14) & 3, bb = (i >> 16) & 3, ll = i >> 18;
                    const int pg = p & 31, sst = pg >> 4, hh2 = (pg >> 3) & 1, j2 = pg & 7;
                    const int key = (p & ~31) + 16 * sst + 8 * (j2 >> 2) + 4 * hh2 + (j2 & 3);
                    CVT[i] = CKV[((size_t)ll * BATCH * MEM_LEN + (size_t)bb * MEM_LEN + key) * 512 + 256 + h * 64 + d];
                }
                for (int r = gw; r < DEPTH * BATCH * MEM_LEN; r += NGW) {
                    const int ll = r / (BATCH * MEM_LEN);
                    const float gkl = args.in[20][ll * X_DH + lane];
#pragma unroll
                    for (int h = 0; h < X_HEADS; ++h) {
                        const float kk = bf2f(CKV[(size_t)r * 512 + h * 64 + lane]);
                        const float rk = 1.0f / sqrtf(wave_sum(kk * kk) * (1.f / 64.f) + NORM_EPS);
                        CKN[(size_t)r * 256 + h * 64 + lane] = f2bf(kk * rk * gkl);
                    }
                }
            }
            {
                const float* cw = args.in[10] + (size_t)l * CONV_W * CONV_CH;
                const float* cb = args.in[11] + l * CONV_CH; const float* lg = args.in[12] + l * CONV_CH; const float* lb = args.in[13] + l * CONV_CH;
                float* ct = ldsf + 1024;
                const int c = tid & 255, half = tid >> 8;
                float wreg[CONV_W];
#pragma unroll
                for (int j = 0; j < CONV_W; ++j) wreg[j] = cw[j * CONV_CH + c];
                const float cbias = cb[c];
                for (int item = bid; item < T / 32; item += G) {
                    const int tok0 = item * 32;
                    const int tb = tok0 % SEQ;
                    const int t0 = tb + half * 16;
                    float hwin[46];
#pragma unroll
                    for (int i = 0; i < 46; ++i) {
                        const int tp = t0 - 30 + i;
                        float hv = 0.f;
                        if (tp >= 0) { const bf16_t* zr = Z + (size_t)(tok0 - tb + tp) * ZLD + Z_CU; hv = bf2f(zr[c]) * sigmoidf(bf2f(zr[256 + c])); }
                        hwin[i] = hv;
                    }
                    __syncthreads();
#pragma unroll
                    for (int o = 0; o < 16; ++o) {
                        float a = cbias;
#pragma unroll
                        for (int j = 0; j < CONV_W; ++j) a += hwin[o + j] * wreg[j];
                        ct[(half * 16 + o) * 256 + c] = a;
                    }
                    __syncthreads();
#pragma unroll
                    for (int i = 0; i < 4; ++i) {
                        const int tt = wave * 4 + i;
                        const f32x4 v = *(const f32x4*)&ct[tt * 256 + lane * 4];
                        const float mu = wave_sum(v[0] + v[1] + v[2] + v[3]) * (1.f / 256.f);
                        const f32x4 dv = v - mu;
                        const float var = wave_sum(dv[0] * dv[0] + dv[1] * dv[1] + dv[2] * dv[2] + dv[3] * dv[3]) * (1.f / 256.f);
                        const float rstd = 1.0f / sqrtf(var + NORM_EPS);
                        const f32x4 gg = *(const f32x4*)(lg + lane * 4), bb = *(const f32x4*)(lb + lane * 4);
                        f32x4 y = dv * rstd * gg + bb;
                        uint2 o; o.x = pk2(siluf(y[0]), siluf(y[1])); o.y = pk2(siluf(y[2]), siluf(y[3]));
                        *(uint2*)(MIX + (size_t)(tok0 + tt) * D_MODEL + MIX_CONV + lane * 4) = o;
                    }
                }
            }
        } else if (k == 3 && PH_ON(3)) {
            if (rep == 0)
            for (int e = bid * NTHREADS + tid; e < BATCH * GLA_HEADS * 4608; e += G * NTHREADS) {
                const int bh = e / 4608, idx = e % 4608, d = idx / 96;
                float state = 0.f;
#pragma unroll 16
                for (int c = 0; c < 64; ++c) {
                    const size_t it = (size_t)bh * 64 + c;
                    const float tmp = SLOC[it * 4608 + idx], dec = DEC[it * 48 + d];
                    SLOC[it * 4608 + idx] = state; state = dec * state + tmp; }
            }
            {
                unsigned* hist32 = (unsigned*)lds_raw;
                unsigned* rs = (unsigned*)(lds_raw + 131072);
                volatile unsigned* qsh = (volatile unsigned*)(lds_raw + LDSCTL_OFF + 64);
                unsigned* qhead = ctl + CW_Q3 + 64 * l + rep;
                const int qc = lane & 15, g4 = lane >> 4, qh = wave >> 2, kg = wave & 3;
                const int row = 16 * qh + qc;
                for (;;) {
                    __syncthreads();
                    if (tid == 0) qsh[0] = atomicAdd(qhead, 1u);
                    __syncthreads();
                    const int it = (int)qsh[0];
                    if (it >= BATCH * 128) break;
                    const int b = it & 3, qt = 127 - (it >> 2);
                    const int tokb = b * SEQ, q0 = qt * 32, tq = q0 + row;
                    bf16x8 qf[9][2];
                    {
                        const bf16_t* zq = Z + (size_t)(tokb + tq) * ZLD + Z_IQ + g4 * 8;
#pragma unroll
                        for (int h = 0; h < 8; ++h)
#pragma unroll
                            for (int ks = 0; ks < 2; ++ks) qf[h][ks] = *(const bf16x8*)(zq + h * 64 + ks * 32);
                        const bf16_t* ql = QL + (size_t)(tokb + tq) * 64 + g4 * 8;
#pragma unroll
                        for (int ks = 0; ks < 2; ++ks) qf[8][ks] = *(const bf16x8*)(ql + ks * 32);
                    }
                    float ch[8];
                    { const f32x4 c0 = *(const f32x4*)(CH + (size_t)(tokb + tq) * 8), c1 = *(const f32x4*)(CH + (size_t)(tokb + tq) * 8 + 4);
                      ch[0] = c0[0]; ch[1] = c0[1]; ch[2] = c0[2]; ch[3] = c0[3]; ch[4] = c1[0]; ch[5] = c1[1]; ch[6] = c1[2]; ch[7] = c1[3]; }
                    if (qt < 8) {
                        if (kg == 0 && g4 == 0) for (int kt = 0; kt <= qt; ++kt) MASK[((size_t)(b * 128) + kt) * SEQ + tq] = (kt < qt || row == 31) ? 0xffffffffu : ((1u << (row + 1)) - 1u);
                        continue;
                    }
#pragma unroll
                    for (int i = 0; i < 16; ++i) ((uint4*)hist32)[tid + 512 * i] = make_uint4(0u, 0u, 0u, 0u);
                    if (tid < 32) { rs[tid] = 0u; rs[32 + tid] = TOPK; rs[64 + tid] = 0u; rs[96 + tid] = 0u; }
                    __syncthreads();
#define DSA_SCORE(kt_) \
                        f32x4 sc[2]; \
                        { const bf16_t* kp = IK + (size_t)(tokb + (kt_) * 32 + qc) * 64 + g4 * 8; \
                          bf16x8 kf[2][2]; \
                          _Pragma("unroll") for (int u = 0; u < 2; ++u) _Pragma("unroll") for (int ks = 0; ks < 2; ++ks) kf[u][ks] = *(const bf16x8*)(kp + u * 16 * 64 + ks * 32); \
                          _Pragma("unroll") for (int u = 0; u < 2; ++u) { sc[u] = (f32x4){0.f, 0.f, 0.f, 0.f}; \
                              _Pragma("unroll") for (int ks = 0; ks < 2; ++ks) sc[u] = __builtin_amdgcn_mfma_f32_16x16x32_bf16(kf[u][ks], qf[8][ks], sc[u], 0, 0, 0); } \
                          _Pragma("unroll") for (int h = 0; h < 8; ++h) _Pragma("unroll") for (int u = 0; u < 2; ++u) { f32x4 a = (f32x4){0.f, 0.f, 0.f, 0.f}; \
                              _Pragma("unroll") for (int ks = 0; ks < 2; ++ks) a = __builtin_amdgcn_mfma_f32_16x16x32_bf16(kf[u][ks], qf[h][ks], a, 0, 0, 0); \
                              _Pragma("unroll") for (int i = 0; i < 4; ++i) sc[u][i] = __builtin_fmaf(fabsf(a[i]), ch[h], sc[u][i]); } }
                    for (int pass = 0; pass < 2; ++pass) {
                        const unsigned mmask = (pass == 0) ? 0u : 0xFFE00000u;
                        const int bshift = (pass == 0) ? 21 : 10;
                        const unsigned bmask = 2047u;
                        const unsigned prefm = rs[row];
                        for (int kt = kg; kt <= qt; kt += 4) {
                            DSA_SCORE(kt)
#pragma unroll
                            for (int u = 0; u < 2; ++u)
#pragma unroll
                                for (int i = 0; i < 4; ++i) {
                                    const int sidx = kt * 32 + 16 * u + 4 * g4 + i;
                                    const unsigned key = fkey(sc[u][i]);
                                    if (sidx <= tq && (key & mmask) == prefm) { const unsigned bin = (key >> bshift) & bmask; atomicAdd(&hist32[row * 1024 + (bin >> 1)], 1u << ((bin & 1u) * 16u)); }
                                }
                        }
                        __syncthreads();
                        for (int rr = 0; rr < 4; ++rr) {
                            const int R = wave * 4 + rr;
                            const unsigned kremR = rs[32 + R];
                            const uint4* hw = (const uint4*)(hist32 + R * 1024 + lane * 16);
                            const uint4 w0 = hw[0], w1 = hw[1], w2 = hw[2], w3 = hw[3];
                            const unsigned wv[16] = {w0.x, w0.y, w0.z, w0.w, w1.x, w1.y, w1.z, w1.w, w2.x, w2.y, w2.z, w2.w, w3.x, w3.y, w3.z, w3.w};
                            unsigned cntl = 0u;
#pragma unroll
                            for (int i = 0; i < 16; ++i) cntl += (wv[i] & 0xffffu) + (wv[i] >> 16);
                            unsigned suf = cntl;
#pragma unroll
                            for (int o = 1; o < 64; o <<= 1) { const unsigned tv = __shfl_down(suf, o); if (lane + o < 64) suf += tv; }
                            const unsigned excl = suf - cntl;
                            if (excl < kremR && kremR <= suf) {
                                unsigned above = excl, eq = 0u; int bin = 0; bool found = false;
#pragma unroll
                                for (int i = 15; i >= 0; --i) { const unsigned hi = wv[i] >> 16, lo = wv[i] & 0xffffu;
                                    if (!found) { if (above + hi >= kremR) { bin = 2 * (lane * 16 + i) + 1; eq = hi; found = true; } else above += hi; }
                                    if (!found) { if (above + lo >= kremR) { bin = 2 * (lane * 16 + i); eq = lo; found = true; } else above += lo; } }
                                rs[R] = rs[R] | ((unsigned)bin << bshift); rs[32 + R] = kremR - above; rs[64 + R] = eq;
                            }
                        }
                        __syncthreads();
#pragma unroll
                        for (int i = 0; i < 16; ++i) ((uint4*)hist32)[tid + 512 * i] = make_uint4(0u, 0u, 0u, 0u);
                        __syncthreads();
                    }
                    {
                        const unsigned tau = rs[row]; const bool tiecrit = rs[64 + row] > rs[32 + row];
                        unsigned* mcol = MASK + (size_t)(b * 128) * SEQ + tq;
                        for (int kt = kg; kt <= qt; kt += 4) {
                            DSA_SCORE(kt)
                            unsigned bits = 0u;
#pragma unroll
                            for (int u = 0; u < 2; ++u)
#pragma unroll
                                for (int i = 0; i < 4; ++i) {
                                    const int sidx = kt * 32 + 16 * u + 4 * g4 + i;
                                    const unsigned key = fkey(sc[u][i]), key22 = key & 0xFFFFFC00u;
                                    const bool valid = sidx <= tq;
                                    if (valid && (key22 > tau || (key22 == tau && !tiecrit))) bits |= 1u << (16 * u + 4 * g4 + i);
                                    if (valid && key22 == tau && tiecrit) { const unsigned idx = atomicAdd(&rs[96 + row], 1u); if (idx < 511u) { hist32[row * 1024 + 2 * idx] = key; hist32[row * 1024 + 2 * idx + 1] = (unsigned)sidx; } }
                                }
                            bits |= (unsigned)__shfl_xor((int)bits, 16);
                            bits |= (unsigned)__shfl_xor((int)bits, 32);
                            if (g4 == 0) mcol[(size_t)kt * SEQ] = bits;
                        }
                        asm volatile("s_waitcnt vmcnt(0)" ::: "memory");
                        __syncthreads();
                        if (tid < 32 && rs[64 + tid] > rs[32 + tid]) {
                            int tdx = tid; asm volatile("" : "+v"(tdx));
                            unsigned nl = rs[96 + tid]; if (nl > 511u) nl = 511u;
                            const unsigned need = rs[32 + tid];
                            unsigned* lst = hist32 + tdx * 1024;
                            for (unsigned q = 0; q < need && q < nl; ++q) {
                                unsigned bk = 0u, bs = 0xffffffffu, bi = 0u;
                                for (unsigned e2 = 0; e2 < nl; ++e2) { const unsigned kv = lst[2 * e2], sv = lst[2 * e2 + 1]; if (sv != 0xffffffffu && (kv > bk || (kv == bk && sv < bs))) { bk = kv; bs = sv; bi = e2; } }
                                lst[2 * bi + 1] = 0xffffffffu;
                                if (bs != 0xffffffffu) atomicOr(MASK + ((size_t)(b * 128) + (bs >> 5)) * SEQ + q0 + tdx, 1u << (bs & 31u));
                            }
                        }
                    }
#undef DSA_SCORE
                }
            }
        } else if (k == 4 && PH_ON(4)) {
            float* qt = ldsf;
            float* kt = qt + 64 * 49;
            float* vs = kt + 64 * 49;
            float* Am = vs + 64 * 97;
            float* Sin = Am + 64 * 65;
            const float* gon = args.in[7] + l * GLA_DV;
            volatile unsigned* qsh = (volatile unsigned*)(lds_raw + LDSCTL_OFF + 64);
            unsigned* qhead = ctl + CW_Q4 + 64 * l + rep;
            float* biasd = (float*)(lds_raw + 131072);
            for (int i = tid; i < 6 * 224; i += NTHREADS) { const int h = i / 224, d = i % 224 - 32; biasd[i] = d < 0 ? 0.f : args.in[2][t5_bucket(d) * DSA_HEADS + h] * 1.4426950408889634f; }
            constexpr int N_ATT = BATCH * 32 * 3;
            for (;;) {
                __syncthreads();
                if (tid == 0) qsh[0] = atomicAdd(qhead, 1u);
                __syncthreads();
                const int qit = (int)qsh[0];
#ifndef MK_GLA2_REP
#define MK_GLA2_REP 1
#endif
                if (qit >= N_ATT + MK_GLA2_REP * BATCH * GLA_HEADS * 64) break;
                if (qit < N_ATT) {
                    const int qt = 31 - qit / 12, rem = qit % 12, b = rem & 3, h0 = 2 * (rem >> 2);
                    const int tokb = b * SEQ, q0 = qt * 128, nkt = 4 * (qt + 1);
                    int tid_a = tid; asm volatile("" : "+v"(tid_a));
                    const int la = tid_a & 63, r = la & 31, hh = la >> 5;
                    const int qg = wave & 3, hd = wave >> 2, h = h0 + hd;
                    const int tq = q0 + 32 * qg + r;
                    LDSAS unsigned char* lb = (LDSAS unsigned char*)lds_raw;
                    LDSAS unsigned* maskl = (LDSAS unsigned*)(lb + 65536);
                    for (int idx = tid_a; idx < nkt * 128; idx += NTHREADS) maskl[idx] = MASK[((size_t)(b * 128) + (idx >> 7)) * SEQ + q0 + (idx & 127)];
                    bf16x8 qf[4];
#pragma unroll
                    for (int ks = 0; ks < 4; ++ks) qf[ks] = *(const bf16x8*)(QN + (size_t)(tokb + tq) * 384 + h * 64 + ks * 16 + hh * 8);
                    f32x16 oacc[2];
#pragma unroll
                    for (int dt = 0; dt < 2; ++dt)
#pragma unroll
                        for (int i = 0; i < 16; ++i) oacc[dt][i] = 0.f;
                    float lsum = 0.f;
                    const int krow = 4 * wave + (la >> 4), kpos = la & 15;
                    const int vrow = 16 * wave + (la >> 2), vpos = la & 3;
                    const char* ksrc = (const char*)KN + ((size_t)(tokb + krow) * 384 + h0 * 64) * 2 + ((kpos ^ (krow & 15)) * 16);
                    const char* vsrc = (const char*)VT + ((size_t)(b * 128) * 384 + h0 * 64 + vrow) * 64 + ((vpos ^ ((vrow >> 2) & 3)) * 16);
                    int koff[4], voff[2][2];
#pragma unroll
                    for (int ks = 0; ks < 4; ++ks) koff[ks] = r * 256 + (((hd * 8 + ks * 2 + hh) ^ (r & 15)) * 16);
#pragma unroll
                    for (int dt = 0; dt < 2; ++dt)
#pragma unroll
                        for (int sst = 0; sst < 2; ++sst) { const int vr = hd * 64 + dt * 32 + r; voff[dt][sst] = 8192 + vr * 64 + (((2 * sst + hh) ^ ((vr >> 2) & 3)) * 16); }
#define ATT_ISSUE(kt_, st_) do { const int ktc = (kt_) < nkt ? (kt_) : nkt - 1; \
                        __builtin_amdgcn_global_load_lds((const unsigned*)(ksrc + (size_t)ktc * (32 * 768)), (LDSAS unsigned*)(lb + (st_) * 16384 + wave * 1024), 16, 0, 0); \
                        __builtin_amdgcn_global_load_lds((const unsigned*)(vsrc + (size_t)ktc * (384 * 64)), (LDSAS unsigned*)(lb + (st_) * 16384 + 8192 + wave * 1024), 16, 0, 0); } while (0)
                    __syncthreads();
                    ATT_ISSUE(0, 0); ATT_ISSUE(1, 1); ATT_ISSUE(2, 2);
                    for (int kt = 0; kt < nkt; ++kt) {
                        asm volatile("s_waitcnt vmcnt(4)" ::: "memory");
                        __builtin_amdgcn_s_barrier();
                        asm volatile("" ::: "memory");
                        ATT_ISSUE(kt + 3, (kt + 3) & 3);
                        if (kt * 32 <= q0 + 32 * qg + 31) {
                            LDSAS unsigned char* st = lb + (kt & 3) * 16384;
                            const unsigned mwh = maskl[kt * 128 + 32 * qg + r] >> (4 * hh);
                            const int mind = (q0 + 32 * qg) - (kt * 32 + 31);
                            f32x16 S;
#pragma unroll
                            for (int i = 0; i < 16; ++i) S[i] = 0.f;
#pragma unroll
                            for (int ks = 0; ks < 4; ++ks) { const bf16x8 a = *(const LDSAS bf16x8*)(st + koff[ks]); S = MFMA32(a, qf[ks], S); }
                            float p[16];
                            if (mind >= 113) {
                                const float bu = biasd[h * 224 + 223];
#pragma unroll
                                for (int i = 0; i < 16; ++i) p[i] = __uint_as_float(__float_as_uint(__builtin_amdgcn_exp2f(S[i] + bu)) & (unsigned)__builtin_amdgcn_sbfe((int)mwh, (i & 3) + 8 * (i >> 2), 1));
                            } else {
                                const float* bp = biasd + h * 224 + (tq - kt * 32 - 4 * hh + 5);
#pragma unroll
                                for (int i = 0; i < 16; ++i) p[i] = __uint_as_float(__float_as_uint(__builtin_amdgcn_exp2f(S[i] + bp[27 - (i & 3) - 8 * (i >> 2)])) & (unsigned)__builtin_amdgcn_sbfe((int)mwh, (i & 3) + 8 * (i >> 2), 1));
                            }
                            float ps = 0.f;
#pragma unroll
                            for (int i = 0; i < 16; ++i) ps += p[i];
                            lsum += ps;
                            uint4 u0, u1;
                            u0.x = pkbf(p[0], p[1]); u0.y = pkbf(p[2], p[3]); u0.z = pkbf(p[4], p[5]); u0.w = pkbf(p[6], p[7]);
                            u1.x = pkbf(p[8], p[9]); u1.y = pkbf(p[10], p[11]); u1.z = pkbf(p[12], p[13]); u1.w = pkbf(p[14], p[15]);
                            const bf16x8 pf0 = __builtin_bit_cast(bf16x8, u0), pf1 = __builtin_bit_cast(bf16x8, u1);
#pragma unroll
                            for (int dt = 0; dt < 2; ++dt) {
                                const bf16x8 a0 = *(const LDSAS bf16x8*)(st + voff[dt][0]);
                                const bf16x8 a1 = *(const LDSAS bf16x8*)(st + voff[dt][1]);
                                oacc[dt] = MFMA32(a0, pf0, oacc[dt]);
                                oacc[dt] = MFMA32(a1, pf1, oacc[dt]);
                            }
                        }
                    }
#undef ATT_ISSUE
                    asm volatile("s_waitcnt vmcnt(0)" ::: "memory");
                    {
                        const float lt = lsum + __shfl_xor(lsum, 32);
                        float inv = 1.f / lt;
                        bf16_t* mo = MIX + (size_t)(tokb + tq) * D_MODEL + MIX_DSA + h * 64;
#pragma unroll
                        for (int dt = 0; dt < 2; ++dt)
#pragma unroll
                            for (int g4 = 0; g4 < 4; ++g4) {
                                uint2 o; o.x = pkbf(oacc[dt][4 * g4] * inv, oacc[dt][4 * g4 + 1] * inv); o.y = pkbf(oacc[dt][4 * g4 + 2] * inv, oacc[dt][4 * g4 + 3] * inv);
                                *(uint2*)(mo + dt * 32 + 8 * g4 + 4 * hh) = o;
                            }
                    }
                    continue;
                }
                const int item = (qit - N_ATT) % (BATCH * GLA_HEADS * 64);
                const int bh = item >> 6, c = item & 63, b = bh >> 2, h = bh & 3, tok0 = b * SEQ + c * 64;
                int tid_g = tid; asm volatile("" : "+v"(tid_g));
                __syncthreads();
                {
                    float* qT = ldsf + 3328;
                    float* kt2 = ldsf + 6592;
                    float* vs2 = ldsf + 9920;
                    float* AmT = ldsf + 16320;
                    float* Sin2 = ldsf + 20672;
                    float* ssq = ldsf + 25472;
                    float* qt2 = ldsf;
                    if (tid_g < 384) {
                        const int t = tid_g / 6, c8 = (tid_g % 6) * 8;
                        const bf16_t* zr = Z + (size_t)(tok0 + t) * ZLD;
                        const uint4 qu = *(const uint4*)(zr + Z_GQ + h * 48 + c8), ku = *(const uint4*)(zr + Z_GK + h * 48 + c8);
                        const f32x4 b0 = *(const f32x4*)(BCUM + (size_t)(tok0 + t) * 192 + h * 48 + c8), b1 = *(const f32x4*)(BCUM + (size_t)(tok0 + t) * 192 + h * 48 + c8 + 4);
                        const float qv[8] = {__uint_as_float(qu.x << 16), __uint_as_float(qu.x & 0xffff0000u), __uint_as_float(qu.y << 16), __uint_as_float(qu.y & 0xffff0000u), __uint_as_float(qu.z << 16), __uint_as_float(qu.z & 0xffff0000u), __uint_as_float(qu.w << 16), __uint_as_float(qu.w & 0xffff0000u)};
                        const float kv[8] = {__uint_as_float(ku.x << 16), __uint_as_float(ku.x & 0xffff0000u), __uint_as_float(ku.y << 16), __uint_as_float(ku.y & 0xffff0000u), __uint_as_float(ku.z << 16), __uint_as_float(ku.z & 0xffff0000u), __uint_as_float(ku.w << 16), __uint_as_float(ku.w & 0xffff0000u)};
                        const float bb[8] = {b0[0], b0[1], b0[2], b0[3], b1[0], b1[1], b1[2], b1[3]};
#pragma unroll
                        for (int e = 0; e < 8; ++e) { const float qq = qv[e] * 0.14433756729740643f * __expf(bb[e]); qt2[t * 52 + c8 + e] = qq; qT[(c8 + e) * 68 + t] = qq; kt2[t * 52 + c8 + e] = kv[e] * __expf(-bb[e]); }
                    }
                    for (int i = tid_g; i < 64 * 12; i += NTHREADS) { const int t = i / 12, c8 = (i % 12) * 8;
                        const uint4 vu = *(const uint4*)(Z + (size_t)(tok0 + t) * ZLD + Z_GV + h * 96 + c8);
                        *(f32x4*)&vs2[t * 100 + c8] = (f32x4){__uint_as_float(vu.x << 16), __uint_as_float(vu.x & 0xffff0000u), __uint_as_float(vu.y << 16), __uint_as_float(vu.y & 0xffff0000u)};
                        *(f32x4*)&vs2[t * 100 + c8 + 4] = (f32x4){__uint_as_float(vu.z << 16), __uint_as_float(vu.z & 0xffff0000u), __uint_as_float(vu.w << 16), __uint_as_float(vu.w & 0xffff0000u)}; }
                    for (int i = tid_g; i < 48 * 24; i += NTHREADS) { const int d = i / 24, v4 = (i % 24) * 4; *(f32x4*)&Sin2[d * 100 + v4] = *(const f32x4*)(SLOC + (size_t)item * 4608 + d * 96 + v4); }
                    __syncthreads();
                    if (tid_g < 256) {
                        const int t0 = (tid_g >> 4) * 4, s0 = (tid_g & 15) * 4;
                        float a[4][4];
#pragma unroll
                        for (int x = 0; x < 4; ++x)
#pragma unroll
                            for (int y = 0; y < 4; ++y) a[x][y] = 0.f;
                        if (s0 <= t0 + 3) {
#pragma unroll 3
                            for (int d = 0; d < 48; d += 4) {
                                f32x4 qv4[4], kv4[4];
#pragma unroll
                                for (int x = 0; x < 4; ++x) { qv4[x] = *(const f32x4*)&qt2[(t0 + x) * 52 + d]; kv4[x] = *(const f32x4*)&kt2[(s0 + x) * 52 + d]; }
#pragma unroll
                                for (int x = 0; x < 4; ++x)
#pragma unroll
                                    for (int y = 0; y < 4; ++y) a[x][y] += qv4[x][0] * kv4[y][0] + qv4[x][1] * kv4[y][1] + qv4[x][2] * kv4[y][2] + qv4[x][3] * kv4[y][3];
                            }
                        }
#pragma unroll
                        for (int y = 0; y < 4; ++y) *(f32x4*)&AmT[(s0 + y) * 68 + t0] = (f32x4){(s0 + y <= t0) ? a[0][y] : 0.f, (s0 + y <= t0 + 1) ? a[1][y] : 0.f, (s0 + y <= t0 + 2) ? a[2][y] : 0.f, (s0 + y <= t0 + 3) ? a[3][y] : 0.f};
                    }
                    __syncthreads();
                    float o[4][4];
                    const int t0 = (tid_g / 24) * 4, v0 = (tid_g % 24) * 4;
#pragma unroll
                    for (int x = 0; x < 4; ++x)
#pragma unroll
                        for (int y = 0; y < 4; ++y) o[x][y] = 0.f;
                    float* part = ldsf + 25536;
                    if (tid_g < 384) {
                        for (int sidx = 0; sidx <= t0 + 3; ++sidx) { const f32x4 av = *(const f32x4*)&AmT[sidx * 68 + t0], vv = *(const f32x4*)&vs2[sidx * 100 + v0];
#pragma unroll
                            for (int x = 0; x < 4; ++x)
#pragma unroll
                                for (int y = 0; y < 4; ++y) o[x][y] += av[x] * vv[y]; }
#pragma unroll 4
                        for (int d = 0; d < 48; ++d) { const f32x4 qv4 = *(const f32x4*)&qT[d * 68 + t0], sv = *(const f32x4*)&Sin2[d * 100 + v0];
#pragma unroll
                            for (int x = 0; x < 4; ++x)
#pragma unroll
                                for (int y = 0; y < 4; ++y) o[x][y] += qv4[x] * sv[y]; }
#pragma unroll
                        for (int x = 0; x < 4; ++x) part[(t0 + x) * 24 + (v0 >> 2)] = o[x][0] * o[x][0] + o[x][1] * o[x][1] + o[x][2] * o[x][2] + o[x][3] * o[x][3];
                    }
                    __syncthreads();
                    if (tid_g < 64) { float sq = 0.f;
#pragma unroll
                        for (int q = 0; q < 24; ++q) sq += part[tid_g * 24 + q];
                        ssq[tid_g] = sq; }
                    __syncthreads();
                    if (tid_g < 384) {
                        const f32x4 gg = *(const f32x4*)(gon + v0);
#pragma unroll
                        for (int x = 0; x < 4; ++x) {
                            const float rinv = 1.0f / sqrtf(ssq[t0 + x] * (1.f / 96.f) + NORM_EPS);
                            const uint2 ru = *(const uint2*)(Z + (size_t)(tok0 + t0 + x) * ZLD + Z_GR + h * 96 + v0);
                            uint2 w; w.x = pk2(o[x][0] * rinv * gg[0] * siluf(__uint_as_float(ru.x << 16)), o[x][1] * rinv * gg[1] * siluf(__uint_as_float(ru.x & 0xffff0000u)));
                            w.y = pk2(o[x][2] * rinv * gg[2] * siluf(__uint_as_float(ru.y << 16)), o[x][3] * rinv * gg[3] * siluf(__uint_as_float(ru.y & 0xffff0000u)));
                            *(uint2*)(MIX + (size_t)(tok0 + t0 + x) * D_MODEL + MIX_GLA + h * 96 + v0) = w;
                        }
                    }
                }
            }
        } else if (k == 5 && PH_ON(5)) {
            pg8::Gemm g{MIX, WOUT + (size_t)l * D_MODEL * D_MODEL, T, D_MODEL, D_MODEL}; pg8::StaticOrder S; S.init(T, D_MODEL, G, bid);
            pg8::EpiRes E{xin, OUT, D_MODEL};
            pg8::gemm_phase<pg8::EpiRes, pg8::StaticOrder, true, true>(tid, ldsq, g, S, E);
        } else if (k == 6 && PH_ON(6)) {
            const float* g = args.in[15] + l * D_MODEL;
            for (int r = gw; r < T; r += NGW) rmsnorm_row_bf16(OUT + (size_t)r * D_MODEL, g, XN + (size_t)r * D_MODEL, lane);
            {
                float* scr = ldsf + wave * (64 * 33);
                constexpr int I_G = 16 * 16, I_D = 8 * 32, I_E = 2 * I_G + I_D;
                for (int it = gw; it < N_EXPERTS * I_E; it += NGW) {
                    const int e = it / I_E; int r = it % I_E;
                    const size_t we = (size_t)l * N_EXPERTS + e;
                    if (r < I_G) { transpose_item(args.in[27] + we * D_MODEL * D_EXPERT, D_MODEL, D_EXPERT, 16, WGU + (size_t)e * 1024 * D_MODEL, 0, 2, 0, scr, r, lane); continue; } r -= I_G;
                    if (r < I_G) { transpose_item(args.in[28] + we * D_MODEL * D_EXPERT, D_MODEL, D_EXPERT, 16, WGU + (size_t)e * 1024 * D_MODEL, 0, 2, 1, scr, r, lane); continue; } r -= I_G;
                    transpose_item(args.in[29] + we * D_EXPERT * D_MODEL, D_EXPERT, D_MODEL, 32, WDN + (size_t)e * D_MODEL * D_EXPERT, 0, 1, 0, scr, r, lane);
                }
            }
        } else if (k == 7 && PH_ON(7)) {
            pg8::Gemm g{XN, WCQ + (size_t)l * XW * D_MODEL, T, XW, D_MODEL}; pg8::StaticOrder S; S.init(T, XW, G, bid);
            pg8::EpiStoreBf16 E{CQ, XW, 0xffff};
            pg8::gemm_phase<pg8::EpiStoreBf16, pg8::StaticOrder, true, true>(tid, ldsq, g, S, E);
        } else if (k == 8 && PH_ON(8)) {
            {
                const float* gq = args.in[19] + l * X_DH;
                const int r = lane & 31, hh = lane >> 5;
                for (int item = gw; item < BATCH * X_HEADS * (SEQ / 32); item += NGW) {
                    const int tt = item & 127, h = (item >> 7) & 3, b = item >> 9;
                    const int tok = b * SEQ + tt * 32 + r;
                    bf16x8 qf[4];
                    {
                        float qv[4][8]; float ss = 0.f;
#pragma unroll
                        for (int ks = 0; ks < 4; ++ks) { const uint4 u = *(const uint4*)(CQ + (size_t)tok * XW + h * 64 + ks * 16 + hh * 8);
                            qv[ks][0] = __uint_as_float(u.x << 16); qv[ks][1] = __uint_as_float(u.x & 0xffff0000u); qv[ks][2] = __uint_as_float(u.y << 16); qv[ks][3] = __uint_as_float(u.y & 0xffff0000u);
                            qv[ks][4] = __uint_as_float(u.z << 16); qv[ks][5] = __uint_as_float(u.z & 0xffff0000u); qv[ks][6] = __uint_as_float(u.w << 16); qv[ks][7] = __uint_as_float(u.w & 0xffff0000u);
#pragma unroll
                            for (int e = 0; e < 8; ++e) ss += qv[ks][e] * qv[ks][e]; }
                        ss += __shfl_xor(ss, 32);
                        const float rq = (0.125f * 1.4426950408889634f) / sqrtf(ss * (1.f / 64.f) + NORM_EPS);
#pragma unroll
                        for (int ks = 0; ks < 4; ++ks) { const f32x4 g0 = *(const f32x4*)(gq + ks * 16 + hh * 8), g1 = *(const f32x4*)(gq + ks * 16 + hh * 8 + 4);
                            uint4 u; u.x = pkbf(qv[ks][0] * rq * g0[0], qv[ks][1] * rq * g0[1]); u.y = pkbf(qv[ks][2] * rq * g0[2], qv[ks][3] * rq * g0[3]);
                            u.z = pkbf(qv[ks][4] * rq * g1[0], qv[ks][5] * rq * g1[1]); u.w = pkbf(qv[ks][6] * rq * g1[2], qv[ks][7] * rq * g1[3]);
                            qf[ks] = __builtin_bit_cast(bf16x8, u); }
                    }
                    f32x16 oacc[2];
#pragma unroll
                    for (int dt = 0; dt < 2; ++dt)
#pragma unroll
                        for (int e = 0; e < 16; ++e) oacc[dt][e] = 0.f;
                    float lsm = 0.f;
                    const bf16_t* kb = CKN + ((size_t)l * BATCH * MEM_LEN + (size_t)b * MEM_LEN + r) * 256 + h * 64 + hh * 8;
                    const bf16_t* vb = CVT + ((size_t)((l * BATCH + b) * X_HEADS + h) * 64 + r) * 256 + hh * 8;
#pragma unroll 2
                    for (int kt = 0; kt < 8; ++kt) {
                        f32x16 S;
#pragma unroll
                        for (int e = 0; e < 16; ++e) S[e] = 0.f;
#pragma unroll
                        for (int ks = 0; ks < 4; ++ks) { const bf16x8 a = *(const bf16x8*)(kb + (size_t)kt * 32 * 256 + ks * 16); S = MFMA32(a, qf[ks], S); }
                        float p[16]; float ps = 0.f;
#pragma unroll
                        for (int e = 0; e < 16; ++e) { p[e] = __builtin_amdgcn_exp2f(S[e]); ps += p[e]; }
                        lsm += ps;
                        uint4 u0, u1;
                        u0.x = pkbf(p[0], p[1]); u0.y = pkbf(p[2], p[3]); u0.z = pkbf(p[4], p[5]); u0.w = pkbf(p[6], p[7]);
                        u1.x = pkbf(p[8], p[9]); u1.y = pkbf(p[10], p[11]); u1.z = pkbf(p[12], p[13]); u1.w = pkbf(p[14], p[15]);
                        const bf16x8 pf0 = __builtin_bit_cast(bf16x8, u0), pf1 = __builtin_bit_cast(bf16x8, u1);
#pragma unroll
                        for (int dt = 0; dt < 2; ++dt) {
                            const bf16x8 a0 = *(const bf16x8*)(vb + (size_t)dt * 32 * 256 + kt * 32);
                            const bf16x8 a1 = *(const bf16x8*)(vb + (size_t)dt * 32 * 256 + kt * 32 + 16);
                            oacc[dt] = MFMA32(a0, pf0, oacc[dt]);
                            oacc[dt] = MFMA32(a1, pf1, oacc[dt]);
                        }
                    }
                    const float inv = 1.f / (lsm + __shfl_xor(lsm, 32));
                    bf16_t* op = COIN + (size_t)tok * XW + h * 64;
#pragma unroll
                    for (int dt = 0; dt < 2; ++dt)
#pragma unroll
                        for (int g4 = 0; g4 < 4; ++g4) {
                            uint2 o; o.x = pkbf(oacc[dt][4 * g4] * inv, oacc[dt][4 * g4 + 1] * inv); o.y = pkbf(oacc[dt][4 * g4 + 2] * inv, oacc[dt][4 * g4 + 3] * inv);
                            *(uint2*)(op + dt * 32 + 8 * g4 + 4 * hh) = o;
                        }
                }
            }
        } else if (k == 9 && PH_ON(9)) {
            pg8::Gemm g{COIN, WCO + (size_t)l * D_MODEL * XW, T, D_MODEL, XW}; pg8::StaticOrder S; S.init(T, D_MODEL, G, bid);
            pg8::EpiRes E{OUT, OUT, D_MODEL};
            pg8::gemm_phase<pg8::EpiRes, pg8::StaticOrder, true, true>(tid, ldsq, g, S, E);
        } else if (k == 10 && PH_ON(10)) {
            const float* g = args.in[22] + l * D_MODEL;
            const float* wrg = args.in[23] + (size_t)l * D_MODEL * N_GROUPS; const float* brg = args.in[24] + l * N_GROUPS;
            const float* wre = args.in[25] + (size_t)l * D_MODEL * N_EXPERTS; const float* bre = args.in[26] + l * N_EXPERTS;
            unsigned* lcnt = (unsigned*)lds_raw;
            unsigned* lbase = lcnt + 16;
            unsigned* ler = lcnt + 32;
            float* wt = (float*)lds_raw + 256;
            for (int i = tid; i < D_MODEL * 20; i += NTHREADS) { const int kk = i / 20, jj = i % 20; wt[kk * 21 + jj] = (jj < 4) ? wrg[kk * 4 + jj] : wre[kk * 16 + jj - 4]; }
            for (int chunk = bid; chunk < T / 64; chunk += G) {
            __syncthreads();
            if (tid < 16) lcnt[tid] = 0u;
            __syncthreads();
            for (int tg = 0; tg < 2; ++tg) {
                const int r0 = chunk * 64 + wave * 8 + tg * 4;
                float rinv4[4];
#pragma unroll
                for (int t4 = 0; t4 < 4; ++t4) { const float* xr = OUT + (size_t)(r0 + t4) * D_MODEL; float s = 0.f;
#pragma unroll 4
                    for (int i = 0; i < 16; ++i) { const float xv = xr[lane + 64 * i]; s += xv * xv; }
                    rinv4[t4] = 1.0f / sqrtf(wave_sum(s) * (1.f / 1024.f) + NORM_EPS); }
                float acc4[4][20];
#pragma unroll
                for (int t4 = 0; t4 < 4; ++t4)
#pragma unroll
                    for (int j = 0; j < 20; ++j) acc4[t4][j] = 0.f;
#pragma unroll 1
                for (int i = 0; i < 16; ++i) {
                    const int kk = lane + 64 * i;
                    float w[20];
#pragma unroll
                    for (int j = 0; j < 20; ++j) w[j] = wt[kk * 21 + j];
                    const float gk = g[kk];
#pragma unroll
                    for (int t4 = 0; t4 < 4; ++t4) {
                        const float xn = OUT[(size_t)(r0 + t4) * D_MODEL + kk] * rinv4[t4] * gk;
                        XN[(size_t)(r0 + t4) * D_MODEL + kk] = f2bf(xn);
#pragma unroll
                        for (int j = 0; j < 20; ++j) acc4[t4][j] += xn * w[j];
                    }
                }
#pragma unroll
                for (int t4 = 0; t4 < 4; ++t4)
#pragma unroll
                    for (int j = 0; j < 20; ++j) acc4[t4][j] = wave_sum(acc4[t4][j]);
#pragma unroll
            for (int t4 = 0; t4 < 4; ++t4) {
                const int ti = tg * 4 + t4;
                const int r = r0 + t4;
                float acc[20];
#pragma unroll
                for (int j = 0; j < 20; ++j) acc[j] = acc4[t4][j];

                if (lane == 0) {
                    float gl[4]; int gs = 0;
#pragma unroll
                    for (int j = 0; j < 4; ++j) gl[j] = acc[j] + brg[j];
                    float gmax = gl[0];
#pragma unroll
                    for (int j = 1; j < 4; ++j) if (gl[j] > gmax) { gmax = gl[j]; gs = j; }
                    float den = 0.f;
#pragma unroll
                    for (int j = 0; j < 4; ++j) den += __expf(gl[j] - gmax);
                    const float gwt = 1.f / den;
                    float el[4];
#pragma unroll
                    for (int j = 0; j < 4; ++j) { float vsel = 0.f;
#pragma unroll
                        for (int gg2 = 0; gg2 < 4; ++gg2) vsel = (gg2 == gs) ? (acc[4 + gg2 * 4 + j] + bre[gg2 * 4 + j]) : vsel;
                        el[j] = vsel; }
                    int i1 = 0; float e1v = el[0];
#pragma unroll
                    for (int j = 1; j < 4; ++j) if (el[j] > e1v) { e1v = el[j]; i1 = j; }
                    int i2 = -1; float e2v = -INFINITY;
#pragma unroll
                    for (int j = 0; j < 4; ++j) if (j != i1 && el[j] > e2v) { e2v = el[j]; i2 = j; }
                    const float e2 = __expf(e2v - e1v);
                    const float w1 = 1.f / (1.f + e2), w2 = e2 / (1.f + e2);
                    const int ex1 = gs * 4 + i1, ex2 = gs * 4 + i2;
                    tok_e[r * 2] = ex1; tok_e[r * 2 + 1] = ex2;
                    tok_g[r * 2] = w1 * gwt; tok_g[r * 2 + 1] = w2 * gwt;
                    const unsigned r1 = atomicAdd(&lcnt[ex1], 1u), r2 = atomicAdd(&lcnt[ex2], 1u);
                    ler[(wave * 8 + ti) * 2] = (unsigned)ex1 | (r1 << 8); ler[(wave * 8 + ti) * 2 + 1] = (unsigned)ex2 | (r2 << 8);
                }
            }
            }
            __syncthreads();
            if (tid < 16) lbase[tid] = atomicAdd(&cnt[tid + 16 * rep], lcnt[tid]);
            __syncthreads();
            if (tid < 128) { const unsigned v = ler[tid]; tok_r[(chunk * 64) * 2 + tid] = (int)(lbase[v & 255u] + (v >> 8)); }
            }
        } else if (k >= 11 && k <= 14 && PH_ON(11)) {
            int off[N_EXPERTS + 1];
            off[0] = 0;
#pragma unroll
            for (int e = 0; e < N_EXPERTS; ++e) { const int c = (int)__hip_atomic_load(&cnt[e], __ATOMIC_RELAXED, __HIP_MEMORY_SCOPE_AGENT); off[e + 1] = off[e] + ((c + PADR - 1) / PADR) * PADR; }
            const int total_rows = off[N_EXPERTS];
            if (k == 11) {
                for (int i = gw; i < 2 * T; i += NGW) {
                    const int e = tok_e[i]; int o = 0;
#pragma unroll
                    for (int q = 0; q < N_EXPERTS; ++q) o = (q == e) ? off[q] : o;
                    const uint4* src = (const uint4*)(XN + (size_t)(i >> 1) * D_MODEL); uint4* dst = (uint4*)(XG + (size_t)(o + tok_r[i]) * D_MODEL);
                    dst[lane] = src[lane]; dst[lane + 64] = src[lane + 64];
                }
                for (int e = 0; e < N_EXPERTS; ++e) {
                    int oe = 0, oe1 = 0;
#pragma unroll
                    for (int q = 0; q < N_EXPERTS; ++q) { oe = (q == e) ? off[q] : oe; oe1 = (q == e) ? off[q + 1] : oe1; }
                    const int c = (int)__hip_atomic_load(&cnt[e], __ATOMIC_RELAXED, __HIP_MEMORY_SCOPE_AGENT);
                    for (int r = oe + c + gw; r < oe1; r += NGW) { uint4* dst = (uint4*)(XG + (size_t)r * D_MODEL); dst[lane] = make_uint4(0u, 0u, 0u, 0u); dst[lane + 64] = make_uint4(0u, 0u, 0u, 0u); }
                }
            } else if (k == 12) {
                pg8::Gemm g{XG, WGU, total_rows, 1024, D_MODEL};
                pg8::GroupSched S;
#pragma unroll
                for (int q = 0; q < 17; ++q) S.off[q] = off[q];
                S.nunits = (total_rows / 256) * 4; S.G = G; S.c = bid;
                pg8::EpiGateUp E{HB, D_EXPERT};
                pg8::gemm_phase<pg8::EpiGateUp, pg8::GroupSched, true, true>(tid, ldsq, g, S, E);
            } else if (k == 13) {
                pg8::Gemm g{HB, WDN, total_rows, 1024, D_EXPERT};
                pg8::GroupSched S;
#pragma unroll
                for (int q = 0; q < 17; ++q) S.off[q] = off[q];
                S.nunits = (total_rows / 256) * 4; S.G = G; S.c = bid;
                pg8::EpiStoreBf16 E{DB, D_MODEL, 3};
                pg8::gemm_phase<pg8::EpiStoreBf16, pg8::GroupSched, true, true>(tid, ldsq, g, S, E);
            } else {
                for (int r = gw; r < T; r += NGW) {
                    const int e0 = tok_e[r * 2], e1 = tok_e[r * 2 + 1]; int o0 = 0, o1 = 0;
#pragma unroll
                    for (int q = 0; q < N_EXPERTS; ++q) { o0 = (q == e0) ? off[q] : o0; o1 = (q == e1) ? off[q] : o1; }
                    const size_t r0 = (size_t)(o0 + tok_r[r * 2]), r1 = (size_t)(o1 + tok_r[r * 2 + 1]);
                    const float g0 = tok_g[r * 2], g1 = tok_g[r * 2 + 1];
#pragma unroll
                    for (int j = 0; j < 4; ++j) {
                        const int c = lane * 4 + 256 * j;
                        const uint2 a = *(const uint2*)(DB + r0 * 1024 + c), bq = *(const uint2*)(DB + r1 * 1024 + c);
                        f32x4 x = *(const f32x4*)(OUT + (size_t)r * D_MODEL + c);
                        x[0] += g0 * __uint_as_float(a.x << 16) + g1 * __uint_as_float(bq.x << 16);
                        x[1] += g0 * __uint_as_float(a.x & 0xffff0000u) + g1 * __uint_as_float(bq.x & 0xffff0000u);
                        x[2] += g0 * __uint_as_float(a.y << 16) + g1 * __uint_as_float(bq.y << 16);
                        x[3] += g0 * __uint_as_float(a.y & 0xffff0000u) + g1 * __uint_as_float(bq.y & 0xffff0000u);
                        *(f32x4*)(OUT + (size_t)r * D_MODEL + c) = x;
                    }
                }
            }
        }
    }
#ifdef MK_PROF_A
    if (KSEL < 0) {
        xcd_barrier(bar);
        if (bid == 0 && threadIdx.x == 0) ctl[8192 + DEPTH * NP] = (unsigned)__builtin_amdgcn_s_memrealtime();
        xcd_barrier(bar);
        const float da = (float)(ctl[8192 + MK_PROF_A + 1] - ctl[8192 + MK_PROF_A]) * 0.01f;
        const float db = (MK_PROF_B < 0) ? (float)(ctl[8192 + DEPTH * NP] - ctl[8192]) * 0.01f : (float)(ctl[8192 + MK_PROF_B + 1] - ctl[8192 + MK_PROF_B]) * 0.01f;
        for (size_t i = (size_t)T * D_MODEL / 2 + (size_t)bid * NTHREADS + threadIdx.x; i < (size_t)T * D_MODEL; i += (size_t)G * NTHREADS) OUT[i] = db;
        if (bid == 0 && threadIdx.x == 0) OUT[0] = 100.f * da;
    }
#endif
}

#ifndef MK_SINGLE
#define MK_SINGLE 1
#endif
extern "C" void kernel_launch(void* const* d_in, const int* in_sizes, int n_in, void* d_out, int out_size, void* d_ws, size_t ws_size, hipStream_t stream) {
    static int grid = 0;
    if (grid == 0) {
        if (n_in != 30 || out_size != T * D_MODEL || ws_size < WS_END) { fprintf(stderr, "kernel_launch: unexpected sizes n_in %d out %d ws %zu (need %zu)\n", n_in, out_size, ws_size, (size_t)WS_END); grid = -1; return; }
        int dev = 0, cus = 0;
        if (hipGetDevice(&dev) != hipSuccess || hipDeviceGetAttribute(&cus, hipDeviceAttributeMultiprocessorCount, dev) != hipSuccess) { grid = -1; return; }
        bool okattr = true;
#define SETATTR(K) okattr = okattr && (hipFuncSetAttribute((const void*)mk_fwd<K>, hipFuncAttributeMaxDynamicSharedMemorySize, LDS_BYTES) == hipSuccess)
#if MK_SINGLE
        SETATTR(-1);
#else
        SETATTR(0); SETATTR(1); SETATTR(2); SETATTR(3); SETATTR(4); SETATTR(5); SETATTR(6); SETATTR(7); SETATTR(8); SETATTR(9); SETATTR(10); SETATTR(11); SETATTR(12); SETATTR(13); SETATTR(14);
#endif
        if (!okattr) { fprintf(stderr, "kernel_launch: hipFuncSetAttribute failed\n"); grid = -1; return; }
        (void)hipGetLastError();
        grid = cus > 0 ? cus : 256;
    }
    if (grid < 0) return;
    (void)hipMemsetAsync((char*)d_ws + WS_CTL, 0, CTL_BYTES, stream);
    Args a{};
    for (int i = 0; i < 30; ++i) a.in[i] = (const float*)d_in[i];
    a.out = (float*)d_out; a.ws = (unsigned char*)d_ws;
#if MK_SINGLE
    a.ph_lo = 0; a.ph_hi = DEPTH * NP;
    hipLaunchKernelGGL(mk_fwd<-1>, dim3(grid), dim3(NTHREADS), LDS_BYTES, stream, a);
#else
    for (int ph = 0; ph < DEPTH * NP; ++ph) {
        a.ph_lo = ph; a.ph_hi = ph + 1;
        switch (ph % NP) {
#define LCASE(K) case K: hipLaunchKernelGGL(mk_fwd<K>, dim3(grid), dim3(NTHREADS), LDS_BYTES, stream, a); break
            LCASE(0); LCASE(1); LCASE(2); LCASE(3); LCASE(4); LCASE(5); LCASE(6); LCASE(7); LCASE(8); LCASE(9); LCASE(10); LCASE(11); LCASE(12); LCASE(13); LCASE(14);
        }
    }
#endif
}
```

```cpp
#include <hip/hip_runtime.h>
#include <cstdio>
#include <cstdint>

constexpr int D_MODEL = 1024, BATCH = 4, SEQ = 4096, DEPTH = 2, T = BATCH * SEQ;
constexpr int MEM_LEN = 256;
constexpr int GLA_HEADS = 4, GLA_DK = 48, GLA_DV = 96, GLA_RANK = 16;
constexpr int DSA_HEADS = 6, DSA_DH = 64, IDX_HEADS = 8, IDX_DIM = 64, TOPK = 256;
constexpr int CONV_CH = 256, CONV_W = 31;
constexpr int NUM_BUCKETS = 32;
constexpr int X_HEADS = 4, X_DH = 64, XW = X_HEADS * X_DH;
constexpr int N_GROUPS = 4, EPG = 4, N_EXPERTS = 16, D_EXPERT = 512;
constexpr float NORM_EPS = 1e-6f;
constexpr int D_IN = 3416;
constexpr int Z_GQ = 0, Z_GK = 192, Z_GV = 384, Z_GLR = 768, Z_GR = 784, Z_DQ = 1168, Z_DK = 1552, Z_DV = 1936, Z_IQ = 2320, Z_IK = 2832, Z_IW = 2896, Z_CU = 2904;
constexpr int ZLD = 3584;
constexpr int MIX_GLA = 0, MIX_DSA = 384, MIX_CONV = 768;
constexpr int PADR = 256;
constexpr int MAXROWS = 2 * T + N_EXPERTS * PADR;

typedef unsigned short bf16_t;
typedef float f32x4 __attribute__((ext_vector_type(4)));

constexpr size_t MiB = 1u << 20;
constexpr size_t WS_CTL = 0, CTL_BYTES = 1 * MiB;
constexpr size_t WS_WIN0 = 1 * MiB, WS_WCKV = 8 * MiB, WS_WIN1 = 10 * MiB, WS_WOUT = 17 * MiB, WS_WCQ = 21 * MiB, WS_WCO = 22 * MiB;
constexpr size_t WS_XN = 24 * MiB;
constexpr size_t WS_MEMN = 56 * MiB;
constexpr size_t WS_Z = 60 * MiB;
constexpr size_t WS_WGU = WS_Z, WS_WDN = WS_Z + 32 * MiB, WS_HB = WS_Z + 48 * MiB;
constexpr size_t WS_MIX = 172 * MiB;
constexpr size_t WS_QN = 204 * MiB, WS_KN = 216 * MiB;
constexpr size_t WS_VT = 228 * MiB;
constexpr size_t WS_MASK = 240 * MiB;
constexpr size_t WS_IK = 248 * MiB, WS_QL = 250 * MiB, WS_CH = 252 * MiB;
constexpr size_t WS_XG = WS_MIX, WS_DB = WS_MIX;
constexpr size_t WS_CQ = 256 * MiB, WS_COIN = 264 * MiB;
constexpr size_t WS_BCUM = 256 * MiB, WS_SLOC = 268 * MiB, WS_DEC = 286 * MiB;
constexpr size_t WS_CKV = 288 * MiB;
constexpr size_t WS_CKN = 290 * MiB;
constexpr size_t WS_CVT = 292 * MiB;
constexpr size_t WS_ROUTE = 291 * MiB;
constexpr size_t WS_END = 293 * MiB;
constexpr int CW_CNT = 1024;
constexpr int CW_Q3 = 2048, CW_Q4 = 2304;

constexpr int NTHREADS = 512, NWAVES = 8;
constexpr int LDS_BYTES = 147456;

__device__ __forceinline__ float bf2f(bf16_t u) { return __uint_as_float(((unsigned)u) << 16); }
__device__ __forceinline__ bf16_t f2bf(float f) { unsigned u = __float_as_uint(f); return (bf16_t)((u + 0x7fffu + ((u >> 16) & 1u)) >> 16); }
__device__ __forceinline__ unsigned pk2(float lo, float hi) { return (unsigned)f2bf(lo) | ((unsigned)f2bf(hi) << 16); }
__device__ __forceinline__ float wave_sum(float v) {
#pragma unroll
    for (int o = 1; o < 64; o <<= 1) v += __shfl_xor(v, o);
    return v;
}
__device__ __forceinline__ float siluf(float x) { return x / (1.f + __expf(-x)); }
__device__ __forceinline__ float sigmoidf(float x) { return 1.f / (1.f + __expf(-x)); }


typedef short bf16x8 __attribute__((ext_vector_type(8)));
typedef float f32x16 __attribute__((ext_vector_type(16)));
typedef unsigned u32x4v __attribute__((ext_vector_type(4)));
typedef __bf16 bf16x2_t __attribute__((ext_vector_type(2)));
typedef float f32x2_t __attribute__((ext_vector_type(2)));
#define LDSAS __attribute__((address_space(3)))
#define MFMA32(a, b, c) __builtin_amdgcn_mfma_f32_32x32x16_bf16((a), (b), (c), 0, 0, 0)
__device__ __forceinline__ int crow(int reg, int hh) { return (reg & 3) + 8 * (reg >> 2) + 4 * hh; }
__device__ __forceinline__ unsigned pkbf(float a, float b) { f32x2_t v = {a, b}; bf16x2_t r = __builtin_convertvector(v, bf16x2_t); return __builtin_bit_cast(unsigned, r); }

struct Args {
    const float* in[30];
    float* out;
    unsigned char* ws;
    int ph_lo, ph_hi;
};

template <class Epi>
__device__ __forceinline__ void gemm_tile_v1(const int tid, float* lds, const bf16_t* A, int lda, const int* rowidx, int row0,
                                             const float* B, int ldb, int col0, int ncols, int K, const Epi& epi) {
    float* As = lds;
    float* Bs = lds + 16 * 132;
    const int ty = tid >> 4, tx = tid & 15;
    float acc[4][8];
#pragma unroll
    for (int i = 0; i < 4; ++i)
#pragma unroll
        for (int j = 0; j < 8; ++j) acc[i][j] = 0.f;
    const int ar = tid >> 2, ak = (tid & 3) * 4;
    const int grow = rowidx ? rowidx[row0 + ar] : (row0 + ar);
    const bf16_t* ap = A + (size_t)(grow >= 0 ? grow : 0) * lda + ak;
    const bool aval = grow >= 0;
    const int bk = tid >> 5, bn = (tid & 31) * 4;
    const bool bval = bn < ncols;
    const float* bp = B + (size_t)bk * ldb + col0 + bn;
    for (int k0 = 0; k0 < K; k0 += 16) {
        uint2 av = make_uint2(0u, 0u);
        if (aval) av = *(const uint2*)(ap + k0);
        f32x4 bv = (f32x4){0.f, 0.f, 0.f, 0.f};
        if (bval) bv = *(const f32x4*)(bp + (size_t)k0 * ldb);
        __syncthreads();
        As[(ak + 0) * 132 + ar] = __uint_as_float(av.x << 16);
        As[(ak + 1) * 132 + ar] = __uint_as_float(av.x & 0xffff0000u);
        As[(ak + 2) * 132 + ar] = __uint_as_float(av.y << 16);
        As[(ak + 3) * 132 + ar] = __uint_as_float(av.y & 0xffff0000u);
        *(f32x4*)&Bs[bk * 132 + bn] = bv;
        __syncthreads();
#pragma unroll
        for (int k = 0; k < 16; ++k) {
            const f32x4 a4 = *(const f32x4*)&As[k * 132 + ty * 4];
            const f32x4 b0 = *(const f32x4*)&Bs[k * 132 + tx * 8];
            const f32x4 b1 = *(const f32x4*)&Bs[k * 132 + tx * 8 + 4];
#pragma unroll
            for (int i = 0; i < 4; ++i) {
                acc[i][0] += a4[i] * b0[0]; acc[i][1] += a4[i] * b0[1]; acc[i][2] += a4[i] * b0[2]; acc[i][3] += a4[i] * b0[3];
                acc[i][4] += a4[i] * b1[0]; acc[i][5] += a4[i] * b1[1]; acc[i][6] += a4[i] * b1[2]; acc[i][7] += a4[i] * b1[3];
            }
        }
    }
    __syncthreads();
#pragma unroll
    for (int i = 0; i < 4; ++i)
        epi(row0 + ty * 4 + i, col0 + tx * 8, (f32x4){acc[i][0], acc[i][1], acc[i][2], acc[i][3]}, (f32x4){acc[i][4], acc[i][5], acc[i][6], acc[i][7]});
}

template <class Epi>
__device__ __forceinline__ void gemm_v1(const int tid, float* lds, const bf16_t* A, int lda, int M, const float* B, int ldb, int N, int K, const Epi& epi) {
    const int nct = (N + 127) / 128, nrt = M / 128;
    for (int tile = blockIdx.x; tile < nrt * nct; tile += gridDim.x) {
        const int rt = tile / nct, ct = tile % nct;
        const int nc = (N - ct * 128) < 128 ? (N - ct * 128) : 128;
        gemm_tile_v1(tid, lds, A, lda, nullptr, rt * 128, B, ldb, ct * 128, nc, K, epi);
    }
}

namespace pg8 {
#define PG8_LAS __attribute__((address_space(3)))
typedef PG8_LAS unsigned char* PG8_LAS_T;
typedef short bf16x8 __attribute__((ext_vector_type(8)));
typedef unsigned u32x4 __attribute__((ext_vector_type(4)));
constexpr int BM = 256, BK = 64, HALF = 128, HTB = HALF * BK * 2  , STAGE_BYTES = 8 * HTB, NXCD = 8, WGM = 8;

__host__ __device__ __forceinline__ int lds_byte(int r, int c) { const int st = (r >> 4) * 2 + (c >> 5), rr = r & 15, cc = c & 31, ob = rr * 64 + cc * 2; return st * 1024 + (ob ^ (((ob >> 9) & 1) << 5)); }
__host__ __device__ __forceinline__ void stage_rc(int b, int& R, int& C) { const int st = b / 1024, sb = b % 1024, swz = sb ^ (((sb >> 9) & 1) << 5); R = (st >> 1) * 16 + swz / 64; C = (st & 1) * 32 + (swz % 64) / 2; }
__host__ __device__ __forceinline__ int perm32(int rho) { const int n = rho >> 4, i = rho & 15; return 8 * (i >> 2) + 4 * n + (i & 3); }

struct Unit { int pm, pn; };
struct Gemm { const bf16_t* A; const bf16_t* Bt; int M, N, K; };

struct StaticOrder {
    int nM, nN, nwg, G, c;
    __host__ __device__ void init(int M, int N, int G_, int c_) { nM = M / BM; nN = N / BM; nwg = nM * nN; G = G_; c = c_; }
    __host__ __device__ bool next(int i, Unit& u) const {
        const long L = (long)i * G + c; if (L >= nwg) return false;
        int wgid = (int)L; { const int q = nwg / NXCD, r = nwg % NXCD, xcd = wgid % NXCD, off = wgid / NXCD; wgid = (xcd < r ? xcd * (q + 1) : r * (q + 1) + (xcd - r) * q) + off; }
        const int nig = WGM * nN, gid = wgid / nig, fm = gid * WGM, gsz = (nM - fm) < WGM ? (nM - fm) : WGM;
        u.pm = fm + ((wgid % nig) % gsz); u.pn = (wgid % nig) / gsz; return true;
    }
    __device__ __forceinline__ void a_ready(const Unit&) const {}
    __device__ __forceinline__ void done(const Unit&) const {}
};

__device__ __forceinline__ unsigned cvt_pk_bf16(float lo, float hi) { unsigned r; asm volatile("v_cvt_pk_bf16_f32 %0, %1, %2" : "=v"(r) : "v"(lo), "v"(hi)); return r; }
typedef float f32x2 __attribute__((ext_vector_type(2)));
template <class Epi, class Sched, bool ALIGN_EPI = false, bool SP2 = false>
__device__ __forceinline__ void gemm_phase(const int tid, PG8_LAS unsigned char* lds, const Gemm g, const Sched& S, const Epi& E) {
    const int wid = __builtin_amdgcn_readfirstlane(tid >> 6), lane = tid & 63, wr = wid >> 2, wc = wid & 3, fr = lane & 15, fq = lane >> 4;
    const int K = g.K, nt = K / BK;
    unsigned voffA[2], voffB[2];
#pragma unroll
    for (int i = 0; i < 2; ++i) { int R, C; stage_rc(tid * 16 + i * 8192, R, C); const int Rb = Epi::PERM ? ((R & ~31) + perm32(R & 31)) : R;
        voffA[i] = (unsigned)(R * K + C) * 2u; voffB[i] = (unsigned)(Rb * K + C) * 2u; }
    const size_t kstep = (size_t)(BK * 2);
    const size_t hstep = (size_t)HALF * K * 2;
    const size_t tstep = 2 * hstep;
    const unsigned ldsw = (unsigned)wid * 1024u;
    const int aoff = lds_byte(wr * 64 + fr, fq * 8), boff = lds_byte(wc * 32 + fr, fq * 8);
#define PG8_SA(b, h) (((b) * 2 + (h)) * HTB)
#define PG8_SB(b, h) ((4 + (b) * 2 + (h)) * HTB)
#define PG8_STAGE(bufoff, gbase, voff) do { _Pragma("unroll") for (int _i = 0; _i < 2; ++_i) \
        __builtin_amdgcn_global_load_lds((const unsigned*)((const char*)(gbase) + (voff)[_i]), (PG8_LAS unsigned*)(lds + (bufoff) + ldsw + _i * 8192), 16, 0, 0); } while (0)
#define PG8_LDA(dst, b, h) do { _Pragma("unroll") for (int m = 0; m < 4; ++m) _Pragma("unroll") for (int k = 0; k < 2; ++k) dst[m][k] = *(const PG8_LAS bf16x8*)(lds + PG8_SA(b, h) + aoff + m * 2048 + k * 1024); } while (0)
#define PG8_LDB(dst, b, h) do { _Pragma("unroll") for (int n = 0; n < 2; ++n) _Pragma("unroll") for (int k = 0; k < 2; ++k) dst[n][k] = *(const PG8_LAS bf16x8*)(lds + PG8_SB(b, h) + boff + n * 2048 + k * 1024); } while (0)
#define PG8_MMA(ai, bj, At, Bt) do { __builtin_amdgcn_s_setprio(1); _Pragma("unroll") for (int m = 0; m < 4; ++m) _Pragma("unroll") for (int n = 0; n < 2; ++n) _Pragma("unroll") for (int k = 0; k < 2; ++k) \
        acc[ai][bj][m][n] = __builtin_amdgcn_mfma_f32_16x16x32_bf16(Bt[n][k], At[m][k], acc[ai][bj][m][n], 0, 0, 0); __builtin_amdgcn_s_setprio(0); } while (0)
#define PG8_WAIT_V(n) asm volatile("s_waitcnt vmcnt(" #n ")" ::: "memory")
#define PG8_WAIT_L(n) asm volatile("s_waitcnt lgkmcnt(" #n ")" ::: "memory")
#define PG8_BAR __builtin_amdgcn_s_barrier()
#define PG8_SCHED __builtin_amdgcn_sched_barrier(0)
    Unit cur, nxt; int ui = 0;
    if (!S.next(0, cur)) return;
    f32x4 acc[2][2][4][2];
#pragma unroll
    for (int a = 0; a < 2; ++a)
#pragma unroll
        for (int b = 0; b < 2; ++b)
#pragma unroll
            for (int m = 0; m < 4; ++m)
#pragma unroll
                for (int n = 0; n < 2; ++n) acc[a][b][m][n] = (f32x4){0.f, 0.f, 0.f, 0.f};
    bf16x8 At[4][2], B0[2][2], B1[2][2];
    const char* cA = (const char*)g.A + (size_t)cur.pm * tstep; const char* cB = (const char*)g.Bt + (size_t)cur.pn * tstep;
    S.a_ready(cur);
    if constexpr (SP2) {
        PG8_STAGE(PG8_SB(0, 0), cB, voffB); PG8_STAGE(PG8_SB(0, 1), cB + hstep, voffB); PG8_STAGE(PG8_SA(0, 0), cA, voffA); PG8_STAGE(PG8_SA(0, 1), cA + hstep, voffA);
        if (wr == 1) PG8_BAR;
        PG8_WAIT_V(2); PG8_BAR;
        PG8_STAGE(PG8_SB(1, 0), cB + kstep, voffB); PG8_STAGE(PG8_SA(1, 0), cA + kstep, voffA); PG8_STAGE(PG8_SB(1, 1), cB + hstep + kstep, voffB);
        PG8_WAIT_V(6); PG8_BAR;
    } else {
        PG8_STAGE(PG8_SB(0, 0), cB, voffB); PG8_STAGE(PG8_SA(0, 0), cA, voffA); PG8_STAGE(PG8_SB(0, 1), cB + hstep, voffB); PG8_STAGE(PG8_SA(0, 1), cA + hstep, voffA);
        if (wr == 1) PG8_BAR;
        PG8_WAIT_V(4); PG8_BAR;
        PG8_STAGE(PG8_SB(1, 0), cB + kstep, voffB); PG8_STAGE(PG8_SA(1, 0), cA + kstep, voffA); PG8_STAGE(PG8_SB(1, 1), cB + hstep + kstep, voffB);
        PG8_WAIT_V(6); PG8_BAR;
    }
    for (;;) {
        const bool has_next = S.next(ui + 1, nxt);
        const char* nA = has_next ? (const char*)g.A + (size_t)nxt.pm * tstep : cA; const char* nB = has_next ? (const char*)g.Bt + (size_t)nxt.pn * tstep : cB;
        for (int t = 0; t < nt; t += 2) {
            const bool last = (t == nt - 2);
            const char* a1 = cA + (size_t)(t + 1) * kstep;
            const char* a2 = last ? nA : cA + (size_t)(t + 2) * kstep; const char* b2 = last ? nB : cB + (size_t)(t + 2) * kstep;
            const char* a3 = a2 + kstep; const char* b3 = b2 + kstep;
            if (last && has_next) S.a_ready(nxt);
            if constexpr (SP2) {
            PG8_LDB(B0, 0, 0); PG8_LDB(B1, 0, 1); PG8_SCHED; PG8_LDA(At, 0, 0); PG8_STAGE(PG8_SA(1, 1), a1 + hstep, voffA);
            PG8_WAIT_V(8); PG8_WAIT_L(0); PG8_BAR; PG8_MMA(0, 0, At, B0); PG8_MMA(0, 1, At, B1); PG8_BAR; PG8_SCHED;
            PG8_LDA(At, 0, 1); PG8_STAGE(PG8_SB(0, 0), b2, voffB); PG8_STAGE(PG8_SB(0, 1), b2 + hstep, voffB); PG8_STAGE(PG8_SA(0, 0), a2, voffA);
            PG8_WAIT_V(8); PG8_WAIT_L(0); PG8_BAR; PG8_MMA(1, 0, At, B0); PG8_MMA(1, 1, At, B1); PG8_BAR; PG8_SCHED;
            PG8_LDB(B0, 1, 0); PG8_LDB(B1, 1, 1); PG8_SCHED; PG8_LDA(At, 1, 0); PG8_STAGE(PG8_SA(0, 1), a2 + hstep, voffA);
            PG8_WAIT_V(8); PG8_WAIT_L(0); PG8_BAR; PG8_MMA(0, 0, At, B0); PG8_MMA(0, 1, At, B1); PG8_BAR; PG8_SCHED;
            PG8_LDA(At, 1, 1); PG8_STAGE(PG8_SB(1, 0), b3, voffB); PG8_STAGE(PG8_SB(1, 1), b3 + hstep, voffB); PG8_STAGE(PG8_SA(1, 0), a3, voffA);
            PG8_WAIT_V(8); PG8_WAIT_L(0); PG8_BAR; PG8_MMA(1, 0, At, B0); PG8_MMA(1, 1, At, B1); PG8_BAR; PG8_SCHED;
            } else {
            PG8_LDB(B0, 0, 0); PG8_SCHED; PG8_LDA(At, 0, 0); PG8_STAGE(PG8_SA(1, 1), a1 + hstep, voffA);
            PG8_WAIT_L(8); PG8_BAR; PG8_WAIT_L(0); PG8_MMA(0, 0, At, B0); PG8_BAR; PG8_SCHED;
            PG8_LDB(B1, 0, 1); PG8_STAGE(PG8_SB(0, 0), b2, voffB);
            PG8_BAR; PG8_WAIT_L(0); PG8_MMA(0, 1, At, B1); PG8_BAR;
            PG8_LDA(At, 0, 1); PG8_STAGE(PG8_SA(0, 0), a2, voffA);
            PG8_BAR; PG8_WAIT_L(0); PG8_MMA(1, 0, At, B0); PG8_BAR; PG8_SCHED;
            PG8_STAGE(PG8_SB(0, 1), b2 + hstep, voffB);
            PG8_WAIT_V(6); PG8_BAR; PG8_MMA(1, 1, At, B1); PG8_BAR;
            PG8_LDB(B0, 1, 0); PG8_SCHED; PG8_LDA(At, 1, 0); PG8_STAGE(PG8_SA(0, 1), a2 + hstep, voffA);
            PG8_WAIT_L(8); PG8_BAR; PG8_WAIT_L(0); PG8_MMA(0, 0, At, B0); PG8_BAR; PG8_SCHED;
            PG8_LDB(B1, 1, 1); PG8_STAGE(PG8_SB(1, 0), b3, voffB);
            PG8_BAR; PG8_WAIT_L(0); PG8_MMA(0, 1, At, B1); PG8_BAR;
            PG8_LDA(At, 1, 1); PG8_STAGE(PG8_SA(1, 0), a3, voffA);
            PG8_BAR; PG8_WAIT_L(0); PG8_MMA(1, 0, At, B0); PG8_BAR; PG8_SCHED;
            PG8_STAGE(PG8_SB(1, 1), b3 + hstep, voffB);
            PG8_WAIT_V(6); PG8_BAR; PG8_MMA(1, 1, At, B1); PG8_BAR;
            }
        }
        if constexpr (ALIGN_EPI) { if (wr == 0) PG8_BAR; }
        if constexpr (!Epi::AFTER_DRAIN) { E(acc, cur, wr, wc, fr, fq); S.done(cur); }
        if (!has_next) break;
#pragma unroll
        for (int a = 0; a < 2; ++a)
#pragma unroll
            for (int b = 0; b < 2; ++b)
#pragma unroll
                for (int m = 0; m < 4; ++m)
#pragma unroll
                    for (int n = 0; n < 2; ++n) acc[a][b][m][n] = (f32x4){0.f, 0.f, 0.f, 0.f};
        cur = nxt; cA = nA; cB = nB; ++ui;
        if constexpr (ALIGN_EPI) { if (wr == 1) PG8_BAR; }
    }
    PG8_WAIT_V(0);
    if constexpr (!ALIGN_EPI) { if (wr == 0) PG8_BAR; }
    PG8_BAR;
    if constexpr (Epi::AFTER_DRAIN) { E.fused(acc, cur, wr, wc, fr, fq, lds, wid, lane); S.done(cur); }
#undef PG8_SA
#undef PG8_SB
#undef PG8_STAGE
#undef PG8_LDA
#undef PG8_LDB
#undef PG8_MMA
#undef PG8_WAIT_V
#undef PG8_WAIT_L
#undef PG8_BAR
#undef PG8_SCHED
}

struct EpiStoreBf16 {
    static constexpr bool PERM = true, AFTER_DRAIN = false;
    bf16_t* O; int ldc; int pnmask;
    __device__ __forceinline__ void operator()(const f32x4 (&acc)[2][2][4][2], const Unit& u, int wr, int wc, int fr, int fq) const {
        const int row0 = u.pm * BM + wr * 64 + fr; const int col0 = (u.pn & pnmask) * BM + wc * 32 + 8 * fq;
#pragma unroll
        for (int ai = 0; ai < 2; ++ai)
#pragma unroll
            for (int m = 0; m < 4; ++m) { bf16_t* rowp = O + (size_t)(row0 + ai * HALF + m * 16) * ldc + col0;
#pragma unroll
                for (int bj = 0; bj < 2; ++bj) { const f32x4 v0 = acc[ai][bj][m][0], v1 = acc[ai][bj][m][1];
                    u32x4 w; w.x = cvt_pk_bf16(v0[0], v0[1]); w.y = cvt_pk_bf16(v0[2], v0[3]); w.z = cvt_pk_bf16(v1[0], v1[1]); w.w = cvt_pk_bf16(v1[2], v1[3]);
                    *(u32x4*)(rowp + bj * HALF) = w; } }
    }
};
struct EpiRes {
    static constexpr bool PERM = false, AFTER_DRAIN = false;
    const float* base; float* out; int ldc;
    __device__ __forceinline__ void operator()(const f32x4 (&acc)[2][2][4][2], const Unit& u, int wr, int wc, int fr, int fq) const {
        const int row0 = u.pm * BM + wr * 64 + fr; const int col0 = u.pn * BM + wc * 32 + 4 * fq;
#pragma unroll
        for (int ai = 0; ai < 2; ++ai)
#pragma unroll
            for (int m = 0; m < 4; ++m) { const size_t off = (size_t)(row0 + ai * HALF + m * 16) * ldc + col0;
#pragma unroll
                for (int bj = 0; bj < 2; ++bj)
#pragma unroll
                    for (int n = 0; n < 2; ++n) { const f32x4 b = *(const f32x4*)(base + off + bj * HALF + n * 16); *(f32x4*)(out + off + bj * HALF + n * 16) = b + acc[ai][bj][m][n]; } }
    }
};
struct EpiGateUp {
    static constexpr bool PERM = true, AFTER_DRAIN = false;
    bf16_t* O; int ldc;
    __device__ __forceinline__ static float silu(float x) { return x / (1.f + __expf(-x)); }
    __device__ __forceinline__ void operator()(const f32x4 (&acc)[2][2][4][2], const Unit& u, int wr, int wc, int fr, int fq) const {
        const int row0 = u.pm * BM + wr * 64 + fr; const int col0 = ((u.pn & 3) * BM + wc * 32 + 8 * fq) >> 1;
#pragma unroll
        for (int ai = 0; ai < 2; ++ai)
#pragma unroll
            for (int m = 0; m < 4; ++m) { bf16_t* rowp = O + (size_t)(row0 + ai * HALF + m * 16) * ldc + col0;
#pragma unroll
                for (int bj = 0; bj < 2; ++bj) { const f32x4 v0 = acc[ai][bj][m][0], v1 = acc[ai][bj][m][1];
                    uint2 w; w.x = cvt_pk_bf16(silu(v0[0]) * v0[1], silu(v0[2]) * v0[3]); w.y = cvt_pk_bf16(silu(v1[0]) * v1[1], silu(v1[2]) * v1[3]);
                    *(uint2*)(rowp + bj * (HALF / 2)) = w; } }
    }
};
struct InprojSched {
    StaticOrder base; int extra;
    __device__ __forceinline__ bool next(int i, Unit& u) const {
        if (base.next(i, u)) return true;
        const long L = (long)i * base.G + base.c - base.nwg;
        if (L < 0 || L >= extra) return false;
        const int e = (int)L; u.pm = base.nM + (e >> 3) * 4 + ((e >> 1) & 3); u.pn = base.nN + (e >> 3) * 2 + (e & 1); return true;
    }
    __device__ __forceinline__ void a_ready(const Unit&) const {}
    __device__ __forceinline__ void done(const Unit&) const {}
};
struct EpiInproj {
    static constexpr bool PERM = true, AFTER_DRAIN = false;
    bf16_t* Zp; bf16_t* CKVp;
    __device__ __forceinline__ void operator()(const f32x4 (&acc)[2][2][4][2], const Unit& u, int wr, int wc, int fr, int fq) const {
        const bool kv = u.pm >= 64;
        const int ll = (u.pm - 64) >> 2;
        bf16_t* O = kv ? CKVp + (size_t)ll * 1024 * 512 : Zp; const int ldc = kv ? 512 : 3584;
        const int row0 = (kv ? ((u.pm - 64) & 3) : u.pm) * BM + wr * 64 + fr; const int col0 = (kv ? ((u.pn - 14) & 1) : u.pn) * BM + wc * 32 + 8 * fq;
#pragma unroll
        for (int ai = 0; ai < 2; ++ai)
#pragma unroll
            for (int m = 0; m < 4; ++m) { bf16_t* rowp = O + (size_t)(row0 + ai * HALF + m * 16) * ldc + col0;
#pragma unroll
                for (int bj = 0; bj < 2; ++bj) { const f32x4 v0 = acc[ai][bj][m][0], v1 = acc[ai][bj][m][1];
                    u32x4 w; w.x = cvt_pk_bf16(v0[0], v0[1]); w.y = cvt_pk_bf16(v0[2], v0[3]); w.z = cvt_pk_bf16(v1[0], v1[1]); w.w = cvt_pk_bf16(v1[2], v1[3]);
                    *(u32x4*)(rowp + bj * HALF) = w; } }
    }
};
struct GroupSched {
    int off[17]; int nunits, G, c;
    __device__ __forceinline__ bool next(int i, Unit& u) const {
        const int L = i * G + c; if (L >= nunits) return false;
        const int rt = L >> 2, pn = L & 3, row0 = rt * BM; int e = 0;
#pragma unroll
        for (int q = 1; q < 16; ++q) e = (row0 >= off[q]) ? q : e;
        u.pm = rt; u.pn = e * 4 + pn; return true;
    }
    __device__ __forceinline__ void a_ready(const Unit&) const {}
    __device__ __forceinline__ void done(const Unit&) const {}
};
}

__device__ __forceinline__ void rmsnorm_row_bf16(const float* xrow, const float* g, bf16_t* orow, int lane) {
    f32x4 v[4]; float s = 0.f;
#pragma unroll
    for (int j = 0; j < 4; ++j) { v[j] = *(const f32x4*)(xrow + lane * 4 + 256 * j); s += v[j][0] * v[j][0] + v[j][1] * v[j][1] + v[j][2] * v[j][2] + v[j][3] * v[j][3]; }
    const float rinv = 1.0f / sqrtf(wave_sum(s) * (1.f / 1024.f) + NORM_EPS);
#pragma unroll
    for (int j = 0; j < 4; ++j) {
        const f32x4 gg = *(const f32x4*)(g + lane * 4 + 256 * j);
        uint2 o; o.x = pk2(v[j][0] * rinv * gg[0], v[j][1] * rinv * gg[1]); o.y = pk2(v[j][2] * rinv * gg[2], v[j][3] * rinv * gg[3]);
        *(uint2*)(orow + lane * 4 + 256 * j) = o;
    }
}

__device__ __forceinline__ void transpose_item(const float* W, int K, int N, int nblk, bf16_t* WT, int row_off, int rmul, int radd, float* scr, int item, int lane) {
    const int kb = item / nblk, nb = item % nblk, k0 = 64 * kb, n0 = 32 * nb;
    const bool nv = (n0 + (lane & 31)) < N;
#pragma unroll 8
    for (int i = 0; i < 32; ++i) { const int kk = 2 * i + (lane >> 5); scr[kk * 33 + (lane & 31)] = nv ? W[(size_t)(k0 + kk) * N + n0 + (lane & 31)] : 0.f; }
    __builtin_amdgcn_s_waitcnt(0xc07f); __builtin_amdgcn_wave_barrier();
    const int c = lane & 7;
#pragma unroll
    for (int j = 0; j < 4; ++j) { const int n = (lane >> 3) + 8 * j; const float* sp = scr + (8 * c) * 33 + n;
        uint4 o; o.x = pk2(sp[0 * 33], sp[1 * 33]); o.y = pk2(sp[2 * 33], sp[3 * 33]); o.z = pk2(sp[4 * 33], sp[5 * 33]); o.w = pk2(sp[6 * 33], sp[7 * 33]);
        *(uint4*)(WT + (size_t)(row_off + (n0 + n) * rmul + radd) * K + k0 + 8 * c) = o; }
    __builtin_amdgcn_s_waitcnt(0xc07f); __builtin_amdgcn_wave_barrier();
}

__device__ __forceinline__ int t5_bucket(int dist) {
    if (dist < 16) return dist;
    const float d = (float)dist;
    int large = 16 + (int)(__logf(d * (1.f / 16.f)) * (16.0f / 2.0794415416798357f));
    return large < 31 ? large : 31;
}
__device__ __forceinline__ unsigned fkey(float f) { const unsigned u = __float_as_uint(f + 0.0f); return (u & 0x80000000u) ? ~u : (u | 0x80000000u); }


#define LAS __attribute__((address_space(3)))
#define XB_TMO      128
#define XB_XCNT(j)  (256  + 64 * (j))
#define XB_XSUB(j)  (1280 + 64 * (j))
#define XB_XGEN(j)  (2304 + 64 * (j))
#define XB_TOP      3328
#define XB_TOPGEN   3392
#define XCD_BAR_WORDS 3456
#define XB_SPIN_CAP (1u << 24)
__device__ __forceinline__ unsigned xb_ld(unsigned* p)              { return __hip_atomic_load(p, __ATOMIC_RELAXED, __HIP_MEMORY_SCOPE_AGENT); }
__device__ __forceinline__ unsigned xb_add(unsigned* p, unsigned v) { return __hip_atomic_fetch_add(p, v, __ATOMIC_RELAXED, __HIP_MEMORY_SCOPE_AGENT); }
__device__ __forceinline__ unsigned xb_xcc_id() { return (unsigned)__builtin_amdgcn_s_getreg((3 << 11) | 20) & 0xFu; }
#define XB_SPIN(cond, bar) do { unsigned _sp = 0; while (cond) { __builtin_amdgcn_s_sleep(1); \
    if ((++_sp & 255u) == 0u) { if (xb_ld(&(bar)[XB_TMO])) break; if (_sp > XB_SPIN_CAP) { atomicAdd(&(bar)[XB_TMO], 1u); break; } } } } while (0)
struct XcdBarrier { unsigned* bar; unsigned x; volatile LAS unsigned* st; };
__device__ __forceinline__ XcdBarrier xcd_barrier_post(unsigned* bar, volatile LAS unsigned* st) {
    XcdBarrier b; b.bar = bar; b.x = xb_xcc_id(); b.st = st;
    if (threadIdx.x == 0) (void)xb_add(&bar[XB_XCNT(b.x)], 1u);
    return b;
}
__device__ __forceinline__ void xcd_barrier_complete(unsigned* bar, unsigned x, unsigned& nloc, unsigned& nx) {
    const unsigned G = gridDim.x * gridDim.y * gridDim.z;
    unsigned sum, cnt, mine, sp = 0u;
    for (;;) {
        sum = 0u; cnt = 0u; mine = 0u;
#pragma unroll
        for (unsigned j = 0; j < 16; ++j) { const unsigned c = xb_ld(&bar[XB_XCNT(j)]); sum += c; cnt += (c > 0u) ? 1u : 0u; mine = (j == x) ? c : mine; }
        if (sum == G) break;
        __builtin_amdgcn_s_sleep(1);
        if ((++sp & 255u) == 0u) { if (xb_ld(&bar[XB_TMO])) break; if (sp > XB_SPIN_CAP) { atomicAdd(&bar[XB_TMO], 1u); break; } }
    }
    nloc = mine > 0u ? mine : 1u; nx = cnt > 0u ? cnt : 1u;
}
__device__ __forceinline__ void xcd_barrier(const XcdBarrier& b) {
    asm volatile("s_waitcnt vmcnt(0)" ::: "memory");
    __syncthreads();
    if (threadIdx.x == 0) {
        unsigned* bar = b.bar;
        __builtin_amdgcn_s_waitcnt(0);
        unsigned nloc = b.st[0], nx = b.st[1];
        if (nloc == 0u) { xcd_barrier_complete(bar, b.x, nloc, nx); b.st[0] = nloc; b.st[1] = nx; }
        const unsigned old = xb_add(&bar[XB_XSUB(b.x)], 1u);
        const unsigned gen = old / nloc;
        if (old + 1u == (gen + 1u) * nloc) {
            __builtin_amdgcn_fence(__ATOMIC_RELEASE, "agent");
            asm volatile("s_waitcnt vmcnt(0)" ::: "memory");
            const unsigned og = xb_add(&bar[XB_TOP], 1u);
            const unsigned tg = og / nx;
            if (og + 1u == (tg + 1u) * nx) xb_add(&bar[XB_TOPGEN], 1u);
            else XB_SPIN(xb_ld(&bar[XB_TOPGEN]) == tg, bar);
            __builtin_amdgcn_fence(__ATOMIC_ACQUIRE, "agent");
            xb_add(&bar[XB_XGEN(b.x)], 1u);
            asm volatile("s_waitcnt vmcnt(0)" ::: "memory");
        } else {
            XB_SPIN(xb_ld(&bar[XB_XGEN(b.x)]) == gen, bar);
            __builtin_amdgcn_fence(__ATOMIC_ACQUIRE, "agent");
            asm volatile("s_waitcnt vmcnt(0)" ::: "memory");
        }
    }
    __syncthreads();
}
constexpr int CW_BAR = 4096;
constexpr int LDSCTL_OFF = LDS_BYTES - 256;

constexpr int NP = 15;
#ifndef MK_PHMASK
#define MK_PHMASK 0x7fff
#endif
#define PH_ON(x) (((MK_PHMASK) >> (x)) & 1)

template <int KSEL>
__global__ void __launch_bounds__(NTHREADS, 2) mk_fwd(Args args) {
    extern __shared__ __attribute__((aligned(16))) unsigned char lds_raw[];
    float* ldsf = (float*)lds_raw;
    const int G = gridDim.x, bid = blockIdx.x, NGW = G * NWAVES;
    const int wave_s = __builtin_amdgcn_readfirstlane(threadIdx.x >> 6);
    unsigned char* ws = args.ws;
    unsigned* ctl = (unsigned*)(ws + WS_CTL);
    bf16_t* XN = (bf16_t*)(ws + WS_XN);
    bf16_t* Z = (bf16_t*)(ws + WS_Z);
    bf16_t* XG = (bf16_t*)(ws + WS_XG);
    bf16_t* VT = (bf16_t*)(ws + WS_VT); unsigned* MASK = (unsigned*)(ws + WS_MASK); bf16_t* IK = (bf16_t*)(ws + WS_IK); bf16_t* QL = (bf16_t*)(ws + WS_QL); float* CH = (float*)(ws + WS_CH);
    float* BCUM = (float*)(ws + WS_BCUM); float* SLOC = (float*)(ws + WS_SLOC); float* DEC = (float*)(ws + WS_DEC);
    bf16_t* WIN0 = (bf16_t*)(ws + WS_WIN0); bf16_t* WIN1 = (bf16_t*)(ws + WS_WIN1); bf16_t* WOUT = (bf16_t*)(ws + WS_WOUT); bf16_t* WCQ = (bf16_t*)(ws + WS_WCQ); bf16_t* WCKV = (bf16_t*)(ws + WS_WCKV); bf16_t* WCO = (bf16_t*)(ws + WS_WCO);
    bf16_t* WGU = (bf16_t*)(ws + WS_WGU); bf16_t* WDN = (bf16_t*)(ws + WS_WDN);
    pg8::PG8_LAS_T ldsq = (pg8::PG8_LAS_T)lds_raw;
    bf16_t* HB = (bf16_t*)(ws + WS_HB);
    bf16_t* MIX = (bf16_t*)(ws + WS_MIX);
    bf16_t* DB = (bf16_t*)(ws + WS_DB);
    bf16_t* QN = (bf16_t*)(ws + WS_QN);
    bf16_t* KN = (bf16_t*)(ws + WS_KN);
    bf16_t* CQ = (bf16_t*)(ws + WS_CQ);
    bf16_t* COIN = (bf16_t*)(ws + WS_COIN);
    bf16_t* MEMN = (bf16_t*)(ws + WS_MEMN);
    bf16_t* CKV = (bf16_t*)(ws + WS_CKV);
    bf16_t* CKN = (bf16_t*)(ws + WS_CKN);
    bf16_t* CVT = (bf16_t*)(ws + WS_CVT);
    int* tok_e = (int*)(ws + WS_ROUTE);
    int* tok_r = tok_e + 2 * T;
    float* tok_g = (float*)(tok_r + 2 * T);
    float* OUT = args.out;
    XcdBarrier bar; bar.bar = ctl + CW_BAR; bar.x = 0; bar.st = nullptr;
    if (KSEL < 0) {
        volatile LAS unsigned* st = (volatile LAS unsigned*)((LAS unsigned char*)lds_raw + LDSCTL_OFF);
        if (threadIdx.x < 64) st[threadIdx.x] = 0u;
        __syncthreads();
        bar = xcd_barrier_post(ctl + CW_BAR, st);
    }

#ifndef MK_REPEAT_PH
#define MK_REPEAT_PH (-1)
#define MK_REPEAT_N 0
#endif
    const int nvirt = (args.ph_hi - args.ph_lo) + ((MK_REPEAT_PH >= 0) ? MK_REPEAT_N : 0);
    for (int vi = 0; vi < nvirt; ++vi) {
        const int ph = (MK_REPEAT_PH < 0 || vi <= MK_REPEAT_PH) ? args.ph_lo + vi : ((vi <= MK_REPEAT_PH + MK_REPEAT_N) ? MK_REPEAT_PH : args.ph_lo + vi - MK_REPEAT_N);
        const int rep = (MK_REPEAT_PH >= 0 && vi > MK_REPEAT_PH && vi <= MK_REPEAT_PH + MK_REPEAT_N) ? vi - MK_REPEAT_PH : 0;
        if (KSEL < 0 && ph >= NP && (ph % NP) == 0) continue;
        if (KSEL < 0 && vi > 0) xcd_barrier(bar);
        int tid_op = wave_s * 64 + (int)__builtin_amdgcn_mbcnt_hi(~0u, __builtin_amdgcn_mbcnt_lo(~0u, 0u)); asm volatile("" : "+v"(tid_op));
        const int tid = tid_op, lane = tid & 63, wave = __builtin_amdgcn_readfirstlane(tid >> 6), gw = bid * NWAVES + wave;
#ifdef MK_PROF_A
        if (bid == 0 && tid == 0) ctl[8192 + ph] = (unsigned)__builtin_amdgcn_s_memrealtime();
#endif
        const int l = ph / NP, k = (KSEL >= 0) ? KSEL : (ph % NP);
        const float* xin = (l == 0) ? args.in[0] : OUT;
        unsigned* cnt = ctl + CW_CNT + 64 * l;

        if (k == 0 && PH_ON(0)) {
            const float* g = args.in[3] + l * D_MODEL;
            for (int r = gw; r < T; r += NGW) rmsnorm_row_bf16(xin + (size_t)r * D_MODEL, g, XN + (size_t)r * D_MODEL, lane);
            if (l == 0) {
                float* scr = ldsf + wave * (64 * 33);
                constexpr int I_IN = 16 * 112, I_OUT = 16 * 32, I_CQ = 16 * 8, I_CKV = 16 * 16, I_CO = 4 * 32, I_L = I_IN + I_OUT + I_CQ + I_CKV + I_CO;
                for (int it = gw; it < DEPTH * I_L; it += NGW) {
                    const int ll = it / I_L; int r = it % I_L;
                    if (r < I_IN) { transpose_item(args.in[4] + (size_t)ll * D_MODEL * D_IN, D_MODEL, D_IN, 112, (ll == 0 ? WIN0 : WIN1), 0, 1, 0, scr, r, lane); continue; } r -= I_IN;
                    if (r < I_OUT) { transpose_item(args.in[14] + (size_t)ll * D_MODEL * D_MODEL, D_MODEL, D_MODEL, 32, WOUT + (size_t)ll * D_MODEL * D_MODEL, 0, 1, 0, scr, r, lane); continue; } r -= I_OUT;
                    if (r < I_CQ) { transpose_item(args.in[17] + (size_t)ll * D_MODEL * XW, D_MODEL, XW, 8, WCQ + (size_t)ll * XW * D_MODEL, 0, 1, 0, scr, r, lane); continue; } r -= I_CQ;
                    if (r < I_CKV) { transpose_item(args.in[18] + (size_t)ll * D_MODEL * 512, D_MODEL, 512, 16, WCKV + (size_t)ll * 512 * D_MODEL, 0, 1, 0, scr, r, lane); continue; } r -= I_CKV;
                    transpose_item(args.in[21] + (size_t)ll * XW * D_MODEL, XW, D_MODEL, 32, WCO + (size_t)ll * D_MODEL * XW, 0, 1, 0, scr, r, lane);
                }
            }
            if (l == 0)
                for (int r = gw; r < 2 * BATCH * MEM_LEN; r += NGW) {
                    const int ll = r / (BATCH * MEM_LEN), rr = r % (BATCH * MEM_LEN);
                    rmsnorm_row_bf16(args.in[1] + (size_t)rr * D_MODEL, args.in[16] + ll * D_MODEL, MEMN + (size_t)r * D_MODEL, lane);
                }
        } else if (k == 1 && PH_ON(1)) {
            {
                pg8::Gemm g{XN, l == 0 ? WIN0 : WIN1, T, ZLD, D_MODEL};
                pg8::InprojSched S; S.base.init(T, ZLD, G, bid); S.extra = (l == 0) ? 16 : 0;
                pg8::EpiInproj E{Z, CKV};
                pg8::gemm_phase<pg8::EpiInproj, pg8::InprojSched, true, true>(tid, ldsq, g, S, E);
            }
        } else if (k == 2 && PH_ON(2)) {
            {
                float* lr = ldsf;
                float* la = ldsf + 1024;
                float* ks = ldsf + 4160;
                float* vs = ldsf + 7488;
                float* seg = ldsf + 13888;
                const float* wa2 = args.in[5] + (size_t)l * GLA_RANK * 192;
                const float* ba = args.in[6] + l * 192;
                for (int item = bid; item < BATCH * GLA_HEADS * 64; item += G) {
                    const int bh = item >> 6, c = item & 63, b = bh >> 2, h = bh & 3, tok0 = b * SEQ + c * 64;
                    __syncthreads();
                    if (tid < 128) { const int t = tid >> 1, c8 = (tid & 1) * 8; const uint4 u = *(const uint4*)(Z + (size_t)(tok0 + t) * ZLD + Z_GLR + c8);
                        *(f32x4*)&lr[t * 16 + c8] = (f32x4){__uint_as_float(u.x << 16), __uint_as_float(u.x & 0xffff0000u), __uint_as_float(u.y << 16), __uint_as_float(u.y & 0xffff0000u)};
                        *(f32x4*)&lr[t * 16 + c8 + 4] = (f32x4){__uint_as_float(u.z << 16), __uint_as_float(u.z & 0xffff0000u), __uint_as_float(u.w << 16), __uint_as_float(u.w & 0xffff0000u)}; }
                    if (tid < 384) { const int t = tid / 6, c8 = (tid % 6) * 8; const uint4 u = *(const uint4*)(Z + (size_t)(tok0 + t) * ZLD + Z_GK + h * 48 + c8);
                        *(f32x4*)&ks[t * 52 + c8] = (f32x4){__uint_as_float(u.x << 16), __uint_as_float(u.x & 0xffff0000u), __uint_as_float(u.y << 16), __uint_as_float(u.y & 0xffff0000u)};
                        *(f32x4*)&ks[t * 52 + c8 + 4] = (f32x4){__uint_as_float(u.z << 16), __uint_as_float(u.z & 0xffff0000u), __uint_as_float(u.w << 16), __uint_as_float(u.w & 0xffff0000u)}; }
                    for (int i = tid; i < 64 * 12; i += NTHREADS) { const int t = i / 12, c8 = (i % 12) * 8; const uint4 u = *(const uint4*)(Z + (size_t)(tok0 + t) * ZLD + Z_GV + h * 96 + c8);
                        *(f32x4*)&vs[t * 100 + c8] = (f32x4){__uint_as_float(u.x << 16), __uint_as_float(u.x & 0xffff0000u), __uint_as_float(u.y << 16), __uint_as_float(u.y & 0xffff0000u)};
                        *(f32x4*)&vs[t * 100 + c8 + 4] = (f32x4){__uint_as_float(u.z << 16), __uint_as_float(u.z & 0xffff0000u), __uint_as_float(u.w << 16), __uint_as_float(u.w & 0xffff0000u)}; }
                    __syncthreads();
                    for (int i = tid; i < 64 * 48; i += NTHREADS) { const int t = i / 48, d = i % 48;
                        float x = ba[h * 48 + d];
#pragma unroll
                        for (int r = 0; r < GLA_RANK; ++r) x += lr[t * 16 + r] * wa2[r * 192 + h * 48 + d];
                        la[t * 49 + d] = (fminf(x, 0.f) - log1pf(__expf(-fabsf(x)))) * (1.f / 16.f); }
                    __syncthreads();
                    const int cd = tid % 48, cs = tid / 48;
                    if (tid < 384) { float run = 0.f;
#pragma unroll
                        for (int j2 = 0; j2 < 8; ++j2) { run += la[(cs * 8 + j2) * 49 + cd]; la[(cs * 8 + j2) * 49 + cd] = run; }
                        seg[cs * 48 + cd] = run; }
                    __syncthreads();
                    if (tid < 384) { float base = 0.f;
                        for (int q = 0; q < cs; ++q) base += seg[q * 48 + cd];
#pragma unroll
                        for (int j2 = 0; j2 < 8; ++j2) { const float v = la[(cs * 8 + j2) * 49 + cd] + base; la[(cs * 8 + j2) * 49 + cd] = v; BCUM[(size_t)(tok0 + cs * 8 + j2) * 192 + h * 48 + cd] = v; } }
                    __syncthreads();
                    for (int i = tid; i < 64 * 48; i += NTHREADS) { const int t = i / 48, d = i % 48; ks[t * 52 + d] *= __expf(la[63 * 49 + d] - la[t * 49 + d]); }
                    if (tid < 48) DEC[(size_t)item * 48 + tid] = __expf(la[63 * 49 + tid]);
                    __syncthreads();
                    if (tid < 288) {
                        const int d0 = (tid / 24) * 4, v0 = (tid % 24) * 4;
                        float acc[4][4];
#pragma unroll
                        for (int x = 0; x < 4; ++x)
#pragma unroll
                            for (int y = 0; y < 4; ++y) acc[x][y] = 0.f;
#pragma unroll 4
                        for (int sidx = 0; sidx < 64; ++sidx) { const f32x4 kv = *(const f32x4*)&ks[sidx * 52 + d0], vv = *(const f32x4*)&vs[sidx * 100 + v0];
#pragma unroll
                            for (int x = 0; x < 4; ++x)
#pragma unroll
                                for (int y = 0; y < 4; ++y) acc[x][y] += kv[x] * vv[y]; }
#pragma unroll
                        for (int x = 0; x < 4; ++x) *(f32x4*)(SLOC + (size_t)item * 4608 + (d0 + x) * 96 + v0) = (f32x4){acc[x][0], acc[x][1], acc[x][2], acc[x][3]};
                    }
                }
                __syncthreads();
            }
            {
                const float* gq = args.in[8] + l * DSA_DH; const float* gk = args.in[9] + l * DSA_DH;
                for (int it = bid * NTHREADS + tid; it < T * 12; it += G * NTHREADS) {
                    const int tok = it / 12, jj = it % 12, isk = jj / 6, hd = jj % 6;
                    const uint4* src = (const uint4*)(Z + (size_t)tok * ZLD + (isk ? Z_DK : Z_DQ) + hd * 64);
                    uint4 u[8]; float ss = 0.f;
#pragma unroll
                    for (int c = 0; c < 8; ++c) { u[c] = src[c];
                        const float a0 = __uint_as_float(u[c].x << 16), a1 = __uint_as_float(u[c].x & 0xffff0000u), a2 = __uint_as_float(u[c].y << 16), a3 = __uint_as_float(u[c].y & 0xffff0000u);
                        const float a4 = __uint_as_float(u[c].z << 16), a5 = __uint_as_float(u[c].z & 0xffff0000u), a6 = __uint_as_float(u[c].w << 16), a7 = __uint_as_float(u[c].w & 0xffff0000u);
                        ss += a0 * a0 + a1 * a1 + a2 * a2 + a3 * a3 + a4 * a4 + a5 * a5 + a6 * a6 + a7 * a7; }
                    const float rn = (isk ? 1.0f : (0.125f * 1.4426950408889634f)) / sqrtf(ss * (1.f / 64.f) + NORM_EPS);
                    const float* gp = isk ? gk : gq;
                    uint4* dst = (uint4*)((isk ? KN : QN) + (size_t)tok * 384 + hd * 64);
#pragma unroll
                    for (int c = 0; c < 8; ++c) { const f32x4 g0 = *(const f32x4*)(gp + c * 8), g1 = *(const f32x4*)(gp + c * 8 + 4);
                        uint4 o;
                        o.x = pk2(__uint_as_float(u[c].x << 16) * rn * g0[0], __uint_as_float(u[c].x & 0xffff0000u) * rn * g0[1]);
                        o.y = pk2(__uint_as_float(u[c].y << 16) * rn * g0[2], __uint_as_float(u[c].y & 0xffff0000u) * rn * g0[3]);
                        o.z = pk2(__uint_as_float(u[c].z << 16) * rn * g1[0], __uint_as_float(u[c].z & 0xffff0000u) * rn * g1[1]);
                        o.w = pk2(__uint_as_float(u[c].w << 16) * rn * g1[2], __uint_as_float(u[c].w & 0xffff0000u) * rn * g1[3]);
                        dst[c] = o; }
                }
                for (int it = bid * NTHREADS + tid; it < T * 8; it += G * NTHREADS) {
                    const int tok = it >> 3, c8 = (it & 7) * 8;
                    const bf16_t* zr = Z + (size_t)tok * ZLD;
                    const uint4 wu = *(const uint4*)(zr + Z_IW);
                    const float cw[8] = {__uint_as_float(wu.x << 16), __uint_as_float(wu.x & 0xffff0000u), __uint_as_float(wu.y << 16), __uint_as_float(wu.y & 0xffff0000u),
                                         __uint_as_float(wu.z << 16), __uint_as_float(wu.z & 0xffff0000u), __uint_as_float(wu.w << 16), __uint_as_float(wu.w & 0xffff0000u)};
                    float ql[8];
#pragma unroll
                    for (int e = 0; e < 8; ++e) ql[e] = 0.f;
#pragma unroll
                    for (int hq = 0; hq < IDX_HEADS; ++hq) { const float c = cw[hq] * (0.35355339059327373f * 0.0625f); const uint4 qu = *(const uint4*)(zr + Z_IQ + hq * 64 + c8);
                        ql[0] += c * __uint_as_float(qu.x << 16); ql[1] += c * __uint_as_float(qu.x & 0xffff0000u); ql[2] += c * __uint_as_float(qu.y << 16); ql[3] += c * __uint_as_float(qu.y & 0xffff0000u);
                        ql[4] += c * __uint_as_float(qu.z << 16); ql[5] += c * __uint_as_float(qu.z & 0xffff0000u); ql[6] += c * __uint_as_float(qu.w << 16); ql[7] += c * __uint_as_float(qu.w & 0xffff0000u); }
                    uint4 o; o.x = pk2(ql[0], ql[1]); o.y = pk2(ql[2], ql[3]); o.z = pk2(ql[4], ql[5]); o.w = pk2(ql[6], ql[7]);
                    *(uint4*)(QL + (size_t)tok * 64 + c8) = o;
                    *(uint4*)(IK + (size_t)tok * 64 + c8) = *(const uint4*)(zr + Z_IK + c8);
                    if (c8 == 0) { *(f32x4*)(CH + (size_t)tok * 8) = (f32x4){cw[0], cw[1], cw[2], cw[3]} * (0.35355339059327373f * 0.0625f); *(f32x4*)(CH + (size_t)tok * 8 + 4) = (f32x4){cw[4], cw[5], cw[6], cw[7]} * (0.35355339059327373f * 0.0625f); }
                }
            }
            for (int tile = bid; tile < BATCH * 128; tile += G) {
                if (tid < 384) {
                    const bf16_t* zb = Z + (size_t)(tile * 32) * ZLD + Z_DV + tid;
                    unsigned w[16];
#pragma unroll
                    for (int p2 = 0; p2 < 16; ++p2) {
                        const int p = 2 * p2, sst = p >> 4, hh2 = (p >> 3) & 1, j = p & 7;
                        const int key0 = 16 * sst + 8 * (j >> 2) + 4 * hh2 + (j & 3);
                        w[p2] = (unsigned)zb[(size_t)key0 * ZLD] | ((unsigned)zb[(size_t)(key0 + 1) * ZLD] << 16);
                    }
                    uint4* dst = (uint4*)(VT + ((size_t)tile * 384 + tid) * 32);
                    dst[0] = make_uint4(w[0], w[1], w[2], w[3]); dst[1] = make_uint4(w[4], w[5], w[6], w[7]); dst[2] = make_uint4(w[8], w[9], w[10], w[11]); dst[3] = make_uint4(w[12], w[13], w[14], w[15]);
                }
            }
            if (l == 0) {
                for (int i = bid * NTHREADS + tid; i < DEPTH * BATCH * X_HEADS * 64 * MEM_LEN; i += G * NTHREADS) {
                    const int p = i & 255, d = (i >> 8) & 63, h = (i >> 14) & 3, bb = (i >> 16) & 3, ll = i >> 18;
                    const int pg = p & 31, sst = pg >> 4, hh2 = (pg >> 3) & 1, j2 = pg & 7;
                    const int key = (p & ~31) + 16 * sst + 8 * (j2 >> 2) + 4 * hh2 + (j2 & 3);
                    CVT[i] = CKV[((size_t)ll * BATCH * MEM_LEN + (size_t)bb * MEM_LEN + key) * 512 + 256 + h * 64 + d];
                }
                for (int r = gw; r < DEPTH * BATCH * MEM_LEN; r += NGW) {
                    const int ll = r / (BATCH * MEM_LEN);
                    const float gkl = args.in[20][ll * X_DH + lane];
#pragma unroll
                    for (int h = 0; h < X_HEADS; ++h) {
                        const float kk = bf2f(CKV[(size_t)r * 512 + h * 64 + lane]);
                        const float rk = 1.0f / sqrtf(wave_sum(kk * kk) * (1.f / 64.f) + NORM_EPS);
                        CKN[(size_t)r * 256 + h * 64 + lane] = f2bf(kk * rk * gkl);
                    }
                }
            }
            {
                const float* cw = args.in[10] + (size_t)l * CONV_W * CONV_CH;
                const float* cb = args.in[11] + l * CONV_CH; const float* lg = args.in[12] + l * CONV_CH; const float* lb = args.in[13] + l * CONV_CH;
                float* ct = ldsf + 1024;
                float* hL = ldsf + 1024 + 32 * 256;
                const int c = tid & 255, half = tid >> 8;
                float wreg[CONV_W];
#pragma unroll
                for (int j = 0; j < CONV_W; ++j) wreg[j] = cw[j * CONV_CH + c];
                const float cbias = cb[c];
                for (int item = bid; item < T / 32; item += G) {
                    const int tok0 = item * 32;
                    const int tb = tok0 % SEQ;
                    __syncthreads();
                    for (int i = tid; i < 62 * 32; i += NTHREADS) {
                        const int rr = i >> 5, c8 = (i & 31) * 8, tp = tb - 30 + rr;
                        f32x4 h0 = (f32x4){0.f, 0.f, 0.f, 0.f}, h1 = h0;
                        if (tp >= 0) {
                            const bf16_t* zr = Z + (size_t)(tok0 - 30 + rr) * ZLD + Z_CU + c8;
                            const uint4 au = *(const uint4*)zr, gu = *(const uint4*)(zr + 256);
                            h0[0] = __uint_as_float(au.x << 16) * sigmoidf(__uint_as_float(gu.x << 16)); h0[1] = __uint_as_float(au.x & 0xffff0000u) * sigmoidf(__uint_as_float(gu.x & 0xffff0000u));
                            h0[2] = __uint_as_float(au.y << 16) * sigmoidf(__uint_as_float(gu.y << 16)); h0[3] = __uint_as_float(au.y & 0xffff0000u) * sigmoidf(__uint_as_float(gu.y & 0xffff0000u));
                            h1[0] = __uint_as_float(au.z << 16) * sigmoidf(__uint_as_float(gu.z << 16)); h1[1] = __uint_as_float(au.z & 0xffff0000u) * sigmoidf(__uint_as_float(gu.z & 0xffff0000u));
                            h1[2] = __uint_as_float(au.w << 16) * sigmoidf(__uint_as_float(gu.w << 16)); h1[3] = __uint_as_float(au.w & 0xffff0000u) * sigmoidf(__uint_as_float(gu.w & 0xffff0000u));
                        }
                        *(f32x4*)&hL[rr * 256 + c8] = h0; *(f32x4*)&hL[rr * 256 + c8 + 4] = h1;
                    }
                    __syncthreads();
                    {
                        float hwin[46];
#pragma unroll
                        for (int i = 0; i < 46; ++i) hwin[i] = hL[(half * 16 + i) * 256 + c];
#pragma unroll
                        for (int o = 0; o < 16; ++o) {
                            float a = cbias;
#pragma unroll
                            for (int j = 0; j < CONV_W; ++j) a += hwin[o + j] * wreg[j];
                            ct[(half * 16 + o) * 256 + c] = a;
                        }
                    }
                    __syncthreads();
#pragma unroll
                    for (int i = 0; i < 4; ++i) {
                        const int tt = wave * 4 + i;
                        const f32x4 v = *(const f32x4*)&ct[tt * 256 + lane * 4];
                        const float mu = wave_sum(v[0] + v[1] + v[2] + v[3]) * (1.f / 256.f);
                        const f32x4 dv = v - mu;
                        const float var = wave_sum(dv[0] * dv[0] + dv[1] * dv[1] + dv[2] * dv[2] + dv[3] * dv[3]) * (1.f / 256.f);
                        const float rstd = 1.0f / sqrtf(var + NORM_EPS);
                        const f32x4 gg = *(const f32x4*)(lg + lane * 4), bb = *(const f32x4*)(lb + lane * 4);
                        f32x4 y = dv * rstd * gg + bb;
                        uint2 o; o.x = pk2(siluf(y[0]), siluf(y[1])); o.y = pk2(siluf(y[2]), siluf(y[3]));
                        *(uint2*)(MIX + (size_t)(tok0 + tt) * D_MODEL + MIX_CONV + lane * 4) = o;
                    }
                }
            }
        } else if (k == 3 && PH_ON(3)) {
            if (rep == 0)
            for (int e = bid * NTHREADS + tid; e < BATCH * GLA_HEADS * 4608; e += G * NTHREADS) {
                const int bh = e / 4608, idx = e % 4608, d = idx / 96;
                float state = 0.f;
#pragma unroll 16
                for (int c = 0; c < 64; ++c) {
                    const size_t it = (size_t)bh * 64 + c;
                    const float tmp = SLOC[it * 4608 + idx], dec = DEC[it * 48 + d];
                    SLOC[it * 4608 + idx] = state; state = dec * state + tmp; }
            }
            {
                unsigned* hist32 = (unsigned*)lds_raw;
                unsigned* rs = (unsigned*)(lds_raw + 131072);
                volatile unsigned* qsh = (volatile unsigned*)(lds_raw + LDSCTL_OFF + 64);
                unsigned* qhead = ctl + CW_Q3 + 64 * l + rep;
                const int qc = lane & 15, g4 = lane >> 4, qh = wave >> 2, kg = wave & 3;
                const int row = 16 * qh + qc;
                for (;;) {
                    __syncthreads();
                    if (tid == 0) qsh[0] = atomicAdd(qhead, 1u);
                    __syncthreads();
                    const int it = (int)qsh[0];
                    if (it >= BATCH * 128) break;
                    const int b = it & 3, qt = 127 - (it >> 2);
                    const int tokb = b * SEQ, q0 = qt * 32, tq = q0 + row;
                    bf16x8 qf[9][2];
                    {
                        const bf16_t* zq = Z + (size_t)(tokb + tq) * ZLD + Z_IQ + g4 * 8;
#pragma unroll
                        for (int h = 0; h < 8; ++h)
#pragma unroll
                            for (int ks = 0; ks < 2; ++ks) qf[h][ks] = *(const bf16x8*)(zq + h * 64 + ks * 32);
                        const bf16_t* ql = QL + (size_t)(tokb + tq) * 64 + g4 * 8;
#pragma unroll
                        for (int ks = 0; ks < 2; ++ks) qf[8][ks] = *(const bf16x8*)(ql + ks * 32);
                    }
                    float ch[8];
                    { const f32x4 c0 = *(const f32x4*)(CH + (size_t)(tokb + tq) * 8), c1 = *(const f32x4*)(CH + (size_t)(tokb + tq) * 8 + 4);
                      ch[0] = c0[0]; ch[1] = c0[1]; ch[2] = c0[2]; ch[3] = c0[3]; ch[4] = c1[0]; ch[5] = c1[1]; ch[6] = c1[2]; ch[7] = c1[3]; }
                    if (qt < 8) {
                        if (kg == 0 && g4 == 0) for (int kt = 0; kt <= qt; ++kt) MASK[((size_t)(b * 128) + kt) * SEQ + tq] = (kt < qt || row == 31) ? 0xffffffffu : ((1u << (row + 1)) - 1u);
                        continue;
                    }
#pragma unroll
                    for (int i = 0; i < 16; ++i) ((uint4*)hist32)[tid + 512 * i] = make_uint4(0u, 0u, 0u, 0u);
                    if (tid < 32) { rs[tid] = 0u; rs[32 + tid] = TOPK; rs[64 + tid] = 0u; rs[96 + tid] = 0u; }
                    __syncthreads();
#define DSA_SCORE(kt_) \
                        f32x4 sc[2]; \
                        { const bf16_t* kp = IK + (size_t)(tokb + (kt_) * 32 + qc) * 64 + g4 * 8; \
                          bf16x8 kf[2][2]; \
                          _Pragma("unroll") for (int u = 0; u < 2; ++u) _Pragma("unroll") for (int ks = 0; ks < 2; ++ks) kf[u][ks] = *(const bf16x8*)(kp + u * 16 * 64 + ks * 32); \
                          _Pragma("unroll") for (int u = 0; u < 2; ++u) { sc[u] = (f32x4){0.f, 0.f, 0.f, 0.f}; \
                              _Pragma("unroll") for (int ks = 0; ks < 2; ++ks) sc[u] = __builtin_amdgcn_mfma_f32_16x16x32_bf16(kf[u][ks], qf[8][ks], sc[u], 0, 0, 0); } \
                          _Pragma("unroll") for (int h = 0; h < 8; ++h) _Pragma("unroll") for (int u = 0; u < 2; ++u) { f32x4 a = (f32x4){0.f, 0.f, 0.f, 0.f}; \
                              _Pragma("unroll") for (int ks = 0; ks < 2; ++ks) a = __builtin_amdgcn_mfma_f32_16x16x32_bf16(kf[u][ks], qf[h][ks], a, 0, 0, 0); \
                              _Pragma("unroll") for (int i = 0; i < 4; ++i) sc[u][i] = __builtin_fmaf(fabsf(a[i]), ch[h], sc[u][i]); } }
                    for (int pass = 0; pass < 2; ++pass) {
                        const unsigned mmask = (pass == 0) ? 0u : 0xFFE00000u;
                        const int bshift = (pass == 0) ? 21 : 10;
                        const unsigned bmask = 2047u;
                        const unsigned prefm = rs[row];
                        for (int kt = kg; kt <= qt; kt += 4) {
                            DSA_SCORE(kt)
#pragma unroll
                            for (int u = 0; u < 2; ++u)
#pragma unroll
                                for (int i = 0; i < 4; ++i) {
                                    const int sidx = kt * 32 + 16 * u + 4 * g4 + i;
                                    const unsigned key = fkey(sc[u][i]);
                                    if (sidx <= tq && (key & mmask) == prefm) { const unsigned bin = (key >> bshift) & bmask; atomicAdd(&hist32[row * 1024 + (bin >> 1)], 1u << ((bin & 1u) * 16u)); }
                                }
                        }
                        __syncthreads();
                        for (int rr = 0; rr < 4; ++rr) {
                            const int R = wave * 4 + rr;
                            const unsigned kremR = rs[32 + R];
                            const uint4* hw = (const uint4*)(hist32 + R * 1024 + lane * 16);
                            unsigned cntl = 0u;
#pragma unroll
                            for (int q4 = 0; q4 < 4; ++q4) { const uint4 w = hw[q4]; cntl += (w.x & 0xffffu) + (w.x >> 16) + (w.y & 0xffffu) + (w.y >> 16) + (w.z & 0xffffu) + (w.z >> 16) + (w.w & 0xffffu) + (w.w >> 16); }
                            unsigned suf = cntl;
#pragma unroll
                            for (int o = 1; o < 64; o <<= 1) { const unsigned tv = __shfl_down(suf, o); if (lane + o < 64) suf += tv; }
                            const unsigned excl = suf - cntl;
                            if (excl < kremR && kremR <= suf) {
                                unsigned above = excl, eq = 0u; int bin = 0;
#pragma unroll 1
                                for (int i = 15; i >= 0; --i) { const unsigned w = hist32[R * 1024 + lane * 16 + i]; const unsigned hi = w >> 16, lo = w & 0xffffu;
                                    if (above + hi >= kremR) { bin = 2 * (lane * 16 + i) + 1; eq = hi; break; } above += hi;
                                    if (above + lo >= kremR) { bin = 2 * (lane * 16 + i); eq = lo; break; } above += lo; }
                                rs[R] = rs[R] | ((unsigned)bin << bshift); rs[32 + R] = kremR - above; rs[64 + R] = eq;
                            }
                        }
                        __syncthreads();
#pragma unroll
                        for (int i = 0; i < 16; ++i) ((uint4*)hist32)[tid + 512 * i] = make_uint4(0u, 0u, 0u, 0u);
                        __syncthreads();
                    }
                    {
                        const unsigned tau = rs[row]; const bool tiecrit = rs[64 + row] > rs[32 + row];
                        unsigned* mcol = MASK + (size_t)(b * 128) * SEQ + tq;
                        for (int kt = kg; kt <= qt; kt += 4) {
                            DSA_SCORE(kt)
                            unsigned bits = 0u;
#pragma unroll
                            for (int u = 0; u < 2; ++u)
#pragma unroll
                                for (int i = 0; i < 4; ++i) {
                                    const int sidx = kt * 32 + 16 * u + 4 * g4 + i;
                                    const unsigned key = fkey(sc[u][i]), key22 = key & 0xFFFFFC00u;
                                    const bool valid = sidx <= tq;
                                    if (valid && (key22 > tau || (key22 == tau && !tiecrit))) bits |= 1u << (16 * u + 4 * g4 + i);
                                    if (valid && key22 == tau && tiecrit) { const unsigned idx = atomicAdd(&rs[96 + row], 1u); if (idx < 511u) { hist32[row * 1024 + 2 * idx] = key; hist32[row * 1024 + 2 * idx + 1] = (unsigned)sidx; } }
                                }
                            bits |= (unsigned)__shfl_xor((int)bits, 16);
                            bits |= (unsigned)__shfl_xor((int)bits, 32);
                            if (g4 == 0) mcol[(size_t)kt * SEQ] = bits;
                        }
                        asm volatile("s_waitcnt vmcnt(0)" ::: "memory");
                        __syncthreads();
                        if (tid < 32 && rs[64 + tid] > rs[32 + tid]) {
                            int tdx = tid; asm volatile("" : "+v"(tdx));
                            unsigned nl = rs[96 + tid]; if (nl > 511u) nl = 511u;
                            const unsigned need = rs[32 + tid];
                            unsigned* lst = hist32 + tdx * 1024;
                            for (unsigned q = 0; q < need && q < nl; ++q) {
                                unsigned bk = 0u, bs = 0xffffffffu, bi = 0u;
                                for (unsigned e2 = 0; e2 < nl; ++e2) { const unsigned kv = lst[2 * e2], sv = lst[2 * e2 + 1]; if (sv != 0xffffffffu && (kv > bk || (kv == bk && sv < bs))) { bk = kv; bs = sv; bi = e2; } }
                                lst[2 * bi + 1] = 0xffffffffu;
                                if (bs != 0xffffffffu) atomicOr(MASK + ((size_t)(b * 128) + (bs >> 5)) * SEQ + q0 + tdx, 1u << (bs & 31u));
                            }
                        }
                    }
#undef DSA_SCORE
                }
            }
        } else if (k == 4 && PH_ON(4)) {
            float* qt = ldsf;
            float* kt = qt + 64 * 49;
            float* vs = kt + 64 * 49;
            float* Am = vs + 64 * 97;
            float* Sin = Am + 64 * 65;
            const float* gon = args.in[7] + l * GLA_DV;
            volatile unsigned* qsh = (volatile unsigned*)(lds_raw + LDSCTL_OFF + 64);
            unsigned* qhead = ctl + CW_Q4 + 64 * l + rep;
            float* biasd = (float*)(lds_raw + 131072);
            for (int i = tid; i < 6 * 224; i += NTHREADS) { const int h = i / 224, d = i % 224 - 32; biasd[i] = d < 0 ? 0.f : args.in[2][t5_bucket(d) * DSA_HEADS + h] * 1.4426950408889634f; }
            constexpr int N_ATT = BATCH * 32 * 3;
            for (;;) {
                __syncthreads();
                if (tid == 0) qsh[0] = atomicAdd(qhead, 1u);
                __syncthreads();
                const int qit = (int)qsh[0];
#ifndef MK_GLA2_REP
#define MK_GLA2_REP 1
#endif
                if (qit >= N_ATT + MK_GLA2_REP * BATCH * GLA_HEADS * 64) break;
                if (qit < N_ATT) {
                    const int qt = 31 - qit / 12, rem = qit % 12, b = rem & 3, h0 = 2 * (rem >> 2);
                    const int tokb = b * SEQ, q0 = qt * 128, nkt = 4 * (qt + 1);
                    int tid_a = tid; asm volatile("" : "+v"(tid_a));
                    const int la = tid_a & 63, r = la & 31, hh = la >> 5;
                    const int qg = wave & 3, hd = wave >> 2, h = h0 + hd;
                    const int tq = q0 + 32 * qg + r;
                    LDSAS unsigned char* lb = (LDSAS unsigned char*)lds_raw;
                    LDSAS unsigned* maskl = (LDSAS unsigned*)(lb + 65536);
                    for (int idx = tid_a; idx < nkt * 128; idx += NTHREADS) maskl[idx] = MASK[((size_t)(b * 128) + (idx >> 7)) * SEQ + q0 + (idx & 127)];
                    bf16x8 qf[4];
#pragma unroll
                    for (int ks = 0; ks < 4; ++ks) qf[ks] = *(const bf16x8*)(QN + (size_t)(tokb + tq) * 384 + h * 64 + ks * 16 + hh * 8);
                    f32x16 oacc[2];
#pragma unroll
                    for (int dt = 0; dt < 2; ++dt)
#pragma unroll
                        for (int i = 0; i < 16; ++i) oacc[dt][i] = 0.f;
                    float lsum = 0.f;
                    const int krow = 4 * wave + (la >> 4), kpos = la & 15;
                    const int vrow = 16 * wave + (la >> 2), vpos = la & 3;
                    const char* ksrc = (const char*)KN + ((size_t)(tokb + krow) * 384 + h0 * 64) * 2 + ((kpos ^ (krow & 15)) * 16);
                    const char* vsrc = (const char*)VT + ((size_t)(b * 128) * 384 + h0 * 64 + vrow) * 64 + ((vpos ^ ((vrow >> 2) & 3)) * 16);
                    int koff[4], voff[2][2];
#pragma unroll
                    for (int ks = 0; ks < 4; ++ks) koff[ks] = r * 256 + (((hd * 8 + ks * 2 + hh) ^ (r & 15)) * 16);
#pragma unroll
                    for (int dt = 0; dt < 2; ++dt)
#pragma unroll
                        for (int sst = 0; sst < 2; ++sst) { const int vr = hd * 64 + dt * 32 + r; voff[dt][sst] = 8192 + vr * 64 + (((2 * sst + hh) ^ ((vr >> 2) & 3)) * 16); }
#define ATT_ISSUE(kt_, st_) do { const int ktc = (kt_) < nkt ? (kt_) : nkt - 1; \
                        __builtin_amdgcn_global_load_lds((const unsigned*)(ksrc + (size_t)ktc * (32 * 768)), (LDSAS unsigned*)(lb + (st_) * 16384 + wave * 1024), 16, 0, 0); \
                        __builtin_amdgcn_global_load_lds((const unsigned*)(vsrc + (size_t)ktc * (384 * 64)), (LDSAS unsigned*)(lb + (st_) * 16384 + 8192 + wave * 1024), 16, 0, 0); } while (0)
                    __syncthreads();
                    ATT_ISSUE(0, 0); ATT_ISSUE(1, 1); ATT_ISSUE(2, 2);
                    for (int kt = 0; kt < nkt; ++kt) {
                        asm volatile("s_waitcnt vmcnt(4)" ::: "memory");
                        __builtin_amdgcn_s_barrier();
                        asm volatile("" ::: "memory");
                        ATT_ISSUE(kt + 3, (kt + 3) & 3);
                        if (kt * 32 <= q0 + 32 * qg + 31) {
                            LDSAS unsigned char* st = lb + (kt & 3) * 16384;
                            const unsigned mwh = maskl[kt * 128 + 32 * qg + r] >> (4 * hh);
                            const int mind = (q0 + 32 * qg) - (kt * 32 + 31);
                            f32x16 S;
#pragma unroll
                            for (int i = 0; i < 16; ++i) S[i] = 0.f;
#pragma unroll
                            for (int ks = 0; ks < 4; ++ks) { const bf16x8 a = *(const LDSAS bf16x8*)(st + koff[ks]); S = MFMA32(a, qf[ks], S); }
                            float p[16];
                            if (mind >= 113) {
                                const float bu = biasd[h * 224 + 223];
#pragma unroll
                                for (int i = 0; i < 16; ++i) p[i] = __uint_as_float(__float_as_uint(__builtin_amdgcn_exp2f(S[i] + bu)) & (unsigned)__builtin_amdgcn_sbfe((int)mwh, (i & 3) + 8 * (i >> 2), 1));
                            } else {
                                const float* bp = biasd + h * 224 + (tq - kt * 32 - 4 * hh + 5);
#pragma unroll
                                for (int i = 0; i < 16; ++i) p[i] = __uint_as_float(__float_as_uint(__builtin_amdgcn_exp2f(S[i] + bp[27 - (i & 3) - 8 * (i >> 2)])) & (unsigned)__builtin_amdgcn_sbfe((int)mwh, (i & 3) + 8 * (i >> 2), 1));
                            }
                            float ps = 0.f;
#pragma unroll
                            for (int i = 0; i < 16; ++i) ps += p[i];
                            lsum += ps;
                            uint4 u0, u1;
                            u0.x = pkbf(p[0], p[1]); u0.y = pkbf(p[2], p[3]); u0.z = pkbf(p[4], p[5]); u0.w = pkbf(p[6], p[7]);
                            u1.x = pkbf(p[8], p[9]); u1.y = pkbf(p[10], p[11]); u1.z = pkbf(p[12], p[13]); u1.w = pkbf(p[14], p[15]);
                            const bf16x8 pf0 = __builtin_bit_cast(bf16x8, u0), pf1 = __builtin_bit_cast(bf16x8, u1);
#pragma unroll
                            for (int dt = 0; dt < 2; ++dt) {
                                const bf16x8 a0 = *(const LDSAS bf16x8*)(st + voff[dt][0]);
                                const bf16x8 a1 = *(const LDSAS bf16x8*)(st + voff[dt][1]);
                                oacc[dt] = MFMA32(a0, pf0, oacc[dt]);
                                oacc[dt] = MFMA32(a1, pf1, oacc[dt]);
                            }
                        }
                    }
#undef ATT_ISSUE
                    asm volatile("s_waitcnt vmcnt(0)" ::: "memory");
                    {
                        const float lt = lsum + __shfl_xor(lsum, 32);
                        float inv = 1.f / lt;
                        bf16_t* mo = MIX + (size_t)(tokb + tq) * D_MODEL + MIX_DSA + h * 64;
#pragma unroll
                        for (int dt = 0; dt < 2; ++dt)
#pragma unroll
                            for (int g4 = 0; g4 < 4; ++g4) {
                                uint2 o; o.x = pkbf(oacc[dt][4 * g4] * inv, oacc[dt][4 * g4 + 1] * inv); o.y = pkbf(oacc[dt][4 * g4 + 2] * inv, oacc[dt][4 * g4 + 3] * inv);
                                *(uint2*)(mo + dt * 32 + 8 * g4 + 4 * hh) = o;
                            }
                    }
                    continue;
                }
                const int item = (qit - N_ATT) % (BATCH * GLA_HEADS * 64);
                const int bh = item >> 6, c = item & 63, b = bh >> 2, h = bh & 3, tok0 = b * SEQ + c * 64;
                int tid_g = tid; asm volatile("" : "+v"(tid_g));
                __syncthreads();
                {
                    float* qT = ldsf + 3328;
                    float* kt2 = ldsf + 6592;
                    float* vs2 = ldsf + 9920;
                    float* AmT = ldsf + 16320;
                    float* Sin2 = ldsf + 20672;
                    float* ssq = ldsf + 25472;
                    float* qt2 = ldsf;
                    if (tid_g < 384) {
                        const int t = tid_g / 6, c8 = (tid_g % 6) * 8;
                        const bf16_t* zr = Z + (size_t)(tok0 + t) * ZLD;
                        const uint4 qu = *(const uint4*)(zr + Z_GQ + h * 48 + c8), ku = *(const uint4*)(zr + Z_GK + h * 48 + c8);
                        const f32x4 b0 = *(const f32x4*)(BCUM + (size_t)(tok0 + t) * 192 + h * 48 + c8), b1 = *(const f32x4*)(BCUM + (size_t)(tok0 + t) * 192 + h * 48 + c8 + 4);
                        const float qv[8] = {__uint_as_float(qu.x << 16), __uint_as_float(qu.x & 0xffff0000u), __uint_as_float(qu.y << 16), __uint_as_float(qu.y & 0xffff0000u), __uint_as_float(qu.z << 16), __uint_as_float(qu.z & 0xffff0000u), __uint_as_float(qu.w << 16), __uint_as_float(qu.w & 0xffff0000u)};
                        const float kv[8] = {__uint_as_float(ku.x << 16), __uint_as_float(ku.x & 0xffff0000u), __uint_as_float(ku.y << 16), __uint_as_float(ku.y & 0xffff0000u), __uint_as_float(ku.z << 16), __uint_as_float(ku.z & 0xffff0000u), __uint_as_float(ku.w << 16), __uint_as_float(ku.w & 0xffff0000u)};
                        const float bb[8] = {b0[0], b0[1], b0[2], b0[3], b1[0], b1[1], b1[2], b1[3]};
#pragma unroll
                        for (int e = 0; e < 8; ++e) { const float qq = qv[e] * 0.14433756729740643f * __expf(bb[e]); qt2[t * 52 + c8 + e] = qq; qT[(c8 + e) * 68 + t] = qq; kt2[t * 52 + c8 + e] = kv[e] * __expf(-bb[e]); }
                    }
                    for (int i = tid_g; i < 64 * 12; i += NTHREADS) { const int t = i / 12, c8 = (i % 12) * 8;
                        const uint4 vu = *(const uint4*)(Z + (size_t)(tok0 + t) * ZLD + Z_GV + h * 96 + c8);
                        *(f32x4*)&vs2[t * 100 + c8] = (f32x4){__uint_as_float(vu.x << 16), __uint_as_float(vu.x & 0xffff0000u), __uint_as_float(vu.y << 16), __uint_as_float(vu.y & 0xffff0000u)};
                        *(f32x4*)&vs2[t * 100 + c8 + 4] = (f32x4){__uint_as_float(vu.z << 16), __uint_as_float(vu.z & 0xffff0000u), __uint_as_float(vu.w << 16), __uint_as_float(vu.w & 0xffff0000u)}; }
                    for (int i = tid_g; i < 48 * 24; i += NTHREADS) { const int d = i / 24, v4 = (i % 24) * 4; *(f32x4*)&Sin2[d * 100 + v4] = *(const f32x4*)(SLOC + (size_t)item * 4608 + d * 96 + v4); }
                    __syncthreads();
                    if (tid_g < 256) {
                        const int t0 = (tid_g >> 4) * 4, s0 = (tid_g & 15) * 4;
                        float a[4][4];
#pragma unroll
                        for (int x = 0; x < 4; ++x)
#pragma unroll
                            for (int y = 0; y < 4; ++y) a[x][y] = 0.f;
                        if (s0 <= t0 + 3) {
#pragma unroll 3
                            for (int d = 0; d < 48; d += 4) {
                                f32x4 qv4[4], kv4[4];
#pragma unroll
                                for (int x = 0; x < 4; ++x) { qv4[x] = *(const f32x4*)&qt2[(t0 + x) * 52 + d]; kv4[x] = *(const f32x4*)&kt2[(s0 + x) * 52 + d]; }
#pragma unroll
                                for (int x = 0; x < 4; ++x)
#pragma unroll
                                    for (int y = 0; y < 4; ++y) a[x][y] += qv4[x][0] * kv4[y][0] + qv4[x][1] * kv4[y][1] + qv4[x][2] * kv4[y][2] + qv4[x][3] * kv4[y][3];
                            }
                        }
#pragma unroll
                        for (int y = 0; y < 4; ++y) *(f32x4*)&AmT[(s0 + y) * 68 + t0] = (f32x4){(s0 + y <= t0) ? a[0][y] : 0.f, (s0 + y <= t0 + 1) ? a[1][y] : 0.f, (s0 + y <= t0 + 2) ? a[2][y] : 0.f, (s0 + y <= t0 + 3) ? a[3][y] : 0.f};
                    }
                    __syncthreads();
                    float o[4][4];
                    const int t0 = (tid_g / 24) * 4, v0 = (tid_g % 24) * 4;
#pragma unroll
                    for (int x = 0; x < 4; ++x)
#pragma unroll
                        for (int y = 0; y < 4; ++y) o[x][y] = 0.f;
                    float* part = ldsf + 25536;
                    if (tid_g < 384) {
                        for (int sidx = 0; sidx <= t0 + 3; ++sidx) { const f32x4 av = *(const f32x4*)&AmT[sidx * 68 + t0], vv = *(const f32x4*)&vs2[sidx * 100 + v0];
#pragma unroll
                            for (int x = 0; x < 4; ++x)
#pragma unroll
                                for (int y = 0; y < 4; ++y) o[x][y] += av[x] * vv[y]; }
#pragma unroll 4
                        for (int d = 0; d < 48; ++d) { const f32x4 qv4 = *(const f32x4*)&qT[d * 68 + t0], sv = *(const f32x4*)&Sin2[d * 100 + v0];
#pragma unroll
                            for (int x = 0; x < 4; ++x)
#pragma unroll
                                for (int y = 0; y < 4; ++y) o[x][y] += qv4[x] * sv[y]; }
#pragma unroll
                        for (int x = 0; x < 4; ++x) part[(t0 + x) * 24 + (v0 >> 2)] = o[x][0] * o[x][0] + o[x][1] * o[x][1] + o[x][2] * o[x][2] + o[x][3] * o[x][3];
                    }
                    __syncthreads();
                    if (tid_g < 64) { float sq = 0.f;
#pragma unroll
                        for (int q = 0; q < 24; ++q) sq += part[tid_g * 24 + q];
                        ssq[tid_g] = sq; }
                    __syncthreads();
                    if (tid_g < 384) {
                        const f32x4 gg = *(const f32x4*)(gon + v0);
#pragma unroll
                        for (int x = 0; x < 4; ++x) {
                            const float rinv = 1.0f / sqrtf(ssq[t0 + x] * (1.f / 96.f) + NORM_EPS);
                            const uint2 ru = *(const uint2*)(Z + (size_t)(tok0 + t0 + x) * ZLD + Z_GR + h * 96 + v0);
                            uint2 w; w.x = pk2(o[x][0] * rinv * gg[0] * siluf(__uint_as_float(ru.x << 16)), o[x][1] * rinv * gg[1] * siluf(__uint_as_float(ru.x & 0xffff0000u)));
                            w.y = pk2(o[x][2] * rinv * gg[2] * siluf(__uint_as_float(ru.y << 16)), o[x][3] * rinv * gg[3] * siluf(__uint_as_float(ru.y & 0xffff0000u)));
                            *(uint2*)(MIX + (size_t)(tok0 + t0 + x) * D_MODEL + MIX_GLA + h * 96 + v0) = w;
                        }
                    }
                }
            }
        } else if (k == 5 && PH_ON(5)) {
            pg8::Gemm g{MIX, WOUT + (size_t)l * D_MODEL * D_MODEL, T, D_MODEL, D_MODEL}; pg8::StaticOrder S; S.init(T, D_MODEL, G, bid);
            pg8::EpiRes E{xin, OUT, D_MODEL};
            pg8::gemm_phase<pg8::EpiRes, pg8::StaticOrder, true, true>(tid, ldsq, g, S, E);
        } else if (k == 6 && PH_ON(6)) {
            const float* g = args.in[15] + l * D_MODEL;
            for (int r = gw; r < T; r += NGW) rmsnorm_row_bf16(OUT + (size_t)r * D_MODEL, g, XN + (size_t)r * D_MODEL, lane);
            {
                float* scr = ldsf + wave * (64 * 33);
                constexpr int I_G = 16 * 16, I_D = 8 * 32, I_E = 2 * I_G + I_D;
                for (int it = gw; it < N_EXPERTS * I_E; it += NGW) {
                    const int e = it / I_E; int r = it % I_E;
                    const size_t we = (size_t)l * N_EXPERTS + e;
                    if (r < I_G) { transpose_item(args.in[27] + we * D_MODEL * D_EXPERT, D_MODEL, D_EXPERT, 16, WGU + (size_t)e * 1024 * D_MODEL, 0, 2, 0, scr, r, lane); continue; } r -= I_G;
                    if (r < I_G) { transpose_item(args.in[28] + we * D_MODEL * D_EXPERT, D_MODEL, D_EXPERT, 16, WGU + (size_t)e * 1024 * D_MODEL, 0, 2, 1, scr, r, lane); continue; } r -= I_G;
                    transpose_item(args.in[29] + we * D_EXPERT * D_MODEL, D_EXPERT, D_MODEL, 32, WDN + (size_t)e * D_MODEL * D_EXPERT, 0, 1, 0, scr, r, lane);
                }
            }
        } else if (k == 7 && PH_ON(7)) {
            pg8::Gemm g{XN, WCQ + (size_t)l * XW * D_MODEL, T, XW, D_MODEL}; pg8::StaticOrder S; S.init(T, XW, G, bid);
            pg8::EpiStoreBf16 E{CQ, XW, 0xffff};
            pg8::gemm_phase<pg8::EpiStoreBf16, pg8::StaticOrder, true, true>(tid, ldsq, g, S, E);
        } else if (k == 8 && PH_ON(8)) {
            {
                const float* gq = args.in[19] + l * X_DH;
                const int r = lane & 31, hh = lane >> 5;
                for (int item = gw; item < BATCH * X_HEADS * (SEQ / 32); item += NGW) {
                    const int tt = item & 127, h = (item >> 7) & 3, b = item >> 9;
                    const int tok = b * SEQ + tt * 32 + r;
                    bf16x8 qf[4];
                    {
                        float qv[4][8]; float ss = 0.f;
#pragma unroll
                        for (int ks = 0; ks < 4; ++ks) { const uint4 u = *(const uint4*)(CQ + (size_t)tok * XW + h * 64 + ks * 16 + hh * 8);
                            qv[ks][0] = __uint_as_float(u.x << 16); qv[ks][1] = __uint_as_float(u.x & 0xffff0000u); qv[ks][2] = __uint_as_float(u.y << 16); qv[ks][3] = __uint_as_float(u.y & 0xffff0000u);
                            qv[ks][4] = __uint_as_float(u.z << 16); qv[ks][5] = __uint_as_float(u.z & 0xffff0000u); qv[ks][6] = __uint_as_float(u.w << 16); qv[ks][7] = __uint_as_float(u.w & 0xffff0000u);
#pragma unroll
                            for (int e = 0; e < 8; ++e) ss += qv[ks][e] * qv[ks][e]; }
                        ss += __shfl_xor(ss, 32);
                        const float rq = (0.125f * 1.4426950408889634f) / sqrtf(ss * (1.f / 64.f) + NORM_EPS);
#pragma unroll
                        for (int ks = 0; ks < 4; ++ks) { const f32x4 g0 = *(const f32x4*)(gq + ks * 16 + hh * 8), g1 = *(const f32x4*)(gq + ks * 16 + hh * 8 + 4);
                            uint4 u; u.x = pkbf(qv[ks][0] * rq * g0[0], qv[ks][1] * rq * g0[1]); u.y = pkbf(qv[ks][2] * rq * g0[2], qv[ks][3] * rq * g0[3]);
                            u.z = pkbf(qv[ks][4] * rq * g1[0], qv[ks][5] * rq * g1[1]); u.w = pkbf(qv[ks][6] * rq * g1[2], qv[ks][7] * rq * g1[3]);
                            qf[ks] = __builtin_bit_cast(bf16x8, u); }
                    }
                    f32x16 oacc[2];
#pragma unroll
                    for (int dt = 0; dt < 2; ++dt)
#pragma unroll
                        for (int e = 0; e < 16; ++e) oacc[dt][e] = 0.f;
                    float lsm = 0.f;
                    const bf16_t* kb = CKN + ((size_t)l * BATCH * MEM_LEN + (size_t)b * MEM_LEN + r) * 256 + h * 64 + hh * 8;
                    const bf16_t* vb = CVT + ((size_t)((l * BATCH + b) * X_HEADS + h) * 64 + r) * 256 + hh * 8;
#pragma unroll 2
                    for (int kt = 0; kt < 8; ++kt) {
                        f32x16 S;
#pragma unroll
                        for (int e = 0; e < 16; ++e) S[e] = 0.f;
#pragma unroll
                        for (int ks = 0; ks < 4; ++ks) { const bf16x8 a = *(const bf16x8*)(kb + (size_t)kt * 32 * 256 + ks * 16); S = MFMA32(a, qf[ks], S); }
                        float p[16]; float ps = 0.f;
#pragma unroll
                        for (int e = 0; e < 16; ++e) { p[e] = __builtin_amdgcn_exp2f(S[e]); ps += p[e]; }
                        lsm += ps;
                        uint4 u0, u1;
                        u0.x = pkbf(p[0], p[1]); u0.y = pkbf(p[2], p[3]); u0.z = pkbf(p[4], p[5]); u0.w = pkbf(p[6], p[7]);
                        u1.x = pkbf(p[8], p[9]); u1.y = pkbf(p[10], p[11]); u1.z = pkbf(p[12], p[13]); u1.w = pkbf(p[14], p[15]);
                        const bf16x8 pf0 = __builtin_bit_cast(bf16x8, u0), pf1 = __builtin_bit_cast(bf16x8, u1);
#pragma unroll
                        for (int dt = 0; dt < 2; ++dt) {
                            const bf16x8 a0 = *(const bf16x8*)(vb + (size_t)dt * 32 * 256 + kt * 32);
                            const bf16x8 a1 = *(const bf16x8*)(vb + (size_t)dt * 32 * 256 + kt * 32 + 16);
                            oacc[dt] = MFMA32(a0, pf0, oacc[dt]);
                            oacc[dt] = MFMA32(a1, pf1, oacc[dt]);
                        }
                    }
                    const float inv = 1.f / (lsm + __shfl_xor(lsm, 32));
                    bf16_t* op = COIN + (size_t)tok * XW + h * 64;
#pragma unroll
                    for (int dt = 0; dt < 2; ++dt)
#pragma unroll
                        for (int g4 = 0; g4 < 4; ++g4) {
                            uint2 o; o.x = pkbf(oacc[dt][4 * g4] * inv, oacc[dt][4 * g4 + 1] * inv); o.y = pkbf(oacc[dt][4 * g4 + 2] * inv, oacc[dt][4 * g4 + 3] * inv);
                            *(uint2*)(op + dt * 32 + 8 * g4 + 4 * hh) = o;
                        }
                }
            }
        } else if (k == 9 && PH_ON(9)) {
            pg8::Gemm g{COIN, WCO + (size_t)l * D_MODEL * XW, T, D_MODEL, XW}; pg8::StaticOrder S; S.init(T, D_MODEL, G, bid);
            pg8::EpiRes E{OUT, OUT, D_MODEL};
            pg8::gemm_phase<pg8::EpiRes, pg8::StaticOrder, true, true>(tid, ldsq, g, S, E);
        } else if (k == 10 && PH_ON(10)) {
            const float* g = args.in[22] + l * D_MODEL;
            const float* wrg = args.in[23] + (size_t)l * D_MODEL * N_GROUPS; const float* brg = args.in[24] + l * N_GROUPS;
            const float* wre = args.in[25] + (size_t)l * D_MODEL * N_EXPERTS; const float* bre = args.in[26] + l * N_EXPERTS;
            unsigned* lcnt = (unsigned*)lds_raw;
            unsigned* lbase = lcnt + 16;
            unsigned* ler = lcnt + 32;
            float* wt = (float*)lds_raw + 256;
            for (int i = tid; i < D_MODEL * 20; i += NTHREADS) { const int kk = i / 20, jj = i % 20; wt[kk * 21 + jj] = (jj < 4) ? wrg[kk * 4 + jj] : wre[kk * 16 + jj - 4]; }
            for (int chunk = bid; chunk < T / 64; chunk += G) {
            __syncthreads();
            if (tid < 16) lcnt[tid] = 0u;
            __syncthreads();
            for (int tg = 0; tg < 4; ++tg) {
                const int r0 = chunk * 64 + wave * 8 + tg * 2;
                float rinv4[2]; float xk[2][16];
#pragma unroll
                for (int t4 = 0; t4 < 2; ++t4) { const float* xr = OUT + (size_t)(r0 + t4) * D_MODEL; float s = 0.f;
#pragma unroll
                    for (int i = 0; i < 16; ++i) { xk[t4][i] = xr[lane + 64 * i]; s += xk[t4][i] * xk[t4][i]; }
                    rinv4[t4] = 1.0f / sqrtf(wave_sum(s) * (1.f / 1024.f) + NORM_EPS); }
                float acc4[2][20];
#pragma unroll
                for (int t4 = 0; t4 < 2; ++t4)
#pragma unroll
                    for (int j = 0; j < 20; ++j) acc4[t4][j] = 0.f;
#pragma unroll
                for (int i = 0; i < 16; ++i) {
                    const int kk = lane + 64 * i;
                    float w[20];
#pragma unroll
                    for (int j = 0; j < 20; ++j) w[j] = wt[kk * 21 + j];
                    const float gk = g[kk];
#pragma unroll
                    for (int t4 = 0; t4 < 2; ++t4) {
                        const float xn = xk[t4][i] * rinv4[t4] * gk;
                        XN[(size_t)(r0 + t4) * D_MODEL + kk] = f2bf(xn);
#pragma unroll
                        for (int j = 0; j < 20; ++j) acc4[t4][j] += xn * w[j];
                    }
                }
#pragma unroll
                for (int t4 = 0; t4 < 2; ++t4)
#pragma unroll
                    for (int j = 0; j < 20; ++j) acc4[t4][j] = wave_sum(acc4[t4][j]);
#pragma unroll
            for (int t4 = 0; t4 < 2; ++t4) {
                const int ti = tg * 2 + t4;
                const int r = r0 + t4;
                float acc[20];
#pragma unroll
                for (int j = 0; j < 20; ++j) acc[j] = acc4[t4][j];

                if (lane == 0) {
                    float gl[4]; int gs = 0;
#pragma unroll
                    for (int j = 0; j < 4; ++j) gl[j] = acc[j] + brg[j];
                    float gmax = gl[0];
#pragma unroll
                    for (int j = 1; j < 4; ++j) if (gl[j] > gmax) { gmax = gl[j]; gs = j; }
                    float den = 0.f;
#pragma unroll
                    for (int j = 0; j < 4; ++j) den += __expf(gl[j] - gmax);
                    const float gwt = 1.f / den;
                    float el[4];
#pragma unroll
                    for (int j = 0; j < 4; ++j) { float vsel = 0.f;
#pragma unroll
                        for (int gg2 = 0; gg2 < 4; ++gg2) vsel = (gg2 == gs) ? (acc[4 + gg2 * 4 + j] + bre[gg2 * 4 + j]) : vsel;
                        el[j] = vsel; }
                    int i1 = 0; float e1v = el[0];
#pragma unroll
                    for (int j = 1; j < 4; ++j) if (el[j] > e1v) { e1v = el[j]; i1 = j; }
                    int i2 = -1; float e2v = -INFINITY;
#pragma unroll
                    for (int j = 0; j < 4; ++j) if (j != i1 && el[j] > e2v) { e2v = el[j]; i2 = j; }
                    const float e2 = __expf(e2v - e1v);
                    const float w1 = 1.f / (1.f + e2), w2 = e2 / (1.f + e2);
                    const int ex1 = gs * 4 + i1, ex2 = gs * 4 + i2;
                    tok_e[r * 2] = ex1; tok_e[r * 2 + 1] = ex2;
                    tok_g[r * 2] = w1 * gwt; tok_g[r * 2 + 1] = w2 * gwt;
                    const unsigned r1 = atomicAdd(&lcnt[ex1], 1u), r2 = atomicAdd(&lcnt[ex2], 1u);
                    ler[(wave * 8 + ti) * 2] = (unsigned)ex1 | (r1 << 8); ler[(wave * 8 + ti) * 2 + 1] = (unsigned)ex2 | (r2 << 8);
                }
            }
            }
            __syncthreads();
            if (tid < 16) lbase[tid] = atomicAdd(&cnt[tid + 16 * rep], lcnt[tid]);
            __syncthreads();
            if (tid < 128) { const unsigned v = ler[tid]; tok_r[(chunk * 64) * 2 + tid] = (int)(lbase[v & 255u] + (v >> 8)); }
            }
        } else if (k >= 11 && k <= 14 && PH_ON(11)) {
            int off[N_EXPERTS + 1];
            off[0] = 0;
#pragma unroll
            for (int e = 0; e < N_EXPERTS; ++e) { const int c = (int)__hip_atomic_load(&cnt[e], __ATOMIC_RELAXED, __HIP_MEMORY_SCOPE_AGENT); off[e + 1] = off[e] + ((c + PADR - 1) / PADR) * PADR; }
            const int total_rows = off[N_EXPERTS];
            if (k == 11) {
                for (int i = gw; i < 2 * T; i += NGW) {
                    const int e = tok_e[i]; int o = 0;
#pragma unroll
                    for (int q = 0; q < N_EXPERTS; ++q) o = (q == e) ? off[q] : o;
                    const uint4* src = (const uint4*)(XN + (size_t)(i >> 1) * D_MODEL); uint4* dst = (uint4*)(XG + (size_t)(o + tok_r[i]) * D_MODEL);
                    dst[lane] = src[lane]; dst[lane + 64] = src[lane + 64];
                }
                for (int e = 0; e < N_EXPERTS; ++e) {
                    int oe = 0, oe1 = 0;
#pragma unroll
                    for (int q = 0; q < N_EXPERTS; ++q) { oe = (q == e) ? off[q] : oe; oe1 = (q == e) ? off[q + 1] : oe1; }
                    const int c = (int)__hip_atomic_load(&cnt[e], __ATOMIC_RELAXED, __HIP_MEMORY_SCOPE_AGENT);
                    for (int r = oe + c + gw; r < oe1; r += NGW) { uint4* dst = (uint4*)(XG + (size_t)r * D_MODEL); dst[lane] = make_uint4(0u, 0u, 0u, 0u); dst[lane + 64] = make_uint4(0u, 0u, 0u, 0u); }
                }
            } else if (k == 12) {
                pg8::Gemm g{XG, WGU, total_rows, 1024, D_MODEL};
                pg8::GroupSched S;
#pragma unroll
                for (int q = 0; q < 17; ++q) S.off[q] = off[q];
                S.nunits = (total_rows / 256) * 4; S.G = G; S.c = bid;
                pg8::EpiGateUp E{HB, D_EXPERT};
                pg8::gemm_phase<pg8::EpiGateUp, pg8::GroupSched, true, true>(tid, ldsq, g, S, E);
            } else if (k == 13) {
                pg8::Gemm g{HB, WDN, total_rows, 1024, D_EXPERT};
                pg8::GroupSched S;
#pragma unroll
                for (int q = 0; q < 17; ++q) S.off[q] = off[q];
                S.nunits = (total_rows / 256) * 4; S.G = G; S.c = bid;
                pg8::EpiStoreBf16 E{DB, D_MODEL, 3};
                pg8::gemm_phase<pg8::EpiStoreBf16, pg8::GroupSched, true, true>(tid, ldsq, g, S, E);
            } else {
                const float* gnx = args.in[3] + (l + 1 < DEPTH ? l + 1 : l) * D_MODEL;
                for (int r = gw; r < T; r += NGW) {
                    const int e0 = tok_e[r * 2], e1 = tok_e[r * 2 + 1]; int o0 = 0, o1 = 0;
#pragma unroll
                    for (int q = 0; q < N_EXPERTS; ++q) { o0 = (q == e0) ? off[q] : o0; o1 = (q == e1) ? off[q] : o1; }
                    const size_t r0 = (size_t)(o0 + tok_r[r * 2]), r1 = (size_t)(o1 + tok_r[r * 2 + 1]);
                    const float g0 = tok_g[r * 2], g1 = tok_g[r * 2 + 1];
                    f32x4 xv[4]; float ss = 0.f;
#pragma unroll
                    for (int j = 0; j < 4; ++j) {
                        const int c = lane * 4 + 256 * j;
                        const uint2 a = *(const uint2*)(DB + r0 * 1024 + c), bq = *(const uint2*)(DB + r1 * 1024 + c);
                        f32x4 x = *(const f32x4*)(OUT + (size_t)r * D_MODEL + c);
                        x[0] += g0 * __uint_as_float(a.x << 16) + g1 * __uint_as_float(bq.x << 16);
                        x[1] += g0 * __uint_as_float(a.x & 0xffff0000u) + g1 * __uint_as_float(bq.x & 0xffff0000u);
                        x[2] += g0 * __uint_as_float(a.y << 16) + g1 * __uint_as_float(bq.y << 16);
                        x[3] += g0 * __uint_as_float(a.y & 0xffff0000u) + g1 * __uint_as_float(bq.y & 0xffff0000u);
                        *(f32x4*)(OUT + (size_t)r * D_MODEL + c) = x;
                        xv[j] = x; ss += x[0] * x[0] + x[1] * x[1] + x[2] * x[2] + x[3] * x[3];
                    }
                    if (l + 1 < DEPTH) {
                        const float rinv = 1.0f / sqrtf(wave_sum(ss) * (1.f / 1024.f) + NORM_EPS);
#pragma unroll
                        for (int j = 0; j < 4; ++j) { const int c = lane * 4 + 256 * j; const f32x4 gg = *(const f32x4*)(gnx + c);
                            uint2 o; o.x = pk2(xv[j][0] * rinv * gg[0], xv[j][1] * rinv * gg[1]); o.y = pk2(xv[j][2] * rinv * gg[2], xv[j][3] * rinv * gg[3]);
                            *(uint2*)(XN + (size_t)r * D_MODEL + c) = o; }
                    }
                }
            }
        }
    }
#ifdef MK_PROF_A
    if (KSEL < 0) {
        xcd_barrier(bar);
        if (bid == 0 && threadIdx.x == 0) ctl[8192 + DEPTH * NP] = (unsigned)__builtin_amdgcn_s_memrealtime();
        xcd_barrier(bar);
        const float da = (float)(ctl[8192 + MK_PROF_A + 1] - ctl[8192 + MK_PROF_A]) * 0.01f;
        const float db = (MK_PROF_B < 0) ? (float)(ctl[8192 + DEPTH * NP] - ctl[8192]) * 0.01f : (float)(ctl[8192 + MK_PROF_B + 1] - ctl[8192 + MK_PROF_B]) * 0.01f;
        for (size_t i = (size_t)T * D_MODEL / 2 + (size_t)bid * NTHREADS + threadIdx.x; i < (size_t)T * D_MODEL; i += (size_t)G * NTHREADS) OUT[i] = db;
        if (bid == 0 && threadIdx.x == 0) OUT[0] = 100.f * da;
    }
#endif
}

#ifndef MK_SINGLE
#define MK_SINGLE 1
#endif
extern "C" void kernel_launch(void* const* d_in, const int* in_sizes, int n_in, void* d_out, int out_size, void* d_ws, size_t ws_size, hipStream_t stream) {
    static int grid = 0;
    if (grid == 0) {
        if (n_in != 30 || out_size != T * D_MODEL || ws_size < WS_END) { fprintf(stderr, "kernel_launch: unexpected sizes n_in %d out %d ws %zu (need %zu)\n", n_in, out_size, ws_size, (size_t)WS_END); grid = -1; return; }
        int dev = 0, cus = 0;
        if (hipGetDevice(&dev) != hipSuccess || hipDeviceGetAttribute(&cus, hipDeviceAttributeMultiprocessorCount, dev) != hipSuccess) { grid = -1; return; }
        bool okattr = true;
#define SETATTR(K) okattr = okattr && (hipFuncSetAttribute((const void*)mk_fwd<K>, hipFuncAttributeMaxDynamicSharedMemorySize, LDS_BYTES) == hipSuccess)
#if MK_SINGLE
        SETATTR(-1);
#else
        SETATTR(0); SETATTR(1); SETATTR(2); SETATTR(3); SETATTR(4); SETATTR(5); SETATTR(6); SETATTR(7); SETATTR(8); SETATTR(9); SETATTR(10); SETATTR(11); SETATTR(12); SETATTR(13); SETATTR(14);
#endif
        if (!okattr) { fprintf(stderr, "kernel_launch: hipFuncSetAttribute failed\n"); grid = -1; return; }
        (void)hipGetLastError();
        grid = cus > 0 ? cus : 256;
    }
    if (grid < 0) return;
    (void)hipMemsetAsync((char*)d_ws + WS_CTL, 0, CTL_BYTES, stream);
    Args a{};
    for (int i = 0; i < 30; ++i) a.in[i] = (const float*)d_in[i];
    a.out = (float*)d_out; a.ws = (unsigned char*)d_ws;
#if MK_SINGLE
    a.ph_lo = 0; a.ph_hi = DEPTH * NP;
    hipLaunchKernelGGL(mk_fwd<-1>, dim3(grid), dim3(NTHREADS), LDS_BYTES, stream, a);
#else
    for (int ph = 0; ph < DEPTH * NP; ++ph) {
        a.ph_lo = ph; a.ph_hi = ph + 1;
        switch (ph % NP) {
#define LCASE(K) case K: hipLaunchKernelGGL(mk_fwd<K>, dim3(grid), dim3(NTHREADS), LDS_BYTES, stream, a); break
            LCASE(0); LCASE(1); LCASE(2); LCASE(3); LCASE(4); LCASE(5); LCASE(6); LCASE(7); LCASE(8); LCASE(9); LCASE(10); LCASE(11); LCASE(12); LCASE(13); LCASE(14);
        }
    }
#endif
}
```

```cpp
#include <hip/hip_runtime.h>
#include <cstdio>
#include <cstdint>

constexpr int D_MODEL = 1024, BATCH = 4, SEQ = 4096, DEPTH = 2, T = BATCH * SEQ;
constexpr int MEM_LEN = 256;
constexpr int GLA_HEADS = 4, GLA_DK = 48, GLA_DV = 96, GLA_RANK = 16;
constexpr int DSA_HEADS = 6, DSA_DH = 64, IDX_HEADS = 8, IDX_DIM = 64, TOPK = 256;
constexpr int CONV_CH = 256, CONV_W = 31;
constexpr int NUM_BUCKETS = 32;
constexpr int X_HEADS = 4, X_DH = 64, XW = X_HEADS * X_DH;
constexpr int N_GROUPS = 4, EPG = 4, N_EXPERTS = 16, D_EXPERT = 512;
constexpr float NORM_EPS = 1e-6f;
constexpr int D_IN = 3416;
constexpr int Z_GQ = 0, Z_GK = 192, Z_GV = 384, Z_GLR = 768, Z_GR = 784, Z_DQ = 1168, Z_DK = 1552, Z_DV = 1936, Z_IQ = 2320, Z_IK = 2832, Z_IW = 2896, Z_CU = 2904;
constexpr int ZLD = 3584;
constexpr int MIX_GLA = 0, MIX_DSA = 384, MIX_CONV = 768;
constexpr int PADR = 256;
constexpr int MAXROWS = 2 * T + N_EXPERTS * PADR;

typedef unsigned short bf16_t;
typedef float f32x4 __attribute__((ext_vector_type(4)));

constexpr size_t MiB = 1u << 20;
constexpr size_t WS_CTL = 0, CTL_BYTES = 1 * MiB;
constexpr size_t WS_WIN0 = 1 * MiB, WS_WCKV = 8 * MiB, WS_WIN1 = 10 * MiB, WS_WOUT = 17 * MiB, WS_WCQ = 21 * MiB, WS_WCO = 22 * MiB;
constexpr size_t WS_XN = 24 * MiB;
constexpr size_t WS_MEMN = 56 * MiB;
constexpr size_t WS_Z = 60 * MiB;
constexpr size_t WS_WGU = WS_Z, WS_WDN = WS_Z + 32 * MiB, WS_HB = WS_Z + 48 * MiB;
constexpr size_t WS_MIX = 172 * MiB;
constexpr size_t WS_QN = 204 * MiB, WS_KN = 216 * MiB;
constexpr size_t WS_VT = 228 * MiB;
constexpr size_t WS_MASK = 240 * MiB;
constexpr size_t WS_IK = 248 * MiB, WS_QL = 250 * MiB, WS_CH = 252 * MiB;
constexpr size_t WS_XG = WS_MIX, WS_DB = WS_MIX;
constexpr size_t WS_CQ = 256 * MiB, WS_COIN = 264 * MiB;
constexpr size_t WS_BCUM = 256 * MiB, WS_SLOC = 268 * MiB, WS_DEC = 286 * MiB;
constexpr size_t WS_CKV = 288 * MiB;
constexpr size_t WS_CKN = 290 * MiB;
constexpr size_t WS_CVT = 292 * MiB;
constexpr size_t WS_ROUTE = 291 * MiB;
constexpr size_t WS_END = 293 * MiB;
constexpr int CW_CNT = 1024;
constexpr int CW_Q3 = 2048, CW_Q4 = 2304;

constexpr int NTHREADS = 512, NWAVES = 8;
constexpr int LDS_BYTES = 147456;

__device__ __forceinline__ float bf2f(bf16_t u) { return __uint_as_float(((unsigned)u) << 16); }
__device__ __forceinline__ bf16_t f2bf(float f) { unsigned u = __float_as_uint(f); return (bf16_t)((u + 0x7fffu + ((u >> 16) & 1u)) >> 16); }
__device__ __forceinline__ unsigned pk2(float lo, float hi) { return (unsigned)f2bf(lo) | ((unsigned)f2bf(hi) << 16); }
__device__ __forceinline__ float wave_sum(float v) {
    v += __builtin_bit_cast(float, __builtin_amdgcn_update_dpp(0, __builtin_bit_cast(int, v), 0xB1, 0xf, 0xf, false));
    v += __builtin_bit_cast(float, __builtin_amdgcn_update_dpp(0, __builtin_bit_cast(int, v), 0x4E, 0xf, 0xf, false));
    v += __builtin_bit_cast(float, __builtin_amdgcn_update_dpp(0, __builtin_bit_cast(int, v), 0x141, 0xf, 0xf, false));
    v += __builtin_bit_cast(float, __builtin_amdgcn_update_dpp(0, __builtin_bit_cast(int, v), 0x140, 0xf, 0xf, false));
    v += __builtin_bit_cast(float, __builtin_amdgcn_update_dpp(0, __builtin_bit_cast(int, v), 0x142, 0xa, 0xf, false));
    v += __builtin_bit_cast(float, __builtin_amdgcn_update_dpp(0, __builtin_bit_cast(int, v), 0x143, 0xc, 0xf, false));
    return __builtin_bit_cast(float, __builtin_amdgcn_readlane(__builtin_bit_cast(int, v), 63));
}
__device__ __forceinline__ float siluf(float x) { return x / (1.f + __expf(-x)); }
__device__ __forceinline__ float sigmoidf(float x) { return 1.f / (1.f + __expf(-x)); }


typedef short bf16x8 __attribute__((ext_vector_type(8)));
typedef float f32x16 __attribute__((ext_vector_type(16)));
typedef unsigned u32x4v __attribute__((ext_vector_type(4)));
typedef __bf16 bf16x2_t __attribute__((ext_vector_type(2)));
typedef float f32x2_t __attribute__((ext_vector_type(2)));
#define LDSAS __attribute__((address_space(3)))
#define MFMA32(a, b, c) __builtin_amdgcn_mfma_f32_32x32x16_bf16((a), (b), (c), 0, 0, 0)
__device__ __forceinline__ int crow(int reg, int hh) { return (reg & 3) + 8 * (reg >> 2) + 4 * hh; }
__device__ __forceinline__ unsigned pkbf(float a, float b) { f32x2_t v = {a, b}; bf16x2_t r = __builtin_convertvector(v, bf16x2_t); return __builtin_bit_cast(unsigned, r); }

struct Args {
    const float* in[30];
    float* out;
    unsigned char* ws;
    int ph_lo, ph_hi;
};

template <class Epi>
__device__ __forceinline__ void gemm_tile_v1(const int tid, float* lds, const bf16_t* A, int lda, const int* rowidx, int row0,
                                             const float* B, int ldb, int col0, int ncols, int K, const Epi& epi) {
    float* As = lds;
    float* Bs = lds + 16 * 132;
    const int ty = tid >> 4, tx = tid & 15;
    float acc[4][8];
#pragma unroll
    for (int i = 0; i < 4; ++i)
#pragma unroll
        for (int j = 0; j < 8; ++j) acc[i][j] = 0.f;
    const int ar = tid >> 2, ak = (tid & 3) * 4;
    const int grow = rowidx ? rowidx[row0 + ar] : (row0 + ar);
    const bf16_t* ap = A + (size_t)(grow >= 0 ? grow : 0) * lda + ak;
    const bool aval = grow >= 0;
    const int bk = tid >> 5, bn = (tid & 31) * 4;
    const bool bval = bn < ncols;
    const float* bp = B + (size_t)bk * ldb + col0 + bn;
    for (int k0 = 0; k0 < K; k0 += 16) {
        uint2 av = make_uint2(0u, 0u);
        if (aval) av = *(const uint2*)(ap + k0);
        f32x4 bv = (f32x4){0.f, 0.f, 0.f, 0.f};
        if (bval) bv = *(const f32x4*)(bp + (size_t)k0 * ldb);
        __syncthreads();
        As[(ak + 0) * 132 + ar] = __uint_as_float(av.x << 16);
        As[(ak + 1) * 132 + ar] = __uint_as_float(av.x & 0xffff0000u);
        As[(ak + 2) * 132 + ar] = __uint_as_float(av.y << 16);
        As[(ak + 3) * 132 + ar] = __uint_as_float(av.y & 0xffff0000u);
        *(f32x4*)&Bs[bk * 132 + bn] = bv;
        __syncthreads();
#pragma unroll
        for (int k = 0; k < 16; ++k) {
            const f32x4 a4 = *(const f32x4*)&As[k * 132 + ty * 4];
            const f32x4 b0 = *(const f32x4*)&Bs[k * 132 + tx * 8];
            const f32x4 b1 = *(const f32x4*)&Bs[k * 132 + tx * 8 + 4];
#pragma unroll
            for (int i = 0; i < 4; ++i) {
                acc[i][0] += a4[i] * b0[0]; acc[i][1] += a4[i] * b0[1]; acc[i][2] += a4[i] * b0[2]; acc[i][3] += a4[i] * b0[3];
                acc[i][4] += a4[i] * b1[0]; acc[i][5] += a4[i] * b1[1]; acc[i][6] += a4[i] * b1[2]; acc[i][7] += a4[i] * b1[3];
            }
        }
    }
    __syncthreads();
#pragma unroll
    for (int i = 0; i < 4; ++i)
        epi(row0 + ty * 4 + i, col0 + tx * 8, (f32x4){acc[i][0], acc[i][1], acc[i][2], acc[i][3]}, (f32x4){acc[i][4], acc[i][5], acc[i][6], acc[i][7]});
}

template <class Epi>
__device__ __forceinline__ void gemm_v1(const int tid, float* lds, const bf16_t* A, int lda, int M, const float* B, int ldb, int N, int K, const Epi& epi) {
    const int nct = (N + 127) / 128, nrt = M / 128;
    for (int tile = blockIdx.x; tile < nrt * nct; tile += gridDim.x) {
        const int rt = tile / nct, ct = tile % nct;
        const int nc = (N - ct * 128) < 128 ? (N - ct * 128) : 128;
        gemm_tile_v1(tid, lds, A, lda, nullptr, rt * 128, B, ldb, ct * 128, nc, K, epi);
    }
}

namespace pg8 {
#define PG8_LAS __attribute__((address_space(3)))
typedef PG8_LAS unsigned char* PG8_LAS_T;
typedef short bf16x8 __attribute__((ext_vector_type(8)));
typedef unsigned u32x4 __attribute__((ext_vector_type(4)));
constexpr int BM = 256, BK = 64, HALF = 128, HTB = HALF * BK * 2  , STAGE_BYTES = 8 * HTB, NXCD = 8, WGM = 8;

__host__ __device__ __forceinline__ int lds_byte(int r, int c) { const int st = (r >> 4) * 2 + (c >> 5), rr = r & 15, cc = c & 31, ob = rr * 64 + cc * 2; return st * 1024 + (ob ^ (((ob >> 9) & 1) << 5)); }
__host__ __device__ __forceinline__ void stage_rc(int b, int& R, int& C) { const int st = b / 1024, sb = b % 1024, swz = sb ^ (((sb >> 9) & 1) << 5); R = (st >> 1) * 16 + swz / 64; C = (st & 1) * 32 + (swz % 64) / 2; }
__host__ __device__ __forceinline__ int perm32(int rho) { const int n = rho >> 4, i = rho & 15; return 8 * (i >> 2) + 4 * n + (i & 3); }

struct Unit { int pm, pn; };
struct Gemm { const bf16_t* A; const bf16_t* Bt; int M, N, K; };

struct StaticOrder {
    int nM, nN, nwg, G, c;
    __host__ __device__ void init(int M, int N, int G_, int c_) { nM = M / BM; nN = N / BM; nwg = nM * nN; G = G_; c = c_; }
    __host__ __device__ bool next(int i, Unit& u) const {
        const long L = (long)i * G + c; if (L >= nwg) return false;
        int wgid = (int)L; { const int q = nwg / NXCD, r = nwg % NXCD, xcd = wgid % NXCD, off = wgid / NXCD; wgid = (xcd < r ? xcd * (q + 1) : r * (q + 1) + (xcd - r) * q) + off; }
        const int nig = WGM * nN, gid = wgid / nig, fm = gid * WGM, gsz = (nM - fm) < WGM ? (nM - fm) : WGM;
        u.pm = fm + ((wgid % nig) % gsz); u.pn = (wgid % nig) / gsz; return true;
    }
    __device__ __forceinline__ void a_ready(const Unit&) const {}
    __device__ __forceinline__ void done(const Unit&) const {}
};

__device__ __forceinline__ unsigned cvt_pk_bf16(float lo, float hi) { unsigned r; asm volatile("v_cvt_pk_bf16_f32 %0, %1, %2" : "=v"(r) : "v"(lo), "v"(hi)); return r; }
typedef float f32x2 __attribute__((ext_vector_type(2)));
template <class Epi, class Sched, bool ALIGN_EPI = false, bool SP2 = false>
__device__ __forceinline__ void gemm_phase(const int tid, PG8_LAS unsigned char* lds, const Gemm g, const Sched& S, const Epi& E) {
    const int wid = __builtin_amdgcn_readfirstlane(tid >> 6), lane = tid & 63, wr = wid >> 2, wc = wid & 3, fr = lane & 15, fq = lane >> 4;
    const int K = g.K, nt = K / BK;
    unsigned voffA[2], voffB[2];
#pragma unroll
    for (int i = 0; i < 2; ++i) { int R, C; stage_rc(tid * 16 + i * 8192, R, C); const int Rb = Epi::PERM ? ((R & ~31) + perm32(R & 31)) : R;
        voffA[i] = (unsigned)(R * K + C) * 2u; voffB[i] = (unsigned)(Rb * K + C) * 2u; }
    const size_t kstep = (size_t)(BK * 2);
    const size_t hstep = (size_t)HALF * K * 2;
    const size_t tstep = 2 * hstep;
    const unsigned ldsw = (unsigned)wid * 1024u;
    const int aoff = lds_byte(wr * 64 + fr, fq * 8), boff = lds_byte(wc * 32 + fr, fq * 8);
#define PG8_SA(b, h) (((b) * 2 + (h)) * HTB)
#define PG8_SB(b, h) ((4 + (b) * 2 + (h)) * HTB)
#define PG8_STAGE(bufoff, gbase, voff) do { _Pragma("unroll") for (int _i = 0; _i < 2; ++_i) \
        __builtin_amdgcn_global_load_lds((const unsigned*)((const char*)(gbase) + (voff)[_i]), (PG8_LAS unsigned*)(lds + (bufoff) + ldsw + _i * 8192), 16, 0, 0); } while (0)
#define PG8_LDA(dst, b, h) do { _Pragma("unroll") for (int m = 0; m < 4; ++m) _Pragma("unroll") for (int k = 0; k < 2; ++k) dst[m][k] = *(const PG8_LAS bf16x8*)(lds + PG8_SA(b, h) + aoff + m * 2048 + k * 1024); } while (0)
#define PG8_LDB(dst, b, h) do { _Pragma("unroll") for (int n = 0; n < 2; ++n) _Pragma("unroll") for (int k = 0; k < 2; ++k) dst[n][k] = *(const PG8_LAS bf16x8*)(lds + PG8_SB(b, h) + boff + n * 2048 + k * 1024); } while (0)
#define PG8_MMA(ai, bj, At, Bt) do { __builtin_amdgcn_s_setprio(1); _Pragma("unroll") for (int m = 0; m < 4; ++m) _Pragma("unroll") for (int n = 0; n < 2; ++n) _Pragma("unroll") for (int k = 0; k < 2; ++k) \
        acc[ai][bj][m][n] = __builtin_amdgcn_mfma_f32_16x16x32_bf16(Bt[n][k], At[m][k], acc[ai][bj][m][n], 0, 0, 0); __builtin_amdgcn_s_setprio(0); } while (0)
#define PG8_WAIT_V(n) asm volatile("s_waitcnt vmcnt(" #n ")" ::: "memory")
#define PG8_WAIT_L(n) asm volatile("s_waitcnt lgkmcnt(" #n ")" ::: "memory")
#define PG8_BAR __builtin_amdgcn_s_barrier()
#define PG8_SCHED __builtin_amdgcn_sched_barrier(0)
    Unit cur, nxt; int ui = 0;
    if (!S.next(0, cur)) return;
    f32x4 acc[2][2][4][2];
#pragma unroll
    for (int a = 0; a < 2; ++a)
#pragma unroll
        for (int b = 0; b < 2; ++b)
#pragma unroll
            for (int m = 0; m < 4; ++m)
#pragma unroll
                for (int n = 0; n < 2; ++n) acc[a][b][m][n] = (f32x4){0.f, 0.f, 0.f, 0.f};
    bf16x8 At[4][2], B0[2][2], B1[2][2];
    const char* cA = (const char*)g.A + (size_t)cur.pm * tstep; const char* cB = (const char*)g.Bt + (size_t)cur.pn * tstep;
    S.a_ready(cur);
    if constexpr (SP2) {
        PG8_STAGE(PG8_SB(0, 0), cB, voffB); PG8_STAGE(PG8_SB(0, 1), cB + hstep, voffB); PG8_STAGE(PG8_SA(0, 0), cA, voffA); PG8_STAGE(PG8_SA(0, 1), cA + hstep, voffA);
        if (wr == 1) PG8_BAR;
        PG8_WAIT_V(2); PG8_BAR;
        PG8_STAGE(PG8_SB(1, 0), cB + kstep, voffB); PG8_STAGE(PG8_SA(1, 0), cA + kstep, voffA); PG8_STAGE(PG8_SB(1, 1), cB + hstep + kstep, voffB);
        PG8_WAIT_V(6); PG8_BAR;
    } else {
        PG8_STAGE(PG8_SB(0, 0), cB, voffB); PG8_STAGE(PG8_SA(0, 0), cA, voffA); PG8_STAGE(PG8_SB(0, 1), cB + hstep, voffB); PG8_STAGE(PG8_SA(0, 1), cA + hstep, voffA);
        if (wr == 1) PG8_BAR;
        PG8_WAIT_V(4); PG8_BAR;
        PG8_STAGE(PG8_SB(1, 0), cB + kstep, voffB); PG8_STAGE(PG8_SA(1, 0), cA + kstep, voffA); PG8_STAGE(PG8_SB(1, 1), cB + hstep + kstep, voffB);
        PG8_WAIT_V(6); PG8_BAR;
    }
    for (;;) {
        const bool has_next = S.next(ui + 1, nxt);
        const char* nA = has_next ? (const char*)g.A + (size_t)nxt.pm * tstep : cA; const char* nB = has_next ? (const char*)g.Bt + (size_t)nxt.pn * tstep : cB;
        for (int t = 0; t < nt; t += 2) {
            const bool last = (t == nt - 2);
            const char* a1 = cA + (size_t)(t + 1) * kstep;
            const char* a2 = last ? nA : cA + (size_t)(t + 2) * kstep; const char* b2 = last ? nB : cB + (size_t)(t + 2) * kstep;
            const char* a3 = a2 + kstep; const char* b3 = b2 + kstep;
            if (last && has_next) S.a_ready(nxt);
            if constexpr (SP2) {
            PG8_LDB(B0, 0, 0); PG8_LDB(B1, 0, 1); PG8_SCHED; PG8_LDA(At, 0, 0); PG8_STAGE(PG8_SA(1, 1), a1 + hstep, voffA);
            PG8_WAIT_V(8); PG8_WAIT_L(0); PG8_BAR; PG8_MMA(0, 0, At, B0); PG8_MMA(0, 1, At, B1); PG8_BAR; PG8_SCHED;
            PG8_LDA(At, 0, 1); PG8_STAGE(PG8_SB(0, 0), b2, voffB); PG8_STAGE(PG8_SB(0, 1), b2 + hstep, voffB); PG8_STAGE(PG8_SA(0, 0), a2, voffA);
            PG8_WAIT_V(8); PG8_WAIT_L(0); PG8_BAR; PG8_MMA(1, 0, At, B0); PG8_MMA(1, 1, At, B1); PG8_BAR; PG8_SCHED;
            PG8_LDB(B0, 1, 0); PG8_LDB(B1, 1, 1); PG8_SCHED; PG8_LDA(At, 1, 0); PG8_STAGE(PG8_SA(0, 1), a2 + hstep, voffA);
            PG8_WAIT_V(8); PG8_WAIT_L(0); PG8_BAR; PG8_MMA(0, 0, At, B0); PG8_MMA(0, 1, At, B1); PG8_BAR; PG8_SCHED;
            PG8_LDA(At, 1, 1); PG8_STAGE(PG8_SB(1, 0), b3, voffB); PG8_STAGE(PG8_SB(1, 1), b3 + hstep, voffB); PG8_STAGE(PG8_SA(1, 0), a3, voffA);
            PG8_WAIT_V(8); PG8_WAIT_L(0); PG8_BAR; PG8_MMA(1, 0, At, B0); PG8_MMA(1, 1, At, B1); PG8_BAR; PG8_SCHED;
            } else {
            PG8_LDB(B0, 0, 0); PG8_SCHED; PG8_LDA(At, 0, 0); PG8_STAGE(PG8_SA(1, 1), a1 + hstep, voffA);
            PG8_WAIT_L(8); PG8_BAR; PG8_WAIT_L(0); PG8_MMA(0, 0, At, B0); PG8_BAR; PG8_SCHED;
            PG8_LDB(B1, 0, 1); PG8_STAGE(PG8_SB(0, 0), b2, voffB);
            PG8_BAR; PG8_WAIT_L(0); PG8_MMA(0, 1, At, B1); PG8_BAR;
            PG8_LDA(At, 0, 1); PG8_STAGE(PG8_SA(0, 0), a2, voffA);
            PG8_BAR; PG8_WAIT_L(0); PG8_MMA(1, 0, At, B0); PG8_BAR; PG8_SCHED;
            PG8_STAGE(PG8_SB(0, 1), b2 + hstep, voffB);
            PG8_WAIT_V(6); PG8_BAR; PG8_MMA(1, 1, At, B1); PG8_BAR;
            PG8_LDB(B0, 1, 0); PG8_SCHED; PG8_LDA(At, 1, 0); PG8_STAGE(PG8_SA(0, 1), a2 + hstep, voffA);
            PG8_WAIT_L(8); PG8_BAR; PG8_WAIT_L(0); PG8_MMA(0, 0, At, B0); PG8_BAR; PG8_SCHED;
            PG8_LDB(B1, 1, 1); PG8_STAGE(PG8_SB(1, 0), b3, voffB);
            PG8_BAR; PG8_WAIT_L(0); PG8_MMA(0, 1, At, B1); PG8_BAR;
            PG8_LDA(At, 1, 1); PG8_STAGE(PG8_SA(1, 0), a3, voffA);
            PG8_BAR; PG8_WAIT_L(0); PG8_MMA(1, 0, At, B0); PG8_BAR; PG8_SCHED;
            PG8_STAGE(PG8_SB(1, 1), b3 + hstep, voffB);
            PG8_WAIT_V(6); PG8_BAR; PG8_MMA(1, 1, At, B1); PG8_BAR;
            }
        }
        if constexpr (ALIGN_EPI) { if (wr == 0) PG8_BAR; }
        if constexpr (!Epi::AFTER_DRAIN) { E(acc, cur, wr, wc, fr, fq); S.done(cur); }
        if (!has_next) break;
#pragma unroll
        for (int a = 0; a < 2; ++a)
#pragma unroll
            for (int b = 0; b < 2; ++b)
#pragma unroll
                for (int m = 0; m < 4; ++m)
#pragma unroll
                    for (int n = 0; n < 2; ++n) acc[a][b][m][n] = (f32x4){0.f, 0.f, 0.f, 0.f};
        cur = nxt; cA = nA; cB = nB; ++ui;
        if constexpr (ALIGN_EPI) { if (wr == 1) PG8_BAR; }
    }
    PG8_WAIT_V(0);
    if constexpr (!ALIGN_EPI) { if (wr == 0) PG8_BAR; }
    PG8_BAR;
    if constexpr (Epi::AFTER_DRAIN) { E.fused(acc, cur, wr, wc, fr, fq, lds, wid, lane); S.done(cur); }
#undef PG8_SA
#undef PG8_SB
#undef PG8_STAGE
#undef PG8_LDA
#undef PG8_LDB
#undef PG8_MMA
#undef PG8_WAIT_V
#undef PG8_WAIT_L
#undef PG8_BAR
#undef PG8_SCHED
}

struct EpiStoreBf16 {
    static constexpr bool PERM = true, AFTER_DRAIN = false;
    bf16_t* O; int ldc; int pnmask;
    __device__ __forceinline__ void operator()(const f32x4 (&acc)[2][2][4][2], const Unit& u, int wr, int wc, int fr, int fq) const {
        const int row0 = u.pm * BM + wr * 64 + fr; const int col0 = (u.pn & pnmask) * BM + wc * 32 + 8 * fq;
#pragma unroll
        for (int ai = 0; ai < 2; ++ai)
#pragma unroll
            for (int m = 0; m < 4; ++m) { bf16_t* rowp = O + (size_t)(row0 + ai * HALF + m * 16) * ldc + col0;
#pragma unroll
                for (int bj = 0; bj < 2; ++bj) { const f32x4 v0 = acc[ai][bj][m][0], v1 = acc[ai][bj][m][1];
                    u32x4 w; w.x = cvt_pk_bf16(v0[0], v0[1]); w.y = cvt_pk_bf16(v0[2], v0[3]); w.z = cvt_pk_bf16(v1[0], v1[1]); w.w = cvt_pk_bf16(v1[2], v1[3]);
                    *(u32x4*)(rowp + bj * HALF) = w; } }
    }
};
struct EpiRes {
    static constexpr bool PERM = false, AFTER_DRAIN = false;
    const float* base; float* out; int ldc;
    __device__ __forceinline__ void operator()(const f32x4 (&acc)[2][2][4][2], const Unit& u, int wr, int wc, int fr, int fq) const {
        const int row0 = u.pm * BM + wr * 64 + fr; const int col0 = u.pn * BM + wc * 32 + 4 * fq;
#pragma unroll
        for (int ai = 0; ai < 2; ++ai)
#pragma unroll
            for (int m = 0; m < 4; ++m) { const size_t off = (size_t)(row0 + ai * HALF + m * 16) * ldc + col0;
#pragma unroll
                for (int bj = 0; bj < 2; ++bj)
#pragma unroll
                    for (int n = 0; n < 2; ++n) { const f32x4 b = *(const f32x4*)(base + off + bj * HALF + n * 16); *(f32x4*)(out + off + bj * HALF + n * 16) = b + acc[ai][bj][m][n]; } }
    }
};
struct EpiGateUp {
    static constexpr bool PERM = true, AFTER_DRAIN = false;
    bf16_t* O; int ldc;
    __device__ __forceinline__ static float silu(float x) { return x / (1.f + __expf(-x)); }
    __device__ __forceinline__ void operator()(const f32x4 (&acc)[2][2][4][2], const Unit& u, int wr, int wc, int fr, int fq) const {
        const int row0 = u.pm * BM + wr * 64 + fr; const int col0 = ((u.pn & 3) * BM + wc * 32 + 8 * fq) >> 1;
#pragma unroll
        for (int ai = 0; ai < 2; ++ai)
#pragma unroll
            for (int m = 0; m < 4; ++m) { bf16_t* rowp = O + (size_t)(row0 + ai * HALF + m * 16) * ldc + col0;
#pragma unroll
                for (int bj = 0; bj < 2; ++bj) { const f32x4 v0 = acc[ai][bj][m][0], v1 = acc[ai][bj][m][1];
                    uint2 w; w.x = cvt_pk_bf16(silu(v0[0]) * v0[1], silu(v0[2]) * v0[3]); w.y = cvt_pk_bf16(silu(v1[0]) * v1[1], silu(v1[2]) * v1[3]);
                    *(uint2*)(rowp + bj * (HALF / 2)) = w; } }
    }
};
struct InprojSched {
    StaticOrder base; int extra;
    __device__ __forceinline__ bool next(int i, Unit& u) const {
        if (base.next(i, u)) return true;
        const long L = (long)i * base.G + base.c - base.nwg;
        if (L < 0 || L >= extra) return false;
        const int e = (int)L; u.pm = base.nM + (e >> 3) * 4 + ((e >> 1) & 3); u.pn = base.nN + (e >> 3) * 2 + (e & 1); return true;
    }
    __device__ __forceinline__ void a_ready(const Unit&) const {}
    __device__ __forceinline__ void done(const Unit&) const {}
};
struct EpiInproj {
    static constexpr bool PERM = true, AFTER_DRAIN = false;
    bf16_t* Zp; bf16_t* CKVp;
    __device__ __forceinline__ void operator()(const f32x4 (&acc)[2][2][4][2], const Unit& u, int wr, int wc, int fr, int fq) const {
        const bool kv = u.pm >= 64;
        const int ll = (u.pm - 64) >> 2;
        bf16_t* O = kv ? CKVp + (size_t)ll * 1024 * 512 : Zp; const int ldc = kv ? 512 : 3584;
        const int row0 = (kv ? ((u.pm - 64) & 3) : u.pm) * BM + wr * 64 + fr; const int col0 = (kv ? ((u.pn - 14) & 1) : u.pn) * BM + wc * 32 + 8 * fq;
#pragma unroll
        for (int ai = 0; ai < 2; ++ai)
#pragma unroll
            for (int m = 0; m < 4; ++m) { bf16_t* rowp = O + (size_t)(row0 + ai * HALF + m * 16) * ldc + col0;
#pragma unroll
                for (int bj = 0; bj < 2; ++bj) { const f32x4 v0 = acc[ai][bj][m][0], v1 = acc[ai][bj][m][1];
                    u32x4 w; w.x = cvt_pk_bf16(v0[0], v0[1]); w.y = cvt_pk_bf16(v0[2], v0[3]); w.z = cvt_pk_bf16(v1[0], v1[1]); w.w = cvt_pk_bf16(v1[2], v1[3]);
                    *(u32x4*)(rowp + bj * HALF) = w; } }
    }
};
struct GroupSched {
    int off[17]; int nunits, G, c;
    __device__ __forceinline__ bool next(int i, Unit& u) const {
        const int L = i * G + c; if (L >= nunits) return false;
        const int rt = L >> 2, pn = L & 3, row0 = rt * BM; int e = 0;
#pragma unroll
        for (int q = 1; q < 16; ++q) e = (row0 >= off[q]) ? q : e;
        u.pm = rt; u.pn = e * 4 + pn; return true;
    }
    __device__ __forceinline__ void a_ready(const Unit&) const {}
    __device__ __forceinline__ void done(const Unit&) const {}
};
}

__device__ __forceinline__ void rmsnorm_row_bf16(const float* xrow, const float* g, bf16_t* orow, int lane) {
    f32x4 v[4]; float s = 0.f;
#pragma unroll
    for (int j = 0; j < 4; ++j) { v[j] = *(const f32x4*)(xrow + lane * 4 + 256 * j); s += v[j][0] * v[j][0] + v[j][1] * v[j][1] + v[j][2] * v[j][2] + v[j][3] * v[j][3]; }
    const float rinv = 1.0f / sqrtf(wave_sum(s) * (1.f / 1024.f) + NORM_EPS);
#pragma unroll
    for (int j = 0; j < 4; ++j) {
        const f32x4 gg = *(const f32x4*)(g + lane * 4 + 256 * j);
        uint2 o; o.x = pk2(v[j][0] * rinv * gg[0], v[j][1] * rinv * gg[1]); o.y = pk2(v[j][2] * rinv * gg[2], v[j][3] * rinv * gg[3]);
        *(uint2*)(orow + lane * 4 + 256 * j) = o;
    }
}

__device__ __forceinline__ void transpose_item(const float* W, int K, int N, int nblk, bf16_t* WT, int row_off, int rmul, int radd, float* scr, int item, int lane) {
    const int kb = item / nblk, nb = item % nblk, k0 = 64 * kb, n0 = 32 * nb;
    const bool nv = (n0 + (lane & 31)) < N;
#pragma unroll 8
    for (int i = 0; i < 32; ++i) { const int kk = 2 * i + (lane >> 5); scr[kk * 33 + (lane & 31)] = nv ? W[(size_t)(k0 + kk) * N + n0 + (lane & 31)] : 0.f; }
    __builtin_amdgcn_s_waitcnt(0xc07f); __builtin_amdgcn_wave_barrier();
    const int c = lane & 7;
#pragma unroll
    for (int j = 0; j < 4; ++j) { const int n = (lane >> 3) + 8 * j; const float* sp = scr + (8 * c) * 33 + n;
        uint4 o; o.x = pk2(sp[0 * 33], sp[1 * 33]); o.y = pk2(sp[2 * 33], sp[3 * 33]); o.z = pk2(sp[4 * 33], sp[5 * 33]); o.w = pk2(sp[6 * 33], sp[7 * 33]);
        *(uint4*)(WT + (size_t)(row_off + (n0 + n) * rmul + radd) * K + k0 + 8 * c) = o; }
    __builtin_amdgcn_s_waitcnt(0xc07f); __builtin_amdgcn_wave_barrier();
}

__device__ __forceinline__ int t5_bucket(int dist) {
    if (dist < 16) return dist;
    const float d = (float)dist;
    int large = 16 + (int)(__logf(d * (1.f / 16.f)) * (16.0f / 2.0794415416798357f));
    return large < 31 ? large : 31;
}
__device__ __forceinline__ unsigned fkey(float f) { const unsigned u = __float_as_uint(f + 0.0f); return (u & 0x80000000u) ? ~u : (u | 0x80000000u); }


#define LAS __attribute__((address_space(3)))
#define XB_TMO      128
#define XB_XCNT(j)  (256  + 64 * (j))
#define XB_XSUB(j)  (1280 + 64 * (j))
#define XB_XGEN(j)  (2304 + 64 * (j))
#define XB_TOP      3328
#define XB_TOPGEN   3392
#define XCD_BAR_WORDS 3456
#define XB_SPIN_CAP (1u << 24)
__device__ __forceinline__ unsigned xb_ld(unsigned* p)              { return __hip_atomic_load(p, __ATOMIC_RELAXED, __HIP_MEMORY_SCOPE_AGENT); }
__device__ __forceinline__ unsigned xb_add(unsigned* p, unsigned v) { return __hip_atomic_fetch_add(p, v, __ATOMIC_RELAXED, __HIP_MEMORY_SCOPE_AGENT); }
__device__ __forceinline__ unsigned xb_xcc_id() { return (unsigned)__builtin_amdgcn_s_getreg((3 << 11) | 20) & 0xFu; }
#define XB_SPIN(cond, bar) do { unsigned _sp = 0; while (cond) { __builtin_amdgcn_s_sleep(1); \
    if ((++_sp & 255u) == 0u) { if (xb_ld(&(bar)[XB_TMO])) break; if (_sp > XB_SPIN_CAP) { atomicAdd(&(bar)[XB_TMO], 1u); break; } } } } while (0)
struct XcdBarrier { unsigned* bar; unsigned x; volatile LAS unsigned* st; };
__device__ __forceinline__ XcdBarrier xcd_barrier_post(unsigned* bar, volatile LAS unsigned* st) {
    XcdBarrier b; b.bar = bar; b.x = xb_xcc_id(); b.st = st;
    if (threadIdx.x == 0) (void)xb_add(&bar[XB_XCNT(b.x)], 1u);
    return b;
}
__device__ __forceinline__ void xcd_barrier_complete(unsigned* bar, unsigned x, unsigned& nloc, unsigned& nx) {
    const unsigned G = gridDim.x * gridDim.y * gridDim.z;
    unsigned sum, cnt, mine, sp = 0u;
    for (;;) {
        sum = 0u; cnt = 0u; mine = 0u;
#pragma unroll
        for (unsigned j = 0; j < 16; ++j) { const unsigned c = xb_ld(&bar[XB_XCNT(j)]); sum += c; cnt += (c > 0u) ? 1u : 0u; mine = (j == x) ? c : mine; }
        if (sum == G) break;
        __builtin_amdgcn_s_sleep(1);
        if ((++sp & 255u) == 0u) { if (xb_ld(&bar[XB_TMO])) break; if (sp > XB_SPIN_CAP) { atomicAdd(&bar[XB_TMO], 1u); break; } }
    }
    nloc = mine > 0u ? mine : 1u; nx = cnt > 0u ? cnt : 1u;
}
__device__ __forceinline__ void xcd_barrier(const XcdBarrier& b) {
    asm volatile("s_waitcnt vmcnt(0)" ::: "memory");
    __syncthreads();
    if (threadIdx.x == 0) {
        unsigned* bar = b.bar;
        __builtin_amdgcn_s_waitcnt(0);
        unsigned nloc = b.st[0], nx = b.st[1];
        if (nloc == 0u) { xcd_barrier_complete(bar, b.x, nloc, nx); b.st[0] = nloc; b.st[1] = nx; }
        const unsigned old = xb_add(&bar[XB_XSUB(b.x)], 1u);
        const unsigned gen = old / nloc;
        if (old + 1u == (gen + 1u) * nloc) {
            __builtin_amdgcn_fence(__ATOMIC_RELEASE, "agent");
            asm volatile("s_waitcnt vmcnt(0)" ::: "memory");
            const unsigned og = xb_add(&bar[XB_TOP], 1u);
            const unsigned tg = og / nx;
            if (og + 1u == (tg + 1u) * nx) xb_add(&bar[XB_TOPGEN], 1u);
            else XB_SPIN(xb_ld(&bar[XB_TOPGEN]) == tg, bar);
            __builtin_amdgcn_fence(__ATOMIC_ACQUIRE, "agent");
            xb_add(&bar[XB_XGEN(b.x)], 1u);
            asm volatile("s_waitcnt vmcnt(0)" ::: "memory");
        } else {
            XB_SPIN(xb_ld(&bar[XB_XGEN(b.x)]) == gen, bar);
            __builtin_amdgcn_fence(__ATOMIC_ACQUIRE, "agent");
            asm volatile("s_waitcnt vmcnt(0)" ::: "memory");
        }
    }
    __syncthreads();
}
constexpr int CW_BAR = 4096;
constexpr int LDSCTL_OFF = LDS_BYTES - 256;

constexpr int NP = 15;
constexpr int MOEW_IG = 16 * 16, MOEW_ID = 8 * 32, MOEW_IE = 2 * MOEW_IG + MOEW_ID;
constexpr int MOEW_P7 = 2688;
#ifndef MK_PHMASK
#define MK_PHMASK 0x7fff
#endif
#define PH_ON(x) (((MK_PHMASK) >> (x)) & 1)

template <int KSEL>
__global__ void __launch_bounds__(NTHREADS, 2) mk_fwd(Args args) {
    extern __shared__ __attribute__((aligned(16))) unsigned char lds_raw[];
    float* ldsf = (float*)lds_raw;
    const int G = gridDim.x, bid = blockIdx.x, NGW = G * NWAVES;
    const int wave_s = __builtin_amdgcn_readfirstlane(threadIdx.x >> 6);
    unsigned char* ws = args.ws;
    unsigned* ctl = (unsigned*)(ws + WS_CTL);
    bf16_t* XN = (bf16_t*)(ws + WS_XN);
    bf16_t* Z = (bf16_t*)(ws + WS_Z);
    bf16_t* XG = (bf16_t*)(ws + WS_XG);
    bf16_t* VT = (bf16_t*)(ws + WS_VT); unsigned* MASK = (unsigned*)(ws + WS_MASK); bf16_t* IK = (bf16_t*)(ws + WS_IK); bf16_t* QL = (bf16_t*)(ws + WS_QL); float* CH = (float*)(ws + WS_CH);
    float* BCUM = (float*)(ws + WS_BCUM); float* SLOC = (float*)(ws + WS_SLOC); float* DEC = (float*)(ws + WS_DEC);
    bf16_t* WIN0 = (bf16_t*)(ws + WS_WIN0); bf16_t* WIN1 = (bf16_t*)(ws + WS_WIN1); bf16_t* WOUT = (bf16_t*)(ws + WS_WOUT); bf16_t* WCQ = (bf16_t*)(ws + WS_WCQ); bf16_t* WCKV = (bf16_t*)(ws + WS_WCKV); bf16_t* WCO = (bf16_t*)(ws + WS_WCO);
    bf16_t* WGU = (bf16_t*)(ws + WS_WGU); bf16_t* WDN = (bf16_t*)(ws + WS_WDN);
    pg8::PG8_LAS_T ldsq = (pg8::PG8_LAS_T)lds_raw;
    bf16_t* HB = (bf16_t*)(ws + WS_HB);
    bf16_t* MIX = (bf16_t*)(ws + WS_MIX);
    bf16_t* DB = (bf16_t*)(ws + WS_DB);
    bf16_t* QN = (bf16_t*)(ws + WS_QN);
    bf16_t* KN = (bf16_t*)(ws + WS_KN);
    bf16_t* CQ = (bf16_t*)(ws + WS_CQ);
    bf16_t* COIN = (bf16_t*)(ws + WS_COIN);
    bf16_t* MEMN = (bf16_t*)(ws + WS_MEMN);
    bf16_t* CKV = (bf16_t*)(ws + WS_CKV);
    bf16_t* CKN = (bf16_t*)(ws + WS_CKN);
    bf16_t* CVT = (bf16_t*)(ws + WS_CVT);
    int* tok_e = (int*)(ws + WS_ROUTE);
    int* CNTT = (int*)(ws + WS_ROUTE + 768 * 1024);
    bf16_t* WRT = (bf16_t*)(ws + WS_ROUTE + 512 * 1024);
    int* tok_r = tok_e + 2 * T;
    float* tok_g = (float*)(tok_r + 2 * T);
    float* OUT = args.out;
    XcdBarrier bar; bar.bar = ctl + CW_BAR; bar.x = 0; bar.st = nullptr;
    if (KSEL < 0) {
        volatile LAS unsigned* st = (volatile LAS unsigned*)((LAS unsigned char*)lds_raw + LDSCTL_OFF);
        if (threadIdx.x < 64) st[threadIdx.x] = 0u;
        __syncthreads();
        bar = xcd_barrier_post(ctl + CW_BAR, st);
    }

#ifndef MK_REPEAT_PH
#define MK_REPEAT_PH (-1)
#define MK_REPEAT_N 0
#endif
#ifdef MK_XBAR
    if (KSEL < 0) for (int xb = 0; xb < MK_XBAR; ++xb) xcd_barrier(bar);
#endif
    const int nvirt = (args.ph_hi - args.ph_lo) + ((MK_REPEAT_PH >= 0) ? MK_REPEAT_N : 0);
    for (int vi = 0; vi < nvirt; ++vi) {
        const int ph = (MK_REPEAT_PH < 0 || vi <= MK_REPEAT_PH) ? args.ph_lo + vi : ((vi <= MK_REPEAT_PH + MK_REPEAT_N) ? MK_REPEAT_PH : args.ph_lo + vi - MK_REPEAT_N);
        const int rep = (MK_REPEAT_PH >= 0 && vi > MK_REPEAT_PH && vi <= MK_REPEAT_PH + MK_REPEAT_N) ? vi - MK_REPEAT_PH : 0;
        if (KSEL < 0 && ph >= NP && (ph % NP) == 0) continue;
        if (KSEL < 0 && vi > 0) xcd_barrier(bar);
        int tid_op = wave_s * 64 + (int)__builtin_amdgcn_mbcnt_hi(~0u, __builtin_amdgcn_mbcnt_lo(~0u, 0u)); asm volatile("" : "+v"(tid_op));
        const int tid = tid_op, lane = tid & 63, wave = __builtin_amdgcn_readfirstlane(tid >> 6), gw = bid * NWAVES + wave;
#ifdef MK_PROF_A
        if (bid == 0 && tid == 0) ctl[8192 + ph] = (unsigned)__builtin_amdgcn_s_memrealtime();
#endif
        const int l = ph / NP, k = (KSEL >= 0) ? KSEL : (ph % NP);
        const float* xin = (l == 0) ? args.in[0] : OUT;
        unsigned* cnt = ctl + CW_CNT + 64 * l;

        if (k == 0 && PH_ON(0)) {
            const float* g = args.in[3] + l * D_MODEL;
            for (int r = gw; r < T; r += NGW) rmsnorm_row_bf16(xin + (size_t)r * D_MODEL, g, XN + (size_t)r * D_MODEL, lane);
            if (l == 0) {
                float* scr = ldsf + wave * (64 * 33);
                constexpr int I_IN = 16 * 112, I_OUT = 16 * 32, I_CQ = 16 * 8, I_CKV = 16 * 16, I_CO = 4 * 32, I_L = I_IN + I_OUT + I_CQ + I_CKV + I_CO;
                for (int it = gw; it < DEPTH * I_L; it += NGW) {
                    const int ll = it / I_L; int r = it % I_L;
                    if (r < I_IN) { transpose_item(args.in[4] + (size_t)ll * D_MODEL * D_IN, D_MODEL, D_IN, 112, (ll == 0 ? WIN0 : WIN1), 0, 1, 0, scr, r, lane); continue; } r -= I_IN;
                    if (r < I_OUT) { transpose_item(args.in[14] + (size_t)ll * D_MODEL * D_MODEL, D_MODEL, D_MODEL, 32, WOUT + (size_t)ll * D_MODEL * D_MODEL, 0, 1, 0, scr, r, lane); continue; } r -= I_OUT;
                    if (r < I_CQ) { transpose_item(args.in[17] + (size_t)ll * D_MODEL * XW, D_MODEL, XW, 8, WCQ + (size_t)ll * XW * D_MODEL, 0, 1, 0, scr, r, lane); continue; } r -= I_CQ;
                    if (r < I_CKV) { transpose_item(args.in[18] + (size_t)ll * D_MODEL * 512, D_MODEL, 512, 16, WCKV + (size_t)ll * 512 * D_MODEL, 0, 1, 0, scr, r, lane); continue; } r -= I_CKV;
                    transpose_item(args.in[21] + (size_t)ll * XW * D_MODEL, XW, D_MODEL, 32, WCO + (size_t)ll * D_MODEL * XW, 0, 1, 0, scr, r, lane);
                }
            }
            if (l == 0)
                for (int i = bid * NTHREADS + tid; i < DEPTH * 32 * (D_MODEL / 8); i += G * NTHREADS) {
                    const int k8 = (i % (D_MODEL / 8)) * 8, n = (i / (D_MODEL / 8)) % 32, ll = i / (32 * (D_MODEL / 8));
                    float wv[8];
#pragma unroll
                    for (int e = 0; e < 8; ++e) wv[e] = (n < 4) ? args.in[23][((size_t)ll * D_MODEL + k8 + e) * N_GROUPS + n] : ((n < 20) ? args.in[25][((size_t)ll * D_MODEL + k8 + e) * N_EXPERTS + n - 4] : 0.f);
                    uint4 hi, lo;
                    hi.x = pk2(wv[0], wv[1]); hi.y = pk2(wv[2], wv[3]); hi.z = pk2(wv[4], wv[5]); hi.w = pk2(wv[6], wv[7]);
                    lo.x = pk2(wv[0] - __uint_as_float(hi.x << 16), wv[1] - __uint_as_float(hi.x & 0xffff0000u)); lo.y = pk2(wv[2] - __uint_as_float(hi.y << 16), wv[3] - __uint_as_float(hi.y & 0xffff0000u));
                    lo.z = pk2(wv[4] - __uint_as_float(hi.z << 16), wv[5] - __uint_as_float(hi.z & 0xffff0000u)); lo.w = pk2(wv[6] - __uint_as_float(hi.w << 16), wv[7] - __uint_as_float(hi.w & 0xffff0000u));
                    *(uint4*)(WRT + ((size_t)(ll * 2) * 32 + n) * D_MODEL + k8) = hi; *(uint4*)(WRT + ((size_t)(ll * 2 + 1) * 32 + n) * D_MODEL + k8) = lo;
                }
            if (l == 0)
                for (int r = gw; r < 2 * BATCH * MEM_LEN; r += NGW) {
                    const int ll = r / (BATCH * MEM_LEN), rr = r % (BATCH * MEM_LEN);
                    rmsnorm_row_bf16(args.in[1] + (size_t)rr * D_MODEL, args.in[16] + ll * D_MODEL, MEMN + (size_t)r * D_MODEL, lane);
                }
        } else if (k == 1 && PH_ON(1)) {
            {
                pg8::Gemm g{XN, l == 0 ? WIN0 : WIN1, T, ZLD, D_MODEL};
                pg8::InprojSched S; S.base.init(T, ZLD, G, bid); S.extra = (l == 0) ? 16 : 0;
                pg8::EpiInproj E{Z, CKV};
                pg8::gemm_phase<pg8::EpiInproj, pg8::InprojSched, true, true>(tid, ldsq, g, S, E);
            }
        } else if (k == 2 && PH_ON(2)) {
            {
                float* lr = ldsf;
                float* la = ldsf + 1024;
                float* ks = ldsf + 4160;
                float* vs = ldsf + 7488;
                float* seg = ldsf + 13888;
                const float* wa2 = args.in[5] + (size_t)l * GLA_RANK * 192;
                const float* ba = args.in[6] + l * 192;
                for (int item = bid; item < BATCH * GLA_HEADS * 64; item += G) {
                    const int bh = item >> 6, c = item & 63, b = bh >> 2, h = bh & 3, tok0 = b * SEQ + c * 64;
                    __syncthreads();
                    if (tid < 128) { const int t = tid >> 1, c8 = (tid & 1) * 8; const uint4 u = *(const uint4*)(Z + (size_t)(tok0 + t) * ZLD + Z_GLR + c8);
                        *(f32x4*)&lr[t * 16 + c8] = (f32x4){__uint_as_float(u.x << 16), __uint_as_float(u.x & 0xffff0000u), __uint_as_float(u.y << 16), __uint_as_float(u.y & 0xffff0000u)};
                        *(f32x4*)&lr[t * 16 + c8 + 4] = (f32x4){__uint_as_float(u.z << 16), __uint_as_float(u.z & 0xffff0000u), __uint_as_float(u.w << 16), __uint_as_float(u.w & 0xffff0000u)}; }
                    if (tid < 384) { const int t = tid / 6, c8 = (tid % 6) * 8; const uint4 u = *(const uint4*)(Z + (size_t)(tok0 + t) * ZLD + Z_GK + h * 48 + c8);
                        *(f32x4*)&ks[t * 52 + c8] = (f32x4){__uint_as_float(u.x << 16), __uint_as_float(u.x & 0xffff0000u), __uint_as_float(u.y << 16), __uint_as_float(u.y & 0xffff0000u)};
                        *(f32x4*)&ks[t * 52 + c8 + 4] = (f32x4){__uint_as_float(u.z << 16), __uint_as_float(u.z & 0xffff0000u), __uint_as_float(u.w << 16), __uint_as_float(u.w & 0xffff0000u)}; }
                    for (int i = tid; i < 64 * 12; i += NTHREADS) { const int t = i / 12, c8 = (i % 12) * 8; const uint4 u = *(const uint4*)(Z + (size_t)(tok0 + t) * ZLD + Z_GV + h * 96 + c8);
                        *(f32x4*)&vs[t * 100 + c8] = (f32x4){__uint_as_float(u.x << 16), __uint_as_float(u.x & 0xffff0000u), __uint_as_float(u.y << 16), __uint_as_float(u.y & 0xffff0000u)};
                        *(f32x4*)&vs[t * 100 + c8 + 4] = (f32x4){__uint_as_float(u.z << 16), __uint_as_float(u.z & 0xffff0000u), __uint_as_float(u.w << 16), __uint_as_float(u.w & 0xffff0000u)}; }
                    __syncthreads();
                    for (int i = tid; i < 64 * 48; i += NTHREADS) { const int t = i / 48, d = i % 48;
                        float x = ba[h * 48 + d];
#pragma unroll
                        for (int r = 0; r < GLA_RANK; ++r) x += lr[t * 16 + r] * wa2[r * 192 + h * 48 + d];
                        la[t * 49 + d] = (fminf(x, 0.f) - log1pf(__expf(-fabsf(x)))) * (1.f / 16.f); }
                    __syncthreads();
                    const int cd = tid % 48, cs = tid / 48;
                    if (tid < 384) { float run = 0.f;
#pragma unroll
                        for (int j2 = 0; j2 < 8; ++j2) { run += la[(cs * 8 + j2) * 49 + cd]; la[(cs * 8 + j2) * 49 + cd] = run; }
                        seg[cs * 48 + cd] = run; }
                    __syncthreads();
                    if (tid < 384) { float base = 0.f;
                        for (int q = 0; q < cs; ++q) base += seg[q * 48 + cd];
#pragma unroll
                        for (int j2 = 0; j2 < 8; ++j2) { const float v = la[(cs * 8 + j2) * 49 + cd] + base; la[(cs * 8 + j2) * 49 + cd] = v; BCUM[(size_t)(tok0 + cs * 8 + j2) * 192 + h * 48 + cd] = v; } }
                    __syncthreads();
                    for (int i = tid; i < 64 * 48; i += NTHREADS) { const int t = i / 48, d = i % 48; ks[t * 52 + d] *= __expf(la[63 * 49 + d] - la[t * 49 + d]); }
                    if (tid < 48) DEC[(size_t)item * 48 + tid] = __expf(la[63 * 49 + tid]);
                    __syncthreads();
                    if (tid < 288) {
                        const int d0 = (tid / 24) * 4, v0 = (tid % 24) * 4;
                        float acc[4][4];
#pragma unroll
                        for (int x = 0; x < 4; ++x)
#pragma unroll
                            for (int y = 0; y < 4; ++y) acc[x][y] = 0.f;
#pragma unroll 4
                        for (int sidx = 0; sidx < 64; ++sidx) { const f32x4 kv = *(const f32x4*)&ks[sidx * 52 + d0], vv = *(const f32x4*)&vs[sidx * 100 + v0];
#pragma unroll
                            for (int x = 0; x < 4; ++x)
#pragma unroll
                                for (int y = 0; y < 4; ++y) acc[x][y] += kv[x] * vv[y]; }
#pragma unroll
                        for (int y = 0; y < 4; ++y) *(f32x4*)(SLOC + (size_t)item * 4608 + (v0 + y) * 48 + d0) = (f32x4){acc[0][y], acc[1][y], acc[2][y], acc[3][y]};
                    }
                }
                __syncthreads();
            }
            {
                const float* gq = args.in[8] + l * DSA_DH; const float* gk = args.in[9] + l * DSA_DH;
                for (int it = bid * NTHREADS + tid; it < T * 12; it += G * NTHREADS) {
                    const int tok = it / 12, jj = it % 12, isk = jj / 6, hd = jj % 6;
                    const uint4* src = (const uint4*)(Z + (size_t)tok * ZLD + (isk ? Z_DK : Z_DQ) + hd * 64);
                    uint4 u[8]; float ss = 0.f;
#pragma unroll
                    for (int c = 0; c < 8; ++c) { u[c] = src[c];
                        const float a0 = __uint_as_float(u[c].x << 16), a1 = __uint_as_float(u[c].x & 0xffff0000u), a2 = __uint_as_float(u[c].y << 16), a3 = __uint_as_float(u[c].y & 0xffff0000u);
                        const float a4 = __uint_as_float(u[c].z << 16), a5 = __uint_as_float(u[c].z & 0xffff0000u), a6 = __uint_as_float(u[c].w << 16), a7 = __uint_as_float(u[c].w & 0xffff0000u);
                        ss += a0 * a0 + a1 * a1 + a2 * a2 + a3 * a3 + a4 * a4 + a5 * a5 + a6 * a6 + a7 * a7; }
                    const float rn = (isk ? 1.0f : (0.125f * 1.4426950408889634f)) / sqrtf(ss * (1.f / 64.f) + NORM_EPS);
                    const float* gp = isk ? gk : gq;
                    uint4* dst = (uint4*)((isk ? KN : QN) + (size_t)tok * 384 + hd * 64);
#pragma unroll
                    for (int c = 0; c < 8; ++c) { const f32x4 g0 = *(const f32x4*)(gp + c * 8), g1 = *(const f32x4*)(gp + c * 8 + 4);
                        uint4 o;
                        o.x = pk2(__uint_as_float(u[c].x << 16) * rn * g0[0], __uint_as_float(u[c].x & 0xffff0000u) * rn * g0[1]);
                        o.y = pk2(__uint_as_float(u[c].y << 16) * rn * g0[2], __uint_as_float(u[c].y & 0xffff0000u) * rn * g0[3]);
                        o.z = pk2(__uint_as_float(u[c].z << 16) * rn * g1[0], __uint_as_float(u[c].z & 0xffff0000u) * rn * g1[1]);
                        o.w = pk2(__uint_as_float(u[c].w << 16) * rn * g1[2], __uint_as_float(u[c].w & 0xffff0000u) * rn * g1[3]);
                        dst[c] = o; }
                }
                for (int it = bid * NTHREADS + tid; it < T * 8; it += G * NTHREADS) {
                    const int tok = it >> 3, c8 = (it & 7) * 8;
                    const bf16_t* zr = Z + (size_t)tok * ZLD;
                    const uint4 wu = *(const uint4*)(zr + Z_IW);
                    const float cw[8] = {__uint_as_float(wu.x << 16), __uint_as_float(wu.x & 0xffff0000u), __uint_as_float(wu.y << 16), __uint_as_float(wu.y & 0xffff0000u),
                                         __uint_as_float(wu.z << 16), __uint_as_float(wu.z & 0xffff0000u), __uint_as_float(wu.w << 16), __uint_as_float(wu.w & 0xffff0000u)};
                    float ql[8];
#pragma unroll
                    for (int e = 0; e < 8; ++e) ql[e] = 0.f;
#pragma unroll
                    for (int hq = 0; hq < IDX_HEADS; ++hq) { const float c = cw[hq] * (0.35355339059327373f * 0.0625f); const uint4 qu = *(const uint4*)(zr + Z_IQ + hq * 64 + c8);
                        ql[0] += c * __uint_as_float(qu.x << 16); ql[1] += c * __uint_as_float(qu.x & 0xffff0000u); ql[2] += c * __uint_as_float(qu.y << 16); ql[3] += c * __uint_as_float(qu.y & 0xffff0000u);
                        ql[4] += c * __uint_as_float(qu.z << 16); ql[5] += c * __uint_as_float(qu.z & 0xffff0000u); ql[6] += c * __uint_as_float(qu.w << 16); ql[7] += c * __uint_as_float(qu.w & 0xffff0000u); }
                    uint4 o; o.x = pk2(ql[0], ql[1]); o.y = pk2(ql[2], ql[3]); o.z = pk2(ql[4], ql[5]); o.w = pk2(ql[6], ql[7]);
                    *(uint4*)(QL + (size_t)tok * 64 + c8) = o;
                    *(uint4*)(IK + (size_t)tok * 64 + c8) = *(const uint4*)(zr + Z_IK + c8);
                    if (c8 == 0) { *(f32x4*)(CH + (size_t)tok * 8) = (f32x4){cw[0], cw[1], cw[2], cw[3]} * (0.35355339059327373f * 0.0625f); *(f32x4*)(CH + (size_t)tok * 8 + 4) = (f32x4){cw[4], cw[5], cw[6], cw[7]} * (0.35355339059327373f * 0.0625f); }
                }
            }
            for (int tile = bid; tile < BATCH * 128; tile += G) {
                if (tid < 384) {
                    const bf16_t* zb = Z + (size_t)(tile * 32) * ZLD + Z_DV + tid;
                    unsigned w[16];
#pragma unroll
                    for (int p2 = 0; p2 < 16; ++p2) {
                        const int p = 2 * p2, sst = p >> 4, hh2 = (p >> 3) & 1, j = p & 7;
                        const int key0 = 16 * sst + 8 * (j >> 2) + 4 * hh2 + (j & 3);
                        w[p2] = (unsigned)zb[(size_t)key0 * ZLD] | ((unsigned)zb[(size_t)(key0 + 1) * ZLD] << 16);
                    }
                    uint4* dst = (uint4*)(VT + ((size_t)tile * 384 + tid) * 32);
                    dst[0] = make_uint4(w[0], w[1], w[2], w[3]); dst[1] = make_uint4(w[4], w[5], w[6], w[7]); dst[2] = make_uint4(w[8], w[9], w[10], w[11]); dst[3] = make_uint4(w[12], w[13], w[14], w[15]);
                }
            }
            if (l == 0) {
                for (int i = bid * NTHREADS + tid; i < DEPTH * BATCH * X_HEADS * 64 * MEM_LEN; i += G * NTHREADS) {
                    const int p = i & 255, d = (i >> 8) & 63, h = (i >> 14) & 3, bb = (i >> 16) & 3, ll = i >> 18;
                    const int pg = p & 31, sst = pg >> 4, hh2 = (pg >> 3) & 1, j2 = pg & 7;
                    const int key = (p & ~31) + 16 * sst + 8 * (j2 >> 2) + 4 * hh2 + (j2 & 3);
                    CVT[i] = CKV[((size_t)ll * BATCH * MEM_LEN + (size_t)bb * MEM_LEN + key) * 512 + 256 + h * 64 + d];
                }
                for (int r = gw; r < DEPTH * BATCH * MEM_LEN; r += NGW) {
                    const int ll = r / (BATCH * MEM_LEN);
                    const float gkl = args.in[20][ll * X_DH + lane];
#pragma unroll
                    for (int h = 0; h < X_HEADS; ++h) {
                        const float kk = bf2f(CKV[(size_t)r * 512 + h * 64 + lane]);
                        const float rk = 1.0f / sqrtf(wave_sum(kk * kk) * (1.f / 64.f) + NORM_EPS);
                        CKN[(size_t)r * 256 + h * 64 + lane] = f2bf(kk * rk * gkl);
                    }
                }
            }
            {
                const float* cw = args.in[10] + (size_t)l * CONV_W * CONV_CH;
                const float* cb = args.in[11] + l * CONV_CH; const float* lg = args.in[12] + l * CONV_CH; const float* lb = args.in[13] + l * CONV_CH;
                float* ct = ldsf + 1024;
                float* hL = ldsf + 1024 + 32 * 256;
                const int c = tid & 255, half = tid >> 8;
                float wreg[CONV_W];
#pragma unroll
                for (int j = 0; j < CONV_W; ++j) wreg[j] = cw[j * CONV_CH + c];
                const float cbias = cb[c];
                for (int item = bid; item < T / 32; item += G) {
                    const int tok0 = item * 32;
                    const int tb = tok0 % SEQ;
                    __syncthreads();
                    for (int i = tid; i < 62 * 32; i += NTHREADS) {
                        const int rr = i >> 5, c8 = (i & 31) * 8, tp = tb - 30 + rr;
                        f32x4 h0 = (f32x4){0.f, 0.f, 0.f, 0.f}, h1 = h0;
                        if (tp >= 0) {
                            const bf16_t* zr = Z + (size_t)(tok0 - 30 + rr) * ZLD + Z_CU + c8;
                            const uint4 au = *(const uint4*)zr, gu = *(const uint4*)(zr + 256);
                            h0[0] = __uint_as_float(au.x << 16) * sigmoidf(__uint_as_float(gu.x << 16)); h0[1] = __uint_as_float(au.x & 0xffff0000u) * sigmoidf(__uint_as_float(gu.x & 0xffff0000u));
                            h0[2] = __uint_as_float(au.y << 16) * sigmoidf(__uint_as_float(gu.y << 16)); h0[3] = __uint_as_float(au.y & 0xffff0000u) * sigmoidf(__uint_as_float(gu.y & 0xffff0000u));
                            h1[0] = __uint_as_float(au.z << 16) * sigmoidf(__uint_as_float(gu.z << 16)); h1[1] = __uint_as_float(au.z & 0xffff0000u) * sigmoidf(__uint_as_float(gu.z & 0xffff0000u));
                            h1[2] = __uint_as_float(au.w << 16) * sigmoidf(__uint_as_float(gu.w << 16)); h1[3] = __uint_as_float(au.w & 0xffff0000u) * sigmoidf(__uint_as_float(gu.w & 0xffff0000u));
                        }
                        *(f32x4*)&hL[rr * 256 + c8] = h0; *(f32x4*)&hL[rr * 256 + c8 + 4] = h1;
                    }
                    __syncthreads();
                    {
                        float hwin[46];
#pragma unroll
                        for (int i = 0; i < 46; ++i) hwin[i] = hL[(half * 16 + i) * 256 + c];
#pragma unroll
                        for (int o = 0; o < 16; ++o) {
                            float a = cbias;
#pragma unroll
                            for (int j = 0; j < CONV_W; ++j) a += hwin[o + j] * wreg[j];
                            ct[(half * 16 + o) * 256 + c] = a;
                        }
                    }
                    __syncthreads();
#pragma unroll
                    for (int i = 0; i < 4; ++i) {
                        const int tt = wave * 4 + i;
                        const f32x4 v = *(const f32x4*)&ct[tt * 256 + lane * 4];
                        const float mu = wave_sum(v[0] + v[1] + v[2] + v[3]) * (1.f / 256.f);
                        const f32x4 dv = v - mu;
                        const float var = wave_sum(dv[0] * dv[0] + dv[1] * dv[1] + dv[2] * dv[2] + dv[3] * dv[3]) * (1.f / 256.f);
                        const float rstd = 1.0f / sqrtf(var + NORM_EPS);
                        const f32x4 gg = *(const f32x4*)(lg + lane * 4), bb = *(const f32x4*)(lb + lane * 4);
                        f32x4 y = dv * rstd * gg + bb;
                        uint2 o; o.x = pk2(siluf(y[0]), siluf(y[1])); o.y = pk2(siluf(y[2]), siluf(y[3]));
                        *(uint2*)(MIX + (size_t)(tok0 + tt) * D_MODEL + MIX_CONV + lane * 4) = o;
                    }
                }
            }
        } else if (k == 3 && PH_ON(3)) {
            if (rep == 0)
            for (int e = bid * NTHREADS + tid; e < BATCH * GLA_HEADS * 4608; e += G * NTHREADS) {
                const int bh = e / 4608, idx = e % 4608, d = idx % 48;
                float state = 0.f;
#pragma unroll 16
                for (int c = 0; c < 64; ++c) {
                    const size_t it = (size_t)bh * 64 + c;
                    const float tmp = SLOC[it * 4608 + idx], dec = DEC[it * 48 + d];
                    SLOC[it * 4608 + idx] = state; state = dec * state + tmp; }
            }
            {
                unsigned* hist32 = (unsigned*)lds_raw;
                constexpr int HSTR = 1028;
                unsigned* rs = (unsigned*)(lds_raw + 32 * HSTR * 4);
                volatile unsigned* qsh = (volatile unsigned*)(lds_raw + LDSCTL_OFF + 64);
                unsigned* qhead = ctl + CW_Q3 + 64 * l + rep;
                const int qc = lane & 15, g4 = lane >> 4, qh = wave >> 2, kg = wave & 3;
                const int row = 16 * qh + qc;
                for (;;) {
                    __syncthreads();
                    if (tid == 0) qsh[0] = atomicAdd(qhead, 1u);
                    __syncthreads();
                    const int it = (int)qsh[0];
                    if (it >= BATCH * 128) break;
                    const int b = it & 3, qt = 127 - (it >> 2);
                    const int tokb = b * SEQ, q0 = qt * 32, tq = q0 + row;
                    bf16x8 qf[9][2];
                    {
                        const bf16_t* zq = Z + (size_t)(tokb + tq) * ZLD + Z_IQ + g4 * 8;
#pragma unroll
                        for (int h = 0; h < 8; ++h)
#pragma unroll
                            for (int ks = 0; ks < 2; ++ks) qf[h][ks] = *(const bf16x8*)(zq + h * 64 + ks * 32);
                        const bf16_t* ql = QL + (size_t)(tokb + tq) * 64 + g4 * 8;
#pragma unroll
                        for (int ks = 0; ks < 2; ++ks) qf[8][ks] = *(const bf16x8*)(ql + ks * 32);
                    }
                    float ch[8];
                    { const f32x4 c0 = *(const f32x4*)(CH + (size_t)(tokb + tq) * 8), c1 = *(const f32x4*)(CH + (size_t)(tokb + tq) * 8 + 4);
                      ch[0] = c0[0]; ch[1] = c0[1]; ch[2] = c0[2]; ch[3] = c0[3]; ch[4] = c1[0]; ch[5] = c1[1]; ch[6] = c1[2]; ch[7] = c1[3]; }
                    if (qt < 8) {
                        if (rep == 0 && kg == 0 && g4 == 0) for (int kt = 0; kt <= qt; ++kt) MASK[((size_t)(b * 128) + kt) * SEQ + tq] = (kt < qt || row == 31) ? 0xffffffffu : ((1u << (row + 1)) - 1u);
                        continue;
                    }
#pragma unroll
                    for (int i = 0; i < 16; ++i) ((uint4*)hist32)[tid + 512 * i] = make_uint4(0u, 0u, 0u, 0u);
                    if (tid < 32) ((uint4*)hist32)[8192 + tid] = make_uint4(0u, 0u, 0u, 0u);
                    if (tid < 32) { rs[tid] = 0u; rs[32 + tid] = TOPK; rs[64 + tid] = 0u; rs[96 + tid] = 0u; }
                    __syncthreads();
#define DSA_SCORE(kt_) \
                        f32x4 sc[2]; \
                        { const bf16_t* kp = IK + (size_t)(tokb + (kt_) * 32 + qc) * 64 + g4 * 8; \
                          bf16x8 kf[2][2]; \
                          _Pragma("unroll") for (int u = 0; u < 2; ++u) _Pragma("unroll") for (int ks = 0; ks < 2; ++ks) kf[u][ks] = *(const bf16x8*)(kp + u * 16 * 64 + ks * 32); \
                          _Pragma("unroll") for (int u = 0; u < 2; ++u) { sc[u] = (f32x4){0.f, 0.f, 0.f, 0.f}; \
                              _Pragma("unroll") for (int ks = 0; ks < 2; ++ks) sc[u] = __builtin_amdgcn_mfma_f32_16x16x32_bf16(kf[u][ks], qf[8][ks], sc[u], 0, 0, 0); } \
                          _Pragma("unroll") for (int h = 0; h < 8; ++h) _Pragma("unroll") for (int u = 0; u < 2; ++u) { f32x4 a = (f32x4){0.f, 0.f, 0.f, 0.f}; \
                              _Pragma("unroll") for (int ks = 0; ks < 2; ++ks) a = __builtin_amdgcn_mfma_f32_16x16x32_bf16(kf[u][ks], qf[h][ks], a, 0, 0, 0); \
                              _Pragma("unroll") for (int i = 0; i < 4; ++i) sc[u][i] = __builtin_fmaf(fabsf(a[i]), ch[h], sc[u][i]); } }
                    for (int pass = 0; pass < 2; ++pass) {
                        const unsigned mmask = (pass == 0) ? 0u : 0xFFE00000u;
                        const int bshift = (pass == 0) ? 21 : 10;
                        const unsigned bmask = 2047u;
                        const unsigned prefm = rs[row];
                        for (int kt = kg; kt <= qt; kt += 4) {
                            DSA_SCORE(kt)
#pragma unroll
                            for (int u = 0; u < 2; ++u)
#pragma unroll
                                for (int i = 0; i < 4; ++i) {
                                    const int sidx = kt * 32 + 16 * u + 4 * g4 + i;
                                    const unsigned key = fkey(sc[u][i]);
                                    if (sidx <= tq && (key & mmask) == prefm) { const unsigned bin = (key >> bshift) & bmask; if (rep < 2) atomicAdd(&hist32[row * HSTR + (bin >> 1)], 1u << ((bin & 1u) * 16u)); else asm volatile("" :: "v"(bin)); }
                                }
                        }
                        __syncthreads();
                        for (int rr = 0; rr < 4; ++rr) {
                            const int R = wave * 4 + rr;
                            const unsigned kremR = rs[32 + R];
                            const uint4* hw = (const uint4*)(hist32 + R * HSTR + lane * 16);
                            unsigned cntl = 0u;
#pragma unroll
                            for (int q4 = 0; q4 < 4; ++q4) { const uint4 w = hw[q4]; cntl += (w.x & 0xffffu) + (w.x >> 16) + (w.y & 0xffffu) + (w.y >> 16) + (w.z & 0xffffu) + (w.z >> 16) + (w.w & 0xffffu) + (w.w >> 16); }
                            unsigned suf = cntl;
#pragma unroll
                            for (int o = 1; o < 64; o <<= 1) { const unsigned tv = __shfl_down(suf, o); if (lane + o < 64) suf += tv; }
                            const unsigned excl = suf - cntl;
                            if (excl < kremR && kremR <= suf) {
                                unsigned above = excl, eq = 0u; int bin = 0;
#pragma unroll 1
                                for (int i = 15; i >= 0; --i) { const unsigned w = hist32[R * HSTR + lane * 16 + i]; const unsigned hi = w >> 16, lo = w & 0xffffu;
                                    if (above + hi >= kremR) { bin = 2 * (lane * 16 + i) + 1; eq = hi; break; } above += hi;
                                    if (above + lo >= kremR) { bin = 2 * (lane * 16 + i); eq = lo; break; } above += lo; }
                                rs[R] = rs[R] | ((unsigned)bin << bshift); rs[32 + R] = kremR - above; rs[64 + R] = eq;
                            }
                        }
                        __syncthreads();
#pragma unroll
                        for (int i = 0; i < 16; ++i) ((uint4*)hist32)[tid + 512 * i] = make_uint4(0u, 0u, 0u, 0u);
                        if (tid < 32) ((uint4*)hist32)[8192 + tid] = make_uint4(0u, 0u, 0u, 0u);
                        __syncthreads();
                    }
                    {
                        const unsigned tau = rs[row]; const bool tiecrit = rs[64 + row] > rs[32 + row];
                        unsigned* mcol = MASK + (size_t)(b * 128) * SEQ + tq;
                        for (int kt = kg; kt <= qt; kt += 4) {
                            DSA_SCORE(kt)
                            unsigned bits = 0u;
#pragma unroll
                            for (int u = 0; u < 2; ++u)
#pragma unroll
                                for (int i = 0; i < 4; ++i) {
                                    const int sidx = kt * 32 + 16 * u + 4 * g4 + i;
                                    const unsigned key = fkey(sc[u][i]), key22 = key & 0xFFFFFC00u;
                                    const bool valid = sidx <= tq;
                                    if (valid && (key22 > tau || (key22 == tau && !tiecrit))) bits |= 1u << (16 * u + 4 * g4 + i);
                                    if (valid && key22 == tau && tiecrit) { const unsigned idx = atomicAdd(&rs[96 + row], 1u); if (idx < 511u) { hist32[row * HSTR + 2 * idx] = key; hist32[row * HSTR + 2 * idx + 1] = (unsigned)sidx; } }
                                }
                            bits |= (unsigned)__shfl_xor((int)bits, 16);
                            bits |= (unsigned)__shfl_xor((int)bits, 32);
                            if (g4 == 0 && rep == 0) mcol[(size_t)kt * SEQ] = bits;
                        }
                        asm volatile("s_waitcnt vmcnt(0)" ::: "memory");
                        __syncthreads();
                        if (rep == 0 && tid < 32 && rs[64 + tid] > rs[32 + tid]) {
                            int tdx = tid; asm volatile("" : "+v"(tdx));
                            unsigned nl = rs[96 + tid]; if (nl > 511u) nl = 511u;
                            const unsigned need = rs[32 + tid];
                            unsigned* lst = hist32 + tdx * HSTR;
                            for (unsigned q = 0; q < need && q < nl; ++q) {
                                unsigned bk = 0u, bs = 0xffffffffu, bi = 0u;
                                for (unsigned e2 = 0; e2 < nl; ++e2) { const unsigned kv = lst[2 * e2], sv = lst[2 * e2 + 1]; if (sv != 0xffffffffu && (kv > bk || (kv == bk && sv < bs))) { bk = kv; bs = sv; bi = e2; } }
                                lst[2 * bi + 1] = 0xffffffffu;
                                if (bs != 0xffffffffu) atomicOr(MASK + ((size_t)(b * 128) + (bs >> 5)) * SEQ + q0 + tdx, 1u << (bs & 31u));
                            }
                        }
                    }
#undef DSA_SCORE
                }
            }
        } else if (k == 4 && PH_ON(4)) {
            float* qt = ldsf;
            float* kt = qt + 64 * 49;
            float* vs = kt + 64 * 49;
            float* Am = vs + 64 * 97;
            float* Sin = Am + 64 * 65;
            const float* gon = args.in[7] + l * GLA_DV;
            volatile unsigned* qsh = (volatile unsigned*)(lds_raw + LDSCTL_OFF + 64);
            unsigned* qhead = ctl + CW_Q4 + 64 * l + rep;
            float* biasd = (float*)(lds_raw + 131072);
            for (int i = tid; i < 6 * 224; i += NTHREADS) { const int h = i / 224, d = i % 224 - 32; biasd[i] = d < 0 ? 0.f : args.in[2][t5_bucket(d) * DSA_HEADS + h] * 1.4426950408889634f; }
            constexpr int N_ATT = BATCH * 32 * 3;
            for (;;) {
                __syncthreads();
                if (tid == 0) qsh[0] = atomicAdd(qhead, 1u);
                __syncthreads();
                const int qit = (int)qsh[0];
#ifndef MK_GLA2_REP
#define MK_GLA2_REP 1
#endif
                if (qit >= N_ATT + MK_GLA2_REP * BATCH * GLA_HEADS * 64) break;
                if (qit < N_ATT) {
                    const int qt = 31 - qit / 12, rem = qit % 12, b = rem & 3, h0 = 2 * (rem >> 2);
                    const int tokb = b * SEQ, q0 = qt * 128, nkt = 4 * (qt + 1);
                    int tid_a = tid; asm volatile("" : "+v"(tid_a));
                    const int la = tid_a & 63, r = la & 31, hh = la >> 5;
                    const int qg = wave & 3, hd = wave >> 2, h = h0 + hd;
                    const int tq = q0 + 32 * qg + r;
                    LDSAS unsigned char* lb = (LDSAS unsigned char*)lds_raw;
                    LDSAS unsigned* maskl = (LDSAS unsigned*)(lb + 65536);
                    for (int idx = tid_a; idx < nkt * 128; idx += NTHREADS) maskl[idx] = MASK[((size_t)(b * 128) + (idx >> 7)) * SEQ + q0 + (idx & 127)];
                    bf16x8 qf[4];
#pragma unroll
                    for (int ks = 0; ks < 4; ++ks) qf[ks] = *(const bf16x8*)(QN + (size_t)(tokb + tq) * 384 + h * 64 + ks * 16 + hh * 8);
                    f32x16 oacc[2];
#pragma unroll
                    for (int dt = 0; dt < 2; ++dt)
#pragma unroll
                        for (int i = 0; i < 16; ++i) oacc[dt][i] = 0.f;
                    float lsum = 0.f;
                    const int krow = 4 * wave + (la >> 4), kpos = la & 15;
                    const int vrow = 16 * wave + (la >> 2), vpos = la & 3;
                    const char* ksrc = (const char*)KN + ((size_t)(tokb + krow) * 384 + h0 * 64) * 2 + ((kpos ^ (krow & 15)) * 16);
                    const char* vsrc = (const char*)VT + ((size_t)(b * 128) * 384 + h0 * 64 + vrow) * 64 + ((vpos ^ ((vrow >> 2) & 3)) * 16);
                    int koff[4], voff[2][2];
#pragma unroll
                    for (int ks = 0; ks < 4; ++ks) koff[ks] = r * 256 + (((hd * 8 + ks * 2 + hh) ^ (r & 15)) * 16);
#pragma unroll
                    for (int dt = 0; dt < 2; ++dt)
#pragma unroll
                        for (int sst = 0; sst < 2; ++sst) { const int vr = hd * 64 + dt * 32 + r; voff[dt][sst] = 8192 + vr * 64 + (((2 * sst + hh) ^ ((vr >> 2) & 3)) * 16); }
#define ATT_ISSUE(kt_, st_) do { const int ktc = (kt_) < nkt ? (kt_) : nkt - 1; \
                        __builtin_amdgcn_global_load_lds((const unsigned*)(ksrc + (size_t)ktc * (32 * 768)), (LDSAS unsigned*)(lb + (st_) * 16384 + wave * 1024), 16, 0, 0); \
                        __builtin_amdgcn_global_load_lds((const unsigned*)(vsrc + (size_t)ktc * (384 * 64)), (LDSAS unsigned*)(lb + (st_) * 16384 + 8192 + wave * 1024), 16, 0, 0); } while (0)
                    __syncthreads();
                    ATT_ISSUE(0, 0); ATT_ISSUE(1, 1); ATT_ISSUE(2, 2);
                    for (int kt = 0; kt < nkt; ++kt) {
                        asm volatile("s_waitcnt vmcnt(4)" ::: "memory");
                        __builtin_amdgcn_s_barrier();
                        asm volatile("" ::: "memory");
                        ATT_ISSUE(kt + 3, (kt + 3) & 3);
                        if (kt * 32 <= q0 + 32 * qg + 31) {
                            LDSAS unsigned char* st = lb + (kt & 3) * 16384;
                            const unsigned mwh = maskl[kt * 128 + 32 * qg + r] >> (4 * hh);
                            const int mind = (q0 + 32 * qg) - (kt * 32 + 31);
                            f32x16 S;
#pragma unroll
                            for (int i = 0; i < 16; ++i) S[i] = 0.f;
#pragma unroll
                            for (int ks = 0; ks < 4; ++ks) { const bf16x8 a = *(const LDSAS bf16x8*)(st + koff[ks]); S = MFMA32(a, qf[ks], S); }
                            float p[16];
                            if (mind >= 113) {
                                const float bu = biasd[h * 224 + 223];
#pragma unroll
                                for (int i = 0; i < 16; ++i) p[i] = __uint_as_float(__float_as_uint(__builtin_amdgcn_exp2f(S[i] + bu)) & (unsigned)__builtin_amdgcn_sbfe((int)mwh, (i & 3) + 8 * (i >> 2), 1));
                            } else {
                                const float* bp = biasd + h * 224 + (tq - kt * 32 - 4 * hh + 5);
#pragma unroll
                                for (int i = 0; i < 16; ++i) p[i] = __uint_as_float(__float_as_uint(__builtin_amdgcn_exp2f(S[i] + bp[27 - (i & 3) - 8 * (i >> 2)])) & (unsigned)__builtin_amdgcn_sbfe((int)mwh, (i & 3) + 8 * (i >> 2), 1));
                            }
                            float ps = 0.f;
#pragma unroll
                            for (int i = 0; i < 16; ++i) ps += p[i];
                            lsum += ps;
                            uint4 u0, u1;
                            u0.x = pkbf(p[0], p[1]); u0.y = pkbf(p[2], p[3]); u0.z = pkbf(p[4], p[5]); u0.w = pkbf(p[6], p[7]);
                            u1.x = pkbf(p[8], p[9]); u1.y = pkbf(p[10], p[11]); u1.z = pkbf(p[12], p[13]); u1.w = pkbf(p[14], p[15]);
                            const bf16x8 pf0 = __builtin_bit_cast(bf16x8, u0), pf1 = __builtin_bit_cast(bf16x8, u1);
#pragma unroll
                            for (int dt = 0; dt < 2; ++dt) {
                                const bf16x8 a0 = *(const LDSAS bf16x8*)(st + voff[dt][0]);
                                const bf16x8 a1 = *(const LDSAS bf16x8*)(st + voff[dt][1]);
                                oacc[dt] = MFMA32(a0, pf0, oacc[dt]);
                                oacc[dt] = MFMA32(a1, pf1, oacc[dt]);
                            }
                        }
                    }
#undef ATT_ISSUE
                    asm volatile("s_waitcnt vmcnt(0)" ::: "memory");
                    {
                        const float lt = lsum + __shfl_xor(lsum, 32);
                        float inv = 1.f / lt;
                        bf16_t* mo = MIX + (size_t)(tokb + tq) * D_MODEL + MIX_DSA + h * 64;
#pragma unroll
                        for (int dt = 0; dt < 2; ++dt)
#pragma unroll
                            for (int g4 = 0; g4 < 4; ++g4) {
                                uint2 o; o.x = pkbf(oacc[dt][4 * g4] * inv, oacc[dt][4 * g4 + 1] * inv); o.y = pkbf(oacc[dt][4 * g4 + 2] * inv, oacc[dt][4 * g4 + 3] * inv);
                                *(uint2*)(mo + dt * 32 + 8 * g4 + 4 * hh) = o;
                            }
                    }
                    continue;
                }
                const int item = (qit - N_ATT) % (BATCH * GLA_HEADS * 64);
                const int bh = item >> 6, c = item & 63, b = bh >> 2, h = bh & 3, tok0 = b * SEQ + c * 64;
                int tid_g = tid; asm volatile("" : "+v"(tid_g));
                __syncthreads();
                {
                    LDSAS unsigned char* lb = (LDSAS unsigned char*)lds_raw;
                    constexpr int QS_OFF = 0, KS_OFF = 7168, VT_OFF = 14336, ST_OFF = 28160, SQ_OFF = 38912;
                    if (tid_g < 384) {
                        const int t = tid_g / 6, c8 = (tid_g % 6) * 8;
                        const bf16_t* zr = Z + (size_t)(tok0 + t) * ZLD;
                        const uint4 qu = *(const uint4*)(zr + Z_GQ + h * 48 + c8), ku = *(const uint4*)(zr + Z_GK + h * 48 + c8);
                        const f32x4 b0 = *(const f32x4*)(BCUM + (size_t)(tok0 + t) * 192 + h * 48 + c8), b1 = *(const f32x4*)(BCUM + (size_t)(tok0 + t) * 192 + h * 48 + c8 + 4);
                        const float e0 = __expf(b0[0]), e1 = __expf(b0[1]), e2 = __expf(b0[2]), e3 = __expf(b0[3]), e4 = __expf(b1[0]), e5 = __expf(b1[1]), e6 = __expf(b1[2]), e7 = __expf(b1[3]);
                        const float qs = 0.14433756729740643f;
                        u32x4v qo, ko;
                        qo.x = pkbf(__uint_as_float(qu.x << 16) * qs * e0, __uint_as_float(qu.x & 0xffff0000u) * qs * e1); qo.y = pkbf(__uint_as_float(qu.y << 16) * qs * e2, __uint_as_float(qu.y & 0xffff0000u) * qs * e3);
                        qo.z = pkbf(__uint_as_float(qu.z << 16) * qs * e4, __uint_as_float(qu.z & 0xffff0000u) * qs * e5); qo.w = pkbf(__uint_as_float(qu.w << 16) * qs * e6, __uint_as_float(qu.w & 0xffff0000u) * qs * e7);
                        ko.x = pkbf(__uint_as_float(ku.x << 16) / e0, __uint_as_float(ku.x & 0xffff0000u) / e1); ko.y = pkbf(__uint_as_float(ku.y << 16) / e2, __uint_as_float(ku.y & 0xffff0000u) / e3);
                        ko.z = pkbf(__uint_as_float(ku.z << 16) / e4, __uint_as_float(ku.z & 0xffff0000u) / e5); ko.w = pkbf(__uint_as_float(ku.w << 16) / e6, __uint_as_float(ku.w & 0xffff0000u) / e7);
                        *(LDSAS u32x4v*)(lb + QS_OFF + t * 112 + c8 * 2) = qo; *(LDSAS u32x4v*)(lb + KS_OFF + t * 112 + c8 * 2) = ko;
                    }
                    for (int i = tid_g; i < 64 * 12; i += NTHREADS) {
                        const int sidx = i / 12, c8 = (i % 12) * 8;
                        const uint4 vu = *(const uint4*)(Z + (size_t)(tok0 + sidx) * ZLD + Z_GV + h * 96 + c8);
                        const int sl = sidx & 31, pp = (sidx & 32) + (sl & 16) + 8 * ((sl >> 2) & 1) + 4 * ((sl >> 3) & 1) + (sl & 3);
                        LDSAS bf16_t* vp = (LDSAS bf16_t*)(lb + VT_OFF) + c8 * 72 + pp;
                        vp[0] = (bf16_t)(vu.x & 0xffffu); vp[72] = (bf16_t)(vu.x >> 16); vp[144] = (bf16_t)(vu.y & 0xffffu); vp[216] = (bf16_t)(vu.y >> 16);
                        vp[288] = (bf16_t)(vu.z & 0xffffu); vp[360] = (bf16_t)(vu.z >> 16); vp[432] = (bf16_t)(vu.w & 0xffffu); vp[504] = (bf16_t)(vu.w >> 16);
                    }
                    for (int i = tid_g; i < 96 * 6; i += NTHREADS) {
                        const int v = i / 6, c8 = (i % 6) * 8;
                        const f32x4 s0 = *(const f32x4*)(SLOC + (size_t)item * 4608 + v * 48 + c8), s1 = *(const f32x4*)(SLOC + (size_t)item * 4608 + v * 48 + c8 + 4);
                        u32x4v so; so.x = pkbf(s0[0], s0[1]); so.y = pkbf(s0[2], s0[3]); so.z = pkbf(s1[0], s1[1]); so.w = pkbf(s1[2], s1[3]);
                        *(LDSAS u32x4v*)(lb + ST_OFF + v * 112 + c8 * 2) = so;
                    }
                    __syncthreads();
                    const int la = tid_g & 63, r = la & 31, hh = la >> 5;
                    const int wv = (wave < 6) ? wave : 0, vt = wv % 3, tt = wv / 3;
                    f32x16 oT;
#pragma unroll
                    for (int i = 0; i < 16; ++i) oT[i] = 0.f;
                    bf16x8 qB[3];
#pragma unroll
                    for (int ks = 0; ks < 3; ++ks) qB[ks] = *(const LDSAS bf16x8*)(lb + QS_OFF + (32 * tt + r) * 112 + (16 * ks + 8 * hh) * 2);
#pragma unroll
                    for (int st = 0; st < 2; ++st) {
                        if (st <= tt) {
                            f32x16 X;
#pragma unroll
                            for (int i = 0; i < 16; ++i) X[i] = 0.f;
#pragma unroll
                            for (int ks = 0; ks < 3; ++ks) { const bf16x8 kA = *(const LDSAS bf16x8*)(lb + KS_OFF + (32 * st + r) * 112 + (16 * ks + 8 * hh) * 2); X = MFMA32(kA, qB[ks], X); }
                            if (st == tt) {
#pragma unroll
                                for (int i = 0; i < 16; ++i) X[i] = (crow(i, hh) <= r) ? X[i] : 0.f;
                            }
                            u32x4v u0, u1;
                            u0.x = pkbf(X[0], X[1]); u0.y = pkbf(X[2], X[3]); u0.z = pkbf(X[4], X[5]); u0.w = pkbf(X[6], X[7]);
                            u1.x = pkbf(X[8], X[9]); u1.y = pkbf(X[10], X[11]); u1.z = pkbf(X[12], X[13]); u1.w = pkbf(X[14], X[15]);
                            const bf16x8 x0 = __builtin_bit_cast(bf16x8, u0), x1 = __builtin_bit_cast(bf16x8, u1);
                            const bf16x8 v0 = *(const LDSAS bf16x8*)(lb + VT_OFF + (32 * vt + r) * 144 + (32 * st + 8 * hh) * 2);
                            const bf16x8 v1 = *(const LDSAS bf16x8*)(lb + VT_OFF + (32 * vt + r) * 144 + (32 * st + 16 + 8 * hh) * 2);
                            oT = MFMA32(v0, x0, oT); oT = MFMA32(v1, x1, oT);
                        }
                    }
#pragma unroll
                    for (int ks = 0; ks < 3; ++ks) { const bf16x8 sA = *(const LDSAS bf16x8*)(lb + ST_OFF + (32 * vt + r) * 112 + (16 * ks + 8 * hh) * 2); oT = MFMA32(sA, qB[ks], oT); }
                    float ssp = 0.f;
#pragma unroll
                    for (int i = 0; i < 16; ++i) ssp += oT[i] * oT[i];
                    ssp += __shfl_xor(ssp, 32);
                    LDSAS float* sq = (LDSAS float*)(lb + SQ_OFF);
                    if (wave < 6 && hh == 0) sq[(32 * tt + r) * 3 + vt] = ssp;
                    __syncthreads();
                    if (wave < 6) {
                        const int t = 32 * tt + r;
                        const float rinv = 1.0f / sqrtf((sq[t * 3] + sq[t * 3 + 1] + sq[t * 3 + 2]) * (1.f / 96.f) + NORM_EPS);
#pragma unroll
                        for (int g4 = 0; g4 < 4; ++g4) {
                            const int v0i = 32 * vt + 8 * g4 + 4 * hh;
                            const f32x4 gg = *(const f32x4*)(gon + v0i);
                            const uint2 ru = *(const uint2*)(Z + (size_t)(tok0 + t) * ZLD + Z_GR + h * 96 + v0i);
                            uint2 w; w.x = pkbf(oT[4 * g4] * rinv * gg[0] * siluf(__uint_as_float(ru.x << 16)), oT[4 * g4 + 1] * rinv * gg[1] * siluf(__uint_as_float(ru.x & 0xffff0000u)));
                            w.y = pkbf(oT[4 * g4 + 2] * rinv * gg[2] * siluf(__uint_as_float(ru.y << 16)), oT[4 * g4 + 3] * rinv * gg[3] * siluf(__uint_as_float(ru.y & 0xffff0000u)));
                            *(uint2*)(MIX + (size_t)(tok0 + t) * D_MODEL + MIX_GLA + h * 96 + v0i) = w;
                        }
                    }
                }
            }
        } else if (k == 5 && PH_ON(5)) {
            pg8::Gemm g{MIX, WOUT + (size_t)l * D_MODEL * D_MODEL, T, D_MODEL, D_MODEL}; pg8::StaticOrder S; S.init(T, D_MODEL, G, bid);
            pg8::EpiRes E{xin, OUT, D_MODEL};
            pg8::gemm_phase<pg8::EpiRes, pg8::StaticOrder, true, true>(tid, ldsq, g, S, E);
        } else if (k == 6 && PH_ON(6)) {
            const float* g = args.in[15] + l * D_MODEL;
            for (int r = gw; r < T; r += NGW) rmsnorm_row_bf16(OUT + (size_t)r * D_MODEL, g, XN + (size_t)r * D_MODEL, lane);
            {
                float* scr = ldsf + wave * (64 * 33);
                for (int it = MOEW_P7 + gw; it < N_EXPERTS * MOEW_IE; it += NGW) {
                    const int e = it / MOEW_IE; int r = it % MOEW_IE;
                    const size_t we = (size_t)l * N_EXPERTS + e;
                    if (r < MOEW_IG) { transpose_item(args.in[27] + we * D_MODEL * D_EXPERT, D_MODEL, D_EXPERT, 16, WGU + (size_t)e * 1024 * D_MODEL, 0, 2, 0, scr, r, lane); continue; } r -= MOEW_IG;
                    if (r < MOEW_IG) { transpose_item(args.in[28] + we * D_MODEL * D_EXPERT, D_MODEL, D_EXPERT, 16, WGU + (size_t)e * 1024 * D_MODEL, 0, 2, 1, scr, r, lane); continue; } r -= MOEW_IG;
                    transpose_item(args.in[29] + we * D_EXPERT * D_MODEL, D_EXPERT, D_MODEL, 32, WDN + (size_t)e * D_MODEL * D_EXPERT, 0, 1, 0, scr, r, lane);
                }
            }
        } else if (k == 7 && PH_ON(7)) {
            pg8::Gemm g{XN, WCQ + (size_t)l * XW * D_MODEL, T, XW, D_MODEL}; pg8::StaticOrder S; S.init(T, XW, G, bid);
            pg8::EpiStoreBf16 E{CQ, XW, 0xffff};
            pg8::gemm_phase<pg8::EpiStoreBf16, pg8::StaticOrder, true, true>(tid, ldsq, g, S, E);
            if (bid >= T / 256) {
                float* scr = ldsf + wave * (64 * 33);
                const int nidle = (G - T / 256) * NWAVES;
                for (int it = (bid - T / 256) * NWAVES + wave; it < MOEW_P7; it += nidle) {
                    const int e = it / MOEW_IE; int r = it % MOEW_IE;
                    const size_t we = (size_t)l * N_EXPERTS + e;
                    if (r < MOEW_IG) { transpose_item(args.in[27] + we * D_MODEL * D_EXPERT, D_MODEL, D_EXPERT, 16, WGU + (size_t)e * 1024 * D_MODEL, 0, 2, 0, scr, r, lane); continue; } r -= MOEW_IG;
                    if (r < MOEW_IG) { transpose_item(args.in[28] + we * D_MODEL * D_EXPERT, D_MODEL, D_EXPERT, 16, WGU + (size_t)e * 1024 * D_MODEL, 0, 2, 1, scr, r, lane); continue; } r -= MOEW_IG;
                    transpose_item(args.in[29] + we * D_EXPERT * D_MODEL, D_EXPERT, D_MODEL, 32, WDN + (size_t)e * D_MODEL * D_EXPERT, 0, 1, 0, scr, r, lane);
                }
            }
        } else if (k == 8 && PH_ON(8)) {
            {
                const float* gq = args.in[19] + l * X_DH;
                const int r = lane & 31, hh = lane >> 5;
                for (int item = gw; item < BATCH * X_HEADS * (SEQ / 32); item += NGW) {
                    const int tt = item & 127, h = (item >> 7) & 3, b = item >> 9;
                    const int tok = b * SEQ + tt * 32 + r;
                    bf16x8 qf[4];
                    {
                        float qv[4][8]; float ss = 0.f;
#pragma unroll
                        for (int ks = 0; ks < 4; ++ks) { const uint4 u = *(const uint4*)(CQ + (size_t)tok * XW + h * 64 + ks * 16 + hh * 8);
                            qv[ks][0] = __uint_as_float(u.x << 16); qv[ks][1] = __uint_as_float(u.x & 0xffff0000u); qv[ks][2] = __uint_as_float(u.y << 16); qv[ks][3] = __uint_as_float(u.y & 0xffff0000u);
                            qv[ks][4] = __uint_as_float(u.z << 16); qv[ks][5] = __uint_as_float(u.z & 0xffff0000u); qv[ks][6] = __uint_as_float(u.w << 16); qv[ks][7] = __uint_as_float(u.w & 0xffff0000u);
#pragma unroll
                            for (int e = 0; e < 8; ++e) ss += qv[ks][e] * qv[ks][e]; }
                        ss += __shfl_xor(ss, 32);
                        const float rq = (0.125f * 1.4426950408889634f) / sqrtf(ss * (1.f / 64.f) + NORM_EPS);
#pragma unroll
                        for (int ks = 0; ks < 4; ++ks) { const f32x4 g0 = *(const f32x4*)(gq + ks * 16 + hh * 8), g1 = *(const f32x4*)(gq + ks * 16 + hh * 8 + 4);
                            uint4 u; u.x = pkbf(qv[ks][0] * rq * g0[0], qv[ks][1] * rq * g0[1]); u.y = pkbf(qv[ks][2] * rq * g0[2], qv[ks][3] * rq * g0[3]);
                            u.z = pkbf(qv[ks][4] * rq * g1[0], qv[ks][5] * rq * g1[1]); u.w = pkbf(qv[ks][6] * rq * g1[2], qv[ks][7] * rq * g1[3]);
                            qf[ks] = __builtin_bit_cast(bf16x8, u); }
                    }
                    f32x16 oacc[2];
#pragma unroll
                    for (int dt = 0; dt < 2; ++dt)
#pragma unroll
                        for (int e = 0; e < 16; ++e) oacc[dt][e] = 0.f;
                    float lsm = 0.f;
                    const bf16_t* kb = CKN + ((size_t)l * BATCH * MEM_LEN + (size_t)b * MEM_LEN + r) * 256 + h * 64 + hh * 8;
                    const bf16_t* vb = CVT + ((size_t)((l * BATCH + b) * X_HEADS + h) * 64 + r) * 256 + hh * 8;
#pragma unroll 2
                    for (int kt = 0; kt < 8; ++kt) {
                        f32x16 S;
#pragma unroll
                        for (int e = 0; e < 16; ++e) S[e] = 0.f;
#pragma unroll
                        for (int ks = 0; ks < 4; ++ks) { const bf16x8 a = *(const bf16x8*)(kb + (size_t)kt * 32 * 256 + ks * 16); S = MFMA32(a, qf[ks], S); }
                        float p[16]; float ps = 0.f;
#pragma unroll
                        for (int e = 0; e < 16; ++e) { p[e] = __builtin_amdgcn_exp2f(S[e]); ps += p[e]; }
                        lsm += ps;
                        uint4 u0, u1;
                        u0.x = pkbf(p[0], p[1]); u0.y = pkbf(p[2], p[3]); u0.z = pkbf(p[4], p[5]); u0.w = pkbf(p[6], p[7]);
                        u1.x = pkbf(p[8], p[9]); u1.y = pkbf(p[10], p[11]); u1.z = pkbf(p[12], p[13]); u1.w = pkbf(p[14], p[15]);
                        const bf16x8 pf0 = __builtin_bit_cast(bf16x8, u0), pf1 = __builtin_bit_cast(bf16x8, u1);
#pragma unroll
                        for (int dt = 0; dt < 2; ++dt) {
                            const bf16x8 a0 = *(const bf16x8*)(vb + (size_t)dt * 32 * 256 + kt * 32);
                            const bf16x8 a1 = *(const bf16x8*)(vb + (size_t)dt * 32 * 256 + kt * 32 + 16);
                            oacc[dt] = MFMA32(a0, pf0, oacc[dt]);
                            oacc[dt] = MFMA32(a1, pf1, oacc[dt]);
                        }
                    }
                    const float inv = 1.f / (lsm + __shfl_xor(lsm, 32));
                    bf16_t* op = COIN + (size_t)tok * XW + h * 64;
#pragma unroll
                    for (int dt = 0; dt < 2; ++dt)
#pragma unroll
                        for (int g4 = 0; g4 < 4; ++g4) {
                            uint2 o; o.x = pkbf(oacc[dt][4 * g4] * inv, oacc[dt][4 * g4 + 1] * inv); o.y = pkbf(oacc[dt][4 * g4 + 2] * inv, oacc[dt][4 * g4 + 3] * inv);
                            *(uint2*)(op + dt * 32 + 8 * g4 + 4 * hh) = o;
                        }
                }
            }
        } else if (k == 9 && PH_ON(9)) {
            pg8::Gemm g{COIN, WCO + (size_t)l * D_MODEL * XW, T, D_MODEL, XW}; pg8::StaticOrder S; S.init(T, D_MODEL, G, bid);
            pg8::EpiRes E{OUT, OUT, D_MODEL};
            pg8::gemm_phase<pg8::EpiRes, pg8::StaticOrder, true, true>(tid, ldsq, g, S, E);
        } else if (k == 10 && PH_ON(10)) {
            const float* g = args.in[22] + l * D_MODEL;
            const float* brg = args.in[24] + l * N_GROUPS; const float* bre = args.in[26] + l * N_EXPERTS;
            unsigned* lcnt = (unsigned*)lds_raw;
            unsigned* lbase = lcnt + 16;
            unsigned* ler = lcnt + 32;
            float* rinvs = (float*)lds_raw + 192;
            float* lg = (float*)lds_raw + 256;
            float* red = (float*)lds_raw + 2048;
            const bf16_t* wrt_hi = WRT + (size_t)l * 2 * 32 * D_MODEL; const bf16_t* wrt_lo = wrt_hi + 32 * D_MODEL;
            for (int chunk = bid; chunk < T / 64; chunk += G) {
                __syncthreads();
                if (tid < 16) lcnt[tid] = 0u;
#pragma unroll 2
                for (int ti = 0; ti < 8; ++ti) {
                    const int r = chunk * 64 + wave * 8 + ti;
                    const float* xrow = OUT + (size_t)r * D_MODEL;
                    f32x4 v[4]; float ss = 0.f;
#pragma unroll
                    for (int jj = 0; jj < 4; ++jj) { v[jj] = *(const f32x4*)(xrow + lane * 4 + 256 * jj); ss += v[jj][0] * v[jj][0] + v[jj][1] * v[jj][1] + v[jj][2] * v[jj][2] + v[jj][3] * v[jj][3]; }
                    const float rinv = 1.0f / sqrtf(wave_sum(ss) * (1.f / 1024.f) + NORM_EPS);
                    if (lane == 0) rinvs[wave * 8 + ti] = rinv;
#pragma unroll
                    for (int jj = 0; jj < 4; ++jj) { const f32x4 gg = *(const f32x4*)(g + lane * 4 + 256 * jj);
                        uint2 o; o.x = pk2(v[jj][0] * rinv * gg[0], v[jj][1] * rinv * gg[1]); o.y = pk2(v[jj][2] * rinv * gg[2], v[jj][3] * rinv * gg[3]);
                        *(uint2*)(XN + (size_t)r * D_MODEL + lane * 4 + 256 * jj) = o; }
                }
                __syncthreads();
                {
                    const int rr = lane & 31, hh = lane >> 5;
                    f32x16 acc[2];
#pragma unroll
                    for (int mt = 0; mt < 2; ++mt)
#pragma unroll
                        for (int e = 0; e < 16; ++e) acc[mt][e] = 0.f;
                    const float rv0 = rinvs[rr], rv1 = rinvs[32 + rr];
#pragma unroll 2
                    for (int kq = 0; kq < 8; ++kq) {
                        const int k0 = 16 * (8 * wave + kq) + 8 * hh;
                        const bf16x8 bh = *(const bf16x8*)(wrt_hi + (size_t)rr * D_MODEL + k0), bl = *(const bf16x8*)(wrt_lo + (size_t)rr * D_MODEL + k0);
                        const f32x4 g0 = *(const f32x4*)(g + k0), g1 = *(const f32x4*)(g + k0 + 4);
#pragma unroll
                        for (int mt = 0; mt < 2; ++mt) {
                            const float* xp = OUT + (size_t)(chunk * 64 + mt * 32 + rr) * D_MODEL + k0;
                            const f32x4 x0 = *(const f32x4*)xp, x1 = *(const f32x4*)(xp + 4);
                            const float rv = mt ? rv1 : rv0;
                            float xn[8] = {x0[0] * rv * g0[0], x0[1] * rv * g0[1], x0[2] * rv * g0[2], x0[3] * rv * g0[3], x1[0] * rv * g1[0], x1[1] * rv * g1[1], x1[2] * rv * g1[2], x1[3] * rv * g1[3]};
                            u32x4v uh, ul;
                            uh.x = pkbf(xn[0], xn[1]); uh.y = pkbf(xn[2], xn[3]); uh.z = pkbf(xn[4], xn[5]); uh.w = pkbf(xn[6], xn[7]);
                            ul.x = pkbf(xn[0] - __uint_as_float(uh.x << 16), xn[1] - __uint_as_float(uh.x & 0xffff0000u)); ul.y = pkbf(xn[2] - __uint_as_float(uh.y << 16), xn[3] - __uint_as_float(uh.y & 0xffff0000u));
                            ul.z = pkbf(xn[4] - __uint_as_float(uh.z << 16), xn[5] - __uint_as_float(uh.z & 0xffff0000u)); ul.w = pkbf(xn[6] - __uint_as_float(uh.w << 16), xn[7] - __uint_as_float(uh.w & 0xffff0000u));
                            const bf16x8 ah = __builtin_bit_cast(bf16x8, uh), al = __builtin_bit_cast(bf16x8, ul);
                            acc[mt] = MFMA32(ah, bh, acc[mt]); acc[mt] = MFMA32(ah, bl, acc[mt]); acc[mt] = MFMA32(al, bh, acc[mt]);
                        }
                    }
#pragma unroll
                    for (int mt = 0; mt < 2; ++mt)
#pragma unroll
                        for (int e = 0; e < 16; ++e) red[((wave * 2 + mt) * 32 + crow(e, hh)) * 33 + rr] = acc[mt][e];
                }
                __syncthreads();
                for (int idx = tid; idx < 64 * 20; idx += NTHREADS) { const int t = idx / 20, n = idx % 20; float sv = 0.f;
#pragma unroll
                    for (int w = 0; w < 8; ++w) sv += red[((w * 2 + (t >> 5)) * 32 + (t & 31)) * 33 + n];
                    lg[t * 21 + n] = sv; }
                __syncthreads();
                if (tid < 64) {
                    const int r = chunk * 64 + tid;
                    float acc[20];
#pragma unroll
                    for (int jj = 0; jj < 20; ++jj) acc[jj] = lg[tid * 21 + jj];
                    float gl[4]; int gs = 0;
#pragma unroll
                    for (int jj = 0; jj < 4; ++jj) gl[jj] = acc[jj] + brg[jj];
                    float gmax = gl[0];
#pragma unroll
                    for (int jj = 1; jj < 4; ++jj) if (gl[jj] > gmax) { gmax = gl[jj]; gs = jj; }
                    float den = 0.f;
#pragma unroll
                    for (int jj = 0; jj < 4; ++jj) den += __expf(gl[jj] - gmax);
                    const float gwt = 1.f / den;
                    float el[4];
#pragma unroll
                    for (int jj = 0; jj < 4; ++jj) { float vsel = 0.f;
#pragma unroll
                        for (int gg2 = 0; gg2 < 4; ++gg2) vsel = (gg2 == gs) ? (acc[4 + gg2 * 4 + jj] + bre[gg2 * 4 + jj]) : vsel;
                        el[jj] = vsel; }
                    int i1 = 0; float e1v = el[0];
#pragma unroll
                    for (int jj = 1; jj < 4; ++jj) if (el[jj] > e1v) { e1v = el[jj]; i1 = jj; }
                    int i2 = -1; float e2v = -INFINITY;
#pragma unroll
                    for (int jj = 0; jj < 4; ++jj) if (jj != i1 && el[jj] > e2v) { e2v = el[jj]; i2 = jj; }
                    const float e2 = __expf(e2v - e1v);
                    const float w1 = 1.f / (1.f + e2), w2 = e2 / (1.f + e2);
                    const int ex1 = gs * 4 + i1, ex2 = gs * 4 + i2;
                    tok_e[r * 2] = ex1; tok_e[r * 2 + 1] = ex2;
                    tok_g[r * 2] = w1 * gwt; tok_g[r * 2 + 1] = w2 * gwt;
                    const unsigned r1 = atomicAdd(&lcnt[ex1], 1u), r2 = atomicAdd(&lcnt[ex2], 1u);
                    ler[tid * 2] = (unsigned)ex1 | (r1 << 8); ler[tid * 2 + 1] = (unsigned)ex2 | (r2 << 8);
                }
                __syncthreads();
                if (tid < 16) CNTT[((size_t)l * (T / 64) + chunk) * 16 + tid] = (int)lcnt[tid];
                if (tid < 128) tok_r[(chunk * 64) * 2 + tid] = (int)(ler[tid] >> 8);
            }
        } else if (k >= 11 && k <= 14 && PH_ON(11)) {
            int off[N_EXPERTS + 1];
            int* cbt = (int*)lds_raw + 1024;
            if (k == 11) {
                int* segs = (int*)lds_raw;
                int* tot = (int*)lds_raw + 512;
                __syncthreads();
                for (int i = tid; i < (T / 64) * 16; i += NTHREADS) cbt[i] = CNTT[(size_t)l * (T / 64) * 16 + i];
                __syncthreads();
                { const int e = tid & 15, sg = tid >> 4; int sacc = 0;
#pragma unroll
                  for (int c = 0; c < 8; ++c) { const int v = cbt[(sg * 8 + c) * 16 + e]; cbt[(sg * 8 + c) * 16 + e] = sacc; sacc += v; }
                  segs[sg * 16 + e] = sacc; }
                __syncthreads();
                { const int e = tid & 15, sg = tid >> 4; int base = 0;
                  for (int q = 0; q < sg; ++q) base += segs[q * 16 + e];
#pragma unroll
                  for (int c = 0; c < 8; ++c) cbt[(sg * 8 + c) * 16 + e] += base;
                  if (sg == 31) { tot[e] = base + segs[sg * 16 + e]; if (bid == 0) cnt[e] = (unsigned)(base + segs[sg * 16 + e]); } }
                __syncthreads();
                off[0] = 0;
#pragma unroll
                for (int e = 0; e < N_EXPERTS; ++e) off[e + 1] = off[e] + ((tot[e] + PADR - 1) / PADR) * PADR;
            } else {
                off[0] = 0;
#pragma unroll
                for (int e = 0; e < N_EXPERTS; ++e) { const int c = (int)__hip_atomic_load(&cnt[e], __ATOMIC_RELAXED, __HIP_MEMORY_SCOPE_AGENT); off[e + 1] = off[e] + ((c + PADR - 1) / PADR) * PADR; }
            }
            const int total_rows = off[N_EXPERTS];
            if (k == 11) {
                for (int i = gw; i < 2 * T; i += NGW) {
                    const int e = tok_e[i]; int o = 0;
#pragma unroll
                    for (int q = 0; q < N_EXPERTS; ++q) o = (q == e) ? off[q] : o;
                    const int grank = cbt[((i >> 1) >> 6) * 16 + e] + tok_r[i];
                    if (lane == 0) tok_r[i] = grank;
                    const uint4* src = (const uint4*)(XN + (size_t)(i >> 1) * D_MODEL); uint4* dst = (uint4*)(XG + (size_t)(o + grank) * D_MODEL);
                    dst[lane] = src[lane]; dst[lane + 64] = src[lane + 64];
                }
                for (int e = 0; e < N_EXPERTS; ++e) {
                    int oe = 0, oe1 = 0;
#pragma unroll
                    for (int q = 0; q < N_EXPERTS; ++q) { oe = (q == e) ? off[q] : oe; oe1 = (q == e) ? off[q + 1] : oe1; }
                    const int c = ((int*)lds_raw + 512)[e];
                    for (int r = oe + c + gw; r < oe1; r += NGW) { uint4* dst = (uint4*)(XG + (size_t)r * D_MODEL); dst[lane] = make_uint4(0u, 0u, 0u, 0u); dst[lane + 64] = make_uint4(0u, 0u, 0u, 0u); }
                }
            } else if (k == 12) {
                pg8::Gemm g{XG, WGU, total_rows, 1024, D_MODEL};
                pg8::GroupSched S;
#pragma unroll
                for (int q = 0; q < 17; ++q) S.off[q] = off[q];
                S.nunits = (total_rows / 256) * 4; S.G = G; S.c = bid;
                pg8::EpiGateUp E{HB, D_EXPERT};
                pg8::gemm_phase<pg8::EpiGateUp, pg8::GroupSched, true, true>(tid, ldsq, g, S, E);
            } else if (k == 13) {
                pg8::Gemm g{HB, WDN, total_rows, 1024, D_EXPERT};
                pg8::GroupSched S;
#pragma unroll
                for (int q = 0; q < 17; ++q) S.off[q] = off[q];
                S.nunits = (total_rows / 256) * 4; S.G = G; S.c = bid;
                pg8::EpiStoreBf16 E{DB, D_MODEL, 3};
                pg8::gemm_phase<pg8::EpiStoreBf16, pg8::GroupSched, true, true>(tid, ldsq, g, S, E);
            } else {
                const float* gnx = args.in[3] + (l + 1 < DEPTH ? l + 1 : l) * D_MODEL;
                for (int r = gw; r < T; r += NGW) {
                    const int e0 = tok_e[r * 2], e1 = tok_e[r * 2 + 1]; int o0 = 0, o1 = 0;
#pragma unroll
                    for (int q = 0; q < N_EXPERTS; ++q) { o0 = (q == e0) ? off[q] : o0; o1 = (q == e1) ? off[q] : o1; }
                    const size_t r0 = (size_t)(o0 + tok_r[r * 2]), r1 = (size_t)(o1 + tok_r[r * 2 + 1]);
                    const float g0 = tok_g[r * 2], g1 = tok_g[r * 2 + 1];
                    f32x4 xv[4]; float ss = 0.f;
#pragma unroll
                    for (int j = 0; j < 4; ++j) {
                        const int c = lane * 4 + 256 * j;
                        const uint2 a = *(const uint2*)(DB + r0 * 1024 + c), bq = *(const uint2*)(DB + r1 * 1024 + c);
                        f32x4 x = *(const f32x4*)(OUT + (size_t)r * D_MODEL + c);
                        x[0] += g0 * __uint_as_float(a.x << 16) + g1 * __uint_as_float(bq.x << 16);
                        x[1] += g0 * __uint_as_float(a.x & 0xffff0000u) + g1 * __uint_as_float(bq.x & 0xffff0000u);
                        x[2] += g0 * __uint_as_float(a.y << 16) + g1 * __uint_as_float(bq.y << 16);
                        x[3] += g0 * __uint_as_float(a.y & 0xffff0000u) + g1 * __uint_as_float(bq.y & 0xffff0000u);
                        *(f32x4*)(OUT + (size_t)r * D_MODEL + c) = x;
                        xv[j] = x; ss += x[0] * x[0] + x[1] * x[1] + x[2] * x[2] + x[3] * x[3];
                    }
                    if (l + 1 < DEPTH) {
                        const float rinv = 1.0f / sqrtf(wave_sum(ss) * (1.f / 1024.f) + NORM_EPS);
#pragma unroll
                        for (int j = 0; j < 4; ++j) { const int c = lane * 4 + 256 * j; const f32x4 gg = *(const f32x4*)(gnx + c);
                            uint2 o; o.x = pk2(xv[j][0] * rinv * gg[0], xv[j][1] * rinv * gg[1]); o.y = pk2(xv[j][2] * rinv * gg[2], xv[j][3] * rinv * gg[3]);
                            *(uint2*)(XN + (size_t)r * D_MODEL + c) = o; }
                    }
                }
            }
        }
    }
#ifdef MK_PROF_A
    if (KSEL < 0) {
        xcd_barrier(bar);
        if (bid == 0 && threadIdx.x == 0) ctl[8192 + DEPTH * NP] = (unsigned)__builtin_amdgcn_s_memrealtime();
        xcd_barrier(bar);
        const float da = (float)(ctl[8192 + MK_PROF_A + 1] - ctl[8192 + MK_PROF_A]) * 0.01f;
        const float db = (MK_PROF_B < 0) ? (float)(ctl[8192 + DEPTH * NP] - ctl[8192]) * 0.01f : (float)(ctl[8192 + MK_PROF_B + 1] - ctl[8192 + MK_PROF_B]) * 0.01f;
        for (size_t i = (size_t)T * D_MODEL / 2 + (size_t)bid * NTHREADS + threadIdx.x; i < (size_t)T * D_MODEL; i += (size_t)G * NTHREADS) OUT[i] = db;
        if (bid == 0 && threadIdx.x == 0) OUT[0] = 100.f * da;
    }
#endif
}

#ifndef MK_SINGLE
#define MK_SINGLE 1
#endif
extern "C" void kernel_launch(void* const* d_in, const int* in_sizes, int n_in, void* d_out, int out_size, void* d_ws, size_t ws_size, hipStream_t stream) {
    static int grid = 0;
    if (grid == 0) {
        if (n_in != 30 || out_size != T * D_MODEL || ws_size < WS_END) { fprintf(stderr, "kernel_launch: unexpected sizes n_in %d out %d ws %zu (need %zu)\n", n_in, out_size, ws_size, (size_t)WS_END); grid = -1; return; }
        int dev = 0, cus = 0;
        if (hipGetDevice(&dev) != hipSuccess || hipDeviceGetAttribute(&cus, hipDeviceAttributeMultiprocessorCount, dev) != hipSuccess) { grid = -1; return; }
        bool okattr = true;
#define SETATTR(K) okattr = okattr && (hipFuncSetAttribute((const void*)mk_fwd<K>, hipFuncAttributeMaxDynamicSharedMemorySize, LDS_BYTES) == hipSuccess)
#if MK_SINGLE
        SETATTR(-1);
#else
        SETATTR(0); SETATTR(1); SETATTR(2); SETATTR(3); SETATTR(4); SETATTR(5); SETATTR(6); SETATTR(7); SETATTR(8); SETATTR(9); SETATTR(10); SETATTR(11); SETATTR(12); SETATTR(13); SETATTR(14);
#endif
        if (!okattr) { fprintf(stderr, "kernel_launch: hipFuncSetAttribute failed\n"); grid = -1; return; }
        (void)hipGetLastError();
        grid = cus > 0 ? cus : 256;
    }
    if (grid < 0) return;
    (void)hipMemsetAsync((char*)d_ws + WS_CTL, 0, CTL_BYTES, stream);
    Args a{};
    for (int i = 0; i < 30; ++i) a.in[i] = (const float*)d_in[i];
    a.out = (float*)d_out; a.ws = (unsigned char*)d_ws;
#if MK_SINGLE
    a.ph_lo = 0; a.ph_hi = DEPTH * NP;
    hipLaunchKernelGGL(mk_fwd<-1>, dim3(grid), dim3(NTHREADS), LDS_BYTES, stream, a);
#else
    for (int ph = 0; ph < DEPTH * NP; ++ph) {
        a.ph_lo = ph; a.ph_hi = ph + 1;
        switch (ph % NP) {
#define LCASE(K) case K: hipLaunchKernelGGL(mk_fwd<K>, dim3(grid), dim3(NTHREADS), LDS_BYTES, stream, a); break
            LCASE(0); LCASE(1); LCASE(2); LCASE(3); LCASE(4); LCASE(5); LCASE(6); LCASE(7); LCASE(8); LCASE(9); LCASE(10); LCASE(11); LCASE(12); LCASE(13); LCASE(14);
        }
    }
#endif
}
```

```cpp
#include <hip/hip_runtime.h>
#include <cstdio>
#include <cstdint>

constexpr int D_MODEL = 1024, BATCH = 4, SEQ = 4096, DEPTH = 2, T = BATCH * SEQ;
constexpr int MEM_LEN = 256;
constexpr int GLA_HEADS = 4, GLA_DK = 48, GLA_DV = 96, GLA_RANK = 16;
constexpr int DSA_HEADS = 6, DSA_DH = 64, IDX_HEADS = 8, IDX_DIM = 64, TOPK = 256;
constexpr int CONV_CH = 256, CONV_W = 31;
constexpr int NUM_BUCKETS = 32;
constexpr int X_HEADS = 4, X_DH = 64, XW = X_HEADS * X_DH;
constexpr int N_GROUPS = 4, EPG = 4, N_EXPERTS = 16, D_EXPERT = 512;
constexpr float NORM_EPS = 1e-6f;
constexpr int D_IN = 3416;
constexpr int Z_GQ = 0, Z_GK = 192, Z_GV = 384, Z_GLR = 768, Z_GR = 784, Z_DQ = 1168, Z_DK = 1552, Z_DV = 1936, Z_IQ = 2320, Z_IK = 2832, Z_IW = 2896, Z_CU = 2904;
constexpr int ZLD = 3584;
constexpr int MIX_GLA = 0, MIX_DSA = 384, MIX_CONV = 768;
constexpr int PADR = 256;
constexpr int MAXROWS = 2 * T + N_EXPERTS * PADR;

typedef unsigned short bf16_t;
typedef float f32x4 __attribute__((ext_vector_type(4)));

constexpr size_t MiB = 1u << 20;
constexpr size_t WS_CTL = 0, CTL_BYTES = 1 * MiB;
constexpr size_t WS_WIN0 = 1 * MiB, WS_WCKV = 8 * MiB, WS_WIN1 = 10 * MiB, WS_WOUT = 17 * MiB, WS_WCQ = 21 * MiB, WS_WCO = 22 * MiB;
constexpr size_t WS_XN = 24 * MiB;
constexpr size_t WS_MEMN = 56 * MiB;
constexpr size_t WS_Z = 60 * MiB;
constexpr size_t WS_WGU = WS_Z, WS_WDN = WS_Z + 32 * MiB, WS_HB = WS_Z + 48 * MiB;
constexpr size_t WS_MIX = 172 * MiB;
constexpr size_t WS_QN = 204 * MiB, WS_KN = 216 * MiB;
constexpr size_t WS_VT = 228 * MiB;
constexpr size_t WS_MASK = 240 * MiB;
constexpr size_t WS_IK = 248 * MiB, WS_QL = 250 * MiB, WS_CH = 252 * MiB;
constexpr size_t WS_XG = WS_MIX, WS_DB = WS_MIX;
constexpr size_t WS_CQ = 256 * MiB, WS_COIN = 264 * MiB;
constexpr size_t WS_BCUM = 256 * MiB, WS_SLOC = 268 * MiB, WS_DEC = 286 * MiB;
constexpr size_t WS_CKV = 288 * MiB;
constexpr size_t WS_CKN = 290 * MiB;
constexpr size_t WS_CVT = 292 * MiB;
constexpr size_t WS_ROUTE = 291 * MiB;
constexpr size_t WS_END = 293 * MiB;
constexpr int CW_CNT = 1024;
constexpr int CW_Q3 = 2048, CW_Q4 = 2304;

constexpr int NTHREADS = 512, NWAVES = 8;
constexpr int LDS_BYTES = 147456;

__device__ __forceinline__ float bf2f(bf16_t u) { return __uint_as_float(((unsigned)u) << 16); }
__device__ __forceinline__ bf16_t f2bf(float f) { unsigned u = __float_as_uint(f); return (bf16_t)((u + 0x7fffu + ((u >> 16) & 1u)) >> 16); }
__device__ __forceinline__ unsigned pk2(float lo, float hi) { return (unsigned)f2bf(lo) | ((unsigned)f2bf(hi) << 16); }
__device__ __forceinline__ float wave_sum(float v) {
    v += __builtin_bit_cast(float, __builtin_amdgcn_update_dpp(0, __builtin_bit_cast(int, v), 0xB1, 0xf, 0xf, false));
    v += __builtin_bit_cast(float, __builtin_amdgcn_update_dpp(0, __builtin_bit_cast(int, v), 0x4E, 0xf, 0xf, false));
    v += __builtin_bit_cast(float, __builtin_amdgcn_update_dpp(0, __builtin_bit_cast(int, v), 0x141, 0xf, 0xf, false));
    v += __builtin_bit_cast(float, __builtin_amdgcn_update_dpp(0, __builtin_bit_cast(int, v), 0x140, 0xf, 0xf, false));
    v += __builtin_bit_cast(float, __builtin_amdgcn_update_dpp(0, __builtin_bit_cast(int, v), 0x142, 0xa, 0xf, false));
    v += __builtin_bit_cast(float, __builtin_amdgcn_update_dpp(0, __builtin_bit_cast(int, v), 0x143, 0xc, 0xf, false));
    return __builtin_bit_cast(float, __builtin_amdgcn_readlane(__builtin_bit_cast(int, v), 63));
}
__device__ __forceinline__ float siluf(float x) { return x / (1.f + __expf(-x)); }
__device__ __forceinline__ float sigmoidf(float x) { return 1.f / (1.f + __expf(-x)); }


typedef short bf16x8 __attribute__((ext_vector_type(8)));
typedef float f32x16 __attribute__((ext_vector_type(16)));
typedef unsigned u32x4v __attribute__((ext_vector_type(4)));
typedef __bf16 bf16x2_t __attribute__((ext_vector_type(2)));
typedef float f32x2_t __attribute__((ext_vector_type(2)));
#define LDSAS __attribute__((address_space(3)))
#define MFMA32(a, b, c) __builtin_amdgcn_mfma_f32_32x32x16_bf16((a), (b), (c), 0, 0, 0)
__device__ __forceinline__ int crow(int reg, int hh) { return (reg & 3) + 8 * (reg >> 2) + 4 * hh; }
__device__ __forceinline__ unsigned pkbf(float a, float b) { f32x2_t v = {a, b}; bf16x2_t r = __builtin_convertvector(v, bf16x2_t); return __builtin_bit_cast(unsigned, r); }

struct Args {
    const float* in[30];
    float* out;
    unsigned char* ws;
    int ph_lo, ph_hi;
};

template <class Epi>
__device__ __forceinline__ void gemm_tile_v1(const int tid, float* lds, const bf16_t* A, int lda, const int* rowidx, int row0,
                                             const float* B, int ldb, int col0, int ncols, int K, const Epi& epi) {
    float* As = lds;
    float* Bs = lds + 16 * 132;
    const int ty = tid >> 4, tx = tid & 15;
    float acc[4][8];
#pragma unroll
    for (int i = 0; i < 4; ++i)
#pragma unroll
        for (int j = 0; j < 8; ++j) acc[i][j] = 0.f;
    const int ar = tid >> 2, ak = (tid & 3) * 4;
    const int grow = rowidx ? rowidx[row0 + ar] : (row0 + ar);
    const bf16_t* ap = A + (size_t)(grow >= 0 ? grow : 0) * lda + ak;
    const bool aval = grow >= 0;
    const int bk = tid >> 5, bn = (tid & 31) * 4;
    const bool bval = bn < ncols;
    const float* bp = B + (size_t)bk * ldb + col0 + bn;
    for (int k0 = 0; k0 < K; k0 += 16) {
        uint2 av = make_uint2(0u, 0u);
        if (aval) av = *(const uint2*)(ap + k0);
        f32x4 bv = (f32x4){0.f, 0.f, 0.f, 0.f};
        if (bval) bv = *(const f32x4*)(bp + (size_t)k0 * ldb);
        __syncthreads();
        As[(ak + 0) * 132 + ar] = __uint_as_float(av.x << 16);
        As[(ak + 1) * 132 + ar] = __uint_as_float(av.x & 0xffff0000u);
        As[(ak + 2) * 132 + ar] = __uint_as_float(av.y << 16);
        As[(ak + 3) * 132 + ar] = __uint_as_float(av.y & 0xffff0000u);
        *(f32x4*)&Bs[bk * 132 + bn] = bv;
        __syncthreads();
#pragma unroll
        for (int k = 0; k < 16; ++k) {
            const f32x4 a4 = *(const f32x4*)&As[k * 132 + ty * 4];
            const f32x4 b0 = *(const f32x4*)&Bs[k * 132 + tx * 8];
            const f32x4 b1 = *(const f32x4*)&Bs[k * 132 + tx * 8 + 4];
#pragma unroll
            for (int i = 0; i < 4; ++i) {
                acc[i][0] += a4[i] * b0[0]; acc[i][1] += a4[i] * b0[1]; acc[i][2] += a4[i] * b0[2]; acc[i][3] += a4[i] * b0[3];
                acc[i][4] += a4[i] * b1[0]; acc[i][5] += a4[i] * b1[1]; acc[i][6] += a4[i] * b1[2]; acc[i][7] += a4[i] * b1[3];
            }
        }
    }
    __syncthreads();
#pragma unroll
    for (int i = 0; i < 4; ++i)
        epi(row0 + ty * 4 + i, col0 + tx * 8, (f32x4){acc[i][0], acc[i][1], acc[i][2], acc[i][3]}, (f32x4){acc[i][4], acc[i][5], acc[i][6], acc[i][7]});
}

template <class Epi>
__device__ __forceinline__ void gemm_v1(const int tid, float* lds, const bf16_t* A, int lda, int M, const float* B, int ldb, int N, int K, const Epi& epi) {
    const int nct = (N + 127) / 128, nrt = M / 128;
    for (int tile = blockIdx.x; tile < nrt * nct; tile += gridDim.x) {
        const int rt = tile / nct, ct = tile % nct;
        const int nc = (N - ct * 128) < 128 ? (N - ct * 128) : 128;
        gemm_tile_v1(tid, lds, A, lda, nullptr, rt * 128, B, ldb, ct * 128, nc, K, epi);
    }
}

namespace pg8 {
#define PG8_LAS __attribute__((address_space(3)))
typedef PG8_LAS unsigned char* PG8_LAS_T;
typedef short bf16x8 __attribute__((ext_vector_type(8)));
typedef unsigned u32x4 __attribute__((ext_vector_type(4)));
constexpr int BM = 256, BK = 64, HALF = 128, HTB = HALF * BK * 2  , STAGE_BYTES = 8 * HTB, NXCD = 8, WGM = 8;

__host__ __device__ __forceinline__ int lds_byte(int r, int c) { const int st = (r >> 4) * 2 + (c >> 5), rr = r & 15, cc = c & 31, ob = rr * 64 + cc * 2; return st * 1024 + (ob ^ (((ob >> 9) & 1) << 5)); }
__host__ __device__ __forceinline__ void stage_rc(int b, int& R, int& C) { const int st = b / 1024, sb = b % 1024, swz = sb ^ (((sb >> 9) & 1) << 5); R = (st >> 1) * 16 + swz / 64; C = (st & 1) * 32 + (swz % 64) / 2; }
__host__ __device__ __forceinline__ int perm32(int rho) { const int n = rho >> 4, i = rho & 15; return 8 * (i >> 2) + 4 * n + (i & 3); }

struct Unit { int pm, pn; };
struct Gemm { const bf16_t* A; const bf16_t* Bt; int M, N, K; };

struct StaticOrder {
    int nM, nN, nwg, G, c;
    __host__ __device__ void init(int M, int N, int G_, int c_) { nM = M / BM; nN = N / BM; nwg = nM * nN; G = G_; c = c_; }
    __host__ __device__ bool next(int i, Unit& u) const {
        const long L = (long)i * G + c; if (L >= nwg) return false;
        int wgid = (int)L; { const int q = nwg / NXCD, r = nwg % NXCD, xcd = wgid % NXCD, off = wgid / NXCD; wgid = (xcd < r ? xcd * (q + 1) : r * (q + 1) + (xcd - r) * q) + off; }
        const int nig = WGM * nN, gid = wgid / nig, fm = gid * WGM, gsz = (nM - fm) < WGM ? (nM - fm) : WGM;
        u.pm = fm + ((wgid % nig) % gsz); u.pn = (wgid % nig) / gsz; return true;
    }
    __device__ __forceinline__ void a_ready(const Unit&) const {}
    __device__ __forceinline__ void done(const Unit&) const {}
};

__device__ __forceinline__ unsigned cvt_pk_bf16(float lo, float hi) { unsigned r; asm volatile("v_cvt_pk_bf16_f32 %0, %1, %2" : "=v"(r) : "v"(lo), "v"(hi)); return r; }
typedef float f32x2 __attribute__((ext_vector_type(2)));
template <class Epi, class Sched, bool ALIGN_EPI = false, bool SP2 = false>
__device__ __forceinline__ void gemm_phase(const int tid, PG8_LAS unsigned char* lds, const Gemm g, const Sched& S, const Epi& E) {
    const int wid = __builtin_amdgcn_readfirstlane(tid >> 6), lane = tid & 63, wr = wid >> 2, wc = wid & 3, fr = lane & 15, fq = lane >> 4;
    const int K = g.K, nt = K / BK;
    unsigned voffA[2], voffB[2];
#pragma unroll
    for (int i = 0; i < 2; ++i) { int R, C; stage_rc(tid * 16 + i * 8192, R, C); const int Rb = Epi::PERM ? ((R & ~31) + perm32(R & 31)) : R;
        voffA[i] = (unsigned)(R * K + C) * 2u; voffB[i] = (unsigned)(Rb * K + C) * 2u; }
    const size_t kstep = (size_t)(BK * 2);
    const size_t hstep = (size_t)HALF * K * 2;
    const size_t tstep = 2 * hstep;
    const unsigned ldsw = (unsigned)wid * 1024u;
    const int aoff = lds_byte(wr * 64 + fr, fq * 8), boff = lds_byte(wc * 32 + fr, fq * 8);
#define PG8_SA(b, h) (((b) * 2 + (h)) * HTB)
#define PG8_SB(b, h) ((4 + (b) * 2 + (h)) * HTB)
#define PG8_STAGE(bufoff, gbase, voff) do { _Pragma("unroll") for (int _i = 0; _i < 2; ++_i) \
        __builtin_amdgcn_global_load_lds((const unsigned*)((const char*)(gbase) + (voff)[_i]), (PG8_LAS unsigned*)(lds + (bufoff) + ldsw + _i * 8192), 16, 0, 0); } while (0)
#define PG8_LDA(dst, b, h) do { _Pragma("unroll") for (int m = 0; m < 4; ++m) _Pragma("unroll") for (int k = 0; k < 2; ++k) dst[m][k] = *(const PG8_LAS bf16x8*)(lds + PG8_SA(b, h) + aoff + m * 2048 + k * 1024); } while (0)
#define PG8_LDB(dst, b, h) do { _Pragma("unroll") for (int n = 0; n < 2; ++n) _Pragma("unroll") for (int k = 0; k < 2; ++k) dst[n][k] = *(const PG8_LAS bf16x8*)(lds + PG8_SB(b, h) + boff + n * 2048 + k * 1024); } while (0)
#define PG8_MMA(ai, bj, At, Bt) do { __builtin_amdgcn_s_setprio(1); _Pragma("unroll") for (int m = 0; m < 4; ++m) _Pragma("unroll") for (int n = 0; n < 2; ++n) _Pragma("unroll") for (int k = 0; k < 2; ++k) \
        acc[ai][bj][m][n] = __builtin_amdgcn_mfma_f32_16x16x32_bf16(Bt[n][k], At[m][k], acc[ai][bj][m][n], 0, 0, 0); __builtin_amdgcn_s_setprio(0); } while (0)
#define PG8_WAIT_V(n) asm volatile("s_waitcnt vmcnt(" #n ")" ::: "memory")
#define PG8_WAIT_L(n) asm volatile("s_waitcnt lgkmcnt(" #n ")" ::: "memory")
#define PG8_BAR __builtin_amdgcn_s_barrier()
#define PG8_SCHED __builtin_amdgcn_sched_barrier(0)
    Unit cur, nxt; int ui = 0;
    if (!S.next(0, cur)) return;
    f32x4 acc[2][2][4][2];
#pragma unroll
    for (int a = 0; a < 2; ++a)
#pragma unroll
        for (int b = 0; b < 2; ++b)
#pragma unroll
            for (int m = 0; m < 4; ++m)
#pragma unroll
                for (int n = 0; n < 2; ++n) acc[a][b][m][n] = (f32x4){0.f, 0.f, 0.f, 0.f};
    bf16x8 At[4][2], B0[2][2], B1[2][2];
    const char* cA = (const char*)g.A + (size_t)cur.pm * tstep; const char* cB = (const char*)g.Bt + (size_t)cur.pn * tstep;
    S.a_ready(cur);
    if constexpr (SP2) {
        PG8_STAGE(PG8_SB(0, 0), cB, voffB); PG8_STAGE(PG8_SB(0, 1), cB + hstep, voffB); PG8_STAGE(PG8_SA(0, 0), cA, voffA); PG8_STAGE(PG8_SA(0, 1), cA + hstep, voffA);
        if (wr == 1) PG8_BAR;
        PG8_WAIT_V(2); PG8_BAR;
        PG8_STAGE(PG8_SB(1, 0), cB + kstep, voffB); PG8_STAGE(PG8_SA(1, 0), cA + kstep, voffA); PG8_STAGE(PG8_SB(1, 1), cB + hstep + kstep, voffB);
        PG8_WAIT_V(6); PG8_BAR;
    } else {
        PG8_STAGE(PG8_SB(0, 0), cB, voffB); PG8_STAGE(PG8_SA(0, 0), cA, voffA); PG8_STAGE(PG8_SB(0, 1), cB + hstep, voffB); PG8_STAGE(PG8_SA(0, 1), cA + hstep, voffA);
        if (wr == 1) PG8_BAR;
        PG8_WAIT_V(4); PG8_BAR;
        PG8_STAGE(PG8_SB(1, 0), cB + kstep, voffB); PG8_STAGE(PG8_SA(1, 0), cA + kstep, voffA); PG8_STAGE(PG8_SB(1, 1), cB + hstep + kstep, voffB);
        PG8_WAIT_V(6); PG8_BAR;
    }
    for (;;) {
        const bool has_next = S.next(ui + 1, nxt);
        const char* nA = has_next ? (const char*)g.A + (size_t)nxt.pm * tstep : cA; const char* nB = has_next ? (const char*)g.Bt + (size_t)nxt.pn * tstep : cB;
        for (int t = 0; t < nt; t += 2) {
            const bool last = (t == nt - 2);
            const char* a1 = cA + (size_t)(t + 1) * kstep;
            const char* a2 = last ? nA : cA + (size_t)(t + 2) * kstep; const char* b2 = last ? nB : cB + (size_t)(t + 2) * kstep;
            const char* a3 = a2 + kstep; const char* b3 = b2 + kstep;
            if (last && has_next) S.a_ready(nxt);
            if constexpr (SP2) {
            PG8_LDB(B0, 0, 0); PG8_LDB(B1, 0, 1); PG8_SCHED; PG8_LDA(At, 0, 0); PG8_STAGE(PG8_SA(1, 1), a1 + hstep, voffA);
            PG8_WAIT_V(8); PG8_WAIT_L(0); PG8_BAR; PG8_MMA(0, 0, At, B0); PG8_MMA(0, 1, At, B1); PG8_BAR; PG8_SCHED;
            PG8_LDA(At, 0, 1); PG8_STAGE(PG8_SB(0, 0), b2, voffB); PG8_STAGE(PG8_SB(0, 1), b2 + hstep, voffB); PG8_STAGE(PG8_SA(0, 0), a2, voffA);
            PG8_WAIT_V(8); PG8_WAIT_L(0); PG8_BAR; PG8_MMA(1, 0, At, B0); PG8_MMA(1, 1, At, B1); PG8_BAR; PG8_SCHED;
            PG8_LDB(B0, 1, 0); PG8_LDB(B1, 1, 1); PG8_SCHED; PG8_LDA(At, 1, 0); PG8_STAGE(PG8_SA(0, 1), a2 + hstep, voffA);
            PG8_WAIT_V(8); PG8_WAIT_L(0); PG8_BAR; PG8_MMA(0, 0, At, B0); PG8_MMA(0, 1, At, B1); PG8_BAR; PG8_SCHED;
            PG8_LDA(At, 1, 1); PG8_STAGE(PG8_SB(1, 0), b3, voffB); PG8_STAGE(PG8_SB(1, 1), b3 + hstep, voffB); PG8_STAGE(PG8_SA(1, 0), a3, voffA);
            PG8_WAIT_V(8); PG8_WAIT_L(0); PG8_BAR; PG8_MMA(1, 0, At, B0); PG8_MMA(1, 1, At, B1); PG8_BAR; PG8_SCHED;
            } else {
            PG8_LDB(B0, 0, 0); PG8_SCHED; PG8_LDA(At, 0, 0); PG8_STAGE(PG8_SA(1, 1), a1 + hstep, voffA);
            PG8_WAIT_L(8); PG8_BAR; PG8_WAIT_L(0); PG8_MMA(0, 0, At, B0); PG8_BAR; PG8_SCHED;
            PG8_LDB(B1, 0, 1); PG8_STAGE(PG8_SB(0, 0), b2, voffB);
            PG8_BAR; PG8_WAIT_L(0); PG8_MMA(0, 1, At, B1); PG8_BAR;
            PG8_LDA(At, 0, 1); PG8_STAGE(PG8_SA(0, 0), a2, voffA);
            PG8_BAR; PG8_WAIT_L(0); PG8_MMA(1, 0, At, B0); PG8_BAR; PG8_SCHED;
            PG8_STAGE(PG8_SB(0, 1), b2 + hstep, voffB);
            PG8_WAIT_V(6); PG8_BAR; PG8_MMA(1, 1, At, B1); PG8_BAR;
            PG8_LDB(B0, 1, 0); PG8_SCHED; PG8_LDA(At, 1, 0); PG8_STAGE(PG8_SA(0, 1), a2 + hstep, voffA);
            PG8_WAIT_L(8); PG8_BAR; PG8_WAIT_L(0); PG8_MMA(0, 0, At, B0); PG8_BAR; PG8_SCHED;
            PG8_LDB(B1, 1, 1); PG8_STAGE(PG8_SB(1, 0), b3, voffB);
            PG8_BAR; PG8_WAIT_L(0); PG8_MMA(0, 1, At, B1); PG8_BAR;
            PG8_LDA(At, 1, 1); PG8_STAGE(PG8_SA(1, 0), a3, voffA);
            PG8_BAR; PG8_WAIT_L(0); PG8_MMA(1, 0, At, B0); PG8_BAR; PG8_SCHED;
            PG8_STAGE(PG8_SB(1, 1), b3 + hstep, voffB);
            PG8_WAIT_V(6); PG8_BAR; PG8_MMA(1, 1, At, B1); PG8_BAR;
            }
        }
        if constexpr (ALIGN_EPI) { if (wr == 0) PG8_BAR; }
        if constexpr (!Epi::AFTER_DRAIN) { E(acc, cur, wr, wc, fr, fq); S.done(cur); }
        if (!has_next) break;
#pragma unroll
        for (int a = 0; a < 2; ++a)
#pragma unroll
            for (int b = 0; b < 2; ++b)
#pragma unroll
                for (int m = 0; m < 4; ++m)
#pragma unroll
                    for (int n = 0; n < 2; ++n) acc[a][b][m][n] = (f32x4){0.f, 0.f, 0.f, 0.f};
        cur = nxt; cA = nA; cB = nB; ++ui;
        if constexpr (ALIGN_EPI) { if (wr == 1) PG8_BAR; }
    }
    PG8_WAIT_V(0);
    if constexpr (!ALIGN_EPI) { if (wr == 0) PG8_BAR; }
    PG8_BAR;
    if constexpr (Epi::AFTER_DRAIN) { E.fused(acc, cur, wr, wc, fr, fq, lds, wid, lane); S.done(cur); }
#undef PG8_SA
#undef PG8_SB
#undef PG8_STAGE
#undef PG8_LDA
#undef PG8_LDB
#undef PG8_MMA
#undef PG8_WAIT_V
#undef PG8_WAIT_L
#undef PG8_BAR
#undef PG8_SCHED
}

struct EpiStoreBf16 {
    static constexpr bool PERM = true, AFTER_DRAIN = false;
    bf16_t* O; int ldc; int pnmask;
    __device__ __forceinline__ void operator()(const f32x4 (&acc)[2][2][4][2], const Unit& u, int wr, int wc, int fr, int fq) const {
        const int row0 = u.pm * BM + wr * 64 + fr; const int col0 = (u.pn & pnmask) * BM + wc * 32 + 8 * fq;
#pragma unroll
        for (int ai = 0; ai < 2; ++ai)
#pragma unroll
            for (int m = 0; m < 4; ++m) { bf16_t* rowp = O + (size_t)(row0 + ai * HALF + m * 16) * ldc + col0;
#pragma unroll
                for (int bj = 0; bj < 2; ++bj) { const f32x4 v0 = acc[ai][bj][m][0], v1 = acc[ai][bj][m][1];
                    u32x4 w; w.x = cvt_pk_bf16(v0[0], v0[1]); w.y = cvt_pk_bf16(v0[2], v0[3]); w.z = cvt_pk_bf16(v1[0], v1[1]); w.w = cvt_pk_bf16(v1[2], v1[3]);
                    *(u32x4*)(rowp + bj * HALF) = w; } }
    }
};
struct EpiRes {
    static constexpr bool PERM = false, AFTER_DRAIN = false;
    const float* base; float* out; int ldc;
    __device__ __forceinline__ void operator()(const f32x4 (&acc)[2][2][4][2], const Unit& u, int wr, int wc, int fr, int fq) const {
        const int row0 = u.pm * BM + wr * 64 + fr; const int col0 = u.pn * BM + wc * 32 + 4 * fq;
#pragma unroll
        for (int ai = 0; ai < 2; ++ai)
#pragma unroll
            for (int m = 0; m < 4; ++m) { const size_t off = (size_t)(row0 + ai * HALF + m * 16) * ldc + col0;
#pragma unroll
                for (int bj = 0; bj < 2; ++bj)
#pragma unroll
                    for (int n = 0; n < 2; ++n) { const f32x4 b = *(const f32x4*)(base + off + bj * HALF + n * 16); *(f32x4*)(out + off + bj * HALF + n * 16) = b + acc[ai][bj][m][n]; } }
    }
};
struct EpiGateUp {
    static constexpr bool PERM = true, AFTER_DRAIN = false;
    bf16_t* O; int ldc;
    __device__ __forceinline__ static float silu(float x) { return x / (1.f + __expf(-x)); }
    __device__ __forceinline__ void operator()(const f32x4 (&acc)[2][2][4][2], const Unit& u, int wr, int wc, int fr, int fq) const {
        const int row0 = u.pm * BM + wr * 64 + fr; const int col0 = ((u.pn & 3) * BM + wc * 32 + 8 * fq) >> 1;
#pragma unroll
        for (int ai = 0; ai < 2; ++ai)
#pragma unroll
            for (int m = 0; m < 4; ++m) { bf16_t* rowp = O + (size_t)(row0 + ai * HALF + m * 16) * ldc + col0;
#pragma unroll
                for (int bj = 0; bj < 2; ++bj) { const f32x4 v0 = acc[ai][bj][m][0], v1 = acc[ai][bj][m][1];
                    uint2 w; w.x = cvt_pk_bf16(silu(v0[0]) * v0[1], silu(v0[2]) * v0[3]); w.y = cvt_pk_bf16(silu(v1[0]) * v1[1], silu(v1[2]) * v1[3]);
                    *(uint2*)(rowp + bj * (HALF / 2)) = w; } }
    }
};
struct InprojSched {
    StaticOrder base; int extra;
    __device__ __forceinline__ bool next(int i, Unit& u) const {
        if (base.next(i, u)) return true;
        const long L = (long)i * base.G + base.c - base.nwg;
        if (L < 0 || L >= extra) return false;
        const int e = (int)L; u.pm = base.nM + (e >> 3) * 4 + ((e >> 1) & 3); u.pn = base.nN + (e >> 3) * 2 + (e & 1); return true;
    }
    __device__ __forceinline__ void a_ready(const Unit&) const {}
    __device__ __forceinline__ void done(const Unit&) const {}
};
struct EpiInproj {
    static constexpr bool PERM = true, AFTER_DRAIN = false;
    bf16_t* Zp; bf16_t* CKVp;
    __device__ __forceinline__ void operator()(const f32x4 (&acc)[2][2][4][2], const Unit& u, int wr, int wc, int fr, int fq) const {
        const bool kv = u.pm >= 64;
        const int ll = (u.pm - 64) >> 2;
        bf16_t* O = kv ? CKVp + (size_t)ll * 1024 * 512 : Zp; const int ldc = kv ? 512 : 3584;
        const int row0 = (kv ? ((u.pm - 64) & 3) : u.pm) * BM + wr * 64 + fr; const int col0 = (kv ? ((u.pn - 14) & 1) : u.pn) * BM + wc * 32 + 8 * fq;
#pragma unroll
        for (int ai = 0; ai < 2; ++ai)
#pragma unroll
            for (int m = 0; m < 4; ++m) { bf16_t* rowp = O + (size_t)(row0 + ai * HALF + m * 16) * ldc + col0;
#pragma unroll
                for (int bj = 0; bj < 2; ++bj) { const f32x4 v0 = acc[ai][bj][m][0], v1 = acc[ai][bj][m][1];
                    u32x4 w; w.x = cvt_pk_bf16(v0[0], v0[1]); w.y = cvt_pk_bf16(v0[2], v0[3]); w.z = cvt_pk_bf16(v1[0], v1[1]); w.w = cvt_pk_bf16(v1[2], v1[3]);
                    *(u32x4*)(rowp + bj * HALF) = w; } }
    }
};
struct GroupSched {
    int off[17]; int nunits, G, c;
    __device__ __forceinline__ bool next(int i, Unit& u) const {
        const int L = i * G + c; if (L >= nunits) return false;
        const int rt = L >> 2, pn = L & 3, row0 = rt * BM; int e = 0;
#pragma unroll
        for (int q = 1; q < 16; ++q) e = (row0 >= off[q]) ? q : e;
        u.pm = rt; u.pn = e * 4 + pn; return true;
    }
    __device__ __forceinline__ void a_ready(const Unit&) const {}
    __device__ __forceinline__ void done(const Unit&) const {}
};
}

__device__ __forceinline__ void rmsnorm_row_bf16(const float* xrow, const float* g, bf16_t* orow, int lane) {
    f32x4 v[4]; float s = 0.f;
#pragma unroll
    for (int j = 0; j < 4; ++j) { v[j] = *(const f32x4*)(xrow + lane * 4 + 256 * j); s += v[j][0] * v[j][0] + v[j][1] * v[j][1] + v[j][2] * v[j][2] + v[j][3] * v[j][3]; }
    const float rinv = 1.0f / sqrtf(wave_sum(s) * (1.f / 1024.f) + NORM_EPS);
#pragma unroll
    for (int j = 0; j < 4; ++j) {
        const f32x4 gg = *(const f32x4*)(g + lane * 4 + 256 * j);
        uint2 o; o.x = pk2(v[j][0] * rinv * gg[0], v[j][1] * rinv * gg[1]); o.y = pk2(v[j][2] * rinv * gg[2], v[j][3] * rinv * gg[3]);
        *(uint2*)(orow + lane * 4 + 256 * j) = o;
    }
}

__device__ __forceinline__ void transpose_item(const float* W, int K, int N, int nblk, bf16_t* WT, int row_off, int rmul, int radd, float* scr, int item, int lane) {
    const int kb = item / nblk, nb = item % nblk, k0 = 64 * kb, n0 = 32 * nb;
    const bool nv = (n0 + (lane & 31)) < N;
#pragma unroll 8
    for (int i = 0; i < 32; ++i) { const int kk = 2 * i + (lane >> 5); scr[kk * 33 + (lane & 31)] = nv ? W[(size_t)(k0 + kk) * N + n0 + (lane & 31)] : 0.f; }
    __builtin_amdgcn_s_waitcnt(0xc07f); __builtin_amdgcn_wave_barrier();
    const int c = lane & 7;
#pragma unroll
    for (int j = 0; j < 4; ++j) { const int n = (lane >> 3) + 8 * j; const float* sp = scr + (8 * c) * 33 + n;
        uint4 o; o.x = pk2(sp[0 * 33], sp[1 * 33]); o.y = pk2(sp[2 * 33], sp[3 * 33]); o.z = pk2(sp[4 * 33], sp[5 * 33]); o.w = pk2(sp[6 * 33], sp[7 * 33]);
        *(uint4*)(WT + (size_t)(row_off + (n0 + n) * rmul + radd) * K + k0 + 8 * c) = o; }
    __builtin_amdgcn_s_waitcnt(0xc07f); __builtin_amdgcn_wave_barrier();
}

__device__ __forceinline__ int t5_bucket(int dist) {
    if (dist < 16) return dist;
    const float d = (float)dist;
    int large = 16 + (int)(__logf(d * (1.f / 16.f)) * (16.0f / 2.0794415416798357f));
    return large < 31 ? large : 31;
}
__device__ __forceinline__ unsigned fkey(float f) { const unsigned u = __float_as_uint(f + 0.0f); return (u & 0x80000000u) ? ~u : (u | 0x80000000u); }


#define LAS __attribute__((address_space(3)))
#define XB_TMO      128
#define XB_XCNT(j)  (256  + 64 * (j))
#define XB_XSUB(j)  (1280 + 64 * (j))
#define XB_XGEN(j)  (2304 + 64 * (j))
#define XB_TOP      3328
#define XB_TOPGEN   3392
#define XCD_BAR_WORDS 3456
#define XB_SPIN_CAP (1u << 24)
__device__ __forceinline__ unsigned xb_ld(unsigned* p)              { return __hip_atomic_load(p, __ATOMIC_RELAXED, __HIP_MEMORY_SCOPE_AGENT); }
__device__ __forceinline__ unsigned xb_add(unsigned* p, unsigned v) { return __hip_atomic_fetch_add(p, v, __ATOMIC_RELAXED, __HIP_MEMORY_SCOPE_AGENT); }
__device__ __forceinline__ unsigned xb_xcc_id() { return (unsigned)__builtin_amdgcn_s_getreg((3 << 11) | 20) & 0xFu; }
#define XB_SPIN(cond, bar) do { unsigned _sp = 0; while (cond) { __builtin_amdgcn_s_sleep(1); \
    if ((++_sp & 255u) == 0u) { if (xb_ld(&(bar)[XB_TMO])) break; if (_sp > XB_SPIN_CAP) { atomicAdd(&(bar)[XB_TMO], 1u); break; } } } } while (0)
struct XcdBarrier { unsigned* bar; unsigned x; volatile LAS unsigned* st; };
__device__ __forceinline__ XcdBarrier xcd_barrier_post(unsigned* bar, volatile LAS unsigned* st) {
    XcdBarrier b; b.bar = bar; b.x = xb_xcc_id(); b.st = st;
    if (threadIdx.x == 0) (void)xb_add(&bar[XB_XCNT(b.x)], 1u);
    return b;
}
__device__ __forceinline__ void xcd_barrier_complete(unsigned* bar, unsigned x, unsigned& nloc, unsigned& nx) {
    const unsigned G = gridDim.x * gridDim.y * gridDim.z;
    unsigned sum, cnt, mine, sp = 0u;
    for (;;) {
        sum = 0u; cnt = 0u; mine = 0u;
#pragma unroll
        for (unsigned j = 0; j < 16; ++j) { const unsigned c = xb_ld(&bar[XB_XCNT(j)]); sum += c; cnt += (c > 0u) ? 1u : 0u; mine = (j == x) ? c : mine; }
        if (sum == G) break;
        __builtin_amdgcn_s_sleep(1);
        if ((++sp & 255u) == 0u) { if (xb_ld(&bar[XB_TMO])) break; if (sp > XB_SPIN_CAP) { atomicAdd(&bar[XB_TMO], 1u); break; } }
    }
    nloc = mine > 0u ? mine : 1u; nx = cnt > 0u ? cnt : 1u;
}
__device__ __forceinline__ void xcd_barrier(const XcdBarrier& b) {
    asm volatile("s_waitcnt vmcnt(0)" ::: "memory");
    __syncthreads();
    if (threadIdx.x == 0) {
        unsigned* bar = b.bar;
        __builtin_amdgcn_s_waitcnt(0);
        unsigned nloc = b.st[0], nx = b.st[1];
        if (nloc == 0u) { xcd_barrier_complete(bar, b.x, nloc, nx); b.st[0] = nloc; b.st[1] = nx; }
        const unsigned old = xb_add(&bar[XB_XSUB(b.x)], 1u);
        const unsigned gen = old / nloc;
        if (old + 1u == (gen + 1u) * nloc) {
            __builtin_amdgcn_fence(__ATOMIC_RELEASE, "agent");
            asm volatile("s_waitcnt vmcnt(0)" ::: "memory");
            const unsigned og = xb_add(&bar[XB_TOP], 1u);
            const unsigned tg = og / nx;
            if (og + 1u == (tg + 1u) * nx) xb_add(&bar[XB_TOPGEN], 1u);
            else XB_SPIN(xb_ld(&bar[XB_TOPGEN]) == tg, bar);
            __builtin_amdgcn_fence(__ATOMIC_ACQUIRE, "agent");
            xb_add(&bar[XB_XGEN(b.x)], 1u);
            asm volatile("s_waitcnt vmcnt(0)" ::: "memory");
        } else {
            XB_SPIN(xb_ld(&bar[XB_XGEN(b.x)]) == gen, bar);
            __builtin_amdgcn_fence(__ATOMIC_ACQUIRE, "agent");
            asm volatile("s_waitcnt vmcnt(0)" ::: "memory");
        }
    }
    __syncthreads();
}
constexpr int CW_BAR = 4096;
constexpr int LDSCTL_OFF = LDS_BYTES - 256;

constexpr int NP = 15;
constexpr int MOEW_IG = 16 * 16, MOEW_ID = 8 * 32, MOEW_IE = 2 * MOEW_IG + MOEW_ID;
constexpr int MOEW_P7 = 2688;
#ifndef MK_PHMASK
#define MK_PHMASK 0x7fff
#endif
#define PH_ON(x) (((MK_PHMASK) >> (x)) & 1)

template <int KSEL>
__global__ void __launch_bounds__(NTHREADS, 2) mk_fwd(Args args) {
    extern __shared__ __attribute__((aligned(16))) unsigned char lds_raw[];
    float* ldsf = (float*)lds_raw;
    const int G = gridDim.x, bid = blockIdx.x, NGW = G * NWAVES;
    const int wave_s = __builtin_amdgcn_readfirstlane(threadIdx.x >> 6);
    unsigned char* ws = args.ws;
    unsigned* ctl = (unsigned*)(ws + WS_CTL);
    bf16_t* XN = (bf16_t*)(ws + WS_XN);
    bf16_t* Z = (bf16_t*)(ws + WS_Z);
    bf16_t* XG = (bf16_t*)(ws + WS_XG);
    bf16_t* VT = (bf16_t*)(ws + WS_VT); unsigned* MASK = (unsigned*)(ws + WS_MASK); bf16_t* IK = (bf16_t*)(ws + WS_IK); bf16_t* QL = (bf16_t*)(ws + WS_QL); float* CH = (float*)(ws + WS_CH);
    float* BCUM = (float*)(ws + WS_BCUM); float* SLOC = (float*)(ws + WS_SLOC); float* DEC = (float*)(ws + WS_DEC);
    bf16_t* WIN0 = (bf16_t*)(ws + WS_WIN0); bf16_t* WIN1 = (bf16_t*)(ws + WS_WIN1); bf16_t* WOUT = (bf16_t*)(ws + WS_WOUT); bf16_t* WCQ = (bf16_t*)(ws + WS_WCQ); bf16_t* WCKV = (bf16_t*)(ws + WS_WCKV); bf16_t* WCO = (bf16_t*)(ws + WS_WCO);
    bf16_t* WGU = (bf16_t*)(ws + WS_WGU); bf16_t* WDN = (bf16_t*)(ws + WS_WDN);
    pg8::PG8_LAS_T ldsq = (pg8::PG8_LAS_T)lds_raw;
    bf16_t* HB = (bf16_t*)(ws + WS_HB);
    bf16_t* MIX = (bf16_t*)(ws + WS_MIX);
    bf16_t* DB = (bf16_t*)(ws + WS_DB);
    bf16_t* QN = (bf16_t*)(ws + WS_QN);
    bf16_t* KN = (bf16_t*)(ws + WS_KN);
    bf16_t* CQ = (bf16_t*)(ws + WS_CQ);
    bf16_t* COIN = (bf16_t*)(ws + WS_COIN);
    bf16_t* MEMN = (bf16_t*)(ws + WS_MEMN);
    bf16_t* CKV = (bf16_t*)(ws + WS_CKV);
    bf16_t* CKN = (bf16_t*)(ws + WS_CKN);
    bf16_t* CVT = (bf16_t*)(ws + WS_CVT);
    int* tok_e = (int*)(ws + WS_ROUTE);
    int* CNTT = (int*)(ws + WS_ROUTE + 768 * 1024);
    bf16_t* WRT = (bf16_t*)(ws + WS_ROUTE + 512 * 1024);
    int* tok_r = tok_e + 2 * T;
    float* tok_g = (float*)(tok_r + 2 * T);
    float* OUT = args.out;
    XcdBarrier bar; bar.bar = ctl + CW_BAR; bar.x = 0; bar.st = nullptr;
    if (KSEL < 0) {
        volatile LAS unsigned* st = (volatile LAS unsigned*)((LAS unsigned char*)lds_raw + LDSCTL_OFF);
        if (threadIdx.x < 64) st[threadIdx.x] = 0u;
        __syncthreads();
        bar = xcd_barrier_post(ctl + CW_BAR, st);
    }

#ifndef MK_REPEAT_PH
#define MK_REPEAT_PH (-1)
#define MK_REPEAT_N 0
#endif
#ifdef MK_XBAR
    if (KSEL < 0) for (int xb = 0; xb < MK_XBAR; ++xb) xcd_barrier(bar);
#endif
    const int nvirt = (args.ph_hi - args.ph_lo) + ((MK_REPEAT_PH >= 0) ? MK_REPEAT_N : 0);
    for (int vi = 0; vi < nvirt; ++vi) {
        const int ph = (MK_REPEAT_PH < 0 || vi <= MK_REPEAT_PH) ? args.ph_lo + vi : ((vi <= MK_REPEAT_PH + MK_REPEAT_N) ? MK_REPEAT_PH : args.ph_lo + vi - MK_REPEAT_N);
        const int rep = (MK_REPEAT_PH >= 0 && vi > MK_REPEAT_PH && vi <= MK_REPEAT_PH + MK_REPEAT_N) ? vi - MK_REPEAT_PH : 0;
        if (KSEL < 0 && ph >= NP && (ph % NP) == 0) continue;
        if (KSEL < 0 && vi > 0) xcd_barrier(bar);
        int tid_op = wave_s * 64 + (int)__builtin_amdgcn_mbcnt_hi(~0u, __builtin_amdgcn_mbcnt_lo(~0u, 0u)); asm volatile("" : "+v"(tid_op));
        const int tid = tid_op, lane = tid & 63, wave = __builtin_amdgcn_readfirstlane(tid >> 6), gw = bid * NWAVES + wave;
#ifdef MK_PROF_A
        if (bid == 0 && tid == 0) ctl[8192 + ph] = (unsigned)__builtin_amdgcn_s_memrealtime();
#endif
        const int l = ph / NP, k = (KSEL >= 0) ? KSEL : (ph % NP);
        const float* xin = (l == 0) ? args.in[0] : OUT;
        unsigned* cnt = ctl + CW_CNT + 64 * l;

        if (k == 0 && PH_ON(0)) {
            const float* g = args.in[3] + l * D_MODEL;
            for (int r = gw; r < T; r += NGW) rmsnorm_row_bf16(xin + (size_t)r * D_MODEL, g, XN + (size_t)r * D_MODEL, lane);
            if (l == 0) {
                float* scr = ldsf + wave * (64 * 33);
                constexpr int I_IN = 16 * 112, I_OUT = 16 * 32, I_CQ = 16 * 8, I_CKV = 16 * 16, I_CO = 4 * 32, I_L = I_IN + I_OUT + I_CQ + I_CKV + I_CO;
                for (int it = gw; it < DEPTH * I_L; it += NGW) {
                    const int ll = it / I_L; int r = it % I_L;
                    if (r < I_IN) { transpose_item(args.in[4] + (size_t)ll * D_MODEL * D_IN, D_MODEL, D_IN, 112, (ll == 0 ? WIN0 : WIN1), 0, 1, 0, scr, r, lane); continue; } r -= I_IN;
                    if (r < I_OUT) { transpose_item(args.in[14] + (size_t)ll * D_MODEL * D_MODEL, D_MODEL, D_MODEL, 32, WOUT + (size_t)ll * D_MODEL * D_MODEL, 0, 1, 0, scr, r, lane); continue; } r -= I_OUT;
                    if (r < I_CQ) { transpose_item(args.in[17] + (size_t)ll * D_MODEL * XW, D_MODEL, XW, 8, WCQ + (size_t)ll * XW * D_MODEL, 0, 1, 0, scr, r, lane); continue; } r -= I_CQ;
                    if (r < I_CKV) { transpose_item(args.in[18] + (size_t)ll * D_MODEL * 512, D_MODEL, 512, 16, WCKV + (size_t)ll * 512 * D_MODEL, 0, 1, 0, scr, r, lane); continue; } r -= I_CKV;
                    transpose_item(args.in[21] + (size_t)ll * XW * D_MODEL, XW, D_MODEL, 32, WCO + (size_t)ll * D_MODEL * XW, 0, 1, 0, scr, r, lane);
                }
            }
            if (l == 0)
                for (int i = bid * NTHREADS + tid; i < DEPTH * 32 * (D_MODEL / 8); i += G * NTHREADS) {
                    const int k8 = (i % (D_MODEL / 8)) * 8, n = (i / (D_MODEL / 8)) % 32, ll = i / (32 * (D_MODEL / 8));
                    float wv[8];
#pragma unroll
                    for (int e = 0; e < 8; ++e) wv[e] = (n < 4) ? args.in[23][((size_t)ll * D_MODEL + k8 + e) * N_GROUPS + n] : ((n < 20) ? args.in[25][((size_t)ll * D_MODEL + k8 + e) * N_EXPERTS + n - 4] : 0.f);
                    uint4 hi, lo;
                    hi.x = pk2(wv[0], wv[1]); hi.y = pk2(wv[2], wv[3]); hi.z = pk2(wv[4], wv[5]); hi.w = pk2(wv[6], wv[7]);
                    lo.x = pk2(wv[0] - __uint_as_float(hi.x << 16), wv[1] - __uint_as_float(hi.x & 0xffff0000u)); lo.y = pk2(wv[2] - __uint_as_float(hi.y << 16), wv[3] - __uint_as_float(hi.y & 0xffff0000u));
                    lo.z = pk2(wv[4] - __uint_as_float(hi.z << 16), wv[5] - __uint_as_float(hi.z & 0xffff0000u)); lo.w = pk2(wv[6] - __uint_as_float(hi.w << 16), wv[7] - __uint_as_float(hi.w & 0xffff0000u));
                    *(uint4*)(WRT + ((size_t)(ll * 2) * 32 + n) * D_MODEL + k8) = hi; *(uint4*)(WRT + ((size_t)(ll * 2 + 1) * 32 + n) * D_MODEL + k8) = lo;
                }
            if (l == 0)
                for (int r = gw; r < 2 * BATCH * MEM_LEN; r += NGW) {
                    const int ll = r / (BATCH * MEM_LEN), rr = r % (BATCH * MEM_LEN);
                    rmsnorm_row_bf16(args.in[1] + (size_t)rr * D_MODEL, args.in[16] + ll * D_MODEL, MEMN + (size_t)r * D_MODEL, lane);
                }
        } else if (k == 1 && PH_ON(1)) {
            {
                pg8::Gemm g{XN, l == 0 ? WIN0 : WIN1, T, ZLD, D_MODEL};
                pg8::InprojSched S; S.base.init(T, ZLD, G, bid); S.extra = (l == 0) ? 16 : 0;
                pg8::EpiInproj E{Z, CKV};
                pg8::gemm_phase<pg8::EpiInproj, pg8::InprojSched, true, true>(tid, ldsq, g, S, E);
            }
        } else if (k == 2 && PH_ON(2)) {
            {
                float* lr = ldsf;
                float* la = ldsf + 1024;
                float* ks = ldsf + 4160;
                float* vs = ldsf + 7488;
                float* seg = ldsf + 13888;
                const float* wa2 = args.in[5] + (size_t)l * GLA_RANK * 192;
                const float* ba = args.in[6] + l * 192;
                for (int item = bid; item < BATCH * GLA_HEADS * 64; item += G) {
                    const int bh = item >> 6, c = item & 63, b = bh >> 2, h = bh & 3, tok0 = b * SEQ + c * 64;
                    __syncthreads();
                    if (tid < 128) { const int t = tid >> 1, c8 = (tid & 1) * 8; const uint4 u = *(const uint4*)(Z + (size_t)(tok0 + t) * ZLD + Z_GLR + c8);
                        *(f32x4*)&lr[t * 16 + c8] = (f32x4){__uint_as_float(u.x << 16), __uint_as_float(u.x & 0xffff0000u), __uint_as_float(u.y << 16), __uint_as_float(u.y & 0xffff0000u)};
                        *(f32x4*)&lr[t * 16 + c8 + 4] = (f32x4){__uint_as_float(u.z << 16), __uint_as_float(u.z & 0xffff0000u), __uint_as_float(u.w << 16), __uint_as_float(u.w & 0xffff0000u)}; }
                    if (tid < 384) { const int t = tid / 6, c8 = (tid % 6) * 8; const uint4 u = *(const uint4*)(Z + (size_t)(tok0 + t) * ZLD + Z_GK + h * 48 + c8);
                        *(f32x4*)&ks[t * 52 + c8] = (f32x4){__uint_as_float(u.x << 16), __uint_as_float(u.x & 0xffff0000u), __uint_as_float(u.y << 16), __uint_as_float(u.y & 0xffff0000u)};
                        *(f32x4*)&ks[t * 52 + c8 + 4] = (f32x4){__uint_as_float(u.z << 16), __uint_as_float(u.z & 0xffff0000u), __uint_as_float(u.w << 16), __uint_as_float(u.w & 0xffff0000u)}; }
                    for (int i = tid; i < 64 * 12; i += NTHREADS) { const int t = i / 12, c8 = (i % 12) * 8; const uint4 u = *(const uint4*)(Z + (size_t)(tok0 + t) * ZLD + Z_GV + h * 96 + c8);
                        *(f32x4*)&vs[t * 100 + c8] = (f32x4){__uint_as_float(u.x << 16), __uint_as_float(u.x & 0xffff0000u), __uint_as_float(u.y << 16), __uint_as_float(u.y & 0xffff0000u)};
                        *(f32x4*)&vs[t * 100 + c8 + 4] = (f32x4){__uint_as_float(u.z << 16), __uint_as_float(u.z & 0xffff0000u), __uint_as_float(u.w << 16), __uint_as_float(u.w & 0xffff0000u)}; }
                    __syncthreads();
                    for (int i = tid; i < 64 * 48; i += NTHREADS) { const int t = i / 48, d = i % 48;
                        float x = ba[h * 48 + d];
#pragma unroll
                        for (int r = 0; r < GLA_RANK; ++r) x += lr[t * 16 + r] * wa2[r * 192 + h * 48 + d];
                        la[t * 49 + d] = (fminf(x, 0.f) - log1pf(__expf(-fabsf(x)))) * (1.f / 16.f); }
                    __syncthreads();
                    const int cd = tid % 48, cs = tid / 48;
                    if (tid < 384) { float run = 0.f;
#pragma unroll
                        for (int j2 = 0; j2 < 8; ++j2) { run += la[(cs * 8 + j2) * 49 + cd]; la[(cs * 8 + j2) * 49 + cd] = run; }
                        seg[cs * 48 + cd] = run; }
                    __syncthreads();
                    if (tid < 384) { float base = 0.f;
                        for (int q = 0; q < cs; ++q) base += seg[q * 48 + cd];
#pragma unroll
                        for (int j2 = 0; j2 < 8; ++j2) { const float v = la[(cs * 8 + j2) * 49 + cd] + base; la[(cs * 8 + j2) * 49 + cd] = v; BCUM[(size_t)(tok0 + cs * 8 + j2) * 192 + h * 48 + cd] = v; } }
                    __syncthreads();
                    for (int i = tid; i < 64 * 48; i += NTHREADS) { const int t = i / 48, d = i % 48; ks[t * 52 + d] *= __expf(la[63 * 49 + d] - la[t * 49 + d]); }
                    if (tid < 48) DEC[(size_t)item * 48 + tid] = __expf(la[63 * 49 + tid]);
                    __syncthreads();
                    if (tid < 288) {
                        const int d0 = (tid / 24) * 4, v0 = (tid % 24) * 4;
                        float acc[4][4];
#pragma unroll
                        for (int x = 0; x < 4; ++x)
#pragma unroll
                            for (int y = 0; y < 4; ++y) acc[x][y] = 0.f;
#pragma unroll 4
                        for (int sidx = 0; sidx < 64; ++sidx) { const f32x4 kv = *(const f32x4*)&ks[sidx * 52 + d0], vv = *(const f32x4*)&vs[sidx * 100 + v0];
#pragma unroll
                            for (int x = 0; x < 4; ++x)
#pragma unroll
                                for (int y = 0; y < 4; ++y) acc[x][y] += kv[x] * vv[y]; }
#pragma unroll
                        for (int y = 0; y < 4; ++y) *(f32x4*)(SLOC + (size_t)item * 4608 + (v0 + y) * 48 + d0) = (f32x4){acc[0][y], acc[1][y], acc[2][y], acc[3][y]};
                    }
                }
                __syncthreads();
            }
            {
                const float* gq = args.in[8] + l * DSA_DH; const float* gk = args.in[9] + l * DSA_DH;
                for (int it = bid * NTHREADS + tid; it < T * 12; it += G * NTHREADS) {
                    const int tok = it / 12, jj = it % 12, isk = jj / 6, hd = jj % 6;
                    const uint4* src = (const uint4*)(Z + (size_t)tok * ZLD + (isk ? Z_DK : Z_DQ) + hd * 64);
                    uint4 u[8]; float ss = 0.f;
#pragma unroll
                    for (int c = 0; c < 8; ++c) { u[c] = src[c];
                        const float a0 = __uint_as_float(u[c].x << 16), a1 = __uint_as_float(u[c].x & 0xffff0000u), a2 = __uint_as_float(u[c].y << 16), a3 = __uint_as_float(u[c].y & 0xffff0000u);
                        const float a4 = __uint_as_float(u[c].z << 16), a5 = __uint_as_float(u[c].z & 0xffff0000u), a6 = __uint_as_float(u[c].w << 16), a7 = __uint_as_float(u[c].w & 0xffff0000u);
                        ss += a0 * a0 + a1 * a1 + a2 * a2 + a3 * a3 + a4 * a4 + a5 * a5 + a6 * a6 + a7 * a7; }
                    const float rn = (isk ? 1.0f : (0.125f * 1.4426950408889634f)) / sqrtf(ss * (1.f / 64.f) + NORM_EPS);
                    const float* gp = isk ? gk : gq;
                    uint4* dst = (uint4*)((isk ? KN : QN) + (size_t)tok * 384 + hd * 64);
#pragma unroll
                    for (int c = 0; c < 8; ++c) { const f32x4 g0 = *(const f32x4*)(gp + c * 8), g1 = *(const f32x4*)(gp + c * 8 + 4);
                        uint4 o;
                        o.x = pk2(__uint_as_float(u[c].x << 16) * rn * g0[0], __uint_as_float(u[c].x & 0xffff0000u) * rn * g0[1]);
                        o.y = pk2(__uint_as_float(u[c].y << 16) * rn * g0[2], __uint_as_float(u[c].y & 0xffff0000u) * rn * g0[3]);
                        o.z = pk2(__uint_as_float(u[c].z << 16) * rn * g1[0], __uint_as_float(u[c].z & 0xffff0000u) * rn * g1[1]);
                        o.w = pk2(__uint_as_float(u[c].w << 16) * rn * g1[2], __uint_as_float(u[c].w & 0xffff0000u) * rn * g1[3]);
                        dst[c] = o; }
                }
                for (int it = bid * NTHREADS + tid; it < T * 8; it += G * NTHREADS) {
                    const int tok = it >> 3, c8 = (it & 7) * 8;
                    const bf16_t* zr = Z + (size_t)tok * ZLD;
                    const uint4 wu = *(const uint4*)(zr + Z_IW);
                    const float cw[8] = {__uint_as_float(wu.x << 16), __uint_as_float(wu.x & 0xffff0000u), __uint_as_float(wu.y << 16), __uint_as_float(wu.y & 0xffff0000u),
                                         __uint_as_float(wu.z << 16), __uint_as_float(wu.z & 0xffff0000u), __uint_as_float(wu.w << 16), __uint_as_float(wu.w & 0xffff0000u)};
                    float ql[8];
#pragma unroll
                    for (int e = 0; e < 8; ++e) ql[e] = 0.f;
#pragma unroll
                    for (int hq = 0; hq < IDX_HEADS; ++hq) { const float c = cw[hq] * (0.35355339059327373f * 0.0625f); const uint4 qu = *(const uint4*)(zr + Z_IQ + hq * 64 + c8);
                        ql[0] += c * __uint_as_float(qu.x << 16); ql[1] += c * __uint_as_float(qu.x & 0xffff0000u); ql[2] += c * __uint_as_float(qu.y << 16); ql[3] += c * __uint_as_float(qu.y & 0xffff0000u);
                        ql[4] += c * __uint_as_float(qu.z << 16); ql[5] += c * __uint_as_float(qu.z & 0xffff0000u); ql[6] += c * __uint_as_float(qu.w << 16); ql[7] += c * __uint_as_float(qu.w & 0xffff0000u); }
                    uint4 o; o.x = pk2(ql[0], ql[1]); o.y = pk2(ql[2], ql[3]); o.z = pk2(ql[4], ql[5]); o.w = pk2(ql[6], ql[7]);
                    *(uint4*)(QL + (size_t)tok * 64 + c8) = o;
                    *(uint4*)(IK + (size_t)tok * 64 + c8) = *(const uint4*)(zr + Z_IK + c8);
                    if (c8 == 0) { *(f32x4*)(CH + (size_t)tok * 8) = (f32x4){cw[0], cw[1], cw[2], cw[3]} * (0.35355339059327373f * 0.0625f); *(f32x4*)(CH + (size_t)tok * 8 + 4) = (f32x4){cw[4], cw[5], cw[6], cw[7]} * (0.35355339059327373f * 0.0625f); }
                }
            }
            for (int tile = bid; tile < BATCH * 128; tile += G) {
                if (tid < 384) {
                    const bf16_t* zb = Z + (size_t)(tile * 32) * ZLD + Z_DV + tid;
                    unsigned w[16];
#pragma unroll
                    for (int p2 = 0; p2 < 16; ++p2) {
                        const int p = 2 * p2, sst = p >> 4, hh2 = (p >> 3) & 1, j = p & 7;
                        const int key0 = 16 * sst + 8 * (j >> 2) + 4 * hh2 + (j & 3);
                        w[p2] = (unsigned)zb[(size_t)key0 * ZLD] | ((unsigned)zb[(size_t)(key0 + 1) * ZLD] << 16);
                    }
                    uint4* dst = (uint4*)(VT + ((size_t)tile * 384 + tid) * 32);
                    dst[0] = make_uint4(w[0], w[1], w[2], w[3]); dst[1] = make_uint4(w[4], w[5], w[6], w[7]); dst[2] = make_uint4(w[8], w[9], w[10], w[11]); dst[3] = make_uint4(w[12], w[13], w[14], w[15]);
                }
            }
            if (l == 0) {
                for (int i = bid * NTHREADS + tid; i < DEPTH * BATCH * X_HEADS * 64 * MEM_LEN; i += G * NTHREADS) {
                    const int p = i & 255, d = (i >> 8) & 63, h = (i >> 14) & 3, bb = (i >> 16) & 3, ll = i >> 18;
                    const int pg = p & 31, sst = pg >> 4, hh2 = (pg >> 3) & 1, j2 = pg & 7;
                    const int key = (p & ~31) + 16 * sst + 8 * (j2 >> 2) + 4 * hh2 + (j2 & 3);
                    CVT[i] = CKV[((size_t)ll * BATCH * MEM_LEN + (size_t)bb * MEM_LEN + key) * 512 + 256 + h * 64 + d];
                }
                for (int r = gw; r < DEPTH * BATCH * MEM_LEN; r += NGW) {
                    const int ll = r / (BATCH * MEM_LEN);
                    const float gkl = args.in[20][ll * X_DH + lane];
#pragma unroll
                    for (int h = 0; h < X_HEADS; ++h) {
                        const float kk = bf2f(CKV[(size_t)r * 512 + h * 64 + lane]);
                        const float rk = 1.0f / sqrtf(wave_sum(kk * kk) * (1.f / 64.f) + NORM_EPS);
                        CKN[(size_t)r * 256 + h * 64 + lane] = f2bf(kk * rk * gkl);
                    }
                }
            }
            {
                const float* cw = args.in[10] + (size_t)l * CONV_W * CONV_CH;
                const float* cb = args.in[11] + l * CONV_CH; const float* lg = args.in[12] + l * CONV_CH; const float* lb = args.in[13] + l * CONV_CH;
                float* ct = ldsf + 1024;
                float* hL = ldsf + 1024 + 32 * 256;
                const int c = tid & 255, half = tid >> 8;
                float wreg[CONV_W];
#pragma unroll
                for (int j = 0; j < CONV_W; ++j) wreg[j] = cw[j * CONV_CH + c];
                const float cbias = cb[c];
                for (int item = bid; item < T / 32; item += G) {
                    const int tok0 = item * 32;
                    const int tb = tok0 % SEQ;
                    __syncthreads();
                    for (int i = tid; i < 62 * 32; i += NTHREADS) {
                        const int rr = i >> 5, c8 = (i & 31) * 8, tp = tb - 30 + rr;
                        f32x4 h0 = (f32x4){0.f, 0.f, 0.f, 0.f}, h1 = h0;
                        if (tp >= 0) {
                            const bf16_t* zr = Z + (size_t)(tok0 - 30 + rr) * ZLD + Z_CU + c8;
                            const uint4 au = *(const uint4*)zr, gu = *(const uint4*)(zr + 256);
                            h0[0] = __uint_as_float(au.x << 16) * sigmoidf(__uint_as_float(gu.x << 16)); h0[1] = __uint_as_float(au.x & 0xffff0000u) * sigmoidf(__uint_as_float(gu.x & 0xffff0000u));
                            h0[2] = __uint_as_float(au.y << 16) * sigmoidf(__uint_as_float(gu.y << 16)); h0[3] = __uint_as_float(au.y & 0xffff0000u) * sigmoidf(__uint_as_float(gu.y & 0xffff0000u));
                            h1[0] = __uint_as_float(au.z << 16) * sigmoidf(__uint_as_float(gu.z << 16)); h1[1] = __uint_as_float(au.z & 0xffff0000u) * sigmoidf(__uint_as_float(gu.z & 0xffff0000u));
                            h1[2] = __uint_as_float(au.w << 16) * sigmoidf(__uint_as_float(gu.w << 16)); h1[3] = __uint_as_float(au.w & 0xffff0000u) * sigmoidf(__uint_as_float(gu.w & 0xffff0000u));
                        }
                        *(f32x4*)&hL[rr * 256 + c8] = h0; *(f32x4*)&hL[rr * 256 + c8 + 4] = h1;
                    }
                    __syncthreads();
                    {
                        float hwin[46];
#pragma unroll
                        for (int i = 0; i < 46; ++i) hwin[i] = hL[(half * 16 + i) * 256 + c];
#pragma unroll
                        for (int o = 0; o < 16; ++o) {
                            float a = cbias;
#pragma unroll
                            for (int j = 0; j < CONV_W; ++j) a += hwin[o + j] * wreg[j];
                            ct[(half * 16 + o) * 256 + c] = a;
                        }
                    }
                    __syncthreads();
#pragma unroll
                    for (int i = 0; i < 4; ++i) {
                        const int tt = wave * 4 + i;
                        const f32x4 v = *(const f32x4*)&ct[tt * 256 + lane * 4];
                        const float mu = wave_sum(v[0] + v[1] + v[2] + v[3]) * (1.f / 256.f);
                        const f32x4 dv = v - mu;
                        const float var = wave_sum(dv[0] * dv[0] + dv[1] * dv[1] + dv[2] * dv[2] + dv[3] * dv[3]) * (1.f / 256.f);
                        const float rstd = 1.0f / sqrtf(var + NORM_EPS);
                        const f32x4 gg = *(const f32x4*)(lg + lane * 4), bb = *(const f32x4*)(lb + lane * 4);
                        f32x4 y = dv * rstd * gg + bb;
                        uint2 o; o.x = pk2(siluf(y[0]), siluf(y[1])); o.y = pk2(siluf(y[2]), siluf(y[3]));
                        *(uint2*)(MIX + (size_t)(tok0 + tt) * D_MODEL + MIX_CONV + lane * 4) = o;
                    }
                }
            }
        } else if (k == 3 && PH_ON(3)) {
            if (rep == 0)
            for (int e = bid * NTHREADS + tid; e < BATCH * GLA_HEADS * 4608; e += G * NTHREADS) {
                const int bh = e / 4608, idx = e % 4608, d = idx % 48;
                float state = 0.f;
#pragma unroll 16
                for (int c = 0; c < 64; ++c) {
                    const size_t it = (size_t)bh * 64 + c;
                    const float tmp = SLOC[it * 4608 + idx], dec = DEC[it * 48 + d];
                    SLOC[it * 4608 + idx] = state; state = dec * state + tmp; }
            }
            {
                unsigned* hist32 = (unsigned*)lds_raw;
                constexpr int HSTR = 1028;
                unsigned* rs = (unsigned*)(lds_raw + 32 * HSTR * 4);
                volatile unsigned* qsh = (volatile unsigned*)(lds_raw + LDSCTL_OFF + 64);
                unsigned* qhead = ctl + CW_Q3 + 64 * l + rep;
                const int qc = lane & 15, g4 = lane >> 4, qh = wave >> 2, kg = wave & 3;
                const int row = 16 * qh + qc;
                for (;;) {
                    __syncthreads();
                    if (tid == 0) qsh[0] = atomicAdd(qhead, 1u);
                    __syncthreads();
                    const int it = (int)qsh[0];
                    if (it >= BATCH * 128) break;
                    const int b = it & 3, qt = 127 - (it >> 2);
                    const int tokb = b * SEQ, q0 = qt * 32, tq = q0 + row;
                    bf16x8 qf[9][2];
                    {
                        const bf16_t* zq = Z + (size_t)(tokb + tq) * ZLD + Z_IQ + g4 * 8;
#pragma unroll
                        for (int h = 0; h < 8; ++h)
#pragma unroll
                            for (int ks = 0; ks < 2; ++ks) qf[h][ks] = *(const bf16x8*)(zq + h * 64 + ks * 32);
                        const bf16_t* ql = QL + (size_t)(tokb + tq) * 64 + g4 * 8;
#pragma unroll
                        for (int ks = 0; ks < 2; ++ks) qf[8][ks] = *(const bf16x8*)(ql + ks * 32);
                    }
                    float ch[8];
                    { const f32x4 c0 = *(const f32x4*)(CH + (size_t)(tokb + tq) * 8), c1 = *(const f32x4*)(CH + (size_t)(tokb + tq) * 8 + 4);
                      ch[0] = c0[0]; ch[1] = c0[1]; ch[2] = c0[2]; ch[3] = c0[3]; ch[4] = c1[0]; ch[5] = c1[1]; ch[6] = c1[2]; ch[7] = c1[3]; }
                    if (qt < 8) {
                        if (rep == 0 && kg == 0 && g4 == 0) for (int kt = 0; kt <= qt; ++kt) MASK[((size_t)(b * 128) + kt) * SEQ + tq] = (kt < qt || row == 31) ? 0xffffffffu : ((1u << (row + 1)) - 1u);
                        continue;
                    }
#pragma unroll
                    for (int i = 0; i < 16; ++i) ((uint4*)hist32)[tid + 512 * i] = make_uint4(0u, 0u, 0u, 0u);
                    if (tid < 32) ((uint4*)hist32)[8192 + tid] = make_uint4(0u, 0u, 0u, 0u);
                    if (tid < 32) { rs[tid] = 0u; rs[32 + tid] = TOPK; rs[64 + tid] = 0u; rs[96 + tid] = 0u; }
                    __syncthreads();
#define DSA_SCORE(kt_) \
                        f32x4 sc[2]; \
                        { const bf16_t* kp = IK + (size_t)(tokb + (kt_) * 32 + qc) * 64 + g4 * 8; \
                          bf16x8 kf[2][2]; \
                          _Pragma("unroll") for (int u = 0; u < 2; ++u) _Pragma("unroll") for (int ks = 0; ks < 2; ++ks) kf[u][ks] = *(const bf16x8*)(kp + u * 16 * 64 + ks * 32); \
                          _Pragma("unroll") for (int u = 0; u < 2; ++u) { sc[u] = (f32x4){0.f, 0.f, 0.f, 0.f}; \
                              _Pragma("unroll") for (int ks = 0; ks < 2; ++ks) sc[u] = __builtin_amdgcn_mfma_f32_16x16x32_bf16(kf[u][ks], qf[8][ks], sc[u], 0, 0, 0); } \
                          _Pragma("unroll") for (int h = 0; h < 8; ++h) _Pragma("unroll") for (int u = 0; u < 2; ++u) { f32x4 a = (f32x4){0.f, 0.f, 0.f, 0.f}; \
                              _Pragma("unroll") for (int ks = 0; ks < 2; ++ks) a = __builtin_amdgcn_mfma_f32_16x16x32_bf16(kf[u][ks], qf[h][ks], a, 0, 0, 0); \
                              _Pragma("unroll") for (int i = 0; i < 4; ++i) sc[u][i] = __builtin_fmaf(fabsf(a[i]), ch[h], sc[u][i]); } }
                    for (int pass = 0; pass < 2; ++pass) {
                        const unsigned mmask = (pass == 0) ? 0u : 0xFFE00000u;
                        const int bshift = (pass == 0) ? 21 : 10;
                        const unsigned bmask = 2047u;
                        const unsigned prefm = rs[row];
                        for (int kt = kg; kt <= qt; kt += 4) {
                            DSA_SCORE(kt)
#pragma unroll
                            for (int u = 0; u < 2; ++u)
#pragma unroll
                                for (int i = 0; i < 4; ++i) {
                                    const int sidx = kt * 32 + 16 * u + 4 * g4 + i;
                                    const unsigned key = fkey(sc[u][i]);
                                    if (sidx <= tq && (key & mmask) == prefm) { const unsigned bin = (key >> bshift) & bmask; if (rep < 2) atomicAdd(&hist32[row * HSTR + (bin >> 1)], 1u << ((bin & 1u) * 16u)); else asm volatile("" :: "v"(bin)); }
                                }
                        }
                        __syncthreads();
                        for (int rr = 0; rr < 4; ++rr) {
                            const int R = wave * 4 + rr;
                            const unsigned kremR = rs[32 + R];
                            const uint4* hw = (const uint4*)(hist32 + R * HSTR + lane * 16);
                            unsigned cntl = 0u;
#pragma unroll
                            for (int q4 = 0; q4 < 4; ++q4) { const uint4 w = hw[q4]; cntl += (w.x & 0xffffu) + (w.x >> 16) + (w.y & 0xffffu) + (w.y >> 16) + (w.z & 0xffffu) + (w.z >> 16) + (w.w & 0xffffu) + (w.w >> 16); }
                            unsigned suf = cntl;
#pragma unroll
                            for (int o = 1; o < 64; o <<= 1) { const unsigned tv = __shfl_down(suf, o); if (lane + o < 64) suf += tv; }
                            const unsigned excl = suf - cntl;
                            if (excl < kremR && kremR <= suf) {
                                unsigned above = excl, eq = 0u; int bin = 0;
#pragma unroll 1
                                for (int i = 15; i >= 0; --i) { const unsigned w = hist32[R * HSTR + lane * 16 + i]; const unsigned hi = w >> 16, lo = w & 0xffffu;
                                    if (above + hi >= kremR) { bin = 2 * (lane * 16 + i) + 1; eq = hi; break; } above += hi;
                                    if (above + lo >= kremR) { bin = 2 * (lane * 16 + i); eq = lo; break; } above += lo; }
                                rs[R] = rs[R] | ((unsigned)bin << bshift); rs[32 + R] = kremR - above; rs[64 + R] = eq;
                            }
                        }
                        __syncthreads();
#pragma unroll
                        for (int i = 0; i < 16; ++i) ((uint4*)hist32)[tid + 512 * i] = make_uint4(0u, 0u, 0u, 0u);
                        if (tid < 32) ((uint4*)hist32)[8192 + tid] = make_uint4(0u, 0u, 0u, 0u);
                        __syncthreads();
                    }
                    {
                        const unsigned tau = rs[row]; const bool tiecrit = rs[64 + row] > rs[32 + row];
                        unsigned* mcol = MASK + (size_t)(b * 128) * SEQ + tq;
                        for (int kt = kg; kt <= qt; kt += 4) {
                            DSA_SCORE(kt)
                            unsigned bits = 0u;
#pragma unroll
                            for (int u = 0; u < 2; ++u)
#pragma unroll
                                for (int i = 0; i < 4; ++i) {
                                    const int sidx = kt * 32 + 16 * u + 4 * g4 + i;
                                    const unsigned key = fkey(sc[u][i]), key22 = key & 0xFFFFFC00u;
                                    const bool valid = sidx <= tq;
                                    if (valid && (key22 > tau || (key22 == tau && !tiecrit))) bits |= 1u << (16 * u + 4 * g4 + i);
                                    if (valid && key22 == tau && tiecrit) { const unsigned idx = atomicAdd(&rs[96 + row], 1u); if (idx < 511u) { hist32[row * HSTR + 2 * idx] = key; hist32[row * HSTR + 2 * idx + 1] = (unsigned)sidx; } }
                                }
                            bits |= (unsigned)__shfl_xor((int)bits, 16);
                            bits |= (unsigned)__shfl_xor((int)bits, 32);
                            if (g4 == 0 && rep == 0) mcol[(size_t)kt * SEQ] = bits;
                        }
                        asm volatile("s_waitcnt vmcnt(0)" ::: "memory");
                        __syncthreads();
                        if (rep == 0 && tid < 32 && rs[64 + tid] > rs[32 + tid]) {
                            int tdx = tid; asm volatile("" : "+v"(tdx));
                            unsigned nl = rs[96 + tid]; if (nl > 511u) nl = 511u;
                            const unsigned need = rs[32 + tid];
                            unsigned* lst = hist32 + tdx * HSTR;
                            for (unsigned q = 0; q < need && q < nl; ++q) {
                                unsigned bk = 0u, bs = 0xffffffffu, bi = 0u;
                                for (unsigned e2 = 0; e2 < nl; ++e2) { const unsigned kv = lst[2 * e2], sv = lst[2 * e2 + 1]; if (sv != 0xffffffffu && (kv > bk || (kv == bk && sv < bs))) { bk = kv; bs = sv; bi = e2; } }
                                lst[2 * bi + 1] = 0xffffffffu;
                                if (bs != 0xffffffffu) atomicOr(MASK + ((size_t)(b * 128) + (bs >> 5)) * SEQ + q0 + tdx, 1u << (bs & 31u));
                            }
                        }
                    }
#undef DSA_SCORE
                }
            }
        } else if (k == 4 && PH_ON(4)) {
            float* qt = ldsf;
            float* kt = qt + 64 * 49;
            float* vs = kt + 64 * 49;
            float* Am = vs + 64 * 97;
            float* Sin = Am + 64 * 65;
            const float* gon = args.in[7] + l * GLA_DV;
            volatile unsigned* qsh = (volatile unsigned*)(lds_raw + LDSCTL_OFF + 64);
            unsigned* qhead = ctl + CW_Q4 + 64 * l + rep;
            float* biasd = (float*)(lds_raw + 131072);
            for (int i = tid; i < 6 * 224; i += NTHREADS) { const int h = i / 224, d = i % 224 - 32; biasd[i] = d < 0 ? 0.f : args.in[2][t5_bucket(d) * DSA_HEADS + h] * 1.4426950408889634f; }
            constexpr int N_ATT = BATCH * 32 * 3;
            for (;;) {
                __syncthreads();
                if (tid == 0) qsh[0] = atomicAdd(qhead, 1u);
                __syncthreads();
                const int qit = (int)qsh[0];
#ifndef MK_GLA2_REP
#define MK_GLA2_REP 1
#endif
                if (qit >= N_ATT + MK_GLA2_REP * BATCH * GLA_HEADS * 64) break;
                if (qit < N_ATT) {
                    const int qt = 31 - qit / 12, rem = qit % 12, b = rem & 3, h0 = 2 * (rem >> 2);
                    const int tokb = b * SEQ, q0 = qt * 128, nkt = 4 * (qt + 1);
                    int tid_a = tid; asm volatile("" : "+v"(tid_a));
                    const int la = tid_a & 63, r = la & 31, hh = la >> 5;
                    const int qg = wave & 3, hd = wave >> 2, h = h0 + hd;
                    const int tq = q0 + 32 * qg + r;
                    LDSAS unsigned char* lb = (LDSAS unsigned char*)lds_raw;
                    LDSAS unsigned* maskl = (LDSAS unsigned*)(lb + 65536);
                    for (int idx = tid_a; idx < nkt * 128; idx += NTHREADS) maskl[idx] = MASK[((size_t)(b * 128) + (idx >> 7)) * SEQ + q0 + (idx & 127)];
                    bf16x8 qf[4];
#pragma unroll
                    for (int ks = 0; ks < 4; ++ks) qf[ks] = *(const bf16x8*)(QN + (size_t)(tokb + tq) * 384 + h * 64 + ks * 16 + hh * 8);
                    f32x16 oacc[2];
#pragma unroll
                    for (int dt = 0; dt < 2; ++dt)
#pragma unroll
                        for (int i = 0; i < 16; ++i) oacc[dt][i] = 0.f;
                    float lsum = 0.f;
                    const int krow = 4 * wave + (la >> 4), kpos = la & 15;
                    const int vrow = 16 * wave + (la >> 2), vpos = la & 3;
                    const char* ksrc = (const char*)KN + ((size_t)(tokb + krow) * 384 + h0 * 64) * 2 + ((kpos ^ (krow & 15)) * 16);
                    const char* vsrc = (const char*)VT + ((size_t)(b * 128) * 384 + h0 * 64 + vrow) * 64 + ((vpos ^ ((vrow >> 2) & 3)) * 16);
                    int koff[4], voff[2][2];
#pragma unroll
                    for (int ks = 0; ks < 4; ++ks) koff[ks] = r * 256 + (((hd * 8 + ks * 2 + hh) ^ (r & 15)) * 16);
#pragma unroll
                    for (int dt = 0; dt < 2; ++dt)
#pragma unroll
                        for (int sst = 0; sst < 2; ++sst) { const int vr = hd * 64 + dt * 32 + r; voff[dt][sst] = 8192 + vr * 64 + (((2 * sst + hh) ^ ((vr >> 2) & 3)) * 16); }
#define ATT_ISSUE(kt_, st_) do { const int ktc = (kt_) < nkt ? (kt_) : nkt - 1; \
                        __builtin_amdgcn_global_load_lds((const unsigned*)(ksrc + (size_t)ktc * (32 * 768)), (LDSAS unsigned*)(lb + (st_) * 16384 + wave * 1024), 16, 0, 0); \
                        __builtin_amdgcn_global_load_lds((const unsigned*)(vsrc + (size_t)ktc * (384 * 64)), (LDSAS unsigned*)(lb + (st_) * 16384 + 8192 + wave * 1024), 16, 0, 0); } while (0)
                    __syncthreads();
                    ATT_ISSUE(0, 0); ATT_ISSUE(1, 1); ATT_ISSUE(2, 2);
                    for (int kt = 0; kt < nkt; ++kt) {
                        asm volatile("s_waitcnt vmcnt(4)" ::: "memory");
                        __builtin_amdgcn_s_barrier();
                        asm volatile("" ::: "memory");
                        ATT_ISSUE(kt + 3, (kt + 3) & 3);
                        if (kt * 32 <= q0 + 32 * qg + 31) {
                            LDSAS unsigned char* st = lb + (kt & 3) * 16384;
                            const unsigned mwh = maskl[kt * 128 + 32 * qg + r] >> (4 * hh);
                            const int mind = (q0 + 32 * qg) - (kt * 32 + 31);
                            f32x16 S;
#pragma unroll
                            for (int i = 0; i < 16; ++i) S[i] = 0.f;
#pragma unroll
                            for (int ks = 0; ks < 4; ++ks) { const bf16x8 a = *(const LDSAS bf16x8*)(st + koff[ks]); S = MFMA32(a, qf[ks], S); }
                            float p[16];
                            if (mind >= 113) {
                                const float bu = biasd[h * 224 + 223];
#pragma unroll
                                for (int i = 0; i < 16; ++i) p[i] = __uint_as_float(__float_as_uint(__builtin_amdgcn_exp2f(S[i] + bu)) & (unsigned)__builtin_amdgcn_sbfe((int)mwh, (i & 3) + 8 * (i >> 2), 1));
                            } else {
                                const float* bp = biasd + h * 224 + (tq - kt * 32 - 4 * hh + 5);
#pragma unroll
                                for (int i = 0; i < 16; ++i) p[i] = __uint_as_float(__float_as_uint(__builtin_amdgcn_exp2f(S[i] + bp[27 - (i & 3) - 8 * (i >> 2)])) & (unsigned)__builtin_amdgcn_sbfe((int)mwh, (i & 3) + 8 * (i >> 2), 1));
                            }
                            float ps = 0.f;
#pragma unroll
                            for (int i = 0; i < 16; ++i) ps += p[i];
                            lsum += ps;
                            uint4 u0, u1;
                            u0.x = pkbf(p[0], p[1]); u0.y = pkbf(p[2], p[3]); u0.z = pkbf(p[4], p[5]); u0.w = pkbf(p[6], p[7]);
                            u1.x = pkbf(p[8], p[9]); u1.y = pkbf(p[10], p[11]); u1.z = pkbf(p[12], p[13]); u1.w = pkbf(p[14], p[15]);
                            const bf16x8 pf0 = __builtin_bit_cast(bf16x8, u0), pf1 = __builtin_bit_cast(bf16x8, u1);
#pragma unroll
                            for (int dt = 0; dt < 2; ++dt) {
                                const bf16x8 a0 = *(const LDSAS bf16x8*)(st + voff[dt][0]);
                                const bf16x8 a1 = *(const LDSAS bf16x8*)(st + voff[dt][1]);
                                oacc[dt] = MFMA32(a0, pf0, oacc[dt]);
                                oacc[dt] = MFMA32(a1, pf1, oacc[dt]);
                            }
                        }
                    }
#undef ATT_ISSUE
                    asm volatile("s_waitcnt vmcnt(0)" ::: "memory");
                    {
                        const float lt = lsum + __shfl_xor(lsum, 32);
                        float inv = 1.f / lt;
                        bf16_t* mo = MIX + (size_t)(tokb + tq) * D_MODEL + MIX_DSA + h * 64;
#pragma unroll
                        for (int dt = 0; dt < 2; ++dt)
#pragma unroll
                            for (int g4 = 0; g4 < 4; ++g4) {
                                uint2 o; o.x = pkbf(oacc[dt][4 * g4] * inv, oacc[dt][4 * g4 + 1] * inv); o.y = pkbf(oacc[dt][4 * g4 + 2] * inv, oacc[dt][4 * g4 + 3] * inv);
                                *(uint2*)(mo + dt * 32 + 8 * g4 + 4 * hh) = o;
                            }
                    }
                    continue;
                }
                const int item = (qit - N_ATT) % (BATCH * GLA_HEADS * 64);
                const int bh = item >> 6, c = item & 63, b = bh >> 2, h = bh & 3, tok0 = b * SEQ + c * 64;
                int tid_g = tid; asm volatile("" : "+v"(tid_g));
                __syncthreads();
                {
                    LDSAS unsigned char* lb = (LDSAS unsigned char*)lds_raw;
                    constexpr int QS_OFF = 0, KS_OFF = 7168, VT_OFF = 14336, ST_OFF = 28160, SQ_OFF = 38912;
                    if (tid_g < 384) {
                        const int t = tid_g / 6, c8 = (tid_g % 6) * 8;
                        const bf16_t* zr = Z + (size_t)(tok0 + t) * ZLD;
                        const uint4 qu = *(const uint4*)(zr + Z_GQ + h * 48 + c8), ku = *(const uint4*)(zr + Z_GK + h * 48 + c8);
                        const f32x4 b0 = *(const f32x4*)(BCUM + (size_t)(tok0 + t) * 192 + h * 48 + c8), b1 = *(const f32x4*)(BCUM + (size_t)(tok0 + t) * 192 + h * 48 + c8 + 4);
                        const float e0 = __expf(b0[0]), e1 = __expf(b0[1]), e2 = __expf(b0[2]), e3 = __expf(b0[3]), e4 = __expf(b1[0]), e5 = __expf(b1[1]), e6 = __expf(b1[2]), e7 = __expf(b1[3]);
                        const float qs = 0.14433756729740643f;
                        u32x4v qo, ko;
                        qo.x = pkbf(__uint_as_float(qu.x << 16) * qs * e0, __uint_as_float(qu.x & 0xffff0000u) * qs * e1); qo.y = pkbf(__uint_as_float(qu.y << 16) * qs * e2, __uint_as_float(qu.y & 0xffff0000u) * qs * e3);
                        qo.z = pkbf(__uint_as_float(qu.z << 16) * qs * e4, __uint_as_float(qu.z & 0xffff0000u) * qs * e5); qo.w = pkbf(__uint_as_float(qu.w << 16) * qs * e6, __uint_as_float(qu.w & 0xffff0000u) * qs * e7);
                        ko.x = pkbf(__uint_as_float(ku.x << 16) / e0, __uint_as_float(ku.x & 0xffff0000u) / e1); ko.y = pkbf(__uint_as_float(ku.y << 16) / e2, __uint_as_float(ku.y & 0xffff0000u) / e3);
                        ko.z = pkbf(__uint_as_float(ku.z << 16) / e4, __uint_as_float(ku.z & 0xffff0000u) / e5); ko.w = pkbf(__uint_as_float(ku.w << 16) / e6, __uint_as_float(ku.w & 0xffff0000u) / e7);
                        *(LDSAS u32x4v*)(lb + QS_OFF + t * 112 + c8 * 2) = qo; *(LDSAS u32x4v*)(lb + KS_OFF + t * 112 + c8 * 2) = ko;
                    }
                    for (int i = tid_g; i < 64 * 12; i += NTHREADS) {
                        const int sidx = i / 12, c8 = (i % 12) * 8;
                        const uint4 vu = *(const uint4*)(Z + (size_t)(tok0 + sidx) * ZLD + Z_GV + h * 96 + c8);
                        const int sl = sidx & 31, pp = (sidx & 32) + (sl & 16) + 8 * ((sl >> 2) & 1) + 4 * ((sl >> 3) & 1) + (sl & 3);
                        LDSAS bf16_t* vp = (LDSAS bf16_t*)(lb + VT_OFF) + c8 * 72 + pp;
                        vp[0] = (bf16_t)(vu.x & 0xffffu); vp[72] = (bf16_t)(vu.x >> 16); vp[144] = (bf16_t)(vu.y & 0xffffu); vp[216] = (bf16_t)(vu.y >> 16);
                        vp[288] = (bf16_t)(vu.z & 0xffffu); vp[360] = (bf16_t)(vu.z >> 16); vp[432] = (bf16_t)(vu.w & 0xffffu); vp[504] = (bf16_t)(vu.w >> 16);
                    }
                    for (int i = tid_g; i < 96 * 6; i += NTHREADS) {
                        const int v = i / 6, c8 = (i % 6) * 8;
                        const f32x4 s0 = *(const f32x4*)(SLOC + (size_t)item * 4608 + v * 48 + c8), s1 = *(const f32x4*)(SLOC + (size_t)item * 4608 + v * 48 + c8 + 4);
                        u32x4v so; so.x = pkbf(s0[0], s0[1]); so.y = pkbf(s0[2], s0[3]); so.z = pkbf(s1[0], s1[1]); so.w = pkbf(s1[2], s1[3]);
                        *(LDSAS u32x4v*)(lb + ST_OFF + v * 112 + c8 * 2) = so;
                    }
                    __syncthreads();
                    const int la = tid_g & 63, r = la & 31, hh = la >> 5;
                    const int wv = (wave < 6) ? wave : 0, vt = wv % 3, tt = wv / 3;
                    f32x16 oT;
#pragma unroll
                    for (int i = 0; i < 16; ++i) oT[i] = 0.f;
                    bf16x8 qB[3];
#pragma unroll
                    for (int ks = 0; ks < 3; ++ks) qB[ks] = *(const LDSAS bf16x8*)(lb + QS_OFF + (32 * tt + r) * 112 + (16 * ks + 8 * hh) * 2);
#pragma unroll
                    for (int st = 0; st < 2; ++st) {
                        if (st <= tt) {
                            f32x16 X;
#pragma unroll
                            for (int i = 0; i < 16; ++i) X[i] = 0.f;
#pragma unroll
                            for (int ks = 0; ks < 3; ++ks) { const bf16x8 kA = *(const LDSAS bf16x8*)(lb + KS_OFF + (32 * st + r) * 112 + (16 * ks + 8 * hh) * 2); X = MFMA32(kA, qB[ks], X); }
                            if (st == tt) {
#pragma unroll
                                for (int i = 0; i < 16; ++i) X[i] = (crow(i, hh) <= r) ? X[i] : 0.f;
                            }
                            u32x4v u0, u1;
                            u0.x = pkbf(X[0], X[1]); u0.y = pkbf(X[2], X[3]); u0.z = pkbf(X[4], X[5]); u0.w = pkbf(X[6], X[7]);
                            u1.x = pkbf(X[8], X[9]); u1.y = pkbf(X[10], X[11]); u1.z = pkbf(X[12], X[13]); u1.w = pkbf(X[14], X[15]);
                            const bf16x8 x0 = __builtin_bit_cast(bf16x8, u0), x1 = __builtin_bit_cast(bf16x8, u1);
                            const bf16x8 v0 = *(const LDSAS bf16x8*)(lb + VT_OFF + (32 * vt + r) * 144 + (32 * st + 8 * hh) * 2);
                            const bf16x8 v1 = *(const LDSAS bf16x8*)(lb + VT_OFF + (32 * vt + r) * 144 + (32 * st + 16 + 8 * hh) * 2);
                            oT = MFMA32(v0, x0, oT); oT = MFMA32(v1, x1, oT);
                        }
                    }
#pragma unroll
                    for (int ks = 0; ks < 3; ++ks) { const bf16x8 sA = *(const LDSAS bf16x8*)(lb + ST_OFF + (32 * vt + r) * 112 + (16 * ks + 8 * hh) * 2); oT = MFMA32(sA, qB[ks], oT); }
                    float ssp = 0.f;
#pragma unroll
                    for (int i = 0; i < 16; ++i) ssp += oT[i] * oT[i];
                    ssp += __shfl_xor(ssp, 32);
                    LDSAS float* sq = (LDSAS float*)(lb + SQ_OFF);
                    if (wave < 6 && hh == 0) sq[(32 * tt + r) * 3 + vt] = ssp;
                    __syncthreads();
                    if (wave < 6) {
                        const int t = 32 * tt + r;
                        const float rinv = 1.0f / sqrtf((sq[t * 3] + sq[t * 3 + 1] + sq[t * 3 + 2]) * (1.f / 96.f) + NORM_EPS);
#pragma unroll
                        for (int g4 = 0; g4 < 4; ++g4) {
                            const int v0i = 32 * vt + 8 * g4 + 4 * hh;
                            const f32x4 gg = *(const f32x4*)(gon + v0i);
                            const uint2 ru = *(const uint2*)(Z + (size_t)(tok0 + t) * ZLD + Z_GR + h * 96 + v0i);
                            uint2 w; w.x = pkbf(oT[4 * g4] * rinv * gg[0] * siluf(__uint_as_float(ru.x << 16)), oT[4 * g4 + 1] * rinv * gg[1] * siluf(__uint_as_float(ru.x & 0xffff0000u)));
                            w.y = pkbf(oT[4 * g4 + 2] * rinv * gg[2] * siluf(__uint_as_float(ru.y << 16)), oT[4 * g4 + 3] * rinv * gg[3] * siluf(__uint_as_float(ru.y & 0xffff0000u)));
                            *(uint2*)(MIX + (size_t)(tok0 + t) * D_MODEL + MIX_GLA + h * 96 + v0i) = w;
                        }
                    }
                }
            }
        } else if (k == 5 && PH_ON(5)) {
            pg8::Gemm g{MIX, WOUT + (size_t)l * D_MODEL * D_MODEL, T, D_MODEL, D_MODEL}; pg8::StaticOrder S; S.init(T, D_MODEL, G, bid);
            pg8::EpiRes E{xin, OUT, D_MODEL};
            pg8::gemm_phase<pg8::EpiRes, pg8::StaticOrder, true, true>(tid, ldsq, g, S, E);
        } else if (k == 6 && PH_ON(6)) {
            const float* g = args.in[15] + l * D_MODEL;
            for (int r = gw; r < T; r += NGW) rmsnorm_row_bf16(OUT + (size_t)r * D_MODEL, g, XN + (size_t)r * D_MODEL, lane);
            {
                float* scr = ldsf + wave * (64 * 33);
                for (int it = MOEW_P7 + gw; it < N_EXPERTS * MOEW_IE; it += NGW) {
                    const int e = it / MOEW_IE; int r = it % MOEW_IE;
                    const size_t we = (size_t)l * N_EXPERTS + e;
                    if (r < MOEW_IG) { transpose_item(args.in[27] + we * D_MODEL * D_EXPERT, D_MODEL, D_EXPERT, 16, WGU + (size_t)e * 1024 * D_MODEL, 0, 2, 0, scr, r, lane); continue; } r -= MOEW_IG;
                    if (r < MOEW_IG) { transpose_item(args.in[28] + we * D_MODEL * D_EXPERT, D_MODEL, D_EXPERT, 16, WGU + (size_t)e * 1024 * D_MODEL, 0, 2, 1, scr, r, lane); continue; } r -= MOEW_IG;
                    transpose_item(args.in[29] + we * D_EXPERT * D_MODEL, D_EXPERT, D_MODEL, 32, WDN + (size_t)e * D_MODEL * D_EXPERT, 0, 1, 0, scr, r, lane);
                }
            }
        } else if (k == 7 && PH_ON(7)) {
            pg8::Gemm g{XN, WCQ + (size_t)l * XW * D_MODEL, T, XW, D_MODEL}; pg8::StaticOrder S; S.init(T, XW, G, bid);
            pg8::EpiStoreBf16 E{CQ, XW, 0xffff};
            pg8::gemm_phase<pg8::EpiStoreBf16, pg8::StaticOrder, true, true>(tid, ldsq, g, S, E);
            if (bid >= T / 256) {
                float* scr = ldsf + wave * (64 * 33);
                const int nidle = (G - T / 256) * NWAVES;
                for (int it = (bid - T / 256) * NWAVES + wave; it < MOEW_P7; it += nidle) {
                    const int e = it / MOEW_IE; int r = it % MOEW_IE;
                    const size_t we = (size_t)l * N_EXPERTS + e;
                    if (r < MOEW_IG) { transpose_item(args.in[27] + we * D_MODEL * D_EXPERT, D_MODEL, D_EXPERT, 16, WGU + (size_t)e * 1024 * D_MODEL, 0, 2, 0, scr, r, lane); continue; } r -= MOEW_IG;
                    if (r < MOEW_IG) { transpose_item(args.in[28] + we * D_MODEL * D_EXPERT, D_MODEL, D_EXPERT, 16, WGU + (size_t)e * 1024 * D_MODEL, 0, 2, 1, scr, r, lane); continue; } r -= MOEW_IG;
                    transpose_item(args.in[29] + we * D_EXPERT * D_MODEL, D_EXPERT, D_MODEL, 32, WDN + (size_t)e * D_MODEL * D_EXPERT, 0, 1, 0, scr, r, lane);
                }
            }
        } else if (k == 8 && PH_ON(8)) {
            {
                const float* gq = args.in[19] + l * X_DH;
                const int r = lane & 31, hh = lane >> 5;
                for (int item = gw; item < BATCH * X_HEADS * (SEQ / 32); item += NGW) {
                    const int tt = item & 127, h = (item >> 7) & 3, b = item >> 9;
                    const int tok = b * SEQ + tt * 32 + r;
                    bf16x8 qf[4];
                    {
                        float qv[4][8]; float ss = 0.f;
#pragma unroll
                        for (int ks = 0; ks < 4; ++ks) { const uint4 u = *(const uint4*)(CQ + (size_t)tok * XW + h * 64 + ks * 16 + hh * 8);
                            qv[ks][0] = __uint_as_float(u.x << 16); qv[ks][1] = __uint_as_float(u.x & 0xffff0000u); qv[ks][2] = __uint_as_float(u.y << 16); qv[ks][3] = __uint_as_float(u.y & 0xffff0000u);
                            qv[ks][4] = __uint_as_float(u.z << 16); qv[ks][5] = __uint_as_float(u.z & 0xffff0000u); qv[ks][6] = __uint_as_float(u.w << 16); qv[ks][7] = __uint_as_float(u.w & 0xffff0000u);
#pragma unroll
                            for (int e = 0; e < 8; ++e) ss += qv[ks][e] * qv[ks][e]; }
                        ss += __shfl_xor(ss, 32);
                        const float rq = (0.125f * 1.4426950408889634f) / sqrtf(ss * (1.f / 64.f) + NORM_EPS);
#pragma unroll
                        for (int ks = 0; ks < 4; ++ks) { const f32x4 g0 = *(const f32x4*)(gq + ks * 16 + hh * 8), g1 = *(const f32x4*)(gq + ks * 16 + hh * 8 + 4);
                            uint4 u; u.x = pkbf(qv[ks][0] * rq * g0[0], qv[ks][1] * rq * g0[1]); u.y = pkbf(qv[ks][2] * rq * g0[2], qv[ks][3] * rq * g0[3]);
                            u.z = pkbf(qv[ks][4] * rq * g1[0], qv[ks][5] * rq * g1[1]); u.w = pkbf(qv[ks][6] * rq * g1[2], qv[ks][7] * rq * g1[3]);
                            qf[ks] = __builtin_bit_cast(bf16x8, u); }
                    }
                    f32x16 oacc[2];
#pragma unroll
                    for (int dt = 0; dt < 2; ++dt)
#pragma unroll
                        for (int e = 0; e < 16; ++e) oacc[dt][e] = 0.f;
                    float lsm = 0.f;
                    const bf16_t* kb = CKN + ((size_t)l * BATCH * MEM_LEN + (size_t)b * MEM_LEN + r) * 256 + h * 64 + hh * 8;
                    const bf16_t* vb = CVT + ((size_t)((l * BATCH + b) * X_HEADS + h) * 64 + r) * 256 + hh * 8;
#pragma unroll 2
                    for (int kt = 0; kt < 8; ++kt) {
                        f32x16 S;
#pragma unroll
                        for (int e = 0; e < 16; ++e) S[e] = 0.f;
#pragma unroll
                        for (int ks = 0; ks < 4; ++ks) { const bf16x8 a = *(const bf16x8*)(kb + (size_t)kt * 32 * 256 + ks * 16); S = MFMA32(a, qf[ks], S); }
                        float p[16]; float ps = 0.f;
#pragma unroll
                        for (int e = 0; e < 16; ++e) { p[e] = __builtin_amdgcn_exp2f(S[e]); ps += p[e]; }
                        lsm += ps;
                        uint4 u0, u1;
                        u0.x = pkbf(p[0], p[1]); u0.y = pkbf(p[2], p[3]); u0.z = pkbf(p[4], p[5]); u0.w = pkbf(p[6], p[7]);
                        u1.x = pkbf(p[8], p[9]); u1.y = pkbf(p[10], p[11]); u1.z = pkbf(p[12], p[13]); u1.w = pkbf(p[14], p[15]);
                        const bf16x8 pf0 = __builtin_bit_cast(bf16x8, u0), pf1 = __builtin_bit_cast(bf16x8, u1);
#pragma unroll
                        for (int dt = 0; dt < 2; ++dt) {
                            const bf16x8 a0 = *(const bf16x8*)(vb + (size_t)dt * 32 * 256 + kt * 32);
                            const bf16x8 a1 = *(const bf16x8*)(vb + (size_t)dt * 32 * 256 + kt * 32 + 16);
                            oacc[dt] = MFMA32(a0, pf0, oacc[dt]);
                            oacc[dt] = MFMA32(a1, pf1, oacc[dt]);
                        }
                    }
                    const float inv = 1.f / (lsm + __shfl_xor(lsm, 32));
                    bf16_t* op = COIN + (size_t)tok * XW + h * 64;
#pragma unroll
                    for (int dt = 0; dt < 2; ++dt)
#pragma unroll
                        for (int g4 = 0; g4 < 4; ++g4) {
                            uint2 o; o.x = pkbf(oacc[dt][4 * g4] * inv, oacc[dt][4 * g4 + 1] * inv); o.y = pkbf(oacc[dt][4 * g4 + 2] * inv, oacc[dt][4 * g4 + 3] * inv);
                            *(uint2*)(op + dt * 32 + 8 * g4 + 4 * hh) = o;
                        }
                }
            }
        } else if (k == 9 && PH_ON(9)) {
            pg8::Gemm g{COIN, WCO + (size_t)l * D_MODEL * XW, T, D_MODEL, XW}; pg8::StaticOrder S; S.init(T, D_MODEL, G, bid);
            pg8::EpiRes E{OUT, OUT, D_MODEL};
            pg8::gemm_phase<pg8::EpiRes, pg8::StaticOrder, true, true>(tid, ldsq, g, S, E);
        } else if (k == 10 && PH_ON(10)) {
            const float* g = args.in[22] + l * D_MODEL;
            const float* brg = args.in[24] + l * N_GROUPS; const float* bre = args.in[26] + l * N_EXPERTS;
            unsigned* lcnt = (unsigned*)lds_raw;
            unsigned* lbase = lcnt + 16;
            unsigned* ler = lcnt + 32;
            float* rinvs = (float*)lds_raw + 192;
            float* lg = (float*)lds_raw + 256;
            float* red = (float*)lds_raw + 2048;
            const bf16_t* wrt_hi = WRT + (size_t)l * 2 * 32 * D_MODEL; const bf16_t* wrt_lo = wrt_hi + 32 * D_MODEL;
            for (int chunk = bid; chunk < T / 64; chunk += G) {
                __syncthreads();
                if (tid < 16) lcnt[tid] = 0u;
#ifndef MK_RT_A
#define MK_RT_A 1
#endif
#ifndef MK_RT_B
#define MK_RT_B 1
#endif
                for (int rta = 0; rta < MK_RT_A; ++rta)
#pragma unroll 2
                for (int ti = 0; ti < 8; ++ti) {
                    const int r = chunk * 64 + wave * 8 + ti;
                    const float* xrow = OUT + (size_t)r * D_MODEL;
                    f32x4 v[4]; float ss = 0.f;
#pragma unroll
                    for (int jj = 0; jj < 4; ++jj) { v[jj] = *(const f32x4*)(xrow + lane * 4 + 256 * jj); ss += v[jj][0] * v[jj][0] + v[jj][1] * v[jj][1] + v[jj][2] * v[jj][2] + v[jj][3] * v[jj][3]; }
                    const float rinv = 1.0f / sqrtf(wave_sum(ss) * (1.f / 1024.f) + NORM_EPS);
                    if (lane == 0) rinvs[wave * 8 + ti] = rinv;
#pragma unroll
                    for (int jj = 0; jj < 4; ++jj) { const f32x4 gg = *(const f32x4*)(g + lane * 4 + 256 * jj);
                        uint2 o; o.x = pk2(v[jj][0] * rinv * gg[0], v[jj][1] * rinv * gg[1]); o.y = pk2(v[jj][2] * rinv * gg[2], v[jj][3] * rinv * gg[3]);
                        *(uint2*)(XN + (size_t)r * D_MODEL + lane * 4 + 256 * jj) = o; }
                }
                __syncthreads();
                for (int rtb = 0; rtb < MK_RT_B; ++rtb) {
                    const int rr = lane & 31, hh = lane >> 5;
                    f32x16 acc[2];
#pragma unroll
                    for (int mt = 0; mt < 2; ++mt)
#pragma unroll
                        for (int e = 0; e < 16; ++e) acc[mt][e] = 0.f;
                    const float rv0 = rinvs[rr], rv1 = rinvs[32 + rr];
#pragma unroll 2
                    for (int kq = 0; kq < 8; ++kq) {
                        const int k0 = 16 * (8 * wave + kq) + 8 * hh;
                        const bf16x8 bh = *(const bf16x8*)(wrt_hi + (size_t)rr * D_MODEL + k0), bl = *(const bf16x8*)(wrt_lo + (size_t)rr * D_MODEL + k0);
                        const f32x4 g0 = *(const f32x4*)(g + k0), g1 = *(const f32x4*)(g + k0 + 4);
#pragma unroll
                        for (int mt = 0; mt < 2; ++mt) {
                            const float* xp = OUT + (size_t)(chunk * 64 + mt * 32 + rr) * D_MODEL + k0;
                            const f32x4 x0 = *(const f32x4*)xp, x1 = *(const f32x4*)(xp + 4);
                            const float rv = mt ? rv1 : rv0;
                            float xn[8] = {x0[0] * rv * g0[0], x0[1] * rv * g0[1], x0[2] * rv * g0[2], x0[3] * rv * g0[3], x1[0] * rv * g1[0], x1[1] * rv * g1[1], x1[2] * rv * g1[2], x1[3] * rv * g1[3]};
                            u32x4v uh, ul;
                            uh.x = pkbf(xn[0], xn[1]); uh.y = pkbf(xn[2], xn[3]); uh.z = pkbf(xn[4], xn[5]); uh.w = pkbf(xn[6], xn[7]);
                            ul.x = pkbf(xn[0] - __uint_as_float(uh.x << 16), xn[1] - __uint_as_float(uh.x & 0xffff0000u)); ul.y = pkbf(xn[2] - __uint_as_float(uh.y << 16), xn[3] - __uint_as_float(uh.y & 0xffff0000u));
                            ul.z = pkbf(xn[4] - __uint_as_float(uh.z << 16), xn[5] - __uint_as_float(uh.z & 0xffff0000u)); ul.w = pkbf(xn[6] - __uint_as_float(uh.w << 16), xn[7] - __uint_as_float(uh.w & 0xffff0000u));
                            const bf16x8 ah = __builtin_bit_cast(bf16x8, uh), al = __builtin_bit_cast(bf16x8, ul);
                            acc[mt] = MFMA32(ah, bh, acc[mt]); acc[mt] = MFMA32(ah, bl, acc[mt]); acc[mt] = MFMA32(al, bh, acc[mt]);
                        }
                    }
#pragma unroll
                    for (int mt = 0; mt < 2; ++mt)
#pragma unroll
                        for (int e = 0; e < 16; ++e) red[((wave * 2 + mt) * 32 + crow(e, hh)) * 33 + rr] = acc[mt][e];
                }
                __syncthreads();
                for (int idx = tid; idx < 64 * 20; idx += NTHREADS) { const int t = idx / 20, n = idx % 20; float sv = 0.f;
#pragma unroll
                    for (int w = 0; w < 8; ++w) sv += red[((w * 2 + (t >> 5)) * 32 + (t & 31)) * 33 + n];
                    lg[t * 21 + n] = sv; }
                __syncthreads();
                if (tid < 64) {
                    const int r = chunk * 64 + tid;
                    float acc[20];
#pragma unroll
                    for (int jj = 0; jj < 20; ++jj) acc[jj] = lg[tid * 21 + jj];
                    float gl[4]; int gs = 0;
#pragma unroll
                    for (int jj = 0; jj < 4; ++jj) gl[jj] = acc[jj] + brg[jj];
                    float gmax = gl[0];
#pragma unroll
                    for (int jj = 1; jj < 4; ++jj) if (gl[jj] > gmax) { gmax = gl[jj]; gs = jj; }
                    float den = 0.f;
#pragma unroll
                    for (int jj = 0; jj < 4; ++jj) den += __expf(gl[jj] - gmax);
                    const float gwt = 1.f / den;
                    float el[4];
#pragma unroll
                    for (int jj = 0; jj < 4; ++jj) { float vsel = 0.f;
#pragma unroll
                        for (int gg2 = 0; gg2 < 4; ++gg2) vsel = (gg2 == gs) ? (acc[4 + gg2 * 4 + jj] + bre[gg2 * 4 + jj]) : vsel;
                        el[jj] = vsel; }
                    int i1 = 0; float e1v = el[0];
#pragma unroll
                    for (int jj = 1; jj < 4; ++jj) if (el[jj] > e1v) { e1v = el[jj]; i1 = jj; }
                    int i2 = -1; float e2v = -INFINITY;
#pragma unroll
                    for (int jj = 0; jj < 4; ++jj) if (jj != i1 && el[jj] > e2v) { e2v = el[jj]; i2 = jj; }
                    const float e2 = __expf(e2v - e1v);
                    const float w1 = 1.f / (1.f + e2), w2 = e2 / (1.f + e2);
                    const int ex1 = gs * 4 + i1, ex2 = gs * 4 + i2;
                    tok_e[r * 2] = ex1; tok_e[r * 2 + 1] = ex2;
                    tok_g[r * 2] = w1 * gwt; tok_g[r * 2 + 1] = w2 * gwt;
                    const unsigned r1 = atomicAdd(&lcnt[ex1], 1u), r2 = atomicAdd(&lcnt[ex2], 1u);
                    ler[tid * 2] = (unsigned)ex1 | (r1 << 8); ler[tid * 2 + 1] = (unsigned)ex2 | (r2 << 8);
                }
                __syncthreads();
                if (tid < 16) CNTT[((size_t)l * (T / 64) + chunk) * 16 + tid] = (int)lcnt[tid];
                if (tid < 128) tok_r[(chunk * 64) * 2 + tid] = (int)(ler[tid] >> 8);
            }
        } else if (k >= 11 && k <= 14 && PH_ON(11)) {
            int off[N_EXPERTS + 1];
            int* cbt = (int*)lds_raw + 1024;
            if (k == 11) {
                int* segs = (int*)lds_raw;
                int* tot = (int*)lds_raw + 512;
                __syncthreads();
                for (int i = tid; i < (T / 64) * 16; i += NTHREADS) cbt[i] = CNTT[(size_t)l * (T / 64) * 16 + i];
                __syncthreads();
                { const int e = tid & 15, sg = tid >> 4; int sacc = 0;
#pragma unroll
                  for (int c = 0; c < 8; ++c) { const int v = cbt[(sg * 8 + c) * 16 + e]; cbt[(sg * 8 + c) * 16 + e] = sacc; sacc += v; }
                  segs[sg * 16 + e] = sacc; }
                __syncthreads();
                { const int e = tid & 15, sg = tid >> 4; int base = 0;
                  for (int q = 0; q < sg; ++q) base += segs[q * 16 + e];
#pragma unroll
                  for (int c = 0; c < 8; ++c) cbt[(sg * 8 + c) * 16 + e] += base;
                  if (sg == 31) { tot[e] = base + segs[sg * 16 + e]; if (bid == 0) cnt[e] = (unsigned)(base + segs[sg * 16 + e]); } }
                __syncthreads();
                off[0] = 0;
#pragma unroll
                for (int e = 0; e < N_EXPERTS; ++e) off[e + 1] = off[e] + ((tot[e] + PADR - 1) / PADR) * PADR;
            } else {
                off[0] = 0;
#pragma unroll
                for (int e = 0; e < N_EXPERTS; ++e) { const int c = (int)__hip_atomic_load(&cnt[e], __ATOMIC_RELAXED, __HIP_MEMORY_SCOPE_AGENT); off[e + 1] = off[e] + ((c + PADR - 1) / PADR) * PADR; }
            }
            const int total_rows = off[N_EXPERTS];
            if (k == 11) {
                for (int tb8 = gw * 8; tb8 < T; tb8 += NGW * 8) {
                    int pe = 0, pdst = 0;
                    if (lane < 16) { const int i = tb8 * 2 + lane; pe = tok_e[i]; int o = 0;
#pragma unroll
                        for (int q = 0; q < N_EXPERTS; ++q) o = (q == pe) ? off[q] : o;
                        const int grank = cbt[(tb8 >> 6) * 16 + pe] + tok_r[i];
                        tok_r[i] = grank; pdst = o + grank; }
#pragma unroll 4
                    for (int t8 = 0; t8 < 8; ++t8) {
                        const uint4* src = (const uint4*)(XN + (size_t)(tb8 + t8) * D_MODEL);
                        const uint4 w0 = src[lane], w1 = src[lane + 64];
                        const int d0 = __builtin_amdgcn_readfirstlane(__shfl(pdst, t8 * 2)), d1 = __builtin_amdgcn_readfirstlane(__shfl(pdst, t8 * 2 + 1));
                        uint4* dst0 = (uint4*)(XG + (size_t)d0 * D_MODEL); uint4* dst1 = (uint4*)(XG + (size_t)d1 * D_MODEL);
                        dst0[lane] = w0; dst0[lane + 64] = w1; dst1[lane] = w0; dst1[lane + 64] = w1;
                    }
                }
                for (int e = 0; e < N_EXPERTS; ++e) {
                    int oe = 0, oe1 = 0;
#pragma unroll
                    for (int q = 0; q < N_EXPERTS; ++q) { oe = (q == e) ? off[q] : oe; oe1 = (q == e) ? off[q + 1] : oe1; }
                    const int c = ((int*)lds_raw + 512)[e];
                    for (int r = oe + c + gw; r < oe1; r += NGW) { uint4* dst = (uint4*)(XG + (size_t)r * D_MODEL); dst[lane] = make_uint4(0u, 0u, 0u, 0u); dst[lane + 64] = make_uint4(0u, 0u, 0u, 0u); }
                }
            } else if (k == 12) {
                pg8::Gemm g{XG, WGU, total_rows, 1024, D_MODEL};
                pg8::GroupSched S;
#pragma unroll
                for (int q = 0; q < 17; ++q) S.off[q] = off[q];
                S.nunits = (total_rows / 256) * 4; S.G = G; S.c = bid;
                pg8::EpiGateUp E{HB, D_EXPERT};
                pg8::gemm_phase<pg8::EpiGateUp, pg8::GroupSched, true, true>(tid, ldsq, g, S, E);
            } else if (k == 13) {
                pg8::Gemm g{HB, WDN, total_rows, 1024, D_EXPERT};
                pg8::GroupSched S;
#pragma unroll
                for (int q = 0; q < 17; ++q) S.off[q] = off[q];
                S.nunits = (total_rows / 256) * 4; S.G = G; S.c = bid;
                pg8::EpiStoreBf16 E{DB, D_MODEL, 3};
                pg8::gemm_phase<pg8::EpiStoreBf16, pg8::GroupSched, true, true>(tid, ldsq, g, S, E);
            } else {
                const float* gnx = args.in[3] + (l + 1 < DEPTH ? l + 1 : l) * D_MODEL;
                for (int tb8 = gw * 8; tb8 < T; tb8 += NGW * 8) {
                int prow = 0; float pgate = 0.f;
                if (lane < 16) { const int i = tb8 * 2 + lane; const int pe = tok_e[i]; int o = 0;
#pragma unroll
                    for (int q = 0; q < N_EXPERTS; ++q) o = (q == pe) ? off[q] : o;
                    prow = o + tok_r[i]; pgate = tok_g[i]; }
#pragma unroll 2
                for (int t8 = 0; t8 < 8; ++t8) {
                    const int r = tb8 + t8;
                    const size_t r0 = (size_t)__builtin_amdgcn_readfirstlane(__shfl(prow, t8 * 2)), r1 = (size_t)__builtin_amdgcn_readfirstlane(__shfl(prow, t8 * 2 + 1));
                    const float g0 = __shfl(pgate, t8 * 2), g1 = __shfl(pgate, t8 * 2 + 1);
                    f32x4 xv[4]; float ss = 0.f;
#pragma unroll
                    for (int j = 0; j < 4; ++j) {
                        const int c = lane * 4 + 256 * j;
                        const uint2 a = *(const uint2*)(DB + r0 * 1024 + c), bq = *(const uint2*)(DB + r1 * 1024 + c);
                        f32x4 x = *(const f32x4*)(OUT + (size_t)r * D_MODEL + c);
                        x[0] += g0 * __uint_as_float(a.x << 16) + g1 * __uint_as_float(bq.x << 16);
                        x[1] += g0 * __uint_as_float(a.x & 0xffff0000u) + g1 * __uint_as_float(bq.x & 0xffff0000u);
                        x[2] += g0 * __uint_as_float(a.y << 16) + g1 * __uint_as_float(bq.y << 16);
                        x[3] += g0 * __uint_as_float(a.y & 0xffff0000u) + g1 * __uint_as_float(bq.y & 0xffff0000u);
                        *(f32x4*)(OUT + (size_t)r * D_MODEL + c) = x;
                        xv[j] = x; ss += x[0] * x[0] + x[1] * x[1] + x[2] * x[2] + x[3] * x[3];
                    }
                    if (l + 1 < DEPTH) {
                        const float rinv = 1.0f / sqrtf(wave_sum(ss) * (1.f / 1024.f) + NORM_EPS);
#pragma unroll
                        for (int j = 0; j < 4; ++j) { const int c = lane * 4 + 256 * j; const f32x4 gg = *(const f32x4*)(gnx + c);
                            uint2 o; o.x = pk2(xv[j][0] * rinv * gg[0], xv[j][1] * rinv * gg[1]); o.y = pk2(xv[j][2] * rinv * gg[2], xv[j][3] * rinv * gg[3]);
                            *(uint2*)(XN + (size_t)r * D_MODEL + c) = o; }
                    }
                }
                }
            }
        }
    }
#ifdef MK_PROF_A
    if (KSEL < 0) {
        xcd_barrier(bar);
        if (bid == 0 && threadIdx.x == 0) ctl[8192 + DEPTH * NP] = (unsigned)__builtin_amdgcn_s_memrealtime();
        xcd_barrier(bar);
        const float da = (float)(ctl[8192 + MK_PROF_A + 1] - ctl[8192 + MK_PROF_A]) * 0.01f;
        const float db = (MK_PROF_B < 0) ? (float)(ctl[8192 + DEPTH * NP] - ctl[8192]) * 0.01f : (float)(ctl[8192 + MK_PROF_B + 1] - ctl[8192 + MK_PROF_B]) * 0.01f;
        for (size_t i = (size_t)T * D_MODEL / 2 + (size_t)bid * NTHREADS + threadIdx.x; i < (size_t)T * D_MODEL; i += (size_t)G * NTHREADS) OUT[i] = db;
        if (bid == 0 && threadIdx.x == 0) OUT[0] = 100.f * da;
    }
#endif
}

#ifndef MK_SINGLE
#define MK_SINGLE 1
#endif
extern "C" void kernel_launch(void* const* d_in, const int* in_sizes, int n_in, void* d_out, int out_size, void* d_ws, size_t ws_size, hipStream_t stream) {
    static int grid = 0;
    if (grid == 0) {
        if (n_in != 30 || out_size != T * D_MODEL || ws_size < WS_END) { fprintf(stderr, "kernel_launch: unexpected sizes n_in %d out %d ws %zu (need %zu)\n", n_in, out_size, ws_size, (size_t)WS_END); grid = -1; return; }
        int dev = 0, cus = 0;
        if (hipGetDevice(&dev) != hipSuccess || hipDeviceGetAttribute(&cus, hipDeviceAttributeMultiprocessorCount, dev) != hipSuccess) { grid = -1; return; }
        bool okattr = true;
#define SETATTR(K) okattr = okattr && (hipFuncSetAttribute((const void*)mk_fwd<K>, hipFuncAttributeMaxDynamicSharedMemorySize, LDS_BYTES) == hipSuccess)
#if MK_SINGLE
        SETATTR(-1);
#else
        SETATTR(0); SETATTR(1); SETATTR(2); SETATTR(3); SETATTR(4); SETATTR(5); SETATTR(6); SETATTR(7); SETATTR(8); SETATTR(9); SETATTR(10); SETATTR(11); SETATTR(12); SETATTR(13); SETATTR(14);
#endif
        if (!okattr) { fprintf(stderr, "kernel_launch: hipFuncSetAttribute failed\n"); grid = -1; return; }
        (void)hipGetLastError();
        grid = cus > 0 ? cus : 256;
    }
    if (grid < 0) return;
    (void)hipMemsetAsync((char*)d_ws + WS_CTL, 0, CTL_BYTES, stream);
    Args a{};
    for (int i = 0; i < 30; ++i) a.in[i] = (const float*)d_in[i];
    a.out = (float*)d_out; a.ws = (unsigned char*)d_ws;
#if MK_SINGLE
    a.ph_lo = 0; a.ph_hi = DEPTH * NP;
    hipLaunchKernelGGL(mk_fwd<-1>, dim3(grid), dim3(NTHREADS), LDS_BYTES, stream, a);
#else
    for (int ph = 0; ph < DEPTH * NP; ++ph) {
        a.ph_lo = ph; a.ph_hi = ph + 1;
        switch (ph % NP) {
#define LCASE(K) case K: hipLaunchKernelGGL(mk_fwd<K>, dim3(grid), dim3(NTHREADS), LDS_BYTES, stream, a); break
            LCASE(0); LCASE(1); LCASE(2); LCASE(3); LCASE(4); LCASE(5); LCASE(6); LCASE(7); LCASE(8); LCASE(9); LCASE(10); LCASE(11); LCASE(12); LCASE(13); LCASE(14);
        }
    }
#endif
}
```

```cpp
#include <hip/hip_runtime.h>
#include <cstdio>
#include <cstdint>

constexpr int D_MODEL = 1024, BATCH = 4, SEQ = 4096, DEPTH = 2, T = BATCH * SEQ;
constexpr int MEM_LEN = 256;
constexpr int GLA_HEADS = 4, GLA_DK = 48, GLA_DV = 96, GLA_RANK = 16;
constexpr int DSA_HEADS = 6, DSA_DH = 64, IDX_HEADS = 8, IDX_DIM = 64, TOPK = 256;
constexpr int CONV_CH = 256, CONV_W = 31;
constexpr int NUM_BUCKETS = 32;
constexpr int X_HEADS = 4, X_DH = 64, XW = X_HEADS * X_DH;
constexpr int N_GROUPS = 4, EPG = 4, N_EXPERTS = 16, D_EXPERT = 512;
constexpr float NORM_EPS = 1e-6f;
constexpr int D_IN = 3416;
constexpr int Z_GQ = 0, Z_GK = 192, Z_GV = 384, Z_GLR = 768, Z_GR = 784, Z_DQ = 1168, Z_DK = 1552, Z_DV = 1936, Z_IQ = 2320, Z_IK = 2832, Z_IW = 2896, Z_CU = 2904;
constexpr int ZLD = 3584;
constexpr int MIX_GLA = 0, MIX_DSA = 384, MIX_CONV = 768;
constexpr int PADR = 256;
constexpr int MAXROWS = 2 * T + N_EXPERTS * PADR;

typedef unsigned short bf16_t;
typedef float f32x4 __attribute__((ext_vector_type(4)));

constexpr size_t MiB = 1u << 20;
constexpr size_t WS_CTL = 0, CTL_BYTES = 1 * MiB;
constexpr size_t WS_WIN0 = 1 * MiB, WS_WCKV = 8 * MiB, WS_WIN1 = 10 * MiB, WS_WOUT = 17 * MiB, WS_WCQ = 21 * MiB, WS_WCO = 22 * MiB;
constexpr size_t WS_XN = 24 * MiB;
constexpr size_t WS_MEMN = 56 * MiB;
constexpr size_t WS_Z = 60 * MiB;
constexpr size_t WS_WGU = WS_Z, WS_WDN = WS_Z + 32 * MiB, WS_HB = WS_Z + 48 * MiB;
constexpr size_t WS_MIX = 172 * MiB;
constexpr size_t WS_QN = 204 * MiB, WS_KN = 216 * MiB;
constexpr size_t WS_VT = 228 * MiB;
constexpr size_t WS_MASK = 240 * MiB;
constexpr size_t WS_IK = 248 * MiB, WS_QL = 250 * MiB, WS_CH = 252 * MiB;
constexpr size_t WS_XG = WS_MIX, WS_DB = WS_MIX;
constexpr size_t WS_CQ = 256 * MiB, WS_COIN = 264 * MiB;
constexpr size_t WS_BCUM = 256 * MiB, WS_SLOC = 268 * MiB, WS_DEC = 286 * MiB;
constexpr size_t WS_CKV = 288 * MiB;
constexpr size_t WS_CKN = 290 * MiB;
constexpr size_t WS_CVT = 292 * MiB;
constexpr size_t WS_ROUTE = 291 * MiB;
constexpr size_t WS_END = 293 * MiB;
constexpr int CW_CNT = 1024;
constexpr int CW_Q3 = 2048, CW_Q4 = 2304;

constexpr int NTHREADS = 512, NWAVES = 8;
constexpr int LDS_BYTES = 147456;

__device__ __forceinline__ float bf2f(bf16_t u) { return __uint_as_float(((unsigned)u) << 16); }
__device__ __forceinline__ bf16_t f2bf(float f) { unsigned u = __float_as_uint(f); return (bf16_t)((u + 0x7fffu + ((u >> 16) & 1u)) >> 16); }
__device__ __forceinline__ unsigned pk2(float lo, float hi) { return (unsigned)f2bf(lo) | ((unsigned)f2bf(hi) << 16); }
__device__ __forceinline__ float wave_sum(float v) {
    v += __builtin_bit_cast(float, __builtin_amdgcn_update_dpp(0, __builtin_bit_cast(int, v), 0xB1, 0xf, 0xf, false));
    v += __builtin_bit_cast(float, __builtin_amdgcn_update_dpp(0, __builtin_bit_cast(int, v), 0x4E, 0xf, 0xf, false));
    v += __builtin_bit_cast(float, __builtin_amdgcn_update_dpp(0, __builtin_bit_cast(int, v), 0x141, 0xf, 0xf, false));
    v += __builtin_bit_cast(float, __builtin_amdgcn_update_dpp(0, __builtin_bit_cast(int, v), 0x140, 0xf, 0xf, false));
    v += __builtin_bit_cast(float, __builtin_amdgcn_update_dpp(0, __builtin_bit_cast(int, v), 0x142, 0xa, 0xf, false));
    v += __builtin_bit_cast(float, __builtin_amdgcn_update_dpp(0, __builtin_bit_cast(int, v), 0x143, 0xc, 0xf, false));
    return __builtin_bit_cast(float, __builtin_amdgcn_readlane(__builtin_bit_cast(int, v), 63));
}
__device__ __forceinline__ float siluf(float x) { return x / (1.f + __expf(-x)); }
__device__ __forceinline__ float sigmoidf(float x) { return 1.f / (1.f + __expf(-x)); }


typedef short bf16x8 __attribute__((ext_vector_type(8)));
typedef float f32x16 __attribute__((ext_vector_type(16)));
typedef unsigned u32x4v __attribute__((ext_vector_type(4)));
typedef __bf16 bf16x2_t __attribute__((ext_vector_type(2)));
typedef float f32x2_t __attribute__((ext_vector_type(2)));
#define LDSAS __attribute__((address_space(3)))
#define MFMA32(a, b, c) __builtin_amdgcn_mfma_f32_32x32x16_bf16((a), (b), (c), 0, 0, 0)
__device__ __forceinline__ int crow(int reg, int hh) { return (reg & 3) + 8 * (reg >> 2) + 4 * hh; }
__device__ __forceinline__ unsigned pkbf(float a, float b) { f32x2_t v = {a, b}; bf16x2_t r = __builtin_convertvector(v, bf16x2_t); return __builtin_bit_cast(unsigned, r); }

struct Args {
    const float* in[30];
    float* out;
    unsigned char* ws;
    int ph_lo, ph_hi;
};

template <class Epi>
__device__ __forceinline__ void gemm_tile_v1(const int tid, float* lds, const bf16_t* A, int lda, const int* rowidx, int row0,
                                             const float* B, int ldb, int col0, int ncols, int K, const Epi& epi) {
    float* As = lds;
    float* Bs = lds + 16 * 132;
    const int ty = tid >> 4, tx = tid & 15;
    float acc[4][8];
#pragma unroll
    for (int i = 0; i < 4; ++i)
#pragma unroll
        for (int j = 0; j < 8; ++j) acc[i][j] = 0.f;
    const int ar = tid >> 2, ak = (tid & 3) * 4;
    const int grow = rowidx ? rowidx[row0 + ar] : (row0 + ar);
    const bf16_t* ap = A + (size_t)(grow >= 0 ? grow : 0) * lda + ak;
    const bool aval = grow >= 0;
    const int bk = tid >> 5, bn = (tid & 31) * 4;
    const bool bval = bn < ncols;
    const float* bp = B + (size_t)bk * ldb + col0 + bn;
    for (int k0 = 0; k0 < K; k0 += 16) {
        uint2 av = make_uint2(0u, 0u);
        if (aval) av = *(const uint2*)(ap + k0);
        f32x4 bv = (f32x4){0.f, 0.f, 0.f, 0.f};
        if (bval) bv = *(const f32x4*)(bp + (size_t)k0 * ldb);
        __syncthreads();
        As[(ak + 0) * 132 + ar] = __uint_as_float(av.x << 16);
        As[(ak + 1) * 132 + ar] = __uint_as_float(av.x & 0xffff0000u);
        As[(ak + 2) * 132 + ar] = __uint_as_float(av.y << 16);
        As[(ak + 3) * 132 + ar] = __uint_as_float(av.y & 0xffff0000u);
        *(f32x4*)&Bs[bk * 132 + bn] = bv;
        __syncthreads();
#pragma unroll
        for (int k = 0; k < 16; ++k) {
            const f32x4 a4 = *(const f32x4*)&As[k * 132 + ty * 4];
            const f32x4 b0 = *(const f32x4*)&Bs[k * 132 + tx * 8];
            const f32x4 b1 = *(const f32x4*)&Bs[k * 132 + tx * 8 + 4];
#pragma unroll
            for (int i = 0; i < 4; ++i) {
                acc[i][0] += a4[i] * b0[0]; acc[i][1] += a4[i] * b0[1]; acc[i][2] += a4[i] * b0[2]; acc[i][3] += a4[i] * b0[3];
                acc[i][4] += a4[i] * b1[0]; acc[i][5] += a4[i] * b1[1]; acc[i][6] += a4[i] * b1[2]; acc[i][7] += a4[i] * b1[3];
            }
        }
    }
    __syncthreads();
#pragma unroll
    for (int i = 0; i < 4; ++i)
        epi(row0 + ty * 4 + i, col0 + tx * 8, (f32x4){acc[i][0], acc[i][1], acc[i][2], acc[i][3]}, (f32x4){acc[i][4], acc[i][5], acc[i][6], acc[i][7]});
}

template <class Epi>
__device__ __forceinline__ void gemm_v1(const int tid, float* lds, const bf16_t* A, int lda, int M, const float* B, int ldb, int N, int K, const Epi& epi) {
    const int nct = (N + 127) / 128, nrt = M / 128;
    for (int tile = blockIdx.x; tile < nrt * nct; tile += gridDim.x) {
        const int rt = tile / nct, ct = tile % nct;
        const int nc = (N - ct * 128) < 128 ? (N - ct * 128) : 128;
        gemm_tile_v1(tid, lds, A, lda, nullptr, rt * 128, B, ldb, ct * 128, nc, K, epi);
    }
}

namespace pg8 {
#define PG8_LAS __attribute__((address_space(3)))
typedef PG8_LAS unsigned char* PG8_LAS_T;
typedef short bf16x8 __attribute__((ext_vector_type(8)));
typedef unsigned u32x4 __attribute__((ext_vector_type(4)));
constexpr int BM = 256, BK = 64, HALF = 128, HTB = HALF * BK * 2  , STAGE_BYTES = 8 * HTB, NXCD = 8, WGM = 8;

__host__ __device__ __forceinline__ int lds_byte(int r, int c) { const int st = (r >> 4) * 2 + (c >> 5), rr = r & 15, cc = c & 31, ob = rr * 64 + cc * 2; return st * 1024 + (ob ^ (((ob >> 9) & 1) << 5)); }
__host__ __device__ __forceinline__ void stage_rc(int b, int& R, int& C) { const int st = b / 1024, sb = b % 1024, swz = sb ^ (((sb >> 9) & 1) << 5); R = (st >> 1) * 16 + swz / 64; C = (st & 1) * 32 + (swz % 64) / 2; }
__host__ __device__ __forceinline__ int perm32(int rho) { const int n = rho >> 4, i = rho & 15; return 8 * (i >> 2) + 4 * n + (i & 3); }

struct Unit { int pm, pn; };
struct Gemm { const bf16_t* A; const bf16_t* Bt; int M, N, K; };

struct StaticOrder {
    int nM, nN, nwg, G, c;
    __host__ __device__ void init(int M, int N, int G_, int c_) { nM = M / BM; nN = N / BM; nwg = nM * nN; G = G_; c = c_; }
    __host__ __device__ bool next(int i, Unit& u) const {
        const long L = (long)i * G + c; if (L >= nwg) return false;
        int wgid = (int)L; { const int q = nwg / NXCD, r = nwg % NXCD, xcd = wgid % NXCD, off = wgid / NXCD; wgid = (xcd < r ? xcd * (q + 1) : r * (q + 1) + (xcd - r) * q) + off; }
        const int nig = WGM * nN, gid = wgid / nig, fm = gid * WGM, gsz = (nM - fm) < WGM ? (nM - fm) : WGM;
        u.pm = fm + ((wgid % nig) % gsz); u.pn = (wgid % nig) / gsz; return true;
    }
    __device__ __forceinline__ void a_ready(const Unit&) const {}
    __device__ __forceinline__ void done(const Unit&) const {}
};

__device__ __forceinline__ unsigned cvt_pk_bf16(float lo, float hi) { unsigned r; asm volatile("v_cvt_pk_bf16_f32 %0, %1, %2" : "=v"(r) : "v"(lo), "v"(hi)); return r; }
typedef float f32x2 __attribute__((ext_vector_type(2)));
template <class Epi, class Sched, bool ALIGN_EPI = false, bool SP2 = false>
__device__ __forceinline__ void gemm_phase(const int tid, PG8_LAS unsigned char* lds, const Gemm g, const Sched& S, const Epi& E) {
    const int wid = __builtin_amdgcn_readfirstlane(tid >> 6), lane = tid & 63, wr = wid >> 2, wc = wid & 3, fr = lane & 15, fq = lane >> 4;
    const int K = g.K, nt = K / BK;
    unsigned voffA[2], voffB[2];
#pragma unroll
    for (int i = 0; i < 2; ++i) { int R, C; stage_rc(tid * 16 + i * 8192, R, C); const int Rb = Epi::PERM ? ((R & ~31) + perm32(R & 31)) : R;
        voffA[i] = (unsigned)(R * K + C) * 2u; voffB[i] = (unsigned)(Rb * K + C) * 2u; }
    const size_t kstep = (size_t)(BK * 2);
    const size_t hstep = (size_t)HALF * K * 2;
    const size_t tstep = 2 * hstep;
    const unsigned ldsw = (unsigned)wid * 1024u;
    const int aoff = lds_byte(wr * 64 + fr, fq * 8), boff = lds_byte(wc * 32 + fr, fq * 8);
#define PG8_SA(b, h) (((b) * 2 + (h)) * HTB)
#define PG8_SB(b, h) ((4 + (b) * 2 + (h)) * HTB)
#define PG8_STAGE(bufoff, gbase, voff) do { _Pragma("unroll") for (int _i = 0; _i < 2; ++_i) \
        __builtin_amdgcn_global_load_lds((const unsigned*)((const char*)(gbase) + (voff)[_i]), (PG8_LAS unsigned*)(lds + (bufoff) + ldsw + _i * 8192), 16, 0, 0); } while (0)
#define PG8_LDA(dst, b, h) do { _Pragma("unroll") for (int m = 0; m < 4; ++m) _Pragma("unroll") for (int k = 0; k < 2; ++k) dst[m][k] = *(const PG8_LAS bf16x8*)(lds + PG8_SA(b, h) + aoff + m * 2048 + k * 1024); } while (0)
#define PG8_LDB(dst, b, h) do { _Pragma("unroll") for (int n = 0; n < 2; ++n) _Pragma("unroll") for (int k = 0; k < 2; ++k) dst[n][k] = *(const PG8_LAS bf16x8*)(lds + PG8_SB(b, h) + boff + n * 2048 + k * 1024); } while (0)
#define PG8_MMA(ai, bj, At, Bt) do { __builtin_amdgcn_s_setprio(1); _Pragma("unroll") for (int m = 0; m < 4; ++m) _Pragma("unroll") for (int n = 0; n < 2; ++n) _Pragma("unroll") for (int k = 0; k < 2; ++k) \
        acc[ai][bj][m][n] = __builtin_amdgcn_mfma_f32_16x16x32_bf16(Bt[n][k], At[m][k], acc[ai][bj][m][n], 0, 0, 0); __builtin_amdgcn_s_setprio(0); } while (0)
#define PG8_WAIT_V(n) asm volatile("s_waitcnt vmcnt(" #n ")" ::: "memory")
#define PG8_WAIT_L(n) asm volatile("s_waitcnt lgkmcnt(" #n ")" ::: "memory")
#define PG8_BAR __builtin_amdgcn_s_barrier()
#define PG8_SCHED __builtin_amdgcn_sched_barrier(0)
    Unit cur, nxt; int ui = 0;
    if (!S.next(0, cur)) return;
    f32x4 acc[2][2][4][2];
#pragma unroll
    for (int a = 0; a < 2; ++a)
#pragma unroll
        for (int b = 0; b < 2; ++b)
#pragma unroll
            for (int m = 0; m < 4; ++m)
#pragma unroll
                for (int n = 0; n < 2; ++n) acc[a][b][m][n] = (f32x4){0.f, 0.f, 0.f, 0.f};
    bf16x8 At[4][2], B0[2][2], B1[2][2];
    const char* cA = (const char*)g.A + (size_t)cur.pm * tstep; const char* cB = (const char*)g.Bt + (size_t)cur.pn * tstep;
    S.a_ready(cur);
    if constexpr (SP2) {
        PG8_STAGE(PG8_SB(0, 0), cB, voffB); PG8_STAGE(PG8_SB(0, 1), cB + hstep, voffB); PG8_STAGE(PG8_SA(0, 0), cA, voffA); PG8_STAGE(PG8_SA(0, 1), cA + hstep, voffA);
        if (wr == 1) PG8_BAR;
        PG8_WAIT_V(2); PG8_BAR;
        PG8_STAGE(PG8_SB(1, 0), cB + kstep, voffB); PG8_STAGE(PG8_SA(1, 0), cA + kstep, voffA); PG8_STAGE(PG8_SB(1, 1), cB + hstep + kstep, voffB);
        PG8_WAIT_V(6); PG8_BAR;
    } else {
        PG8_STAGE(PG8_SB(0, 0), cB, voffB); PG8_STAGE(PG8_SA(0, 0), cA, voffA); PG8_STAGE(PG8_SB(0, 1), cB + hstep, voffB); PG8_STAGE(PG8_SA(0, 1), cA + hstep, voffA);
        if (wr == 1) PG8_BAR;
        PG8_WAIT_V(4); PG8_BAR;
        PG8_STAGE(PG8_SB(1, 0), cB + kstep, voffB); PG8_STAGE(PG8_SA(1, 0), cA + kstep, voffA); PG8_STAGE(PG8_SB(1, 1), cB + hstep + kstep, voffB);
        PG8_WAIT_V(6); PG8_BAR;
    }
    for (;;) {
        const bool has_next = S.next(ui + 1, nxt);
        const char* nA = has_next ? (const char*)g.A + (size_t)nxt.pm * tstep : cA; const char* nB = has_next ? (const char*)g.Bt + (size_t)nxt.pn * tstep : cB;
        for (int t = 0; t < nt; t += 2) {
            const bool last = (t == nt - 2);
            const char* a1 = cA + (size_t)(t + 1) * kstep;
            const char* a2 = last ? nA : cA + (size_t)(t + 2) * kstep; const char* b2 = last ? nB : cB + (size_t)(t + 2) * kstep;
            const char* a3 = a2 + kstep; const char* b3 = b2 + kstep;
            if (last && has_next) S.a_ready(nxt);
            if constexpr (SP2) {
            PG8_LDB(B0, 0, 0); PG8_LDB(B1, 0, 1); PG8_SCHED; PG8_LDA(At, 0, 0); PG8_STAGE(PG8_SA(1, 1), a1 + hstep, voffA);
            PG8_WAIT_V(8); PG8_WAIT_L(0); PG8_BAR; PG8_MMA(0, 0, At, B0); PG8_MMA(0, 1, At, B1); PG8_BAR; PG8_SCHED;
            PG8_LDA(At, 0, 1); PG8_STAGE(PG8_SB(0, 0), b2, voffB); PG8_STAGE(PG8_SB(0, 1), b2 + hstep, voffB); PG8_STAGE(PG8_SA(0, 0), a2, voffA);
            PG8_WAIT_V(8); PG8_WAIT_L(0); PG8_BAR; PG8_MMA(1, 0, At, B0); PG8_MMA(1, 1, At, B1); PG8_BAR; PG8_SCHED;
            PG8_LDB(B0, 1, 0); PG8_LDB(B1, 1, 1); PG8_SCHED; PG8_LDA(At, 1, 0); PG8_STAGE(PG8_SA(0, 1), a2 + hstep, voffA);
            PG8_WAIT_V(8); PG8_WAIT_L(0); PG8_BAR; PG8_MMA(0, 0, At, B0); PG8_MMA(0, 1, At, B1); PG8_BAR; PG8_SCHED;
            PG8_LDA(At, 1, 1); PG8_STAGE(PG8_SB(1, 0), b3, voffB); PG8_STAGE(PG8_SB(1, 1), b3 + hstep, voffB); PG8_STAGE(PG8_SA(1, 0), a3, voffA);
            PG8_WAIT_V(8); PG8_WAIT_L(0); PG8_BAR; PG8_MMA(1, 0, At, B0); PG8_MMA(1, 1, At, B1); PG8_BAR; PG8_SCHED;
            } else {
            PG8_LDB(B0, 0, 0); PG8_SCHED; PG8_LDA(At, 0, 0); PG8_STAGE(PG8_SA(1, 1), a1 + hstep, voffA);
            PG8_WAIT_L(8); PG8_BAR; PG8_WAIT_L(0); PG8_MMA(0, 0, At, B0); PG8_BAR; PG8_SCHED;
            PG8_LDB(B1, 0, 1); PG8_STAGE(PG8_SB(0, 0), b2, voffB);
            PG8_BAR; PG8_WAIT_L(0); PG8_MMA(0, 1, At, B1); PG8_BAR;
            PG8_LDA(At, 0, 1); PG8_STAGE(PG8_SA(0, 0), a2, voffA);
            PG8_BAR; PG8_WAIT_L(0); PG8_MMA(1, 0, At, B0); PG8_BAR; PG8_SCHED;
            PG8_STAGE(PG8_SB(0, 1), b2 + hstep, voffB);
            PG8_WAIT_V(6); PG8_BAR; PG8_MMA(1, 1, At, B1); PG8_BAR;
            PG8_LDB(B0, 1, 0); PG8_SCHED; PG8_LDA(At, 1, 0); PG8_STAGE(PG8_SA(0, 1), a2 + hstep, voffA);
            PG8_WAIT_L(8); PG8_BAR; PG8_WAIT_L(0); PG8_MMA(0, 0, At, B0); PG8_BAR; PG8_SCHED;
            PG8_LDB(B1, 1, 1); PG8_STAGE(PG8_SB(1, 0), b3, voffB);
            PG8_BAR; PG8_WAIT_L(0); PG8_MMA(0, 1, At, B1); PG8_BAR;
            PG8_LDA(At, 1, 1); PG8_STAGE(PG8_SA(1, 0), a3, voffA);
            PG8_BAR; PG8_WAIT_L(0); PG8_MMA(1, 0, At, B0); PG8_BAR; PG8_SCHED;
            PG8_STAGE(PG8_SB(1, 1), b3 + hstep, voffB);
            PG8_WAIT_V(6); PG8_BAR; PG8_MMA(1, 1, At, B1); PG8_BAR;
            }
        }
        if constexpr (ALIGN_EPI) { if (wr == 0) PG8_BAR; }
        if constexpr (!Epi::AFTER_DRAIN) { E(acc, cur, wr, wc, fr, fq); S.done(cur); }
        if (!has_next) break;
#pragma unroll
        for (int a = 0; a < 2; ++a)
#pragma unroll
            for (int b = 0; b < 2; ++b)
#pragma unroll
                for (int m = 0; m < 4; ++m)
#pragma unroll
                    for (int n = 0; n < 2; ++n) acc[a][b][m][n] = (f32x4){0.f, 0.f, 0.f, 0.f};
        cur = nxt; cA = nA; cB = nB; ++ui;
        if constexpr (ALIGN_EPI) { if (wr == 1) PG8_BAR; }
    }
    PG8_WAIT_V(0);
    if constexpr (!ALIGN_EPI) { if (wr == 0) PG8_BAR; }
    PG8_BAR;
    if constexpr (Epi::AFTER_DRAIN) { E.fused(acc, cur, wr, wc, fr, fq, lds, wid, lane); S.done(cur); }
#undef PG8_SA
#undef PG8_SB
#undef PG8_STAGE
#undef PG8_LDA
#undef PG8_LDB
#undef PG8_MMA
#undef PG8_WAIT_V
#undef PG8_WAIT_L
#undef PG8_BAR
#undef PG8_SCHED
}

struct EpiStoreBf16 {
    static constexpr bool PERM = true, AFTER_DRAIN = false;
    bf16_t* O; int ldc; int pnmask;
    __device__ __forceinline__ void operator()(const f32x4 (&acc)[2][2][4][2], const Unit& u, int wr, int wc, int fr, int fq) const {
        const int row0 = u.pm * BM + wr * 64 + fr; const int col0 = (u.pn & pnmask) * BM + wc * 32 + 8 * fq;
#pragma unroll
        for (int ai = 0; ai < 2; ++ai)
#pragma unroll
            for (int m = 0; m < 4; ++m) { bf16_t* rowp = O + (size_t)(row0 + ai * HALF + m * 16) * ldc + col0;
#pragma unroll
                for (int bj = 0; bj < 2; ++bj) { const f32x4 v0 = acc[ai][bj][m][0], v1 = acc[ai][bj][m][1];
                    u32x4 w; w.x = cvt_pk_bf16(v0[0], v0[1]); w.y = cvt_pk_bf16(v0[2], v0[3]); w.z = cvt_pk_bf16(v1[0], v1[1]); w.w = cvt_pk_bf16(v1[2], v1[3]);
                    *(u32x4*)(rowp + bj * HALF) = w; } }
    }
};
struct EpiRes {
    static constexpr bool PERM = false, AFTER_DRAIN = false;
    const float* base; float* out; int ldc;
    __device__ __forceinline__ void operator()(const f32x4 (&acc)[2][2][4][2], const Unit& u, int wr, int wc, int fr, int fq) const {
        const int row0 = u.pm * BM + wr * 64 + fr; const int col0 = u.pn * BM + wc * 32 + 4 * fq;
#pragma unroll
        for (int ai = 0; ai < 2; ++ai)
#pragma unroll
            for (int m = 0; m < 4; ++m) { const size_t off = (size_t)(row0 + ai * HALF + m * 16) * ldc + col0;
#pragma unroll
                for (int bj = 0; bj < 2; ++bj)
#pragma unroll
                    for (int n = 0; n < 2; ++n) { const f32x4 b = *(const f32x4*)(base + off + bj * HALF + n * 16); *(f32x4*)(out + off + bj * HALF + n * 16) = b + acc[ai][bj][m][n]; } }
    }
};
struct EpiGateUp {
    static constexpr bool PERM = true, AFTER_DRAIN = false;
    bf16_t* O; int ldc;
    __device__ __forceinline__ static float silu(float x) { return x / (1.f + __expf(-x)); }
    __device__ __forceinline__ void operator()(const f32x4 (&acc)[2][2][4][2], const Unit& u, int wr, int wc, int fr, int fq) const {
        const int row0 = u.pm * BM + wr * 64 + fr; const int col0 = ((u.pn & 3) * BM + wc * 32 + 8 * fq) >> 1;
#pragma unroll
        for (int ai = 0; ai < 2; ++ai)
#pragma unroll
            for (int m = 0; m < 4; ++m) { bf16_t* rowp = O + (size_t)(row0 + ai * HALF + m * 16) * ldc + col0;
#pragma unroll
                for (int bj = 0; bj < 2; ++bj) { const f32x4 v0 = acc[ai][bj][m][0], v1 = acc[ai][bj][m][1];
                    uint2 w; w.x = cvt_pk_bf16(silu(v0[0]) * v0[1], silu(v0[2]) * v0[3]); w.y = cvt_pk_bf16(silu(v1[0]) * v1[1], silu(v1[2]) * v1[3]);
                    *(uint2*)(rowp + bj * (HALF / 2)) = w; } }
    }
};
struct InprojSched {
    StaticOrder base; int extra;
    __device__ __forceinline__ bool next(int i, Unit& u) const {
        if (base.next(i, u)) return true;
        const long L = (long)i * base.G + base.c - base.nwg;
        if (L < 0 || L >= extra) return false;
        const int e = (int)L; u.pm = base.nM + (e >> 3) * 4 + ((e >> 1) & 3); u.pn = base.nN + (e >> 3) * 2 + (e & 1); return true;
    }
    __device__ __forceinline__ void a_ready(const Unit&) const {}
    __device__ __forceinline__ void done(const Unit&) const {}
};
struct EpiInproj {
    static constexpr bool PERM = true, AFTER_DRAIN = false;
    bf16_t* Zp; bf16_t* CKVp;
    __device__ __forceinline__ void operator()(const f32x4 (&acc)[2][2][4][2], const Unit& u, int wr, int wc, int fr, int fq) const {
        const bool kv = u.pm >= 64;
        const int ll = (u.pm - 64) >> 2;
        bf16_t* O = kv ? CKVp + (size_t)ll * 1024 * 512 : Zp; const int ldc = kv ? 512 : 3584;
        const int row0 = (kv ? ((u.pm - 64) & 3) : u.pm) * BM + wr * 64 + fr; const int col0 = (kv ? ((u.pn - 14) & 1) : u.pn) * BM + wc * 32 + 8 * fq;
#pragma unroll
        for (int ai = 0; ai < 2; ++ai)
#pragma unroll
            for (int m = 0; m < 4; ++m) { bf16_t* rowp = O + (size_t)(row0 + ai * HALF + m * 16) * ldc + col0;
#pragma unroll
                for (int bj = 0; bj < 2; ++bj) { const f32x4 v0 = acc[ai][bj][m][0], v1 = acc[ai][bj][m][1];
                    u32x4 w; w.x = cvt_pk_bf16(v0[0], v0[1]); w.y = cvt_pk_bf16(v0[2], v0[3]); w.z = cvt_pk_bf16(v1[0], v1[1]); w.w = cvt_pk_bf16(v1[2], v1[3]);
                    *(u32x4*)(rowp + bj * HALF) = w; } }
    }
};
struct GroupSched {
    int off[17]; int nunits, G, c;
    __device__ __forceinline__ bool next(int i, Unit& u) const {
        const int L = i * G + c; if (L >= nunits) return false;
        const int rt = L >> 2, pn = L & 3, row0 = rt * BM; int e = 0;
#pragma unroll
        for (int q = 1; q < 16; ++q) e = (row0 >= off[q]) ? q : e;
        u.pm = rt; u.pn = e * 4 + pn; return true;
    }
    __device__ __forceinline__ void a_ready(const Unit&) const {}
    __device__ __forceinline__ void done(const Unit&) const {}
};
}

__device__ __forceinline__ void rmsnorm_row_bf16(const float* xrow, const float* g, bf16_t* orow, int lane) {
    f32x4 v[4]; float s = 0.f;
#pragma unroll
    for (int j = 0; j < 4; ++j) { v[j] = *(const f32x4*)(xrow + lane * 4 + 256 * j); s += v[j][0] * v[j][0] + v[j][1] * v[j][1] + v[j][2] * v[j][2] + v[j][3] * v[j][3]; }
    const float rinv = 1.0f / sqrtf(wave_sum(s) * (1.f / 1024.f) + NORM_EPS);
#pragma unroll
    for (int j = 0; j < 4; ++j) {
        const f32x4 gg = *(const f32x4*)(g + lane * 4 + 256 * j);
        uint2 o; o.x = pk2(v[j][0] * rinv * gg[0], v[j][1] * rinv * gg[1]); o.y = pk2(v[j][2] * rinv * gg[2], v[j][3] * rinv * gg[3]);
        *(uint2*)(orow + lane * 4 + 256 * j) = o;
    }
}

__device__ __forceinline__ void transpose_item(const float* W, int K, int N, int nblk, bf16_t* WT, int row_off, int rmul, int radd, float* scr, int item, int lane) {
    const int kb = item / nblk, nb = item % nblk, k0 = 64 * kb, n0 = 32 * nb;
    const bool nv = (n0 + (lane & 31)) < N;
#pragma unroll 8
    for (int i = 0; i < 32; ++i) { const int kk = 2 * i + (lane >> 5); scr[kk * 33 + (lane & 31)] = nv ? W[(size_t)(k0 + kk) * N + n0 + (lane & 31)] : 0.f; }
    __builtin_amdgcn_s_waitcnt(0xc07f); __builtin_amdgcn_wave_barrier();
    const int c = lane & 7;
#pragma unroll
    for (int j = 0; j < 4; ++j) { const int n = (lane >> 3) + 8 * j; const float* sp = scr + (8 * c) * 33 + n;
        uint4 o; o.x = pk2(sp[0 * 33], sp[1 * 33]); o.y = pk2(sp[2 * 33], sp[3 * 33]); o.z = pk2(sp[4 * 33], sp[5 * 33]); o.w = pk2(sp[6 * 33], sp[7 * 33]);
        *(uint4*)(WT + (size_t)(row_off + (n0 + n) * rmul + radd) * K + k0 + 8 * c) = o; }
    __builtin_amdgcn_s_waitcnt(0xc07f); __builtin_amdgcn_wave_barrier();
}

__device__ __forceinline__ int t5_bucket(int dist) {
    if (dist < 16) return dist;
    const float d = (float)dist;
    int large = 16 + (int)(__logf(d * (1.f / 16.f)) * (16.0f / 2.0794415416798357f));
    return large < 31 ? large : 31;
}
__device__ __forceinline__ unsigned fkey(float f) { const unsigned u = __float_as_uint(f + 0.0f); return (u & 0x80000000u) ? ~u : (u | 0x80000000u); }


#define LAS __attribute__((address_space(3)))
#define XB_TMO      128
#define XB_XCNT(j)  (256  + 64 * (j))
#define XB_XSUB(j)  (1280 + 64 * (j))
#define XB_XGEN(j)  (2304 + 64 * (j))
#define XB_TOP      3328
#define XB_TOPGEN   3392
#define XCD_BAR_WORDS 3456
#define XB_SPIN_CAP (1u << 24)
__device__ __forceinline__ unsigned xb_ld(unsigned* p)              { return __hip_atomic_load(p, __ATOMIC_RELAXED, __HIP_MEMORY_SCOPE_AGENT); }
__device__ __forceinline__ unsigned xb_add(unsigned* p, unsigned v) { return __hip_atomic_fetch_add(p, v, __ATOMIC_RELAXED, __HIP_MEMORY_SCOPE_AGENT); }
__device__ __forceinline__ unsigned xb_xcc_id() { return (unsigned)__builtin_amdgcn_s_getreg((3 << 11) | 20) & 0xFu; }
#define XB_SPIN(cond, bar) do { unsigned _sp = 0; while (cond) { __builtin_amdgcn_s_sleep(1); \
    if ((++_sp & 255u) == 0u) { if (xb_ld(&(bar)[XB_TMO])) break; if (_sp > XB_SPIN_CAP) { atomicAdd(&(bar)[XB_TMO], 1u); break; } } } } while (0)
struct XcdBarrier { unsigned* bar; unsigned x; volatile LAS unsigned* st; };
__device__ __forceinline__ XcdBarrier xcd_barrier_post(unsigned* bar, volatile LAS unsigned* st) {
    XcdBarrier b; b.bar = bar; b.x = xb_xcc_id(); b.st = st;
    if (threadIdx.x == 0) (void)xb_add(&bar[XB_XCNT(b.x)], 1u);
    return b;
}
__device__ __forceinline__ void xcd_barrier_complete(unsigned* bar, unsigned x, unsigned& nloc, unsigned& nx) {
    const unsigned G = gridDim.x * gridDim.y * gridDim.z;
    unsigned sum, cnt, mine, sp = 0u;
    for (;;) {
        sum = 0u; cnt = 0u; mine = 0u;
#pragma unroll
        for (unsigned j = 0; j < 16; ++j) { const unsigned c = xb_ld(&bar[XB_XCNT(j)]); sum += c; cnt += (c > 0u) ? 1u : 0u; mine = (j == x) ? c : mine; }
        if (sum == G) break;
        __builtin_amdgcn_s_sleep(1);
        if ((++sp & 255u) == 0u) { if (xb_ld(&bar[XB_TMO])) break; if (sp > XB_SPIN_CAP) { atomicAdd(&bar[XB_TMO], 1u); break; } }
    }
    nloc = mine > 0u ? mine : 1u; nx = cnt > 0u ? cnt : 1u;
}
__device__ __forceinline__ void xcd_barrier(const XcdBarrier& b) {
    asm volatile("s_waitcnt vmcnt(0)" ::: "memory");
    __syncthreads();
    if (threadIdx.x == 0) {
        unsigned* bar = b.bar;
        __builtin_amdgcn_s_waitcnt(0);
        unsigned nloc = b.st[0], nx = b.st[1];
        if (nloc == 0u) { xcd_barrier_complete(bar, b.x, nloc, nx); b.st[0] = nloc; b.st[1] = nx; }
        const unsigned old = xb_add(&bar[XB_XSUB(b.x)], 1u);
        const unsigned gen = old / nloc;
        if (old + 1u == (gen + 1u) * nloc) {
            __builtin_amdgcn_fence(__ATOMIC_RELEASE, "agent");
            asm volatile("s_waitcnt vmcnt(0)" ::: "memory");
            const unsigned og = xb_add(&bar[XB_TOP], 1u);
            const unsigned tg = og / nx;
            if (og + 1u == (tg + 1u) * nx) xb_add(&bar[XB_TOPGEN], 1u);
            else XB_SPIN(xb_ld(&bar[XB_TOPGEN]) == tg, bar);
            __builtin_amdgcn_fence(__ATOMIC_ACQUIRE, "agent");
            xb_add(&bar[XB_XGEN(b.x)], 1u);
            asm volatile("s_waitcnt vmcnt(0)" ::: "memory");
        } else {
            XB_SPIN(xb_ld(&bar[XB_XGEN(b.x)]) == gen, bar);
            __builtin_amdgcn_fence(__ATOMIC_ACQUIRE, "agent");
            asm volatile("s_waitcnt vmcnt(0)" ::: "memory");
        }
    }
    __syncthreads();
}
constexpr int CW_BAR = 4096;
constexpr int LDSCTL_OFF = LDS_BYTES - 256;

constexpr int NP = 15;
constexpr int MOEW_IG = 16 * 16, MOEW_ID = 8 * 32, MOEW_IE = 2 * MOEW_IG + MOEW_ID;
constexpr int MOEW_P7 = 2688;
#ifndef MK_PHMASK
#define MK_PHMASK 0x7fff
#endif
#define PH_ON(x) (((MK_PHMASK) >> (x)) & 1)

template <int KSEL>
__global__ void __launch_bounds__(NTHREADS, 2) mk_fwd(Args args) {
    extern __shared__ __attribute__((aligned(16))) unsigned char lds_raw[];
    float* ldsf = (float*)lds_raw;
    const int G = gridDim.x, bid = blockIdx.x, NGW = G * NWAVES;
    const int wave_s = __builtin_amdgcn_readfirstlane(threadIdx.x >> 6);
    unsigned char* ws = args.ws;
    unsigned* ctl = (unsigned*)(ws + WS_CTL);
    bf16_t* XN = (bf16_t*)(ws + WS_XN);
    bf16_t* Z = (bf16_t*)(ws + WS_Z);
    bf16_t* XG = (bf16_t*)(ws + WS_XG);
    bf16_t* VT = (bf16_t*)(ws + WS_VT); unsigned* MASK = (unsigned*)(ws + WS_MASK); bf16_t* IK = (bf16_t*)(ws + WS_IK); bf16_t* QL = (bf16_t*)(ws + WS_QL); float* CH = (float*)(ws + WS_CH);
    float* BCUM = (float*)(ws + WS_BCUM); float* SLOC = (float*)(ws + WS_SLOC); float* DEC = (float*)(ws + WS_DEC);
    bf16_t* WIN0 = (bf16_t*)(ws + WS_WIN0); bf16_t* WIN1 = (bf16_t*)(ws + WS_WIN1); bf16_t* WOUT = (bf16_t*)(ws + WS_WOUT); bf16_t* WCQ = (bf16_t*)(ws + WS_WCQ); bf16_t* WCKV = (bf16_t*)(ws + WS_WCKV); bf16_t* WCO = (bf16_t*)(ws + WS_WCO);
    bf16_t* WGU = (bf16_t*)(ws + WS_WGU); bf16_t* WDN = (bf16_t*)(ws + WS_WDN);
    pg8::PG8_LAS_T ldsq = (pg8::PG8_LAS_T)lds_raw;
    bf16_t* HB = (bf16_t*)(ws + WS_HB);
    bf16_t* MIX = (bf16_t*)(ws + WS_MIX);
    bf16_t* DB = (bf16_t*)(ws + WS_DB);
    bf16_t* QN = (bf16_t*)(ws + WS_QN);
    bf16_t* KN = (bf16_t*)(ws + WS_KN);
    bf16_t* CQ = (bf16_t*)(ws + WS_CQ);
    bf16_t* COIN = (bf16_t*)(ws + WS_COIN);
    bf16_t* MEMN = (bf16_t*)(ws + WS_MEMN);
    bf16_t* CKV = (bf16_t*)(ws + WS_CKV);
    bf16_t* CKN = (bf16_t*)(ws + WS_CKN);
    bf16_t* CVT = (bf16_t*)(ws + WS_CVT);
    int* tok_e = (int*)(ws + WS_ROUTE);
    int* CNTT = (int*)(ws + WS_ROUTE + 768 * 1024);
    bf16_t* WRT = (bf16_t*)(ws + WS_ROUTE + 512 * 1024);
    int* tok_r = tok_e + 2 * T;
    float* tok_g = (float*)(tok_r + 2 * T);
    float* OUT = args.out;
    XcdBarrier bar; bar.bar = ctl + CW_BAR; bar.x = 0; bar.st = nullptr;
    if (KSEL < 0) {
        volatile LAS unsigned* st = (volatile LAS unsigned*)((LAS unsigned char*)lds_raw + LDSCTL_OFF);
        if (threadIdx.x < 64) st[threadIdx.x] = 0u;
        __syncthreads();
        bar = xcd_barrier_post(ctl + CW_BAR, st);
    }

#ifndef MK_REPEAT_PH
#define MK_REPEAT_PH (-1)
#define MK_REPEAT_N 0
#endif
#ifdef MK_XBAR
    if (KSEL < 0) for (int xb = 0; xb < MK_XBAR; ++xb) xcd_barrier(bar);
#endif
    const int nvirt = (args.ph_hi - args.ph_lo) + ((MK_REPEAT_PH >= 0) ? MK_REPEAT_N : 0);
    for (int vi = 0; vi < nvirt; ++vi) {
        const int ph = (MK_REPEAT_PH < 0 || vi <= MK_REPEAT_PH) ? args.ph_lo + vi : ((vi <= MK_REPEAT_PH + MK_REPEAT_N) ? MK_REPEAT_PH : args.ph_lo + vi - MK_REPEAT_N);
        const int rep = (MK_REPEAT_PH >= 0 && vi > MK_REPEAT_PH && vi <= MK_REPEAT_PH + MK_REPEAT_N) ? vi - MK_REPEAT_PH : 0;
        if (KSEL < 0 && ph >= NP && (ph % NP) == 0) continue;
        if (KSEL < 0 && vi > 0) xcd_barrier(bar);
        int tid_op = wave_s * 64 + (int)__builtin_amdgcn_mbcnt_hi(~0u, __builtin_amdgcn_mbcnt_lo(~0u, 0u)); asm volatile("" : "+v"(tid_op));
        const int tid = tid_op, lane = tid & 63, wave = __builtin_amdgcn_readfirstlane(tid >> 6), gw = bid * NWAVES + wave;
#ifdef MK_PROF_A
        if (bid == 0 && tid == 0) ctl[8192 + ph] = (unsigned)__builtin_amdgcn_s_memrealtime();
#endif
        const int l = ph / NP, k = (KSEL >= 0) ? KSEL : (ph % NP);
        const float* xin = (l == 0) ? args.in[0] : OUT;
        unsigned* cnt = ctl + CW_CNT + 64 * l;

        if (k == 0 && PH_ON(0)) {
            const float* g = args.in[3] + l * D_MODEL;
            for (int r = gw; r < T; r += NGW) rmsnorm_row_bf16(xin + (size_t)r * D_MODEL, g, XN + (size_t)r * D_MODEL, lane);
            if (l == 0) {
                float* scr = ldsf + wave * (64 * 33);
                constexpr int I_IN = 16 * 112, I_OUT = 16 * 32, I_CQ = 16 * 8, I_CKV = 16 * 16, I_CO = 4 * 32, I_L = I_IN + I_OUT + I_CQ + I_CKV + I_CO;
                for (int it = gw; it < DEPTH * I_L; it += NGW) {
                    const int ll = it / I_L; int r = it % I_L;
                    if (r < I_IN) { transpose_item(args.in[4] + (size_t)ll * D_MODEL * D_IN, D_MODEL, D_IN, 112, (ll == 0 ? WIN0 : WIN1), 0, 1, 0, scr, r, lane); continue; } r -= I_IN;
                    if (r < I_OUT) { transpose_item(args.in[14] + (size_t)ll * D_MODEL * D_MODEL, D_MODEL, D_MODEL, 32, WOUT + (size_t)ll * D_MODEL * D_MODEL, 0, 1, 0, scr, r, lane); continue; } r -= I_OUT;
                    if (r < I_CQ) { transpose_item(args.in[17] + (size_t)ll * D_MODEL * XW, D_MODEL, XW, 8, WCQ + (size_t)ll * XW * D_MODEL, 0, 1, 0, scr, r, lane); continue; } r -= I_CQ;
                    if (r < I_CKV) { transpose_item(args.in[18] + (size_t)ll * D_MODEL * 512, D_MODEL, 512, 16, WCKV + (size_t)ll * 512 * D_MODEL, 0, 1, 0, scr, r, lane); continue; } r -= I_CKV;
                    transpose_item(args.in[21] + (size_t)ll * XW * D_MODEL, XW, D_MODEL, 32, WCO + (size_t)ll * D_MODEL * XW, 0, 1, 0, scr, r, lane);
                }
            }
            if (l == 0)
                for (int i = bid * NTHREADS + tid; i < DEPTH * 32 * (D_MODEL / 8); i += G * NTHREADS) {
                    const int k8 = (i % (D_MODEL / 8)) * 8, n = (i / (D_MODEL / 8)) % 32, ll = i / (32 * (D_MODEL / 8));
                    float wv[8];
#pragma unroll
                    for (int e = 0; e < 8; ++e) wv[e] = (n < 4) ? args.in[23][((size_t)ll * D_MODEL + k8 + e) * N_GROUPS + n] : ((n < 20) ? args.in[25][((size_t)ll * D_MODEL + k8 + e) * N_EXPERTS + n - 4] : 0.f);
                    uint4 hi, lo;
                    hi.x = pk2(wv[0], wv[1]); hi.y = pk2(wv[2], wv[3]); hi.z = pk2(wv[4], wv[5]); hi.w = pk2(wv[6], wv[7]);
                    lo.x = pk2(wv[0] - __uint_as_float(hi.x << 16), wv[1] - __uint_as_float(hi.x & 0xffff0000u)); lo.y = pk2(wv[2] - __uint_as_float(hi.y << 16), wv[3] - __uint_as_float(hi.y & 0xffff0000u));
                    lo.z = pk2(wv[4] - __uint_as_float(hi.z << 16), wv[5] - __uint_as_float(hi.z & 0xffff0000u)); lo.w = pk2(wv[6] - __uint_as_float(hi.w << 16), wv[7] - __uint_as_float(hi.w & 0xffff0000u));
                    *(uint4*)(WRT + ((size_t)(ll * 2) * 32 + n) * D_MODEL + k8) = hi; *(uint4*)(WRT + ((size_t)(ll * 2 + 1) * 32 + n) * D_MODEL + k8) = lo;
                }
            if (l == 0)
                for (int r = gw; r < 2 * BATCH * MEM_LEN; r += NGW) {
                    const int ll = r / (BATCH * MEM_LEN), rr = r % (BATCH * MEM_LEN);
                    rmsnorm_row_bf16(args.in[1] + (size_t)rr * D_MODEL, args.in[16] + ll * D_MODEL, MEMN + (size_t)r * D_MODEL, lane);
                }
        } else if (k == 1 && PH_ON(1)) {
            {
                pg8::Gemm g{XN, l == 0 ? WIN0 : WIN1, T, ZLD, D_MODEL};
                pg8::InprojSched S; S.base.init(T, ZLD, G, bid); S.extra = (l == 0) ? 16 : 0;
                pg8::EpiInproj E{Z, CKV};
                pg8::gemm_phase<pg8::EpiInproj, pg8::InprojSched, true, true>(tid, ldsq, g, S, E);
            }
        } else if (k == 2 && PH_ON(2)) {
#ifndef MK_P2C
#define MK_P2C 1
#endif
            for (int rp_mk_p2c = 0; rp_mk_p2c < MK_P2C; ++rp_mk_p2c)
            {
                float* lr = ldsf;
                float* la = ldsf + 1024;
                float* ks = ldsf + 4160;
                float* vs = ldsf + 7488;
                float* seg = ldsf + 13888;
                float* w2t = ldsf + 14272;
                const float* wa2 = args.in[5] + (size_t)l * GLA_RANK * 192;
                const float* ba = args.in[6] + l * 192;
                for (int i = tid; i < 4 * 48 * 4; i += NTHREADS) { const int hd = i / 192, d = (i % 192) % 48, r4 = ((i % 192) / 48) * 4;
                    *(f32x4*)&w2t[(hd * 48 + d) * 16 + r4] = (f32x4){wa2[(r4 + 0) * 192 + hd * 48 + d], wa2[(r4 + 1) * 192 + hd * 48 + d], wa2[(r4 + 2) * 192 + hd * 48 + d], wa2[(r4 + 3) * 192 + hd * 48 + d]}; }
                uint4 pf_lr = make_uint4(0u, 0u, 0u, 0u), pf_k = pf_lr, pf_v0 = pf_lr, pf_v1 = pf_lr;
#define GLA1_FETCH(item_) do { const int bh_ = (item_) >> 6, c_ = (item_) & 63, b_ = bh_ >> 2, h_ = bh_ & 3, tk_ = b_ * SEQ + c_ * 64; \
                    if (tid < 128) pf_lr = *(const uint4*)(Z + (size_t)(tk_ + (tid >> 1)) * ZLD + Z_GLR + (tid & 1) * 8); \
                    if (tid < 384) pf_k = *(const uint4*)(Z + (size_t)(tk_ + tid / 6) * ZLD + Z_GK + h_ * 48 + (tid % 6) * 8); \
                    pf_v0 = *(const uint4*)(Z + (size_t)(tk_ + tid / 12) * ZLD + Z_GV + h_ * 96 + (tid % 12) * 8); \
                    if (tid < 256) pf_v1 = *(const uint4*)(Z + (size_t)(tk_ + (tid + 512) / 12) * ZLD + Z_GV + h_ * 96 + ((tid + 512) % 12) * 8); } while (0)
                if (bid < BATCH * GLA_HEADS * 64) GLA1_FETCH(bid);
                for (int item = bid; item < BATCH * GLA_HEADS * 64; item += G) {
                    const int bh = item >> 6, c = item & 63, b = bh >> 2, h = bh & 3, tok0 = b * SEQ + c * 64;
                    __syncthreads();
                    if (tid < 128) { const int t = tid >> 1, c8 = (tid & 1) * 8; const uint4 u = pf_lr;
                        *(f32x4*)&lr[t * 16 + c8] = (f32x4){__uint_as_float(u.x << 16), __uint_as_float(u.x & 0xffff0000u), __uint_as_float(u.y << 16), __uint_as_float(u.y & 0xffff0000u)};
                        *(f32x4*)&lr[t * 16 + c8 + 4] = (f32x4){__uint_as_float(u.z << 16), __uint_as_float(u.z & 0xffff0000u), __uint_as_float(u.w << 16), __uint_as_float(u.w & 0xffff0000u)}; }
                    if (tid < 384) { const int t = tid / 6, c8 = (tid % 6) * 8; const uint4 u = pf_k;
                        *(f32x4*)&ks[t * 52 + c8] = (f32x4){__uint_as_float(u.x << 16), __uint_as_float(u.x & 0xffff0000u), __uint_as_float(u.y << 16), __uint_as_float(u.y & 0xffff0000u)};
                        *(f32x4*)&ks[t * 52 + c8 + 4] = (f32x4){__uint_as_float(u.z << 16), __uint_as_float(u.z & 0xffff0000u), __uint_as_float(u.w << 16), __uint_as_float(u.w & 0xffff0000u)}; }
                    { const int t = tid / 12, c8 = (tid % 12) * 8; const uint4 u = pf_v0;
                        *(f32x4*)&vs[t * 100 + c8] = (f32x4){__uint_as_float(u.x << 16), __uint_as_float(u.x & 0xffff0000u), __uint_as_float(u.y << 16), __uint_as_float(u.y & 0xffff0000u)};
                        *(f32x4*)&vs[t * 100 + c8 + 4] = (f32x4){__uint_as_float(u.z << 16), __uint_as_float(u.z & 0xffff0000u), __uint_as_float(u.w << 16), __uint_as_float(u.w & 0xffff0000u)}; }
                    if (tid < 256) { const int t = (tid + 512) / 12, c8 = ((tid + 512) % 12) * 8; const uint4 u = pf_v1;
                        *(f32x4*)&vs[t * 100 + c8] = (f32x4){__uint_as_float(u.x << 16), __uint_as_float(u.x & 0xffff0000u), __uint_as_float(u.y << 16), __uint_as_float(u.y & 0xffff0000u)};
                        *(f32x4*)&vs[t * 100 + c8 + 4] = (f32x4){__uint_as_float(u.z << 16), __uint_as_float(u.z & 0xffff0000u), __uint_as_float(u.w << 16), __uint_as_float(u.w & 0xffff0000u)}; }
                    __syncthreads();
                    if (item + G < BATCH * GLA_HEADS * 64) GLA1_FETCH(item + G);
                    const float* w2h = w2t + h * 48 * 16;
                    {
                        const int t = tid >> 3, d0 = (tid & 7) * 6;
                        const f32x4 l0 = *(const f32x4*)&lr[t * 16], l1 = *(const f32x4*)&lr[t * 16 + 4], l2 = *(const f32x4*)&lr[t * 16 + 8], l3 = *(const f32x4*)&lr[t * 16 + 12];
#pragma unroll
                        for (int e = 0; e < 6; ++e) { const int d = d0 + e;
                            const f32x4 w0 = *(const f32x4*)&w2h[d * 16], w1 = *(const f32x4*)&w2h[d * 16 + 4], w2 = *(const f32x4*)&w2h[d * 16 + 8], w3 = *(const f32x4*)&w2h[d * 16 + 12];
                            const float x = ba[h * 48 + d] + (l0[0] * w0[0] + l0[1] * w0[1] + l0[2] * w0[2] + l0[3] * w0[3]) + (l1[0] * w1[0] + l1[1] * w1[1] + l1[2] * w1[2] + l1[3] * w1[3])
                                          + (l2[0] * w2[0] + l2[1] * w2[1] + l2[2] * w2[2] + l2[3] * w2[3]) + (l3[0] * w3[0] + l3[1] * w3[1] + l3[2] * w3[2] + l3[3] * w3[3]);
                            la[t * 49 + d] = (fminf(x, 0.f) - __logf(1.f + __expf(-fabsf(x)))) * (1.f / 16.f); }
                    }
                    __syncthreads();
                    const int cd = tid % 48, cs = tid / 48;
                    if (tid < 384) { float run = 0.f;
#pragma unroll
                        for (int j2 = 0; j2 < 8; ++j2) { run += la[(cs * 8 + j2) * 49 + cd]; la[(cs * 8 + j2) * 49 + cd] = run; }
                        seg[cs * 48 + cd] = run; }
                    __syncthreads();
                    if (tid < 384) { float base = 0.f;
                        for (int q = 0; q < cs; ++q) base += seg[q * 48 + cd];
#pragma unroll
                        for (int j2 = 0; j2 < 8; ++j2) { const float v = la[(cs * 8 + j2) * 49 + cd] + base; la[(cs * 8 + j2) * 49 + cd] = v; BCUM[(size_t)(tok0 + cs * 8 + j2) * 192 + h * 48 + cd] = v; } }
                    __syncthreads();
                    for (int i = tid; i < 64 * 48; i += NTHREADS) { const int t = i / 48, d = i % 48; ks[t * 52 + d] *= __expf(la[63 * 49 + d] - la[t * 49 + d]); }
                    if (tid < 48) DEC[(size_t)item * 48 + tid] = __expf(la[63 * 49 + tid]);
                    __syncthreads();
                    if (tid < 288) {
                        const int d0 = (tid / 24) * 4, v0 = (tid % 24) * 4;
                        float acc[4][4];
#pragma unroll
                        for (int x = 0; x < 4; ++x)
#pragma unroll
                            for (int y = 0; y < 4; ++y) acc[x][y] = 0.f;
#pragma unroll 4
                        for (int sidx = 0; sidx < 64; ++sidx) { const f32x4 kv = *(const f32x4*)&ks[sidx * 52 + d0], vv = *(const f32x4*)&vs[sidx * 100 + v0];
#pragma unroll
                            for (int x = 0; x < 4; ++x)
#pragma unroll
                                for (int y = 0; y < 4; ++y) acc[x][y] += kv[x] * vv[y]; }
#pragma unroll
                        for (int y = 0; y < 4; ++y) *(f32x4*)(SLOC + (size_t)item * 4608 + (v0 + y) * 48 + d0) = (f32x4){acc[0][y], acc[1][y], acc[2][y], acc[3][y]};
                    }
                }
                __syncthreads();
            }
#ifndef MK_P2A
#define MK_P2A 1
#endif
            for (int rp_mk_p2a = 0; rp_mk_p2a < MK_P2A; ++rp_mk_p2a)
            {
                const float* gq = args.in[8] + l * DSA_DH; const float* gk = args.in[9] + l * DSA_DH;
                for (int it = bid * NTHREADS + tid; it < T * 12; it += G * NTHREADS) {
                    const int tok = it / 12, jj = it % 12, isk = jj / 6, hd = jj % 6;
                    const uint4* src = (const uint4*)(Z + (size_t)tok * ZLD + (isk ? Z_DK : Z_DQ) + hd * 64);
                    uint4 u[8]; float ss = 0.f;
#pragma unroll
                    for (int c = 0; c < 8; ++c) { u[c] = src[c];
                        const float a0 = __uint_as_float(u[c].x << 16), a1 = __uint_as_float(u[c].x & 0xffff0000u), a2 = __uint_as_float(u[c].y << 16), a3 = __uint_as_float(u[c].y & 0xffff0000u);
                        const float a4 = __uint_as_float(u[c].z << 16), a5 = __uint_as_float(u[c].z & 0xffff0000u), a6 = __uint_as_float(u[c].w << 16), a7 = __uint_as_float(u[c].w & 0xffff0000u);
                        ss += a0 * a0 + a1 * a1 + a2 * a2 + a3 * a3 + a4 * a4 + a5 * a5 + a6 * a6 + a7 * a7; }
                    const float rn = (isk ? 1.0f : (0.125f * 1.4426950408889634f)) / sqrtf(ss * (1.f / 64.f) + NORM_EPS);
                    const float* gp = isk ? gk : gq;
                    uint4* dst = (uint4*)((isk ? KN : QN) + (size_t)tok * 384 + hd * 64);
#pragma unroll
                    for (int c = 0; c < 8; ++c) { const f32x4 g0 = *(const f32x4*)(gp + c * 8), g1 = *(const f32x4*)(gp + c * 8 + 4);
                        uint4 o;
                        o.x = pk2(__uint_as_float(u[c].x << 16) * rn * g0[0], __uint_as_float(u[c].x & 0xffff0000u) * rn * g0[1]);
                        o.y = pk2(__uint_as_float(u[c].y << 16) * rn * g0[2], __uint_as_float(u[c].y & 0xffff0000u) * rn * g0[3]);
                        o.z = pk2(__uint_as_float(u[c].z << 16) * rn * g1[0], __uint_as_float(u[c].z & 0xffff0000u) * rn * g1[1]);
                        o.w = pk2(__uint_as_float(u[c].w << 16) * rn * g1[2], __uint_as_float(u[c].w & 0xffff0000u) * rn * g1[3]);
                        dst[c] = o; }
                }
                for (int it = bid * NTHREADS + tid; it < T * 8; it += G * NTHREADS) {
                    const int tok = it >> 3, c8 = (it & 7) * 8;
                    const bf16_t* zr = Z + (size_t)tok * ZLD;
                    const uint4 wu = *(const uint4*)(zr + Z_IW);
                    const float cw[8] = {__uint_as_float(wu.x << 16), __uint_as_float(wu.x & 0xffff0000u), __uint_as_float(wu.y << 16), __uint_as_float(wu.y & 0xffff0000u),
                                         __uint_as_float(wu.z << 16), __uint_as_float(wu.z & 0xffff0000u), __uint_as_float(wu.w << 16), __uint_as_float(wu.w & 0xffff0000u)};
                    float ql[8];
#pragma unroll
                    for (int e = 0; e < 8; ++e) ql[e] = 0.f;
#pragma unroll
                    for (int hq = 0; hq < IDX_HEADS; ++hq) { const float c = cw[hq] * (0.35355339059327373f * 0.0625f); const uint4 qu = *(const uint4*)(zr + Z_IQ + hq * 64 + c8);
                        ql[0] += c * __uint_as_float(qu.x << 16); ql[1] += c * __uint_as_float(qu.x & 0xffff0000u); ql[2] += c * __uint_as_float(qu.y << 16); ql[3] += c * __uint_as_float(qu.y & 0xffff0000u);
                        ql[4] += c * __uint_as_float(qu.z << 16); ql[5] += c * __uint_as_float(qu.z & 0xffff0000u); ql[6] += c * __uint_as_float(qu.w << 16); ql[7] += c * __uint_as_float(qu.w & 0xffff0000u); }
                    uint4 o; o.x = pk2(ql[0], ql[1]); o.y = pk2(ql[2], ql[3]); o.z = pk2(ql[4], ql[5]); o.w = pk2(ql[6], ql[7]);
                    *(uint4*)(QL + (size_t)tok * 64 + c8) = o;
                    *(uint4*)(IK + (size_t)tok * 64 + c8) = *(const uint4*)(zr + Z_IK + c8);
                    if (c8 == 0) { *(f32x4*)(CH + (size_t)tok * 8) = (f32x4){cw[0], cw[1], cw[2], cw[3]} * (0.35355339059327373f * 0.0625f); *(f32x4*)(CH + (size_t)tok * 8 + 4) = (f32x4){cw[4], cw[5], cw[6], cw[7]} * (0.35355339059327373f * 0.0625f); }
                }
            }
#ifndef MK_P2E
#define MK_P2E 1
#endif
            for (int rp_mk_p2e = 0; rp_mk_p2e < MK_P2E; ++rp_mk_p2e)
            for (int tile = bid; tile < BATCH * 128; tile += G) {
                if (tid < 384) {
                    const bf16_t* zb = Z + (size_t)(tile * 32) * ZLD + Z_DV + tid;
                    unsigned w[16];
#pragma unroll
                    for (int p2 = 0; p2 < 16; ++p2) {
                        const int p = 2 * p2, sst = p >> 4, hh2 = (p >> 3) & 1, j = p & 7;
                        const int key0 = 16 * sst + 8 * (j >> 2) + 4 * hh2 + (j & 3);
                        w[p2] = (unsigned)zb[(size_t)key0 * ZLD] | ((unsigned)zb[(size_t)(key0 + 1) * ZLD] << 16);
                    }
                    uint4* dst = (uint4*)(VT + ((size_t)tile * 384 + tid) * 32);
                    dst[0] = make_uint4(w[0], w[1], w[2], w[3]); dst[1] = make_uint4(w[4], w[5], w[6], w[7]); dst[2] = make_uint4(w[8], w[9], w[10], w[11]); dst[3] = make_uint4(w[12], w[13], w[14], w[15]);
                }
            }
            if (l == 0) {
                for (int i = bid * NTHREADS + tid; i < DEPTH * BATCH * X_HEADS * 64 * MEM_LEN; i += G * NTHREADS) {
                    const int p = i & 255, d = (i >> 8) & 63, h = (i >> 14) & 3, bb = (i >> 16) & 3, ll = i >> 18;
                    const int pg = p & 31, sst = pg >> 4, hh2 = (pg >> 3) & 1, j2 = pg & 7;
                    const int key = (p & ~31) + 16 * sst + 8 * (j2 >> 2) + 4 * hh2 + (j2 & 3);
                    CVT[i] = CKV[((size_t)ll * BATCH * MEM_LEN + (size_t)bb * MEM_LEN + key) * 512 + 256 + h * 64 + d];
                }
                for (int r = gw; r < DEPTH * BATCH * MEM_LEN; r += NGW) {
                    const int ll = r / (BATCH * MEM_LEN);
                    const float gkl = args.in[20][ll * X_DH + lane];
#pragma unroll
                    for (int h = 0; h < X_HEADS; ++h) {
                        const float kk = bf2f(CKV[(size_t)r * 512 + h * 64 + lane]);
                        const float rk = 1.0f / sqrtf(wave_sum(kk * kk) * (1.f / 64.f) + NORM_EPS);
                        CKN[(size_t)r * 256 + h * 64 + lane] = f2bf(kk * rk * gkl);
                    }
                }
            }
#ifndef MK_P2B
#define MK_P2B 1
#endif
            for (int rp_mk_p2b = 0; rp_mk_p2b < MK_P2B; ++rp_mk_p2b)
            {
                const float* cw = args.in[10] + (size_t)l * CONV_W * CONV_CH;
                const float* cb = args.in[11] + l * CONV_CH; const float* lg = args.in[12] + l * CONV_CH; const float* lb = args.in[13] + l * CONV_CH;
                float* ct = ldsf + 1024;
                float* hL = ldsf + 1024 + 32 * 256;
                const int c = tid & 255, half = tid >> 8;
                float wreg[CONV_W];
#pragma unroll
                for (int j = 0; j < CONV_W; ++j) wreg[j] = cw[j * CONV_CH + c];
                const float cbias = cb[c];
                for (int item = bid; item < T / 32; item += G) {
                    const int tok0 = item * 32;
                    const int tb = tok0 % SEQ;
                    __syncthreads();
                    for (int i = tid; i < 62 * 32; i += NTHREADS) {
                        const int rr = i >> 5, c8 = (i & 31) * 8, tp = tb - 30 + rr;
                        f32x4 h0 = (f32x4){0.f, 0.f, 0.f, 0.f}, h1 = h0;
                        if (tp >= 0) {
                            const bf16_t* zr = Z + (size_t)(tok0 - 30 + rr) * ZLD + Z_CU + c8;
                            const uint4 au = *(const uint4*)zr, gu = *(const uint4*)(zr + 256);
                            h0[0] = __uint_as_float(au.x << 16) * sigmoidf(__uint_as_float(gu.x << 16)); h0[1] = __uint_as_float(au.x & 0xffff0000u) * sigmoidf(__uint_as_float(gu.x & 0xffff0000u));
                            h0[2] = __uint_as_float(au.y << 16) * sigmoidf(__uint_as_float(gu.y << 16)); h0[3] = __uint_as_float(au.y & 0xffff0000u) * sigmoidf(__uint_as_float(gu.y & 0xffff0000u));
                            h1[0] = __uint_as_float(au.z << 16) * sigmoidf(__uint_as_float(gu.z << 16)); h1[1] = __uint_as_float(au.z & 0xffff0000u) * sigmoidf(__uint_as_float(gu.z & 0xffff0000u));
                            h1[2] = __uint_as_float(au.w << 16) * sigmoidf(__uint_as_float(gu.w << 16)); h1[3] = __uint_as_float(au.w & 0xffff0000u) * sigmoidf(__uint_as_float(gu.w & 0xffff0000u));
                        }
                        *(f32x4*)&hL[rr * 256 + c8] = h0; *(f32x4*)&hL[rr * 256 + c8 + 4] = h1;
                    }
                    __syncthreads();
                    {
                        float hwin[46];
#pragma unroll
                        for (int i = 0; i < 46; ++i) hwin[i] = hL[(half * 16 + i) * 256 + c];
#pragma unroll
                        for (int o = 0; o < 16; ++o) {
                            float a = cbias;
#pragma unroll
                            for (int j = 0; j < CONV_W; ++j) a += hwin[o + j] * wreg[j];
                            ct[(half * 16 + o) * 256 + c] = a;
                        }
                    }
                    __syncthreads();
#pragma unroll
                    for (int i = 0; i < 4; ++i) {
                        const int tt = wave * 4 + i;
                        const f32x4 v = *(const f32x4*)&ct[tt * 256 + lane * 4];
                        const float mu = wave_sum(v[0] + v[1] + v[2] + v[3]) * (1.f / 256.f);
                        const f32x4 dv = v - mu;
                        const float var = wave_sum(dv[0] * dv[0] + dv[1] * dv[1] + dv[2] * dv[2] + dv[3] * dv[3]) * (1.f / 256.f);
                        const float rstd = 1.0f / sqrtf(var + NORM_EPS);
                        const f32x4 gg = *(const f32x4*)(lg + lane * 4), bb = *(const f32x4*)(lb + lane * 4);
                        f32x4 y = dv * rstd * gg + bb;
                        uint2 o; o.x = pk2(siluf(y[0]), siluf(y[1])); o.y = pk2(siluf(y[2]), siluf(y[3]));
                        *(uint2*)(MIX + (size_t)(tok0 + tt) * D_MODEL + MIX_CONV + lane * 4) = o;
                    }
                }
            }
        } else if (k == 3 && PH_ON(3)) {
            if (rep == 0)
            for (int e = bid * NTHREADS + tid; e < BATCH * GLA_HEADS * 4608; e += G * NTHREADS) {
                const int bh = e / 4608, idx = e % 4608, d = idx % 48;
                float state = 0.f;
#pragma unroll 16
                for (int c = 0; c < 64; ++c) {
                    const size_t it = (size_t)bh * 64 + c;
                    const float tmp = SLOC[it * 4608 + idx], dec = DEC[it * 48 + d];
                    SLOC[it * 4608 + idx] = state; state = dec * state + tmp; }
            }
            {
                unsigned* hist32 = (unsigned*)lds_raw;
                constexpr int HSTR = 1028;
                unsigned* rs = (unsigned*)(lds_raw + 32 * HSTR * 4);
                volatile unsigned* qsh = (volatile unsigned*)(lds_raw + LDSCTL_OFF + 64);
                unsigned* qhead = ctl + CW_Q3 + 64 * l + rep;
                const int qc = lane & 15, g4 = lane >> 4, qh = wave >> 2, kg = wave & 3;
                const int row = 16 * qh + qc;
                for (;;) {
                    __syncthreads();
                    if (tid == 0) qsh[0] = atomicAdd(qhead, 1u);
                    __syncthreads();
                    const int it = (int)qsh[0];
                    if (it >= BATCH * 128) break;
                    const int b = it & 3, qt = 127 - (it >> 2);
                    const int tokb = b * SEQ, q0 = qt * 32, tq = q0 + row;
                    bf16x8 qf[9][2];
                    {
                        const bf16_t* zq = Z + (size_t)(tokb + tq) * ZLD + Z_IQ + g4 * 8;
#pragma unroll
                        for (int h = 0; h < 8; ++h)
#pragma unroll
                            for (int ks = 0; ks < 2; ++ks) qf[h][ks] = *(const bf16x8*)(zq + h * 64 + ks * 32);
                        const bf16_t* ql = QL + (size_t)(tokb + tq) * 64 + g4 * 8;
#pragma unroll
                        for (int ks = 0; ks < 2; ++ks) qf[8][ks] = *(const bf16x8*)(ql + ks * 32);
                    }
                    float ch[8];
                    { const f32x4 c0 = *(const f32x4*)(CH + (size_t)(tokb + tq) * 8), c1 = *(const f32x4*)(CH + (size_t)(tokb + tq) * 8 + 4);
                      ch[0] = c0[0]; ch[1] = c0[1]; ch[2] = c0[2]; ch[3] = c0[3]; ch[4] = c1[0]; ch[5] = c1[1]; ch[6] = c1[2]; ch[7] = c1[3]; }
                    if (qt < 8) {
                        if (rep == 0 && kg == 0 && g4 == 0) for (int kt = 0; kt <= qt; ++kt) MASK[((size_t)(b * 128) + kt) * SEQ + tq] = (kt < qt || row == 31) ? 0xffffffffu : ((1u << (row + 1)) - 1u);
                        continue;
                    }
#pragma unroll
                    for (int i = 0; i < 16; ++i) ((uint4*)hist32)[tid + 512 * i] = make_uint4(0u, 0u, 0u, 0u);
                    if (tid < 32) ((uint4*)hist32)[8192 + tid] = make_uint4(0u, 0u, 0u, 0u);
                    if (tid < 32) { rs[tid] = 0u; rs[32 + tid] = TOPK; rs[64 + tid] = 0u; rs[96 + tid] = 0u; }
                    __syncthreads();
#define DSA_SCORE(kt_) \
                        f32x4 sc[2]; \
                        { const bf16_t* kp = IK + (size_t)(tokb + (kt_) * 32 + qc) * 64 + g4 * 8; \
                          bf16x8 kf[2][2]; \
                          _Pragma("unroll") for (int u = 0; u < 2; ++u) _Pragma("unroll") for (int ks = 0; ks < 2; ++ks) kf[u][ks] = *(const bf16x8*)(kp + u * 16 * 64 + ks * 32); \
                          _Pragma("unroll") for (int u = 0; u < 2; ++u) { sc[u] = (f32x4){0.f, 0.f, 0.f, 0.f}; \
                              _Pragma("unroll") for (int ks = 0; ks < 2; ++ks) sc[u] = __builtin_amdgcn_mfma_f32_16x16x32_bf16(kf[u][ks], qf[8][ks], sc[u], 0, 0, 0); } \
                          _Pragma("unroll") for (int h = 0; h < 8; ++h) _Pragma("unroll") for (int u = 0; u < 2; ++u) { f32x4 a = (f32x4){0.f, 0.f, 0.f, 0.f}; \
                              _Pragma("unroll") for (int ks = 0; ks < 2; ++ks) a = __builtin_amdgcn_mfma_f32_16x16x32_bf16(kf[u][ks], qf[h][ks], a, 0, 0, 0); \
                              _Pragma("unroll") for (int i = 0; i < 4; ++i) sc[u][i] = __builtin_fmaf(fabsf(a[i]), ch[h], sc[u][i]); } }
                    for (int pass = 0; pass < 2; ++pass) {
                        const unsigned mmask = (pass == 0) ? 0u : 0xFFE00000u;
                        const int bshift = (pass == 0) ? 21 : 10;
                        const unsigned bmask = 2047u;
                        const unsigned prefm = rs[row];
                        for (int kt = kg; kt <= qt; kt += 4) {
                            DSA_SCORE(kt)
#pragma unroll
                            for (int u = 0; u < 2; ++u)
#pragma unroll
                                for (int i = 0; i < 4; ++i) {
                                    const int sidx = kt * 32 + 16 * u + 4 * g4 + i;
                                    const unsigned key = fkey(sc[u][i]);
                                    if (sidx <= tq && (key & mmask) == prefm) { const unsigned bin = (key >> bshift) & bmask; if (rep < 2) atomicAdd(&hist32[row * HSTR + (bin >> 1)], 1u << ((bin & 1u) * 16u)); else asm volatile("" :: "v"(bin)); }
                                }
                        }
                        __syncthreads();
                        for (int rr = 0; rr < 4; ++rr) {
                            const int R = wave * 4 + rr;
                            const unsigned kremR = rs[32 + R];
                            const uint4* hw = (const uint4*)(hist32 + R * HSTR + lane * 16);
                            unsigned cntl = 0u;
#pragma unroll
                            for (int q4 = 0; q4 < 4; ++q4) { const uint4 w = hw[q4]; cntl += (w.x & 0xffffu) + (w.x >> 16) + (w.y & 0xffffu) + (w.y >> 16) + (w.z & 0xffffu) + (w.z >> 16) + (w.w & 0xffffu) + (w.w >> 16); }
                            unsigned suf = cntl;
#pragma unroll
                            for (int o = 1; o < 64; o <<= 1) { const unsigned tv = __shfl_down(suf, o); if (lane + o < 64) suf += tv; }
                            const unsigned excl = suf - cntl;
                            if (excl < kremR && kremR <= suf) {
                                unsigned above = excl, eq = 0u; int bin = 0;
#pragma unroll 1
                                for (int i = 15; i >= 0; --i) { const unsigned w = hist32[R * HSTR + lane * 16 + i]; const unsigned hi = w >> 16, lo = w & 0xffffu;
                                    if (above + hi >= kremR) { bin = 2 * (lane * 16 + i) + 1; eq = hi; break; } above += hi;
                                    if (above + lo >= kremR) { bin = 2 * (lane * 16 + i); eq = lo; break; } above += lo; }
                                rs[R] = rs[R] | ((unsigned)bin << bshift); rs[32 + R] = kremR - above; rs[64 + R] = eq;
                            }
                        }
                        __syncthreads();
#pragma unroll
                        for (int i = 0; i < 16; ++i) ((uint4*)hist32)[tid + 512 * i] = make_uint4(0u, 0u, 0u, 0u);
                        if (tid < 32) ((uint4*)hist32)[8192 + tid] = make_uint4(0u, 0u, 0u, 0u);
                        __syncthreads();
                    }
                    {
                        const unsigned tau = rs[row]; const bool tiecrit = rs[64 + row] > rs[32 + row];
                        unsigned* mcol = MASK + (size_t)(b * 128) * SEQ + tq;
                        for (int kt = kg; kt <= qt; kt += 4) {
                            DSA_SCORE(kt)
                            unsigned bits = 0u;
#pragma unroll
                            for (int u = 0; u < 2; ++u)
#pragma unroll
                                for (int i = 0; i < 4; ++i) {
                                    const int sidx = kt * 32 + 16 * u + 4 * g4 + i;
                                    const unsigned key = fkey(sc[u][i]), key22 = key & 0xFFFFFC00u;
                                    const bool valid = sidx <= tq;
                                    if (valid && (key22 > tau || (key22 == tau && !tiecrit))) bits |= 1u << (16 * u + 4 * g4 + i);
                                    if (valid && key22 == tau && tiecrit) { const unsigned idx = atomicAdd(&rs[96 + row], 1u); if (idx < 511u) { hist32[row * HSTR + 2 * idx] = key; hist32[row * HSTR + 2 * idx + 1] = (unsigned)sidx; } }
                                }
                            bits |= (unsigned)__shfl_xor((int)bits, 16);
                            bits |= (unsigned)__shfl_xor((int)bits, 32);
                            if (g4 == 0 && rep == 0) mcol[(size_t)kt * SEQ] = bits;
                        }
                        asm volatile("s_waitcnt vmcnt(0)" ::: "memory");
                        __syncthreads();
                        if (rep == 0 && tid < 32 && rs[64 + tid] > rs[32 + tid]) {
                            int tdx = tid; asm volatile("" : "+v"(tdx));
                            unsigned nl = rs[96 + tid]; if (nl > 511u) nl = 511u;
                            const unsigned need = rs[32 + tid];
                            unsigned* lst = hist32 + tdx * HSTR;
                            for (unsigned q = 0; q < need && q < nl; ++q) {
                                unsigned bk = 0u, bs = 0xffffffffu, bi = 0u;
                                for (unsigned e2 = 0; e2 < nl; ++e2) { const unsigned kv = lst[2 * e2], sv = lst[2 * e2 + 1]; if (sv != 0xffffffffu && (kv > bk || (kv == bk && sv < bs))) { bk = kv; bs = sv; bi = e2; } }
                                lst[2 * bi + 1] = 0xffffffffu;
                                if (bs != 0xffffffffu) atomicOr(MASK + ((size_t)(b * 128) + (bs >> 5)) * SEQ + q0 + tdx, 1u << (bs & 31u));
                            }
                        }
                    }
#undef DSA_SCORE
                }
            }
        } else if (k == 4 && PH_ON(4)) {
            float* qt = ldsf;
            float* kt = qt + 64 * 49;
            float* vs = kt + 64 * 49;
            float* Am = vs + 64 * 97;
            float* Sin = Am + 64 * 65;
            const float* gon = args.in[7] + l * GLA_DV;
            volatile unsigned* qsh = (volatile unsigned*)(lds_raw + LDSCTL_OFF + 64);
            unsigned* qhead = ctl + CW_Q4 + 64 * l + rep;
            float* biasd = (float*)(lds_raw + 131072);
            for (int i = tid; i < 6 * 224; i += NTHREADS) { const int h = i / 224, d = i % 224 - 32; biasd[i] = d < 0 ? 0.f : args.in[2][t5_bucket(d) * DSA_HEADS + h] * 1.4426950408889634f; }
            constexpr int N_ATT = BATCH * 32 * 3;
            for (;;) {
                __syncthreads();
                if (tid == 0) qsh[0] = atomicAdd(qhead, 1u);
                __syncthreads();
                const int qit = (int)qsh[0];
#ifndef MK_GLA2_REP
#define MK_GLA2_REP 1
#endif
                if (qit >= N_ATT + MK_GLA2_REP * BATCH * GLA_HEADS * 64) break;
                if (qit < N_ATT) {
                    const int qt = 31 - qit / 12, rem = qit % 12, b = rem & 3, h0 = 2 * (rem >> 2);
                    const int tokb = b * SEQ, q0 = qt * 128, nkt = 4 * (qt + 1);
                    int tid_a = tid; asm volatile("" : "+v"(tid_a));
                    const int la = tid_a & 63, r = la & 31, hh = la >> 5;
                    const int qg = wave & 3, hd = wave >> 2, h = h0 + hd;
                    const int tq = q0 + 32 * qg + r;
                    LDSAS unsigned char* lb = (LDSAS unsigned char*)lds_raw;
                    LDSAS unsigned* maskl = (LDSAS unsigned*)(lb + 65536);
                    for (int idx = tid_a; idx < nkt * 128; idx += NTHREADS) maskl[idx] = MASK[((size_t)(b * 128) + (idx >> 7)) * SEQ + q0 + (idx & 127)];
                    bf16x8 qf[4];
#pragma unroll
                    for (int ks = 0; ks < 4; ++ks) qf[ks] = *(const bf16x8*)(QN + (size_t)(tokb + tq) * 384 + h * 64 + ks * 16 + hh * 8);
                    f32x16 oacc[2];
#pragma unroll
                    for (int dt = 0; dt < 2; ++dt)
#pragma unroll
                        for (int i = 0; i < 16; ++i) oacc[dt][i] = 0.f;
                    float lsum = 0.f;
                    const int krow = 4 * wave + (la >> 4), kpos = la & 15;
                    const int vrow = 16 * wave + (la >> 2), vpos = la & 3;
                    const char* ksrc = (const char*)KN + ((size_t)(tokb + krow) * 384 + h0 * 64) * 2 + ((kpos ^ (krow & 15)) * 16);
                    const char* vsrc = (const char*)VT + ((size_t)(b * 128) * 384 + h0 * 64 + vrow) * 64 + ((vpos ^ ((vrow >> 2) & 3)) * 16);
                    int koff[4], voff[2][2];
#pragma unroll
                    for (int ks = 0; ks < 4; ++ks) koff[ks] = r * 256 + (((hd * 8 + ks * 2 + hh) ^ (r & 15)) * 16);
#pragma unroll
                    for (int dt = 0; dt < 2; ++dt)
#pragma unroll
                        for (int sst = 0; sst < 2; ++sst) { const int vr = hd * 64 + dt * 32 + r; voff[dt][sst] = 8192 + vr * 64 + (((2 * sst + hh) ^ ((vr >> 2) & 3)) * 16); }
#define ATT_ISSUE(kt_, st_) do { const int ktc = (kt_) < nkt ? (kt_) : nkt - 1; \
                        __builtin_amdgcn_global_load_lds((const unsigned*)(ksrc + (size_t)ktc * (32 * 768)), (LDSAS unsigned*)(lb + (st_) * 16384 + wave * 1024), 16, 0, 0); \
                        __builtin_amdgcn_global_load_lds((const unsigned*)(vsrc + (size_t)ktc * (384 * 64)), (LDSAS unsigned*)(lb + (st_) * 16384 + 8192 + wave * 1024), 16, 0, 0); } while (0)
                    __syncthreads();
                    ATT_ISSUE(0, 0); ATT_ISSUE(1, 1); ATT_ISSUE(2, 2);
                    for (int kt = 0; kt < nkt; ++kt) {
                        asm volatile("s_waitcnt vmcnt(4)" ::: "memory");
                        __builtin_amdgcn_s_barrier();
                        asm volatile("" ::: "memory");
                        ATT_ISSUE(kt + 3, (kt + 3) & 3);
                        if (kt * 32 <= q0 + 32 * qg + 31) {
                            LDSAS unsigned char* st = lb + (kt & 3) * 16384;
                            const unsigned mwh = maskl[kt * 128 + 32 * qg + r] >> (4 * hh);
                            const int mind = (q0 + 32 * qg) - (kt * 32 + 31);
                            f32x16 S;
#pragma unroll
                            for (int i = 0; i < 16; ++i) S[i] = 0.f;
#pragma unroll
                            for (int ks = 0; ks < 4; ++ks) { const bf16x8 a = *(const LDSAS bf16x8*)(st + koff[ks]); S = MFMA32(a, qf[ks], S); }
                            float p[16];
                            if (mind >= 113) {
                                const float bu = biasd[h * 224 + 223];
#pragma unroll
                                for (int i = 0; i < 16; ++i) p[i] = __uint_as_float(__float_as_uint(__builtin_amdgcn_exp2f(S[i] + bu)) & (unsigned)__builtin_amdgcn_sbfe((int)mwh, (i & 3) + 8 * (i >> 2), 1));
                            } else {
                                const float* bp = biasd + h * 224 + (tq - kt * 32 - 4 * hh + 5);
#pragma unroll
                                for (int i = 0; i < 16; ++i) p[i] = __uint_as_float(__float_as_uint(__builtin_amdgcn_exp2f(S[i] + bp[27 - (i & 3) - 8 * (i >> 2)])) & (unsigned)__builtin_amdgcn_sbfe((int)mwh, (i & 3) + 8 * (i >> 2), 1));
                            }
                            float ps = 0.f;
#pragma unroll
                            for (int i = 0; i < 16; ++i) ps += p[i];
                            lsum += ps;
                            uint4 u0, u1;
                            u0.x = pkbf(p[0], p[1]); u0.y = pkbf(p[2], p[3]); u0.z = pkbf(p[4], p[5]); u0.w = pkbf(p[6], p[7]);
                            u1.x = pkbf(p[8], p[9]); u1.y = pkbf(p[10], p[11]); u1.z = pkbf(p[12], p[13]); u1.w = pkbf(p[14], p[15]);
                            const bf16x8 pf0 = __builtin_bit_cast(bf16x8, u0), pf1 = __builtin_bit_cast(bf16x8, u1);
#pragma unroll
                            for (int dt = 0; dt < 2; ++dt) {
                                const bf16x8 a0 = *(const LDSAS bf16x8*)(st + voff[dt][0]);
                                const bf16x8 a1 = *(const LDSAS bf16x8*)(st + voff[dt][1]);
                                oacc[dt] = MFMA32(a0, pf0, oacc[dt]);
                                oacc[dt] = MFMA32(a1, pf1, oacc[dt]);
                            }
                        }
                    }
#undef ATT_ISSUE
                    asm volatile("s_waitcnt vmcnt(0)" ::: "memory");
                    {
                        const float lt = lsum + __shfl_xor(lsum, 32);
                        float inv = 1.f / lt;
                        bf16_t* mo = MIX + (size_t)(tokb + tq) * D_MODEL + MIX_DSA + h * 64;
#pragma unroll
                        for (int dt = 0; dt < 2; ++dt)
#pragma unroll
                            for (int g4 = 0; g4 < 4; ++g4) {
                                uint2 o; o.x = pkbf(oacc[dt][4 * g4] * inv, oacc[dt][4 * g4 + 1] * inv); o.y = pkbf(oacc[dt][4 * g4 + 2] * inv, oacc[dt][4 * g4 + 3] * inv);
                                *(uint2*)(mo + dt * 32 + 8 * g4 + 4 * hh) = o;
                            }
                    }
                    continue;
                }
                const int item = (qit - N_ATT) % (BATCH * GLA_HEADS * 64);
                const int bh = item >> 6, c = item & 63, b = bh >> 2, h = bh & 3, tok0 = b * SEQ + c * 64;
                int tid_g = tid; asm volatile("" : "+v"(tid_g));
                __syncthreads();
                {
                    LDSAS unsigned char* lb = (LDSAS unsigned char*)lds_raw;
                    constexpr int QS_OFF = 0, KS_OFF = 7168, VT_OFF = 14336, ST_OFF = 28160, SQ_OFF = 38912;
                    if (tid_g < 384) {
                        const int t = tid_g / 6, c8 = (tid_g % 6) * 8;
                        const bf16_t* zr = Z + (size_t)(tok0 + t) * ZLD;
                        const uint4 qu = *(const uint4*)(zr + Z_GQ + h * 48 + c8), ku = *(const uint4*)(zr + Z_GK + h * 48 + c8);
                        const f32x4 b0 = *(const f32x4*)(BCUM + (size_t)(tok0 + t) * 192 + h * 48 + c8), b1 = *(const f32x4*)(BCUM + (size_t)(tok0 + t) * 192 + h * 48 + c8 + 4);
                        const float e0 = __expf(b0[0]), e1 = __expf(b0[1]), e2 = __expf(b0[2]), e3 = __expf(b0[3]), e4 = __expf(b1[0]), e5 = __expf(b1[1]), e6 = __expf(b1[2]), e7 = __expf(b1[3]);
                        const float qs = 0.14433756729740643f;
                        u32x4v qo, ko;
                        qo.x = pkbf(__uint_as_float(qu.x << 16) * qs * e0, __uint_as_float(qu.x & 0xffff0000u) * qs * e1); qo.y = pkbf(__uint_as_float(qu.y << 16) * qs * e2, __uint_as_float(qu.y & 0xffff0000u) * qs * e3);
                        qo.z = pkbf(__uint_as_float(qu.z << 16) * qs * e4, __uint_as_float(qu.z & 0xffff0000u) * qs * e5); qo.w = pkbf(__uint_as_float(qu.w << 16) * qs * e6, __uint_as_float(qu.w & 0xffff0000u) * qs * e7);
                        ko.x = pkbf(__uint_as_float(ku.x << 16) / e0, __uint_as_float(ku.x & 0xffff0000u) / e1); ko.y = pkbf(__uint_as_float(ku.y << 16) / e2, __uint_as_float(ku.y & 0xffff0000u) / e3);
                        ko.z = pkbf(__uint_as_float(ku.z << 16) / e4, __uint_as_float(ku.z & 0xffff0000u) / e5); ko.w = pkbf(__uint_as_float(ku.w << 16) / e6, __uint_as_float(ku.w & 0xffff0000u) / e7);
                        *(LDSAS u32x4v*)(lb + QS_OFF + t * 112 + c8 * 2) = qo; *(LDSAS u32x4v*)(lb + KS_OFF + t * 112 + c8 * 2) = ko;
                    }
                    for (int i = tid_g; i < 64 * 12; i += NTHREADS) {
                        const int sidx = i / 12, c8 = (i % 12) * 8;
                        const uint4 vu = *(const uint4*)(Z + (size_t)(tok0 + sidx) * ZLD + Z_GV + h * 96 + c8);
                        const int sl = sidx & 31, pp = (sidx & 32) + (sl & 16) + 8 * ((sl >> 2) & 1) + 4 * ((sl >> 3) & 1) + (sl & 3);
                        LDSAS bf16_t* vp = (LDSAS bf16_t*)(lb + VT_OFF) + c8 * 72 + pp;
                        vp[0] = (bf16_t)(vu.x & 0xffffu); vp[72] = (bf16_t)(vu.x >> 16); vp[144] = (bf16_t)(vu.y & 0xffffu); vp[216] = (bf16_t)(vu.y >> 16);
                        vp[288] = (bf16_t)(vu.z & 0xffffu); vp[360] = (bf16_t)(vu.z >> 16); vp[432] = (bf16_t)(vu.w & 0xffffu); vp[504] = (bf16_t)(vu.w >> 16);
                    }
                    for (int i = tid_g; i < 96 * 6; i += NTHREADS) {
                        const int v = i / 6, c8 = (i % 6) * 8;
                        const f32x4 s0 = *(const f32x4*)(SLOC + (size_t)item * 4608 + v * 48 + c8), s1 = *(const f32x4*)(SLOC + (size_t)item * 4608 + v * 48 + c8 + 4);
                        u32x4v so; so.x = pkbf(s0[0], s0[1]); so.y = pkbf(s0[2], s0[3]); so.z = pkbf(s1[0], s1[1]); so.w = pkbf(s1[2], s1[3]);
                        *(LDSAS u32x4v*)(lb + ST_OFF + v * 112 + c8 * 2) = so;
                    }
                    __syncthreads();
                    const int la = tid_g & 63, r = la & 31, hh = la >> 5;
                    const int wv = (wave < 6) ? wave : 0, vt = wv % 3, tt = wv / 3;
                    f32x16 oT;
#pragma unroll
                    for (int i = 0; i < 16; ++i) oT[i] = 0.f;
                    bf16x8 qB[3];
#pragma unroll
                    for (int ks = 0; ks < 3; ++ks) qB[ks] = *(const LDSAS bf16x8*)(lb + QS_OFF + (32 * tt + r) * 112 + (16 * ks + 8 * hh) * 2);
#pragma unroll
                    for (int st = 0; st < 2; ++st) {
                        if (st <= tt) {
                            f32x16 X;
#pragma unroll
                            for (int i = 0; i < 16; ++i) X[i] = 0.f;
#pragma unroll
                            for (int ks = 0; ks < 3; ++ks) { const bf16x8 kA = *(const LDSAS bf16x8*)(lb + KS_OFF + (32 * st + r) * 112 + (16 * ks + 8 * hh) * 2); X = MFMA32(kA, qB[ks], X); }
                            if (st == tt) {
#pragma unroll
                                for (int i = 0; i < 16; ++i) X[i] = (crow(i, hh) <= r) ? X[i] : 0.f;
                            }
                            u32x4v u0, u1;
                            u0.x = pkbf(X[0], X[1]); u0.y = pkbf(X[2], X[3]); u0.z = pkbf(X[4], X[5]); u0.w = pkbf(X[6], X[7]);
                            u1.x = pkbf(X[8], X[9]); u1.y = pkbf(X[10], X[11]); u1.z = pkbf(X[12], X[13]); u1.w = pkbf(X[14], X[15]);
                            const bf16x8 x0 = __builtin_bit_cast(bf16x8, u0), x1 = __builtin_bit_cast(bf16x8, u1);
                            const bf16x8 v0 = *(const LDSAS bf16x8*)(lb + VT_OFF + (32 * vt + r) * 144 + (32 * st + 8 * hh) * 2);
                            const bf16x8 v1 = *(const LDSAS bf16x8*)(lb + VT_OFF + (32 * vt + r) * 144 + (32 * st + 16 + 8 * hh) * 2);
                            oT = MFMA32(v0, x0, oT); oT = MFMA32(v1, x1, oT);
                        }
                    }
#pragma unroll
                    for (int ks = 0; ks < 3; ++ks) { const bf16x8 sA = *(const LDSAS bf16x8*)(lb + ST_OFF + (32 * vt + r) * 112 + (16 * ks + 8 * hh) * 2); oT = MFMA32(sA, qB[ks], oT); }
                    float ssp = 0.f;
#pragma unroll
                    for (int i = 0; i < 16; ++i) ssp += oT[i] * oT[i];
                    ssp += __shfl_xor(ssp, 32);
                    LDSAS float* sq = (LDSAS float*)(lb + SQ_OFF);
                    if (wave < 6 && hh == 0) sq[(32 * tt + r) * 3 + vt] = ssp;
                    __syncthreads();
                    if (wave < 6) {
                        const int t = 32 * tt + r;
                        const float rinv = 1.0f / sqrtf((sq[t * 3] + sq[t * 3 + 1] + sq[t * 3 + 2]) * (1.f / 96.f) + NORM_EPS);
#pragma unroll
                        for (int g4 = 0; g4 < 4; ++g4) {
                            const int v0i = 32 * vt + 8 * g4 + 4 * hh;
                            const f32x4 gg = *(const f32x4*)(gon + v0i);
                            const uint2 ru = *(const uint2*)(Z + (size_t)(tok0 + t) * ZLD + Z_GR + h * 96 + v0i);
                            uint2 w; w.x = pkbf(oT[4 * g4] * rinv * gg[0] * siluf(__uint_as_float(ru.x << 16)), oT[4 * g4 + 1] * rinv * gg[1] * siluf(__uint_as_float(ru.x & 0xffff0000u)));
                            w.y = pkbf(oT[4 * g4 + 2] * rinv * gg[2] * siluf(__uint_as_float(ru.y << 16)), oT[4 * g4 + 3] * rinv * gg[3] * siluf(__uint_as_float(ru.y & 0xffff0000u)));
                            *(uint2*)(MIX + (size_t)(tok0 + t) * D_MODEL + MIX_GLA + h * 96 + v0i) = w;
                        }
                    }
                }
            }
        } else if (k == 5 && PH_ON(5)) {
            pg8::Gemm g{MIX, WOUT + (size_t)l * D_MODEL * D_MODEL, T, D_MODEL, D_MODEL}; pg8::StaticOrder S; S.init(T, D_MODEL, G, bid);
            pg8::EpiRes E{xin, OUT, D_MODEL};
            pg8::gemm_phase<pg8::EpiRes, pg8::StaticOrder, true, true>(tid, ldsq, g, S, E);
        } else if (k == 6 && PH_ON(6)) {
            const float* g = args.in[15] + l * D_MODEL;
            for (int r = gw; r < T; r += NGW) rmsnorm_row_bf16(OUT + (size_t)r * D_MODEL, g, XN + (size_t)r * D_MODEL, lane);
            {
                float* scr = ldsf + wave * (64 * 33);
                for (int it = MOEW_P7 + gw; it < N_EXPERTS * MOEW_IE; it += NGW) {
                    const int e = it / MOEW_IE; int r = it % MOEW_IE;
                    const size_t we = (size_t)l * N_EXPERTS + e;
                    if (r < MOEW_IG) { transpose_item(args.in[27] + we * D_MODEL * D_EXPERT, D_MODEL, D_EXPERT, 16, WGU + (size_t)e * 1024 * D_MODEL, 0, 2, 0, scr, r, lane); continue; } r -= MOEW_IG;
                    if (r < MOEW_IG) { transpose_item(args.in[28] + we * D_MODEL * D_EXPERT, D_MODEL, D_EXPERT, 16, WGU + (size_t)e * 1024 * D_MODEL, 0, 2, 1, scr, r, lane); continue; } r -= MOEW_IG;
                    transpose_item(args.in[29] + we * D_EXPERT * D_MODEL, D_EXPERT, D_MODEL, 32, WDN + (size_t)e * D_MODEL * D_EXPERT, 0, 1, 0, scr, r, lane);
                }
            }
        } else if (k == 7 && PH_ON(7)) {
            pg8::Gemm g{XN, WCQ + (size_t)l * XW * D_MODEL, T, XW, D_MODEL}; pg8::StaticOrder S; S.init(T, XW, G, bid);
            pg8::EpiStoreBf16 E{CQ, XW, 0xffff};
            pg8::gemm_phase<pg8::EpiStoreBf16, pg8::StaticOrder, true, true>(tid, ldsq, g, S, E);
            if (bid >= T / 256) {
                float* scr = ldsf + wave * (64 * 33);
                const int nidle = (G - T / 256) * NWAVES;
                for (int it = (bid - T / 256) * NWAVES + wave; it < MOEW_P7; it += nidle) {
                    const int e = it / MOEW_IE; int r = it % MOEW_IE;
                    const size_t we = (size_t)l * N_EXPERTS + e;
                    if (r < MOEW_IG) { transpose_item(args.in[27] + we * D_MODEL * D_EXPERT, D_MODEL, D_EXPERT, 16, WGU + (size_t)e * 1024 * D_MODEL, 0, 2, 0, scr, r, lane); continue; } r -= MOEW_IG;
                    if (r < MOEW_IG) { transpose_item(args.in[28] + we * D_MODEL * D_EXPERT, D_MODEL, D_EXPERT, 16, WGU + (size_t)e * 1024 * D_MODEL, 0, 2, 1, scr, r, lane); continue; } r -= MOEW_IG;
                    transpose_item(args.in[29] + we * D_EXPERT * D_MODEL, D_EXPERT, D_MODEL, 32, WDN + (size_t)e * D_MODEL * D_EXPERT, 0, 1, 0, scr, r, lane);
                }
            }
        } else if (k == 8 && PH_ON(8)) {
            {
                const float* gq = args.in[19] + l * X_DH;
                const int r = lane & 31, hh = lane >> 5;
                for (int item = gw; item < BATCH * X_HEADS * (SEQ / 32); item += NGW) {
                    const int tt = item & 127, h = (item >> 7) & 3, b = item >> 9;
                    const int tok = b * SEQ + tt * 32 + r;
                    bf16x8 qf[4];
                    {
                        float qv[4][8]; float ss = 0.f;
#pragma unroll
                        for (int ks = 0; ks < 4; ++ks) { const uint4 u = *(const uint4*)(CQ + (size_t)tok * XW + h * 64 + ks * 16 + hh * 8);
                            qv[ks][0] = __uint_as_float(u.x << 16); qv[ks][1] = __uint_as_float(u.x & 0xffff0000u); qv[ks][2] = __uint_as_float(u.y << 16); qv[ks][3] = __uint_as_float(u.y & 0xffff0000u);
                            qv[ks][4] = __uint_as_float(u.z << 16); qv[ks][5] = __uint_as_float(u.z & 0xffff0000u); qv[ks][6] = __uint_as_float(u.w << 16); qv[ks][7] = __uint_as_float(u.w & 0xffff0000u);
#pragma unroll
                            for (int e = 0; e < 8; ++e) ss += qv[ks][e] * qv[ks][e]; }
                        ss += __shfl_xor(ss, 32);
                        const float rq = (0.125f * 1.4426950408889634f) / sqrtf(ss * (1.f / 64.f) + NORM_EPS);
#pragma unroll
                        for (int ks = 0; ks < 4; ++ks) { const f32x4 g0 = *(const f32x4*)(gq + ks * 16 + hh * 8), g1 = *(const f32x4*)(gq + ks * 16 + hh * 8 + 4);
                            uint4 u; u.x = pkbf(qv[ks][0] * rq * g0[0], qv[ks][1] * rq * g0[1]); u.y = pkbf(qv[ks][2] * rq * g0[2], qv[ks][3] * rq * g0[3]);
                            u.z = pkbf(qv[ks][4] * rq * g1[0], qv[ks][5] * rq * g1[1]); u.w = pkbf(qv[ks][6] * rq * g1[2], qv[ks][7] * rq * g1[3]);
                            qf[ks] = __builtin_bit_cast(bf16x8, u); }
                    }
                    f32x16 oacc[2];
#pragma unroll
                    for (int dt = 0; dt < 2; ++dt)
#pragma unroll
                        for (int e = 0; e < 16; ++e) oacc[dt][e] = 0.f;
                    float lsm = 0.f;
                    const bf16_t* kb = CKN + ((size_t)l * BATCH * MEM_LEN + (size_t)b * MEM_LEN + r) * 256 + h * 64 + hh * 8;
                    const bf16_t* vb = CVT + ((size_t)((l * BATCH + b) * X_HEADS + h) * 64 + r) * 256 + hh * 8;
#pragma unroll 2
                    for (int kt = 0; kt < 8; ++kt) {
                        f32x16 S;
#pragma unroll
                        for (int e = 0; e < 16; ++e) S[e] = 0.f;
#pragma unroll
                        for (int ks = 0; ks < 4; ++ks) { const bf16x8 a = *(const bf16x8*)(kb + (size_t)kt * 32 * 256 + ks * 16); S = MFMA32(a, qf[ks], S); }
                        float p[16]; float ps = 0.f;
#pragma unroll
                        for (int e = 0; e < 16; ++e) { p[e] = __builtin_amdgcn_exp2f(S[e]); ps += p[e]; }
                        lsm += ps;
                        uint4 u0, u1;
                        u0.x = pkbf(p[0], p[1]); u0.y = pkbf(p[2], p[3]); u0.z = pkbf(p[4], p[5]); u0.w = pkbf(p[6], p[7]);
                        u1.x = pkbf(p[8], p[9]); u1.y = pkbf(p[10], p[11]); u1.z = pkbf(p[12], p[13]); u1.w = pkbf(p[14], p[15]);
                        const bf16x8 pf0 = __builtin_bit_cast(bf16x8, u0), pf1 = __builtin_bit_cast(bf16x8, u1);
#pragma unroll
                        for (int dt = 0; dt < 2; ++dt) {
                            const bf16x8 a0 = *(const bf16x8*)(vb + (size_t)dt * 32 * 256 + kt * 32);
                            const bf16x8 a1 = *(const bf16x8*)(vb + (size_t)dt * 32 * 256 + kt * 32 + 16);
                            oacc[dt] = MFMA32(a0, pf0, oacc[dt]);
                            oacc[dt] = MFMA32(a1, pf1, oacc[dt]);
                        }
                    }
                    const float inv = 1.f / (lsm + __shfl_xor(lsm, 32));
                    bf16_t* op = COIN + (size_t)tok * XW + h * 64;
#pragma unroll
                    for (int dt = 0; dt < 2; ++dt)
#pragma unroll
                        for (int g4 = 0; g4 < 4; ++g4) {
                            uint2 o; o.x = pkbf(oacc[dt][4 * g4] * inv, oacc[dt][4 * g4 + 1] * inv); o.y = pkbf(oacc[dt][4 * g4 + 2] * inv, oacc[dt][4 * g4 + 3] * inv);
                            *(uint2*)(op + dt * 32 + 8 * g4 + 4 * hh) = o;
                        }
                }
            }
        } else if (k == 9 && PH_ON(9)) {
            pg8::Gemm g{COIN, WCO + (size_t)l * D_MODEL * XW, T, D_MODEL, XW}; pg8::StaticOrder S; S.init(T, D_MODEL, G, bid);
            pg8::EpiRes E{OUT, OUT, D_MODEL};
            pg8::gemm_phase<pg8::EpiRes, pg8::StaticOrder, true, true>(tid, ldsq, g, S, E);
        } else if (k == 10 && PH_ON(10)) {
            const float* g = args.in[22] + l * D_MODEL;
            const float* brg = args.in[24] + l * N_GROUPS; const float* bre = args.in[26] + l * N_EXPERTS;
            unsigned* lcnt = (unsigned*)lds_raw;
            unsigned* lbase = lcnt + 16;
            unsigned* ler = lcnt + 32;
            float* rinvs = (float*)lds_raw + 192;
            float* lg = (float*)lds_raw + 256;
            float* red = (float*)lds_raw + 2048;
            const bf16_t* wrt_hi = WRT + (size_t)l * 2 * 32 * D_MODEL; const bf16_t* wrt_lo = wrt_hi + 32 * D_MODEL;
            for (int chunk = bid; chunk < T / 64; chunk += G) {
                __syncthreads();
                if (tid < 16) lcnt[tid] = 0u;
#ifndef MK_RT_A
#define MK_RT_A 1
#endif
#ifndef MK_RT_B
#define MK_RT_B 1
#endif
                for (int rta = 0; rta < MK_RT_A; ++rta)
#pragma unroll 2
                for (int ti = 0; ti < 8; ++ti) {
                    const int r = chunk * 64 + wave * 8 + ti;
                    const float* xrow = OUT + (size_t)r * D_MODEL;
                    f32x4 v[4]; float ss = 0.f;
#pragma unroll
                    for (int jj = 0; jj < 4; ++jj) { v[jj] = *(const f32x4*)(xrow + lane * 4 + 256 * jj); ss += v[jj][0] * v[jj][0] + v[jj][1] * v[jj][1] + v[jj][2] * v[jj][2] + v[jj][3] * v[jj][3]; }
                    const float rinv = 1.0f / sqrtf(wave_sum(ss) * (1.f / 1024.f) + NORM_EPS);
                    if (lane == 0) rinvs[wave * 8 + ti] = rinv;
#pragma unroll
                    for (int jj = 0; jj < 4; ++jj) { const f32x4 gg = *(const f32x4*)(g + lane * 4 + 256 * jj);
                        uint2 o; o.x = pk2(v[jj][0] * rinv * gg[0], v[jj][1] * rinv * gg[1]); o.y = pk2(v[jj][2] * rinv * gg[2], v[jj][3] * rinv * gg[3]);
                        *(uint2*)(XN + (size_t)r * D_MODEL + lane * 4 + 256 * jj) = o; }
                }
                __syncthreads();
                for (int rtb = 0; rtb < MK_RT_B; ++rtb) {
                    const int rr = lane & 31, hh = lane >> 5;
                    f32x16 acc[2];
#pragma unroll
                    for (int mt = 0; mt < 2; ++mt)
#pragma unroll
                        for (int e = 0; e < 16; ++e) acc[mt][e] = 0.f;
                    const float rv0 = rinvs[rr], rv1 = rinvs[32 + rr];
#pragma unroll 2
                    for (int kq = 0; kq < 8; ++kq) {
                        const int k0 = 16 * (8 * wave + kq) + 8 * hh;
                        const bf16x8 bh = *(const bf16x8*)(wrt_hi + (size_t)rr * D_MODEL + k0), bl = *(const bf16x8*)(wrt_lo + (size_t)rr * D_MODEL + k0);
                        const f32x4 g0 = *(const f32x4*)(g + k0), g1 = *(const f32x4*)(g + k0 + 4);
#pragma unroll
                        for (int mt = 0; mt < 2; ++mt) {
                            const float* xp = OUT + (size_t)(chunk * 64 + mt * 32 + rr) * D_MODEL + k0;
                            const f32x4 x0 = *(const f32x4*)xp, x1 = *(const f32x4*)(xp + 4);
                            const float rv = mt ? rv1 : rv0;
                            float xn[8] = {x0[0] * rv * g0[0], x0[1] * rv * g0[1], x0[2] * rv * g0[2], x0[3] * rv * g0[3], x1[0] * rv * g1[0], x1[1] * rv * g1[1], x1[2] * rv * g1[2], x1[3] * rv * g1[3]};
                            u32x4v uh, ul;
                            uh.x = pkbf(xn[0], xn[1]); uh.y = pkbf(xn[2], xn[3]); uh.z = pkbf(xn[4], xn[5]); uh.w = pkbf(xn[6], xn[7]);
                            ul.x = pkbf(xn[0] - __uint_as_float(uh.x << 16), xn[1] - __uint_as_float(uh.x & 0xffff0000u)); ul.y = pkbf(xn[2] - __uint_as_float(uh.y << 16), xn[3] - __uint_as_float(uh.y & 0xffff0000u));
                            ul.z = pkbf(xn[4] - __uint_as_float(uh.z << 16), xn[5] - __uint_as_float(uh.z & 0xffff0000u)); ul.w = pkbf(xn[6] - __uint_as_float(uh.w << 16), xn[7] - __uint_as_float(uh.w & 0xffff0000u));
                            const bf16x8 ah = __builtin_bit_cast(bf16x8, uh), al = __builtin_bit_cast(bf16x8, ul);
                            acc[mt] = MFMA32(ah, bh, acc[mt]); acc[mt] = MFMA32(ah, bl, acc[mt]); acc[mt] = MFMA32(al, bh, acc[mt]);
                        }
                    }
#pragma unroll
                    for (int mt = 0; mt < 2; ++mt)
#pragma unroll
                        for (int e = 0; e < 16; ++e) red[((wave * 2 + mt) * 32 + crow(e, hh)) * 33 + rr] = acc[mt][e];
                }
                __syncthreads();
                for (int idx = tid; idx < 64 * 20; idx += NTHREADS) { const int t = idx / 20, n = idx % 20; float sv = 0.f;
#pragma unroll
                    for (int w = 0; w < 8; ++w) sv += red[((w * 2 + (t >> 5)) * 32 + (t & 31)) * 33 + n];
                    lg[t * 21 + n] = sv; }
                __syncthreads();
                if (tid < 64) {
                    const int r = chunk * 64 + tid;
                    float acc[20];
#pragma unroll
                    for (int jj = 0; jj < 20; ++jj) acc[jj] = lg[tid * 21 + jj];
                    float gl[4]; int gs = 0;
#pragma unroll
                    for (int jj = 0; jj < 4; ++jj) gl[jj] = acc[jj] + brg[jj];
                    float gmax = gl[0];
#pragma unroll
                    for (int jj = 1; jj < 4; ++jj) if (gl[jj] > gmax) { gmax = gl[jj]; gs = jj; }
                    float den = 0.f;
#pragma unroll
                    for (int jj = 0; jj < 4; ++jj) den += __expf(gl[jj] - gmax);
                    const float gwt = 1.f / den;
                    float el[4];
#pragma unroll
                    for (int jj = 0; jj < 4; ++jj) { float vsel = 0.f;
#pragma unroll
                        for (int gg2 = 0; gg2 < 4; ++gg2) vsel = (gg2 == gs) ? (acc[4 + gg2 * 4 + jj] + bre[gg2 * 4 + jj]) : vsel;
                        el[jj] = vsel; }
                    int i1 = 0; float e1v = el[0];
#pragma unroll
                    for (int jj = 1; jj < 4; ++jj) if (el[jj] > e1v) { e1v = el[jj]; i1 = jj; }
                    int i2 = -1; float e2v = -INFINITY;
#pragma unroll
                    for (int jj = 0; jj < 4; ++jj) if (jj != i1 && el[jj] > e2v) { e2v = el[jj]; i2 = jj; }
                    const float e2 = __expf(e2v - e1v);
                    const float w1 = 1.f / (1.f + e2), w2 = e2 / (1.f + e2);
                    const int ex1 = gs * 4 + i1, ex2 = gs * 4 + i2;
                    tok_e[r * 2] = ex1; tok_e[r * 2 + 1] = ex2;
                    tok_g[r * 2] = w1 * gwt; tok_g[r * 2 + 1] = w2 * gwt;
                    const unsigned r1 = atomicAdd(&lcnt[ex1], 1u), r2 = atomicAdd(&lcnt[ex2], 1u);
                    ler[tid * 2] = (unsigned)ex1 | (r1 << 8); ler[tid * 2 + 1] = (unsigned)ex2 | (r2 << 8);
                }
                __syncthreads();
                if (tid < 16) CNTT[((size_t)l * (T / 64) + chunk) * 16 + tid] = (int)lcnt[tid];
                if (tid < 128) tok_r[(chunk * 64) * 2 + tid] = (int)(ler[tid] >> 8);
            }
        } else if (k >= 11 && k <= 14 && PH_ON(11)) {
            int off[N_EXPERTS + 1];
            int* cbt = (int*)lds_raw + 1024;
            if (k == 11) {
                int* segs = (int*)lds_raw;
                int* tot = (int*)lds_raw + 512;
                __syncthreads();
                for (int i = tid; i < (T / 64) * 16; i += NTHREADS) cbt[i] = CNTT[(size_t)l * (T / 64) * 16 + i];
                __syncthreads();
                { const int e = tid & 15, sg = tid >> 4; int sacc = 0;
#pragma unroll
                  for (int c = 0; c < 8; ++c) { const int v = cbt[(sg * 8 + c) * 16 + e]; cbt[(sg * 8 + c) * 16 + e] = sacc; sacc += v; }
                  segs[sg * 16 + e] = sacc; }
                __syncthreads();
                { const int e = tid & 15, sg = tid >> 4; int base = 0;
                  for (int q = 0; q < sg; ++q) base += segs[q * 16 + e];
#pragma unroll
                  for (int c = 0; c < 8; ++c) cbt[(sg * 8 + c) * 16 + e] += base;
                  if (sg == 31) { tot[e] = base + segs[sg * 16 + e]; if (bid == 0) cnt[e] = (unsigned)(base + segs[sg * 16 + e]); } }
                __syncthreads();
                off[0] = 0;
#pragma unroll
                for (int e = 0; e < N_EXPERTS; ++e) off[e + 1] = off[e] + ((tot[e] + PADR - 1) / PADR) * PADR;
            } else {
                off[0] = 0;
#pragma unroll
                for (int e = 0; e < N_EXPERTS; ++e) { const int c = (int)__hip_atomic_load(&cnt[e], __ATOMIC_RELAXED, __HIP_MEMORY_SCOPE_AGENT); off[e + 1] = off[e] + ((c + PADR - 1) / PADR) * PADR; }
            }
            const int total_rows = off[N_EXPERTS];
            if (k == 11) {
                for (int tb8 = gw * 8; tb8 < T; tb8 += NGW * 8) {
                    int pe = 0, pdst = 0;
                    if (lane < 16) { const int i = tb8 * 2 + lane; pe = tok_e[i]; int o = 0;
#pragma unroll
                        for (int q = 0; q < N_EXPERTS; ++q) o = (q == pe) ? off[q] : o;
                        const int grank = cbt[(tb8 >> 6) * 16 + pe] + tok_r[i];
                        tok_r[i] = grank; pdst = o + grank; }
#pragma unroll 4
                    for (int t8 = 0; t8 < 8; ++t8) {
                        const uint4* src = (const uint4*)(XN + (size_t)(tb8 + t8) * D_MODEL);
                        const uint4 w0 = src[lane], w1 = src[lane + 64];
                        const int d0 = __builtin_amdgcn_readfirstlane(__shfl(pdst, t8 * 2)), d1 = __builtin_amdgcn_readfirstlane(__shfl(pdst, t8 * 2 + 1));
                        uint4* dst0 = (uint4*)(XG + (size_t)d0 * D_MODEL); uint4* dst1 = (uint4*)(XG + (size_t)d1 * D_MODEL);
                        dst0[lane] = w0; dst0[lane + 64] = w1; dst1[lane] = w0; dst1[lane + 64] = w1;
                    }
                }
                for (int e = 0; e < N_EXPERTS; ++e) {
                    int oe = 0, oe1 = 0;
#pragma unroll
                    for (int q = 0; q < N_EXPERTS; ++q) { oe = (q == e) ? off[q] : oe; oe1 = (q == e) ? off[q + 1] : oe1; }
                    const int c = ((int*)lds_raw + 512)[e];
                    for (int r = oe + c + gw; r < oe1; r += NGW) { uint4* dst = (uint4*)(XG + (size_t)r * D_MODEL); dst[lane] = make_uint4(0u, 0u, 0u, 0u); dst[lane + 64] = make_uint4(0u, 0u, 0u, 0u); }
                }
            } else if (k == 12) {
                pg8::Gemm g{XG, WGU, total_rows, 1024, D_MODEL};
                pg8::GroupSched S;
#pragma unroll
                for (int q = 0; q < 17; ++q) S.off[q] = off[q];
                S.nunits = (total_rows / 256) * 4; S.G = G; S.c = bid;
                pg8::EpiGateUp E{HB, D_EXPERT};
                pg8::gemm_phase<pg8::EpiGateUp, pg8::GroupSched, true, true>(tid, ldsq, g, S, E);
            } else if (k == 13) {
                pg8::Gemm g{HB, WDN, total_rows, 1024, D_EXPERT};
                pg8::GroupSched S;
#pragma unroll
                for (int q = 0; q < 17; ++q) S.off[q] = off[q];
                S.nunits = (total_rows / 256) * 4; S.G = G; S.c = bid;
                pg8::EpiStoreBf16 E{DB, D_MODEL, 3};
                pg8::gemm_phase<pg8::EpiStoreBf16, pg8::GroupSched, true, true>(tid, ldsq, g, S, E);
            } else {
                const float* gnx = args.in[3] + (l + 1 < DEPTH ? l + 1 : l) * D_MODEL;
                for (int tb8 = gw * 8; tb8 < T; tb8 += NGW * 8) {
                int prow = 0; float pgate = 0.f;
                if (lane < 16) { const int i = tb8 * 2 + lane; const int pe = tok_e[i]; int o = 0;
#pragma unroll
                    for (int q = 0; q < N_EXPERTS; ++q) o = (q == pe) ? off[q] : o;
                    prow = o + tok_r[i]; pgate = tok_g[i]; }
#pragma unroll 2
                for (int t8 = 0; t8 < 8; ++t8) {
                    const int r = tb8 + t8;
                    const size_t r0 = (size_t)__builtin_amdgcn_readfirstlane(__shfl(prow, t8 * 2)), r1 = (size_t)__builtin_amdgcn_readfirstlane(__shfl(prow, t8 * 2 + 1));
                    const float g0 = __shfl(pgate, t8 * 2), g1 = __shfl(pgate, t8 * 2 + 1);
                    f32x4 xv[4]; float ss = 0.f;
#pragma unroll
                    for (int j = 0; j < 4; ++j) {
                        const int c = lane * 4 + 256 * j;
                        const uint2 a = *(const uint2*)(DB + r0 * 1024 + c), bq = *(const uint2*)(DB + r1 * 1024 + c);
                        f32x4 x = *(const f32x4*)(OUT + (size_t)r * D_MODEL + c);
                        x[0] += g0 * __uint_as_float(a.x << 16) + g1 * __uint_as_float(bq.x << 16);
                        x[1] += g0 * __uint_as_float(a.x & 0xffff0000u) + g1 * __uint_as_float(bq.x & 0xffff0000u);
                        x[2] += g0 * __uint_as_float(a.y << 16) + g1 * __uint_as_float(bq.y << 16);
                        x[3] += g0 * __uint_as_float(a.y & 0xffff0000u) + g1 * __uint_as_float(bq.y & 0xffff0000u);
                        *(f32x4*)(OUT + (size_t)r * D_MODEL + c) = x;
                        xv[j] = x; ss += x[0] * x[0] + x[1] * x[1] + x[2] * x[2] + x[3] * x[3];
                    }
                    if (l + 1 < DEPTH) {
                        const float rinv = 1.0f / sqrtf(wave_sum(ss) * (1.f / 1024.f) + NORM_EPS);
#pragma unroll
                        for (int j = 0; j < 4; ++j) { const int c = lane * 4 + 256 * j; const f32x4 gg = *(const f32x4*)(gnx + c);
                            uint2 o; o.x = pk2(xv[j][0] * rinv * gg[0], xv[j][1] * rinv * gg[1]); o.y = pk2(xv[j][2] * rinv * gg[2], xv[j][3] * rinv * gg[3]);
                            *(uint2*)(XN + (size_t)r * D_MODEL + c) = o; }
                    }
                }
                }
            }
        }
    }
#ifdef MK_PROF_A
    if (KSEL < 0) {
        xcd_barrier(bar);
        if (bid == 0 && threadIdx.x == 0) ctl[8192 + DEPTH * NP] = (unsigned)__builtin_amdgcn_s_memrealtime();
        xcd_barrier(bar);
        const float da = (float)(ctl[8192 + MK_PROF_A + 1] - ctl[8192 + MK_PROF_A]) * 0.01f;
        const float db = (MK_PROF_B < 0) ? (float)(ctl[8192 + DEPTH * NP] - ctl[8192]) * 0.01f : (float)(ctl[8192 + MK_PROF_B + 1] - ctl[8192 + MK_PROF_B]) * 0.01f;
        for (size_t i = (size_t)T * D_MODEL / 2 + (size_t)bid * NTHREADS + threadIdx.x; i < (size_t)T * D_MODEL; i += (size_t)G * NTHREADS) OUT[i] = db;
        if (bid == 0 && threadIdx.x == 0) OUT[0] = 100.f * da;
    }
#endif
}

#ifndef MK_SINGLE
#define MK_SINGLE 1
#endif
extern "C" void kernel_launch(void* const* d_in, const int* in_sizes, int n_in, void* d_out, int out_size, void* d_ws, size_t ws_size, hipStream_t stream) {
    static int grid = 0;
    if (grid == 0) {
        if (n_in != 30 || out_size != T * D_MODEL || ws_size < WS_END) { fprintf(stderr, "kernel_launch: unexpected sizes n_in %d out %d ws %zu (need %zu)\n", n_in, out_size, ws_size, (size_t)WS_END); grid = -1; return; }
        int dev = 0, cus = 0;
        if (hipGetDevice(&dev) != hipSuccess || hipDeviceGetAttribute(&cus, hipDeviceAttributeMultiprocessorCount, dev) != hipSuccess) { grid = -1; return; }
        bool okattr = true;
#define SETATTR(K) okattr = okattr && (hipFuncSetAttribute((const void*)mk_fwd<K>, hipFuncAttributeMaxDynamicSharedMemorySize, LDS_BYTES) == hipSuccess)
#if MK_SINGLE
        SETATTR(-1);
#else
        SETATTR(0); SETATTR(1); SETATTR(2); SETATTR(3); SETATTR(4); SETATTR(5); SETATTR(6); SETATTR(7); SETATTR(8); SETATTR(9); SETATTR(10); SETATTR(11); SETATTR(12); SETATTR(13); SETATTR(14);
#endif
        if (!okattr) { fprintf(stderr, "kernel_launch: hipFuncSetAttribute failed\n"); grid = -1; return; }
        (void)hipGetLastError();
        grid = cus > 0 ? cus : 256;
    }
    if (grid < 0) return;
    (void)hipMemsetAsync((char*)d_ws + WS_CTL, 0, CTL_BYTES, stream);
    Args a{};
    for (int i = 0; i < 30; ++i) a.in[i] = (const float*)d_in[i];
    a.out = (float*)d_out; a.ws = (unsigned char*)d_ws;
#if MK_SINGLE
    a.ph_lo = 0; a.ph_hi = DEPTH * NP;
    hipLaunchKernelGGL(mk_fwd<-1>, dim3(grid), dim3(NTHREADS), LDS_BYTES, stream, a);
#else
    for (int ph = 0; ph < DEPTH * NP; ++ph) {
        a.ph_lo = ph; a.ph_hi = ph + 1;
        switch (ph % NP) {
#define LCASE(K) case K: hipLaunchKernelGGL(mk_fwd<K>, dim3(grid), dim3(NTHREADS), LDS_BYTES, stream, a); break
            LCASE(0); LCASE(1); LCASE(2); LCASE(3); LCASE(4); LCASE(5); LCASE(6); LCASE(7); LCASE(8); LCASE(9); LCASE(10); LCASE(11); LCASE(12); LCASE(13); LCASE(14);
        }
    }
#endif
}
```

```cpp
#include <hip/hip_runtime.h>
#include <cstdio>
#include <cstdint>

constexpr int D_MODEL = 1024, BATCH = 4, SEQ = 4096, DEPTH = 2, T = BATCH * SEQ;
constexpr int MEM_LEN = 256;
constexpr int GLA_HEADS = 4, GLA_DK = 48, GLA_DV = 96, GLA_RANK = 16;
constexpr int DSA_HEADS = 6, DSA_DH = 64, IDX_HEADS = 8, IDX_DIM = 64, TOPK = 256;
constexpr int CONV_CH = 256, CONV_W = 31;
constexpr int NUM_BUCKETS = 32;
constexpr int X_HEADS = 4, X_DH = 64, XW = X_HEADS * X_DH;
constexpr int N_GROUPS = 4, EPG = 4, N_EXPERTS = 16, D_EXPERT = 512;
constexpr float NORM_EPS = 1e-6f;
constexpr int D_IN = 3416;
constexpr int Z_GQ = 0, Z_GK = 192, Z_GV = 384, Z_GLR = 768, Z_GR = 784, Z_DQ = 1168, Z_DK = 1552, Z_DV = 1936, Z_IQ = 2320, Z_IK = 2832, Z_IW = 2896, Z_CU = 2904;
constexpr int ZLD = 3584;
constexpr int MIX_GLA = 0, MIX_DSA = 384, MIX_CONV = 768;
constexpr int PADR = 256;
constexpr int MAXROWS = 2 * T + N_EXPERTS * PADR;

typedef unsigned short bf16_t;
typedef float f32x4 __attribute__((ext_vector_type(4)));

constexpr size_t MiB = 1u << 20;
constexpr size_t WS_CTL = 0, CTL_BYTES = 1 * MiB;
constexpr size_t WS_WIN0 = 1 * MiB, WS_WCKV = 8 * MiB, WS_WIN1 = 10 * MiB, WS_WOUT = 17 * MiB, WS_WCQ = 21 * MiB, WS_WCO = 22 * MiB;
constexpr size_t WS_XN = 24 * MiB;
constexpr size_t WS_MEMN = 56 * MiB;
constexpr size_t WS_Z = 60 * MiB;
constexpr size_t WS_WGU = WS_Z, WS_WDN = WS_Z + 32 * MiB, WS_HB = WS_Z + 48 * MiB;
constexpr size_t WS_MIX = 172 * MiB;
constexpr size_t WS_QN = 204 * MiB, WS_KN = 216 * MiB;
constexpr size_t WS_VT = 228 * MiB;
constexpr size_t WS_MASK = 240 * MiB;
constexpr size_t WS_IK = 248 * MiB, WS_QL = 250 * MiB, WS_CH = 252 * MiB;
constexpr size_t WS_XG = WS_MIX, WS_DB = WS_MIX;
constexpr size_t WS_CQ = 256 * MiB, WS_COIN = 264 * MiB;
constexpr size_t WS_BCUM = 256 * MiB, WS_SLOC = 268 * MiB, WS_DEC = 286 * MiB;
constexpr size_t WS_CKV = 288 * MiB;
constexpr size_t WS_CKN = 290 * MiB;
constexpr size_t WS_CVT = 292 * MiB;
constexpr size_t WS_ROUTE = 291 * MiB;
constexpr size_t WS_END = 293 * MiB;
constexpr int CW_CNT = 1024;
constexpr int CW_Q3 = 2048, CW_Q4 = 2304;

constexpr int NTHREADS = 512, NWAVES = 8;
constexpr int LDS_BYTES = 147456;

__device__ __forceinline__ float bf2f(bf16_t u) { return __uint_as_float(((unsigned)u) << 16); }
__device__ __forceinline__ bf16_t f2bf(float f) { unsigned u = __float_as_uint(f); return (bf16_t)((u + 0x7fffu + ((u >> 16) & 1u)) >> 16); }
__device__ __forceinline__ unsigned pk2(float lo, float hi) { return (unsigned)f2bf(lo) | ((unsigned)f2bf(hi) << 16); }
__device__ __forceinline__ float wave_sum(float v) {
    v += __builtin_bit_cast(float, __builtin_amdgcn_update_dpp(0, __builtin_bit_cast(int, v), 0xB1, 0xf, 0xf, false));
    v += __builtin_bit_cast(float, __builtin_amdgcn_update_dpp(0, __builtin_bit_cast(int, v), 0x4E, 0xf, 0xf, false));
    v += __builtin_bit_cast(float, __builtin_amdgcn_update_dpp(0, __builtin_bit_cast(int, v), 0x141, 0xf, 0xf, false));
    v += __builtin_bit_cast(float, __builtin_amdgcn_update_dpp(0, __builtin_bit_cast(int, v), 0x140, 0xf, 0xf, false));
    v += __builtin_bit_cast(float, __builtin_amdgcn_update_dpp(0, __builtin_bit_cast(int, v), 0x142, 0xa, 0xf, false));
    v += __builtin_bit_cast(float, __builtin_amdgcn_update_dpp(0, __builtin_bit_cast(int, v), 0x143, 0xc, 0xf, false));
    return __builtin_bit_cast(float, __builtin_amdgcn_readlane(__builtin_bit_cast(int, v), 63));
}
__device__ __forceinline__ float siluf(float x) { return x / (1.f + __expf(-x)); }
__device__ __forceinline__ float sigmoidf(float x) { return 1.f / (1.f + __expf(-x)); }


typedef short bf16x8 __attribute__((ext_vector_type(8)));
typedef float f32x16 __attribute__((ext_vector_type(16)));
typedef unsigned u32x4v __attribute__((ext_vector_type(4)));
typedef __bf16 bf16x2_t __attribute__((ext_vector_type(2)));
typedef float f32x2_t __attribute__((ext_vector_type(2)));
#define LDSAS __attribute__((address_space(3)))
#define MFMA32(a, b, c) __builtin_amdgcn_mfma_f32_32x32x16_bf16((a), (b), (c), 0, 0, 0)
__device__ __forceinline__ int crow(int reg, int hh) { return (reg & 3) + 8 * (reg >> 2) + 4 * hh; }
__device__ __forceinline__ unsigned pkbf(float a, float b) { f32x2_t v = {a, b}; bf16x2_t r = __builtin_convertvector(v, bf16x2_t); return __builtin_bit_cast(unsigned, r); }

struct Args {
    const float* in[30];
    float* out;
    unsigned char* ws;
    int ph_lo, ph_hi;
};

template <class Epi>
__device__ __forceinline__ void gemm_tile_v1(const int tid, float* lds, const bf16_t* A, int lda, const int* rowidx, int row0,
                                             const float* B, int ldb, int col0, int ncols, int K, const Epi& epi) {
    float* As = lds;
    float* Bs = lds + 16 * 132;
    const int ty = tid >> 4, tx = tid & 15;
    float acc[4][8];
#pragma unroll
    for (int i = 0; i < 4; ++i)
#pragma unroll
        for (int j = 0; j < 8; ++j) acc[i][j] = 0.f;
    const int ar = tid >> 2, ak = (tid & 3) * 4;
    const int grow = rowidx ? rowidx[row0 + ar] : (row0 + ar);
    const bf16_t* ap = A + (size_t)(grow >= 0 ? grow : 0) * lda + ak;
    const bool aval = grow >= 0;
    const int bk = tid >> 5, bn = (tid & 31) * 4;
    const bool bval = bn < ncols;
    const float* bp = B + (size_t)bk * ldb + col0 + bn;
    for (int k0 = 0; k0 < K; k0 += 16) {
        uint2 av = make_uint2(0u, 0u);
        if (aval) av = *(const uint2*)(ap + k0);
        f32x4 bv = (f32x4){0.f, 0.f, 0.f, 0.f};
        if (bval) bv = *(const f32x4*)(bp + (size_t)k0 * ldb);
        __syncthreads();
        As[(ak + 0) * 132 + ar] = __uint_as_float(av.x << 16);
        As[(ak + 1) * 132 + ar] = __uint_as_float(av.x & 0xffff0000u);
        As[(ak + 2) * 132 + ar] = __uint_as_float(av.y << 16);
        As[(ak + 3) * 132 + ar] = __uint_as_float(av.y & 0xffff0000u);
        *(f32x4*)&Bs[bk * 132 + bn] = bv;
        __syncthreads();
#pragma unroll
        for (int k = 0; k < 16; ++k) {
            const f32x4 a4 = *(const f32x4*)&As[k * 132 + ty * 4];
            const f32x4 b0 = *(const f32x4*)&Bs[k * 132 + tx * 8];
            const f32x4 b1 = *(const f32x4*)&Bs[k * 132 + tx * 8 + 4];
#pragma unroll
            for (int i = 0; i < 4; ++i) {
                acc[i][0] += a4[i] * b0[0]; acc[i][1] += a4[i] * b0[1]; acc[i][2] += a4[i] * b0[2]; acc[i][3] += a4[i] * b0[3];
                acc[i][4] += a4[i] * b1[0]; acc[i][5] += a4[i] * b1[1]; acc[i][6] += a4[i] * b1[2]; acc[i][7] += a4[i] * b1[3];
            }
        }
    }
    __syncthreads();
#pragma unroll
    for (int i = 0; i < 4; ++i)
        epi(row0 + ty * 4 + i, col0 + tx * 8, (f32x4){acc[i][0], acc[i][1], acc[i][2], acc[i][3]}, (f32x4){acc[i][4], acc[i][5], acc[i][6], acc[i][7]});
}

template <class Epi>
__device__ __forceinline__ void gemm_v1(const int tid, float* lds, const bf16_t* A, int lda, int M, const float* B, int ldb, int N, int K, const Epi& epi) {
    const int nct = (N + 127) / 128, nrt = M / 128;
    for (int tile = blockIdx.x; tile < nrt * nct; tile += gridDim.x) {
        const int rt = tile / nct, ct = tile % nct;
        const int nc = (N - ct * 128) < 128 ? (N - ct * 128) : 128;
        gemm_tile_v1(tid, lds, A, lda, nullptr, rt * 128, B, ldb, ct * 128, nc, K, epi);
    }
}

namespace pg8 {
#define PG8_LAS __attribute__((address_space(3)))
typedef PG8_LAS unsigned char* PG8_LAS_T;
typedef short bf16x8 __attribute__((ext_vector_type(8)));
typedef unsigned u32x4 __attribute__((ext_vector_type(4)));
constexpr int BM = 256, BK = 64, HALF = 128, HTB = HALF * BK * 2  , STAGE_BYTES = 8 * HTB, NXCD = 8, WGM = 8;

__host__ __device__ __forceinline__ int lds_byte(int r, int c) { const int st = (r >> 4) * 2 + (c >> 5), rr = r & 15, cc = c & 31, ob = rr * 64 + cc * 2; return st * 1024 + (ob ^ (((ob >> 9) & 1) << 5)); }
__host__ __device__ __forceinline__ void stage_rc(int b, int& R, int& C) { const int st = b / 1024, sb = b % 1024, swz = sb ^ (((sb >> 9) & 1) << 5); R = (st >> 1) * 16 + swz / 64; C = (st & 1) * 32 + (swz % 64) / 2; }
__host__ __device__ __forceinline__ int perm32(int rho) { const int n = rho >> 4, i = rho & 15; return 8 * (i >> 2) + 4 * n + (i & 3); }

struct Unit { int pm, pn; };
struct Gemm { const bf16_t* A; const bf16_t* Bt; int M, N, K; };

struct StaticOrder {
    int nM, nN, nwg, G, c;
    __host__ __device__ void init(int M, int N, int G_, int c_) { nM = M / BM; nN = N / BM; nwg = nM * nN; G = G_; c = c_; }
    __host__ __device__ bool next(int i, Unit& u) const {
        const long L = (long)i * G + c; if (L >= nwg) return false;
        int wgid = (int)L; { const int q = nwg / NXCD, r = nwg % NXCD, xcd = wgid % NXCD, off = wgid / NXCD; wgid = (xcd < r ? xcd * (q + 1) : r * (q + 1) + (xcd - r) * q) + off; }
        const int nig = WGM * nN, gid = wgid / nig, fm = gid * WGM, gsz = (nM - fm) < WGM ? (nM - fm) : WGM;
        u.pm = fm + ((wgid % nig) % gsz); u.pn = (wgid % nig) / gsz; return true;
    }
    __device__ __forceinline__ void a_ready(const Unit&) const {}
    __device__ __forceinline__ void done(const Unit&) const {}
};

__device__ __forceinline__ unsigned cvt_pk_bf16(float lo, float hi) { unsigned r; asm volatile("v_cvt_pk_bf16_f32 %0, %1, %2" : "=v"(r) : "v"(lo), "v"(hi)); return r; }
typedef float f32x2 __attribute__((ext_vector_type(2)));
template <class Epi, class Sched, bool ALIGN_EPI = false, bool SP2 = false>
__device__ __forceinline__ void gemm_phase(const int tid, PG8_LAS unsigned char* lds, const Gemm g, const Sched& S, const Epi& E) {
    const int wid = __builtin_amdgcn_readfirstlane(tid >> 6), lane = tid & 63, wr = wid >> 2, wc = wid & 3, fr = lane & 15, fq = lane >> 4;
    const int K = g.K, nt = K / BK;
    unsigned voffA[2], voffB[2];
#pragma unroll
    for (int i = 0; i < 2; ++i) { int R, C; stage_rc(tid * 16 + i * 8192, R, C); const int Rb = Epi::PERM ? ((R & ~31) + perm32(R & 31)) : R;
        voffA[i] = (unsigned)(R * K + C) * 2u; voffB[i] = (unsigned)(Rb * K + C) * 2u; }
    const size_t kstep = (size_t)(BK * 2);
    const size_t hstep = (size_t)HALF * K * 2;
    const size_t tstep = 2 * hstep;
    const unsigned ldsw = (unsigned)wid * 1024u;
    const int aoff = lds_byte(wr * 64 + fr, fq * 8), boff = lds_byte(wc * 32 + fr, fq * 8);
#define PG8_SA(b, h) (((b) * 2 + (h)) * HTB)
#define PG8_SB(b, h) ((4 + (b) * 2 + (h)) * HTB)
#define PG8_STAGE(bufoff, gbase, voff) do { _Pragma("unroll") for (int _i = 0; _i < 2; ++_i) \
        __builtin_amdgcn_global_load_lds((const unsigned*)((const char*)(gbase) + (voff)[_i]), (PG8_LAS unsigned*)(lds + (bufoff) + ldsw + _i * 8192), 16, 0, 0); } while (0)
#define PG8_LDA(dst, b, h) do { _Pragma("unroll") for (int m = 0; m < 4; ++m) _Pragma("unroll") for (int k = 0; k < 2; ++k) dst[m][k] = *(const PG8_LAS bf16x8*)(lds + PG8_SA(b, h) + aoff + m * 2048 + k * 1024); } while (0)
#define PG8_LDB(dst, b, h) do { _Pragma("unroll") for (int n = 0; n < 2; ++n) _Pragma("unroll") for (int k = 0; k < 2; ++k) dst[n][k] = *(const PG8_LAS bf16x8*)(lds + PG8_SB(b, h) + boff + n * 2048 + k * 1024); } while (0)
#define PG8_MMA(ai, bj, At, Bt) do { __builtin_amdgcn_s_setprio(1); _Pragma("unroll") for (int m = 0; m < 4; ++m) _Pragma("unroll") for (int n = 0; n < 2; ++n) _Pragma("unroll") for (int k = 0; k < 2; ++k) \
        acc[ai][bj][m][n] = __builtin_amdgcn_mfma_f32_16x16x32_bf16(Bt[n][k], At[m][k], acc[ai][bj][m][n], 0, 0, 0); __builtin_amdgcn_s_setprio(0); } while (0)
#define PG8_WAIT_V(n) asm volatile("s_waitcnt vmcnt(" #n ")" ::: "memory")
#define PG8_WAIT_L(n) asm volatile("s_waitcnt lgkmcnt(" #n ")" ::: "memory")
#define PG8_BAR __builtin_amdgcn_s_barrier()
#define PG8_SCHED __builtin_amdgcn_sched_barrier(0)
    Unit cur, nxt; int ui = 0;
    if (!S.next(0, cur)) return;
    f32x4 acc[2][2][4][2];
#pragma unroll
    for (int a = 0; a < 2; ++a)
#pragma unroll
        for (int b = 0; b < 2; ++b)
#pragma unroll
            for (int m = 0; m < 4; ++m)
#pragma unroll
                for (int n = 0; n < 2; ++n) acc[a][b][m][n] = (f32x4){0.f, 0.f, 0.f, 0.f};
    bf16x8 At[4][2], B0[2][2], B1[2][2];
    const char* cA = (const char*)g.A + (size_t)cur.pm * tstep; const char* cB = (const char*)g.Bt + (size_t)cur.pn * tstep;
    S.a_ready(cur);
    if constexpr (SP2) {
        PG8_STAGE(PG8_SB(0, 0), cB, voffB); PG8_STAGE(PG8_SB(0, 1), cB + hstep, voffB); PG8_STAGE(PG8_SA(0, 0), cA, voffA); PG8_STAGE(PG8_SA(0, 1), cA + hstep, voffA);
        if (wr == 1) PG8_BAR;
        PG8_WAIT_V(2); PG8_BAR;
        PG8_STAGE(PG8_SB(1, 0), cB + kstep, voffB); PG8_STAGE(PG8_SA(1, 0), cA + kstep, voffA); PG8_STAGE(PG8_SB(1, 1), cB + hstep + kstep, voffB);
        PG8_WAIT_V(6); PG8_BAR;
    } else {
        PG8_STAGE(PG8_SB(0, 0), cB, voffB); PG8_STAGE(PG8_SA(0, 0), cA, voffA); PG8_STAGE(PG8_SB(0, 1), cB + hstep, voffB); PG8_STAGE(PG8_SA(0, 1), cA + hstep, voffA);
        if (wr == 1) PG8_BAR;
        PG8_WAIT_V(4); PG8_BAR;
        PG8_STAGE(PG8_SB(1, 0), cB + kstep, voffB); PG8_STAGE(PG8_SA(1, 0), cA + kstep, voffA); PG8_STAGE(PG8_SB(1, 1), cB + hstep + kstep, voffB);
        PG8_WAIT_V(6); PG8_BAR;
    }
    for (;;) {
        const bool has_next = S.next(ui + 1, nxt);
        const char* nA = has_next ? (const char*)g.A + (size_t)nxt.pm * tstep : cA; const char* nB = has_next ? (const char*)g.Bt + (size_t)nxt.pn * tstep : cB;
        for (int t = 0; t < nt; t += 2) {
            const bool last = (t == nt - 2);
            const char* a1 = cA + (size_t)(t + 1) * kstep;
            const char* a2 = last ? nA : cA + (size_t)(t + 2) * kstep; const char* b2 = last ? nB : cB + (size_t)(t + 2) * kstep;
            const char* a3 = a2 + kstep; const char* b3 = b2 + kstep;
            if (last && has_next) S.a_ready(nxt);
            if constexpr (SP2) {
            PG8_LDB(B0, 0, 0); PG8_LDB(B1, 0, 1); PG8_SCHED; PG8_LDA(At, 0, 0); PG8_STAGE(PG8_SA(1, 1), a1 + hstep, voffA);
            PG8_WAIT_V(8); PG8_WAIT_L(0); PG8_BAR; PG8_MMA(0, 0, At, B0); PG8_MMA(0, 1, At, B1); PG8_BAR; PG8_SCHED;
            PG8_LDA(At, 0, 1); PG8_STAGE(PG8_SB(0, 0), b2, voffB); PG8_STAGE(PG8_SB(0, 1), b2 + hstep, voffB); PG8_STAGE(PG8_SA(0, 0), a2, voffA);
            PG8_WAIT_V(8); PG8_WAIT_L(0); PG8_BAR; PG8_MMA(1, 0, At, B0); PG8_MMA(1, 1, At, B1); PG8_BAR; PG8_SCHED;
            PG8_LDB(B0, 1, 0); PG8_LDB(B1, 1, 1); PG8_SCHED; PG8_LDA(At, 1, 0); PG8_STAGE(PG8_SA(0, 1), a2 + hstep, voffA);
            PG8_WAIT_V(8); PG8_WAIT_L(0); PG8_BAR; PG8_MMA(0, 0, At, B0); PG8_MMA(0, 1, At, B1); PG8_BAR; PG8_SCHED;
            PG8_LDA(At, 1, 1); PG8_STAGE(PG8_SB(1, 0), b3, voffB); PG8_STAGE(PG8_SB(1, 1), b3 + hstep, voffB); PG8_STAGE(PG8_SA(1, 0), a3, voffA);
            PG8_WAIT_V(8); PG8_WAIT_L(0); PG8_BAR; PG8_MMA(1, 0, At, B0); PG8_MMA(1, 1, At, B1); PG8_BAR; PG8_SCHED;
            } else {
            PG8_LDB(B0, 0, 0); PG8_SCHED; PG8_LDA(At, 0, 0); PG8_STAGE(PG8_SA(1, 1), a1 + hstep, voffA);
            PG8_WAIT_L(8); PG8_BAR; PG8_WAIT_L(0); PG8_MMA(0, 0, At, B0); PG8_BAR; PG8_SCHED;
            PG8_LDB(B1, 0, 1); PG8_STAGE(PG8_SB(0, 0), b2, voffB);
            PG8_BAR; PG8_WAIT_L(0); PG8_MMA(0, 1, At, B1); PG8_BAR;
            PG8_LDA(At, 0, 1); PG8_STAGE(PG8_SA(0, 0), a2, voffA);
            PG8_BAR; PG8_WAIT_L(0); PG8_MMA(1, 0, At, B0); PG8_BAR; PG8_SCHED;
            PG8_STAGE(PG8_SB(0, 1), b2 + hstep, voffB);
            PG8_WAIT_V(6); PG8_BAR; PG8_MMA(1, 1, At, B1); PG8_BAR;
            PG8_LDB(B0, 1, 0); PG8_SCHED; PG8_LDA(At, 1, 0); PG8_STAGE(PG8_SA(0, 1), a2 + hstep, voffA);
            PG8_WAIT_L(8); PG8_BAR; PG8_WAIT_L(0); PG8_MMA(0, 0, At, B0); PG8_BAR; PG8_SCHED;
            PG8_LDB(B1, 1, 1); PG8_STAGE(PG8_SB(1, 0), b3, voffB);
            PG8_BAR; PG8_WAIT_L(0); PG8_MMA(0, 1, At, B1); PG8_BAR;
            PG8_LDA(At, 1, 1); PG8_STAGE(PG8_SA(1, 0), a3, voffA);
            PG8_BAR; PG8_WAIT_L(0); PG8_MMA(1, 0, At, B0); PG8_BAR; PG8_SCHED;
            PG8_STAGE(PG8_SB(1, 1), b3 + hstep, voffB);
            PG8_WAIT_V(6); PG8_BAR; PG8_MMA(1, 1, At, B1); PG8_BAR;
            }
        }
        if constexpr (ALIGN_EPI) { if (wr == 0) PG8_BAR; }
        if constexpr (!Epi::AFTER_DRAIN) { E(acc, cur, wr, wc, fr, fq); S.done(cur); }
        if (!has_next) break;
#pragma unroll
        for (int a = 0; a < 2; ++a)
#pragma unroll
            for (int b = 0; b < 2; ++b)
#pragma unroll
                for (int m = 0; m < 4; ++m)
#pragma unroll
                    for (int n = 0; n < 2; ++n) acc[a][b][m][n] = (f32x4){0.f, 0.f, 0.f, 0.f};
        cur = nxt; cA = nA; cB = nB; ++ui;
        if constexpr (ALIGN_EPI) { if (wr == 1) PG8_BAR; }
    }
    PG8_WAIT_V(0);
    if constexpr (!ALIGN_EPI) { if (wr == 0) PG8_BAR; }
    PG8_BAR;
    if constexpr (Epi::AFTER_DRAIN) { E.fused(acc, cur, wr, wc, fr, fq, lds, wid, lane); S.done(cur); }
#undef PG8_SA
#undef PG8_SB
#undef PG8_STAGE
#undef PG8_LDA
#undef PG8_LDB
#undef PG8_MMA
#undef PG8_WAIT_V
#undef PG8_WAIT_L
#undef PG8_BAR
#undef PG8_SCHED
}

struct EpiStoreBf16 {
    static constexpr bool PERM = true, AFTER_DRAIN = false;
    bf16_t* O; int ldc; int pnmask;
    __device__ __forceinline__ void operator()(const f32x4 (&acc)[2][2][4][2], const Unit& u, int wr, int wc, int fr, int fq) const {
        const int row0 = u.pm * BM + wr * 64 + fr; const int col0 = (u.pn & pnmask) * BM + wc * 32 + 8 * fq;
#pragma unroll
        for (int ai = 0; ai < 2; ++ai)
#pragma unroll
            for (int m = 0; m < 4; ++m) { bf16_t* rowp = O + (size_t)(row0 + ai * HALF + m * 16) * ldc + col0;
#pragma unroll
                for (int bj = 0; bj < 2; ++bj) { const f32x4 v0 = acc[ai][bj][m][0], v1 = acc[ai][bj][m][1];
                    u32x4 w; w.x = cvt_pk_bf16(v0[0], v0[1]); w.y = cvt_pk_bf16(v0[2], v0[3]); w.z = cvt_pk_bf16(v1[0], v1[1]); w.w = cvt_pk_bf16(v1[2], v1[3]);
                    *(u32x4*)(rowp + bj * HALF) = w; } }
    }
};
struct EpiRes {
    static constexpr bool PERM = false, AFTER_DRAIN = false;
    const float* base; float* out; int ldc;
    __device__ __forceinline__ void operator()(const f32x4 (&acc)[2][2][4][2], const Unit& u, int wr, int wc, int fr, int fq) const {
        const int row0 = u.pm * BM + wr * 64 + fr; const int col0 = u.pn * BM + wc * 32 + 4 * fq;
#pragma unroll
        for (int ai = 0; ai < 2; ++ai)
#pragma unroll
            for (int m = 0; m < 4; ++m) { const size_t off = (size_t)(row0 + ai * HALF + m * 16) * ldc + col0;
#pragma unroll
                for (int bj = 0; bj < 2; ++bj)
#pragma unroll
                    for (int n = 0; n < 2; ++n) { const f32x4 b = *(const f32x4*)(base + off + bj * HALF + n * 16); *(f32x4*)(out + off + bj * HALF + n * 16) = b + acc[ai][bj][m][n]; } }
    }
};
struct EpiGateUp {
    static constexpr bool PERM = true, AFTER_DRAIN = false;
    bf16_t* O; int ldc;
    __device__ __forceinline__ static float silu(float x) { return x / (1.f + __expf(-x)); }
    __device__ __forceinline__ void operator()(const f32x4 (&acc)[2][2][4][2], const Unit& u, int wr, int wc, int fr, int fq) const {
        const int row0 = u.pm * BM + wr * 64 + fr; const int col0 = ((u.pn & 3) * BM + wc * 32 + 8 * fq) >> 1;
#pragma unroll
        for (int ai = 0; ai < 2; ++ai)
#pragma unroll
            for (int m = 0; m < 4; ++m) { bf16_t* rowp = O + (size_t)(row0 + ai * HALF + m * 16) * ldc + col0;
#pragma unroll
                for (int bj = 0; bj < 2; ++bj) { const f32x4 v0 = acc[ai][bj][m][0], v1 = acc[ai][bj][m][1];
                    uint2 w; w.x = cvt_pk_bf16(silu(v0[0]) * v0[1], silu(v0[2]) * v0[3]); w.y = cvt_pk_bf16(silu(v1[0]) * v1[1], silu(v1[2]) * v1[3]);
                    *(uint2*)(rowp + bj * (HALF / 2)) = w; } }
    }
};
struct InprojSched {
    StaticOrder base; int extra;
    __device__ __forceinline__ bool next(int i, Unit& u) const {
        if (base.next(i, u)) return true;
        const long L = (long)i * base.G + base.c - base.nwg;
        if (L < 0 || L >= extra) return false;
        const int e = (int)L; u.pm = base.nM + (e >> 3) * 4 + ((e >> 1) & 3); u.pn = base.nN + (e >> 3) * 2 + (e & 1); return true;
    }
    __device__ __forceinline__ void a_ready(const Unit&) const {}
    __device__ __forceinline__ void done(const Unit&) const {}
};
struct EpiInproj {
    static constexpr bool PERM = true, AFTER_DRAIN = false;
    bf16_t* Zp; bf16_t* CKVp;
    __device__ __forceinline__ void operator()(const f32x4 (&acc)[2][2][4][2], const Unit& u, int wr, int wc, int fr, int fq) const {
        const bool kv = u.pm >= 64;
        const int ll = (u.pm - 64) >> 2;
        bf16_t* O = kv ? CKVp + (size_t)ll * 1024 * 512 : Zp; const int ldc = kv ? 512 : 3584;
        const int row0 = (kv ? ((u.pm - 64) & 3) : u.pm) * BM + wr * 64 + fr; const int col0 = (kv ? ((u.pn - 14) & 1) : u.pn) * BM + wc * 32 + 8 * fq;
#pragma unroll
        for (int ai = 0; ai < 2; ++ai)
#pragma unroll
            for (int m = 0; m < 4; ++m) { bf16_t* rowp = O + (size_t)(row0 + ai * HALF + m * 16) * ldc + col0;
#pragma unroll
                for (int bj = 0; bj < 2; ++bj) { const f32x4 v0 = acc[ai][bj][m][0], v1 = acc[ai][bj][m][1];
                    u32x4 w; w.x = cvt_pk_bf16(v0[0], v0[1]); w.y = cvt_pk_bf16(v0[2], v0[3]); w.z = cvt_pk_bf16(v1[0], v1[1]); w.w = cvt_pk_bf16(v1[2], v1[3]);
                    *(u32x4*)(rowp + bj * HALF) = w; } }
    }
};
struct GroupSched {
    int off[17]; int nunits, G, c;
    __device__ __forceinline__ bool next(int i, Unit& u) const {
        const int L = i * G + c; if (L >= nunits) return false;
        const int rt = L >> 2, pn = L & 3, row0 = rt * BM; int e = 0;
#pragma unroll
        for (int q = 1; q < 16; ++q) e = (row0 >= off[q]) ? q : e;
        u.pm = rt; u.pn = e * 4 + pn; return true;
    }
    __device__ __forceinline__ void a_ready(const Unit&) const {}
    __device__ __forceinline__ void done(const Unit&) const {}
};
}

__device__ __forceinline__ void rmsnorm_row_bf16(const float* xrow, const float* g, bf16_t* orow, int lane) {
    f32x4 v[4]; float s = 0.f;
#pragma unroll
    for (int j = 0; j < 4; ++j) { v[j] = *(const f32x4*)(xrow + lane * 4 + 256 * j); s += v[j][0] * v[j][0] + v[j][1] * v[j][1] + v[j][2] * v[j][2] + v[j][3] * v[j][3]; }
    const float rinv = 1.0f / sqrtf(wave_sum(s) * (1.f / 1024.f) + NORM_EPS);
#pragma unroll
    for (int j = 0; j < 4; ++j) {
        const f32x4 gg = *(const f32x4*)(g + lane * 4 + 256 * j);
        uint2 o; o.x = pk2(v[j][0] * rinv * gg[0], v[j][1] * rinv * gg[1]); o.y = pk2(v[j][2] * rinv * gg[2], v[j][3] * rinv * gg[3]);
        *(uint2*)(orow + lane * 4 + 256 * j) = o;
    }
}

__device__ __forceinline__ void transpose_item(const float* W, int K, int N, int nblk, bf16_t* WT, int row_off, int rmul, int radd, float* scr, int item, int lane) {
    const int kb = item / nblk, nb = item % nblk, k0 = 64 * kb, n0 = 32 * nb;
    const bool nv = (n0 + (lane & 31)) < N;
    float wv[32];
    const float* wp = W + (size_t)(k0 + (lane >> 5)) * N + n0 + (lane & 31);
#pragma unroll
    for (int i = 0; i < 32; ++i) wv[i] = nv ? wp[(size_t)(2 * i) * N] : 0.f;
#pragma unroll
    for (int i = 0; i < 32; ++i) scr[(2 * i + (lane >> 5)) * 33 + (lane & 31)] = wv[i];
    __builtin_amdgcn_s_waitcnt(0xc07f); __builtin_amdgcn_wave_barrier();
    const int c = lane & 7;
#pragma unroll
    for (int j = 0; j < 4; ++j) { const int n = (lane >> 3) + 8 * j; const float* sp = scr + (8 * c) * 33 + n;
        uint4 o; o.x = pk2(sp[0 * 33], sp[1 * 33]); o.y = pk2(sp[2 * 33], sp[3 * 33]); o.z = pk2(sp[4 * 33], sp[5 * 33]); o.w = pk2(sp[6 * 33], sp[7 * 33]);
        *(uint4*)(WT + (size_t)(row_off + (n0 + n) * rmul + radd) * K + k0 + 8 * c) = o; }
    __builtin_amdgcn_s_waitcnt(0xc07f); __builtin_amdgcn_wave_barrier();
}

__device__ __forceinline__ int t5_bucket(int dist) {
    if (dist < 16) return dist;
    const float d = (float)dist;
    int large = 16 + (int)(__logf(d * (1.f / 16.f)) * (16.0f / 2.0794415416798357f));
    return large < 31 ? large : 31;
}
__device__ __forceinline__ unsigned fkey(float f) { const unsigned u = __float_as_uint(f + 0.0f); return (u & 0x80000000u) ? ~u : (u | 0x80000000u); }


#define LAS __attribute__((address_space(3)))
#define XB_TMO      128
#define XB_XCNT(j)  (256  + 64 * (j))
#define XB_XSUB(j)  (1280 + 64 * (j))
#define XB_XGEN(j)  (2304 + 64 * (j))
#define XB_TOP      3328
#define XB_TOPGEN   3392
#define XCD_BAR_WORDS 3456
#define XB_SPIN_CAP (1u << 24)
__device__ __forceinline__ unsigned xb_ld(unsigned* p)              { return __hip_atomic_load(p, __ATOMIC_RELAXED, __HIP_MEMORY_SCOPE_AGENT); }
__device__ __forceinline__ unsigned xb_add(unsigned* p, unsigned v) { return __hip_atomic_fetch_add(p, v, __ATOMIC_RELAXED, __HIP_MEMORY_SCOPE_AGENT); }
__device__ __forceinline__ unsigned xb_xcc_id() { return (unsigned)__builtin_amdgcn_s_getreg((3 << 11) | 20) & 0xFu; }
#define XB_SPIN(cond, bar) do { unsigned _sp = 0; while (cond) { __builtin_amdgcn_s_sleep(1); \
    if ((++_sp & 255u) == 0u) { if (xb_ld(&(bar)[XB_TMO])) break; if (_sp > XB_SPIN_CAP) { atomicAdd(&(bar)[XB_TMO], 1u); break; } } } } while (0)
struct XcdBarrier { unsigned* bar; unsigned x; volatile LAS unsigned* st; };
__device__ __forceinline__ XcdBarrier xcd_barrier_post(unsigned* bar, volatile LAS unsigned* st) {
    XcdBarrier b; b.bar = bar; b.x = xb_xcc_id(); b.st = st;
    if (threadIdx.x == 0) (void)xb_add(&bar[XB_XCNT(b.x)], 1u);
    return b;
}
__device__ __forceinline__ void xcd_barrier_complete(unsigned* bar, unsigned x, unsigned& nloc, unsigned& nx) {
    const unsigned G = gridDim.x * gridDim.y * gridDim.z;
    unsigned sum, cnt, mine, sp = 0u;
    for (;;) {
        sum = 0u; cnt = 0u; mine = 0u;
#pragma unroll
        for (unsigned j = 0; j < 16; ++j) { const unsigned c = xb_ld(&bar[XB_XCNT(j)]); sum += c; cnt += (c > 0u) ? 1u : 0u; mine = (j == x) ? c : mine; }
        if (sum == G) break;
        __builtin_amdgcn_s_sleep(1);
        if ((++sp & 255u) == 0u) { if (xb_ld(&bar[XB_TMO])) break; if (sp > XB_SPIN_CAP) { atomicAdd(&bar[XB_TMO], 1u); break; } }
    }
    nloc = mine > 0u ? mine : 1u; nx = cnt > 0u ? cnt : 1u;
}
__device__ __forceinline__ void xcd_barrier(const XcdBarrier& b) {
    asm volatile("s_waitcnt vmcnt(0)" ::: "memory");
    __syncthreads();
    if (threadIdx.x == 0) {
        unsigned* bar = b.bar;
        __builtin_amdgcn_s_waitcnt(0);
        unsigned nloc = b.st[0], nx = b.st[1];
        if (nloc == 0u) { xcd_barrier_complete(bar, b.x, nloc, nx); b.st[0] = nloc; b.st[1] = nx; }
        const unsigned old = xb_add(&bar[XB_XSUB(b.x)], 1u);
        const unsigned gen = old / nloc;
        if (old + 1u == (gen + 1u) * nloc) {
            __builtin_amdgcn_fence(__ATOMIC_RELEASE, "agent");
            asm volatile("s_waitcnt vmcnt(0)" ::: "memory");
            const unsigned og = xb_add(&bar[XB_TOP], 1u);
            const unsigned tg = og / nx;
            if (og + 1u == (tg + 1u) * nx) xb_add(&bar[XB_TOPGEN], 1u);
            else XB_SPIN(xb_ld(&bar[XB_TOPGEN]) == tg, bar);
            __builtin_amdgcn_fence(__ATOMIC_ACQUIRE, "agent");
            xb_add(&bar[XB_XGEN(b.x)], 1u);
            asm volatile("s_waitcnt vmcnt(0)" ::: "memory");
        } else {
            XB_SPIN(xb_ld(&bar[XB_XGEN(b.x)]) == gen, bar);
            __builtin_amdgcn_fence(__ATOMIC_ACQUIRE, "agent");
            asm volatile("s_waitcnt vmcnt(0)" ::: "memory");
        }
    }
    __syncthreads();
}
constexpr int CW_BAR = 4096;
constexpr int LDSCTL_OFF = LDS_BYTES - 256;

constexpr int NP = 15;
constexpr int MOEW_IG = 16 * 16, MOEW_ID = 8 * 32, MOEW_IE = 2 * MOEW_IG + MOEW_ID;
constexpr int MOEW_P7 = 2688;
#ifndef MK_PHMASK
#define MK_PHMASK 0x7fff
#endif
#define PH_ON(x) (((MK_PHMASK) >> (x)) & 1)

template <int KSEL>
__global__ void __launch_bounds__(NTHREADS, 2) mk_fwd(Args args) {
    extern __shared__ __attribute__((aligned(16))) unsigned char lds_raw[];
    float* ldsf = (float*)lds_raw;
    const int G = gridDim.x, bid = blockIdx.x, NGW = G * NWAVES;
    const int wave_s = __builtin_amdgcn_readfirstlane(threadIdx.x >> 6);
    unsigned char* ws = args.ws;
    unsigned* ctl = (unsigned*)(ws + WS_CTL);
    bf16_t* XN = (bf16_t*)(ws + WS_XN);
    bf16_t* Z = (bf16_t*)(ws + WS_Z);
    bf16_t* XG = (bf16_t*)(ws + WS_XG);
    bf16_t* VT = (bf16_t*)(ws + WS_VT); unsigned* MASK = (unsigned*)(ws + WS_MASK); bf16_t* IK = (bf16_t*)(ws + WS_IK); bf16_t* QL = (bf16_t*)(ws + WS_QL); float* CH = (float*)(ws + WS_CH);
    float* BCUM = (float*)(ws + WS_BCUM); float* SLOC = (float*)(ws + WS_SLOC); float* DEC = (float*)(ws + WS_DEC);
    bf16_t* WIN0 = (bf16_t*)(ws + WS_WIN0); bf16_t* WIN1 = (bf16_t*)(ws + WS_WIN1); bf16_t* WOUT = (bf16_t*)(ws + WS_WOUT); bf16_t* WCQ = (bf16_t*)(ws + WS_WCQ); bf16_t* WCKV = (bf16_t*)(ws + WS_WCKV); bf16_t* WCO = (bf16_t*)(ws + WS_WCO);
    bf16_t* WGU = (bf16_t*)(ws + WS_WGU); bf16_t* WDN = (bf16_t*)(ws + WS_WDN);
    pg8::PG8_LAS_T ldsq = (pg8::PG8_LAS_T)lds_raw;
    bf16_t* HB = (bf16_t*)(ws + WS_HB);
    bf16_t* MIX = (bf16_t*)(ws + WS_MIX);
    bf16_t* DB = (bf16_t*)(ws + WS_DB);
    bf16_t* QN = (bf16_t*)(ws + WS_QN);
    bf16_t* KN = (bf16_t*)(ws + WS_KN);
    bf16_t* CQ = (bf16_t*)(ws + WS_CQ);
    bf16_t* COIN = (bf16_t*)(ws + WS_COIN);
    bf16_t* MEMN = (bf16_t*)(ws + WS_MEMN);
    bf16_t* CKV = (bf16_t*)(ws + WS_CKV);
    bf16_t* CKN = (bf16_t*)(ws + WS_CKN);
    bf16_t* CVT = (bf16_t*)(ws + WS_CVT);
    int* tok_e = (int*)(ws + WS_ROUTE);
    int* CNTT = (int*)(ws + WS_ROUTE + 768 * 1024);
    bf16_t* WRT = (bf16_t*)(ws + WS_ROUTE + 512 * 1024);
    int* tok_r = tok_e + 2 * T;
    float* tok_g = (float*)(tok_r + 2 * T);
    float* OUT = args.out;
    XcdBarrier bar; bar.bar = ctl + CW_BAR; bar.x = 0; bar.st = nullptr;
    if (KSEL < 0) {
        volatile LAS unsigned* st = (volatile LAS unsigned*)((LAS unsigned char*)lds_raw + LDSCTL_OFF);
        if (threadIdx.x < 64) st[threadIdx.x] = 0u;
        __syncthreads();
        bar = xcd_barrier_post(ctl + CW_BAR, st);
    }

#ifndef MK_REPEAT_PH
#define MK_REPEAT_PH (-1)
#define MK_REPEAT_N 0
#endif
#ifdef MK_XBAR
    if (KSEL < 0) for (int xb = 0; xb < MK_XBAR; ++xb) xcd_barrier(bar);
#endif
    const int nvirt = (args.ph_hi - args.ph_lo) + ((MK_REPEAT_PH >= 0) ? MK_REPEAT_N : 0);
    for (int vi = 0; vi < nvirt; ++vi) {
        const int ph = (MK_REPEAT_PH < 0 || vi <= MK_REPEAT_PH) ? args.ph_lo + vi : ((vi <= MK_REPEAT_PH + MK_REPEAT_N) ? MK_REPEAT_PH : args.ph_lo + vi - MK_REPEAT_N);
        const int rep = (MK_REPEAT_PH >= 0 && vi > MK_REPEAT_PH && vi <= MK_REPEAT_PH + MK_REPEAT_N) ? vi - MK_REPEAT_PH : 0;
        if (KSEL < 0 && ph >= NP && (ph % NP) == 0) continue;
        if (KSEL < 0 && vi > 0) xcd_barrier(bar);
        int tid_op = wave_s * 64 + (int)__builtin_amdgcn_mbcnt_hi(~0u, __builtin_amdgcn_mbcnt_lo(~0u, 0u)); asm volatile("" : "+v"(tid_op));
        const int tid = tid_op, lane = tid & 63, wave = __builtin_amdgcn_readfirstlane(tid >> 6), gw = bid * NWAVES + wave;
#ifdef MK_PROF_A
        if (bid == 0 && tid == 0) ctl[8192 + ph] = (unsigned)__builtin_amdgcn_s_memrealtime();
#endif
        const int l = ph / NP, k = (KSEL >= 0) ? KSEL : (ph % NP);
        const float* xin = (l == 0) ? args.in[0] : OUT;
        unsigned* cnt = ctl + CW_CNT + 64 * l;

        if (k == 0 && PH_ON(0)) {
            const float* g = args.in[3] + l * D_MODEL;
#pragma unroll 4
            for (int r = gw; r < T; r += NGW) rmsnorm_row_bf16(xin + (size_t)r * D_MODEL, g, XN + (size_t)r * D_MODEL, lane);
            if (l == 0) {
                float* scr = ldsf + wave * (64 * 33);
                constexpr int I_IN = 16 * 112, I_OUT = 16 * 32, I_CQ = 16 * 8, I_CKV = 16 * 16, I_CO = 4 * 32, I_L = I_IN + I_OUT + I_CQ + I_CKV + I_CO;
                for (int it = gw; it < DEPTH * I_L; it += NGW) {
                    const int ll = it / I_L; int r = it % I_L;
                    if (r < I_IN) { transpose_item(args.in[4] + (size_t)ll * D_MODEL * D_IN, D_MODEL, D_IN, 112, (ll == 0 ? WIN0 : WIN1), 0, 1, 0, scr, r, lane); continue; } r -= I_IN;
                    if (r < I_OUT) { transpose_item(args.in[14] + (size_t)ll * D_MODEL * D_MODEL, D_MODEL, D_MODEL, 32, WOUT + (size_t)ll * D_MODEL * D_MODEL, 0, 1, 0, scr, r, lane); continue; } r -= I_OUT;
                    if (r < I_CQ) { transpose_item(args.in[17] + (size_t)ll * D_MODEL * XW, D_MODEL, XW, 8, WCQ + (size_t)ll * XW * D_MODEL, 0, 1, 0, scr, r, lane); continue; } r -= I_CQ;
                    if (r < I_CKV) { transpose_item(args.in[18] + (size_t)ll * D_MODEL * 512, D_MODEL, 512, 16, WCKV + (size_t)ll * 512 * D_MODEL, 0, 1, 0, scr, r, lane); continue; } r -= I_CKV;
                    transpose_item(args.in[21] + (size_t)ll * XW * D_MODEL, XW, D_MODEL, 32, WCO + (size_t)ll * D_MODEL * XW, 0, 1, 0, scr, r, lane);
                }
            }
            if (l == 0)
                for (int i = bid * NTHREADS + tid; i < DEPTH * 32 * (D_MODEL / 8); i += G * NTHREADS) {
                    const int k8 = (i % (D_MODEL / 8)) * 8, n = (i / (D_MODEL / 8)) % 32, ll = i / (32 * (D_MODEL / 8));
                    float wv[8];
#pragma unroll
                    for (int e = 0; e < 8; ++e) wv[e] = (n < 4) ? args.in[23][((size_t)ll * D_MODEL + k8 + e) * N_GROUPS + n] : ((n < 20) ? args.in[25][((size_t)ll * D_MODEL + k8 + e) * N_EXPERTS + n - 4] : 0.f);
                    uint4 hi, lo;
                    hi.x = pk2(wv[0], wv[1]); hi.y = pk2(wv[2], wv[3]); hi.z = pk2(wv[4], wv[5]); hi.w = pk2(wv[6], wv[7]);
                    lo.x = pk2(wv[0] - __uint_as_float(hi.x << 16), wv[1] - __uint_as_float(hi.x & 0xffff0000u)); lo.y = pk2(wv[2] - __uint_as_float(hi.y << 16), wv[3] - __uint_as_float(hi.y & 0xffff0000u));
                    lo.z = pk2(wv[4] - __uint_as_float(hi.z << 16), wv[5] - __uint_as_float(hi.z & 0xffff0000u)); lo.w = pk2(wv[6] - __uint_as_float(hi.w << 16), wv[7] - __uint_as_float(hi.w & 0xffff0000u));
                    *(uint4*)(WRT + ((size_t)(ll * 2) * 32 + n) * D_MODEL + k8) = hi; *(uint4*)(WRT + ((size_t)(ll * 2 + 1) * 32 + n) * D_MODEL + k8) = lo;
                }
            if (l == 0)
                for (int r = gw; r < 2 * BATCH * MEM_LEN; r += NGW) {
                    const int ll = r / (BATCH * MEM_LEN), rr = r % (BATCH * MEM_LEN);
                    rmsnorm_row_bf16(args.in[1] + (size_t)rr * D_MODEL, args.in[16] + ll * D_MODEL, MEMN + (size_t)r * D_MODEL, lane);
                }
        } else if (k == 1 && PH_ON(1)) {
            {
                pg8::Gemm g{XN, l == 0 ? WIN0 : WIN1, T, ZLD, D_MODEL};
                pg8::InprojSched S; S.base.init(T, ZLD, G, bid); S.extra = (l == 0) ? 16 : 0;
                pg8::EpiInproj E{Z, CKV};
                pg8::gemm_phase<pg8::EpiInproj, pg8::InprojSched, true, true>(tid, ldsq, g, S, E);
            }
        } else if (k == 2 && PH_ON(2)) {
#ifndef MK_P2C
#define MK_P2C 1
#endif
            for (int rp_mk_p2c = 0; rp_mk_p2c < MK_P2C; ++rp_mk_p2c)
            {
                float* lr = ldsf;
                float* la = ldsf + 1024;
                float* ks = ldsf + 4160;
                float* vs = ldsf + 7488;
                float* seg = ldsf + 13888;
                float* w2t = ldsf + 14272;
                const float* wa2 = args.in[5] + (size_t)l * GLA_RANK * 192;
                const float* ba = args.in[6] + l * 192;
                for (int i = tid; i < 4 * 48 * 4; i += NTHREADS) { const int hd = i / 192, d = (i % 192) % 48, r4 = ((i % 192) / 48) * 4;
                    *(f32x4*)&w2t[(hd * 48 + d) * 16 + r4] = (f32x4){wa2[(r4 + 0) * 192 + hd * 48 + d], wa2[(r4 + 1) * 192 + hd * 48 + d], wa2[(r4 + 2) * 192 + hd * 48 + d], wa2[(r4 + 3) * 192 + hd * 48 + d]}; }
                uint4 pf_lr = make_uint4(0u, 0u, 0u, 0u), pf_k = pf_lr, pf_v0 = pf_lr, pf_v1 = pf_lr;
#define GLA1_FETCH(item_) do { const int bh_ = (item_) >> 6, c_ = (item_) & 63, b_ = bh_ >> 2, h_ = bh_ & 3, tk_ = b_ * SEQ + c_ * 64; \
                    if (tid < 128) pf_lr = *(const uint4*)(Z + (size_t)(tk_ + (tid >> 1)) * ZLD + Z_GLR + (tid & 1) * 8); \
                    if (tid < 384) pf_k = *(const uint4*)(Z + (size_t)(tk_ + tid / 6) * ZLD + Z_GK + h_ * 48 + (tid % 6) * 8); \
                    pf_v0 = *(const uint4*)(Z + (size_t)(tk_ + tid / 12) * ZLD + Z_GV + h_ * 96 + (tid % 12) * 8); \
                    if (tid < 256) pf_v1 = *(const uint4*)(Z + (size_t)(tk_ + (tid + 512) / 12) * ZLD + Z_GV + h_ * 96 + ((tid + 512) % 12) * 8); } while (0)
                if (bid < BATCH * GLA_HEADS * 64) GLA1_FETCH(bid);
                for (int item = bid; item < BATCH * GLA_HEADS * 64; item += G) {
                    const int bh = item >> 6, c = item & 63, b = bh >> 2, h = bh & 3, tok0 = b * SEQ + c * 64;
                    __syncthreads();
                    if (tid < 128) { const int t = tid >> 1, c8 = (tid & 1) * 8; const uint4 u = pf_lr;
                        *(f32x4*)&lr[t * 16 + c8] = (f32x4){__uint_as_float(u.x << 16), __uint_as_float(u.x & 0xffff0000u), __uint_as_float(u.y << 16), __uint_as_float(u.y & 0xffff0000u)};
                        *(f32x4*)&lr[t * 16 + c8 + 4] = (f32x4){__uint_as_float(u.z << 16), __uint_as_float(u.z & 0xffff0000u), __uint_as_float(u.w << 16), __uint_as_float(u.w & 0xffff0000u)}; }
                    if (tid < 384) { const int t = tid / 6, c8 = (tid % 6) * 8; const uint4 u = pf_k;
                        *(f32x4*)&ks[t * 52 + c8] = (f32x4){__uint_as_float(u.x << 16), __uint_as_float(u.x & 0xffff0000u), __uint_as_float(u.y << 16), __uint_as_float(u.y & 0xffff0000u)};
                        *(f32x4*)&ks[t * 52 + c8 + 4] = (f32x4){__uint_as_float(u.z << 16), __uint_as_float(u.z & 0xffff0000u), __uint_as_float(u.w << 16), __uint_as_float(u.w & 0xffff0000u)}; }
                    { const int t = tid / 12, c8 = (tid % 12) * 8; const uint4 u = pf_v0;
                        *(f32x4*)&vs[t * 100 + c8] = (f32x4){__uint_as_float(u.x << 16), __uint_as_float(u.x & 0xffff0000u), __uint_as_float(u.y << 16), __uint_as_float(u.y & 0xffff0000u)};
                        *(f32x4*)&vs[t * 100 + c8 + 4] = (f32x4){__uint_as_float(u.z << 16), __uint_as_float(u.z & 0xffff0000u), __uint_as_float(u.w << 16), __uint_as_float(u.w & 0xffff0000u)}; }
                    if (tid < 256) { const int t = (tid + 512) / 12, c8 = ((tid + 512) % 12) * 8; const uint4 u = pf_v1;
                        *(f32x4*)&vs[t * 100 + c8] = (f32x4){__uint_as_float(u.x << 16), __uint_as_float(u.x & 0xffff0000u), __uint_as_float(u.y << 16), __uint_as_float(u.y & 0xffff0000u)};
                        *(f32x4*)&vs[t * 100 + c8 + 4] = (f32x4){__uint_as_float(u.z << 16), __uint_as_float(u.z & 0xffff0000u), __uint_as_float(u.w << 16), __uint_as_float(u.w & 0xffff0000u)}; }
                    __syncthreads();
                    if (item + G < BATCH * GLA_HEADS * 64) GLA1_FETCH(item + G);
                    const float* w2h = w2t + h * 48 * 16;
                    {
                        const int t = tid >> 3, d0 = (tid & 7) * 6;
                        const f32x4 l0 = *(const f32x4*)&lr[t * 16], l1 = *(const f32x4*)&lr[t * 16 + 4], l2 = *(const f32x4*)&lr[t * 16 + 8], l3 = *(const f32x4*)&lr[t * 16 + 12];
#pragma unroll
                        for (int e = 0; e < 6; ++e) { const int d = d0 + e;
                            const f32x4 w0 = *(const f32x4*)&w2h[d * 16], w1 = *(const f32x4*)&w2h[d * 16 + 4], w2 = *(const f32x4*)&w2h[d * 16 + 8], w3 = *(const f32x4*)&w2h[d * 16 + 12];
                            const float x = ba[h * 48 + d] + (l0[0] * w0[0] + l0[1] * w0[1] + l0[2] * w0[2] + l0[3] * w0[3]) + (l1[0] * w1[0] + l1[1] * w1[1] + l1[2] * w1[2] + l1[3] * w1[3])
                                          + (l2[0] * w2[0] + l2[1] * w2[1] + l2[2] * w2[2] + l2[3] * w2[3]) + (l3[0] * w3[0] + l3[1] * w3[1] + l3[2] * w3[2] + l3[3] * w3[3]);
                            la[t * 49 + d] = (fminf(x, 0.f) - __logf(1.f + __expf(-fabsf(x)))) * (1.f / 16.f); }
                    }
                    __syncthreads();
                    const int cd = tid % 48, cs = tid / 48;
                    if (tid < 384) { float run = 0.f;
#pragma unroll
                        for (int j2 = 0; j2 < 8; ++j2) { run += la[(cs * 8 + j2) * 49 + cd]; la[(cs * 8 + j2) * 49 + cd] = run; }
                        seg[cs * 48 + cd] = run; }
                    __syncthreads();
                    if (tid < 384) { float base = 0.f;
                        for (int q = 0; q < cs; ++q) base += seg[q * 48 + cd];
#pragma unroll
                        for (int j2 = 0; j2 < 8; ++j2) { const float v = la[(cs * 8 + j2) * 49 + cd] + base; la[(cs * 8 + j2) * 49 + cd] = v; BCUM[(size_t)(tok0 + cs * 8 + j2) * 192 + h * 48 + cd] = v; } }
                    __syncthreads();
                    for (int i = tid; i < 64 * 48; i += NTHREADS) { const int t = i / 48, d = i % 48; ks[t * 52 + d] *= __expf(la[63 * 49 + d] - la[t * 49 + d]); }
                    if (tid < 48) DEC[(size_t)item * 48 + tid] = __expf(la[63 * 49 + tid]);
                    __syncthreads();
                    if (tid < 288) {
                        const int d0 = (tid / 24) * 4, v0 = (tid % 24) * 4;
                        float acc[4][4];
#pragma unroll
                        for (int x = 0; x < 4; ++x)
#pragma unroll
                            for (int y = 0; y < 4; ++y) acc[x][y] = 0.f;
#pragma unroll 4
                        for (int sidx = 0; sidx < 64; ++sidx) { const f32x4 kv = *(const f32x4*)&ks[sidx * 52 + d0], vv = *(const f32x4*)&vs[sidx * 100 + v0];
#pragma unroll
                            for (int x = 0; x < 4; ++x)
#pragma unroll
                                for (int y = 0; y < 4; ++y) acc[x][y] += kv[x] * vv[y]; }
#pragma unroll
                        for (int y = 0; y < 4; ++y) *(f32x4*)(SLOC + (size_t)item * 4608 + (v0 + y) * 48 + d0) = (f32x4){acc[0][y], acc[1][y], acc[2][y], acc[3][y]};
                    }
                }
                __syncthreads();
            }
#ifndef MK_P2A
#define MK_P2A 1
#endif
            for (int rp_mk_p2a = 0; rp_mk_p2a < MK_P2A; ++rp_mk_p2a)
            {
                const float* gq = args.in[8] + l * DSA_DH; const float* gk = args.in[9] + l * DSA_DH;
                for (int it = bid * NTHREADS + tid; it < T * 12; it += G * NTHREADS) {
                    const int tok = it / 12, jj = it % 12, isk = jj / 6, hd = jj % 6;
                    const uint4* src = (const uint4*)(Z + (size_t)tok * ZLD + (isk ? Z_DK : Z_DQ) + hd * 64);
                    uint4 u[8]; float ss = 0.f;
#pragma unroll
                    for (int c = 0; c < 8; ++c) { u[c] = src[c];
                        const float a0 = __uint_as_float(u[c].x << 16), a1 = __uint_as_float(u[c].x & 0xffff0000u), a2 = __uint_as_float(u[c].y << 16), a3 = __uint_as_float(u[c].y & 0xffff0000u);
                        const float a4 = __uint_as_float(u[c].z << 16), a5 = __uint_as_float(u[c].z & 0xffff0000u), a6 = __uint_as_float(u[c].w << 16), a7 = __uint_as_float(u[c].w & 0xffff0000u);
                        ss += a0 * a0 + a1 * a1 + a2 * a2 + a3 * a3 + a4 * a4 + a5 * a5 + a6 * a6 + a7 * a7; }
                    const float rn = (isk ? 1.0f : (0.125f * 1.4426950408889634f)) / sqrtf(ss * (1.f / 64.f) + NORM_EPS);
                    const float* gp = isk ? gk : gq;
                    uint4* dst = (uint4*)((isk ? KN : QN) + (size_t)tok * 384 + hd * 64);
#pragma unroll
                    for (int c = 0; c < 8; ++c) { const f32x4 g0 = *(const f32x4*)(gp + c * 8), g1 = *(const f32x4*)(gp + c * 8 + 4);
                        uint4 o;
                        o.x = pk2(__uint_as_float(u[c].x << 16) * rn * g0[0], __uint_as_float(u[c].x & 0xffff0000u) * rn * g0[1]);
                        o.y = pk2(__uint_as_float(u[c].y << 16) * rn * g0[2], __uint_as_float(u[c].y & 0xffff0000u) * rn * g0[3]);
                        o.z = pk2(__uint_as_float(u[c].z << 16) * rn * g1[0], __uint_as_float(u[c].z & 0xffff0000u) * rn * g1[1]);
                        o.w = pk2(__uint_as_float(u[c].w << 16) * rn * g1[2], __uint_as_float(u[c].w & 0xffff0000u) * rn * g1[3]);
                        dst[c] = o; }
                }
                for (int it = bid * NTHREADS + tid; it < T * 8; it += G * NTHREADS) {
                    const int tok = it >> 3, c8 = (it & 7) * 8;
                    const bf16_t* zr = Z + (size_t)tok * ZLD;
                    const uint4 wu = *(const uint4*)(zr + Z_IW);
                    const float cw[8] = {__uint_as_float(wu.x << 16), __uint_as_float(wu.x & 0xffff0000u), __uint_as_float(wu.y << 16), __uint_as_float(wu.y & 0xffff0000u),
                                         __uint_as_float(wu.z << 16), __uint_as_float(wu.z & 0xffff0000u), __uint_as_float(wu.w << 16), __uint_as_float(wu.w & 0xffff0000u)};
                    float ql[8];
#pragma unroll
                    for (int e = 0; e < 8; ++e) ql[e] = 0.f;
#pragma unroll
                    for (int hq = 0; hq < IDX_HEADS; ++hq) { const float c = cw[hq] * (0.35355339059327373f * 0.0625f); const uint4 qu = *(const uint4*)(zr + Z_IQ + hq * 64 + c8);
                        ql[0] += c * __uint_as_float(qu.x << 16); ql[1] += c * __uint_as_float(qu.x & 0xffff0000u); ql[2] += c * __uint_as_float(qu.y << 16); ql[3] += c * __uint_as_float(qu.y & 0xffff0000u);
                        ql[4] += c * __uint_as_float(qu.z << 16); ql[5] += c * __uint_as_float(qu.z & 0xffff0000u); ql[6] += c * __uint_as_float(qu.w << 16); ql[7] += c * __uint_as_float(qu.w & 0xffff0000u); }
                    uint4 o; o.x = pk2(ql[0], ql[1]); o.y = pk2(ql[2], ql[3]); o.z = pk2(ql[4], ql[5]); o.w = pk2(ql[6], ql[7]);
                    *(uint4*)(QL + (size_t)tok * 64 + c8) = o;
                    *(uint4*)(IK + (size_t)tok * 64 + c8) = *(const uint4*)(zr + Z_IK + c8);
                    if (c8 == 0) { *(f32x4*)(CH + (size_t)tok * 8) = (f32x4){cw[0], cw[1], cw[2], cw[3]} * (0.35355339059327373f * 0.0625f); *(f32x4*)(CH + (size_t)tok * 8 + 4) = (f32x4){cw[4], cw[5], cw[6], cw[7]} * (0.35355339059327373f * 0.0625f); }
                }
            }
#ifndef MK_P2E
#define MK_P2E 1
#endif
            for (int rp_mk_p2e = 0; rp_mk_p2e < MK_P2E; ++rp_mk_p2e)
            for (int tile = bid; tile < BATCH * 128; tile += G) {
                if (tid < 384) {
                    const bf16_t* zb = Z + (size_t)(tile * 32) * ZLD + Z_DV + tid;
                    unsigned w[16];
#pragma unroll
                    for (int p2 = 0; p2 < 16; ++p2) {
                        const int p = 2 * p2, sst = p >> 4, hh2 = (p >> 3) & 1, j = p & 7;
                        const int key0 = 16 * sst + 8 * (j >> 2) + 4 * hh2 + (j & 3);
                        w[p2] = (unsigned)zb[(size_t)key0 * ZLD] | ((unsigned)zb[(size_t)(key0 + 1) * ZLD] << 16);
                    }
                    uint4* dst = (uint4*)(VT + ((size_t)tile * 384 + tid) * 32);
                    dst[0] = make_uint4(w[0], w[1], w[2], w[3]); dst[1] = make_uint4(w[4], w[5], w[6], w[7]); dst[2] = make_uint4(w[8], w[9], w[10], w[11]); dst[3] = make_uint4(w[12], w[13], w[14], w[15]);
                }
            }
            if (l == 0) {
                for (int i = bid * NTHREADS + tid; i < DEPTH * BATCH * X_HEADS * 64 * MEM_LEN; i += G * NTHREADS) {
                    const int p = i & 255, d = (i >> 8) & 63, h = (i >> 14) & 3, bb = (i >> 16) & 3, ll = i >> 18;
                    const int pg = p & 31, sst = pg >> 4, hh2 = (pg >> 3) & 1, j2 = pg & 7;
                    const int key = (p & ~31) + 16 * sst + 8 * (j2 >> 2) + 4 * hh2 + (j2 & 3);
                    CVT[i] = CKV[((size_t)ll * BATCH * MEM_LEN + (size_t)bb * MEM_LEN + key) * 512 + 256 + h * 64 + d];
                }
                for (int r = gw; r < DEPTH * BATCH * MEM_LEN; r += NGW) {
                    const int ll = r / (BATCH * MEM_LEN);
                    const float gkl = args.in[20][ll * X_DH + lane];
#pragma unroll
                    for (int h = 0; h < X_HEADS; ++h) {
                        const float kk = bf2f(CKV[(size_t)r * 512 + h * 64 + lane]);
                        const float rk = 1.0f / sqrtf(wave_sum(kk * kk) * (1.f / 64.f) + NORM_EPS);
                        CKN[(size_t)r * 256 + h * 64 + lane] = f2bf(kk * rk * gkl);
                    }
                }
            }
#ifndef MK_P2B
#define MK_P2B 1
#endif
            for (int rp_mk_p2b = 0; rp_mk_p2b < MK_P2B; ++rp_mk_p2b)
            {
                const float* cw = args.in[10] + (size_t)l * CONV_W * CONV_CH;
                const float* cb = args.in[11] + l * CONV_CH; const float* lg = args.in[12] + l * CONV_CH; const float* lb = args.in[13] + l * CONV_CH;
                float* ct = ldsf + 1024;
                float* hL = ldsf + 1024 + 32 * 256;
                const int c = tid & 255, half = tid >> 8;
                float wreg[CONV_W];
#pragma unroll
                for (int j = 0; j < CONV_W; ++j) wreg[j] = cw[j * CONV_CH + c];
                const float cbias = cb[c];
                for (int item = bid; item < T / 32; item += G) {
                    const int tok0 = item * 32;
                    const int tb = tok0 % SEQ;
                    __syncthreads();
#pragma unroll 4
                    for (int i = tid; i < 62 * 32; i += NTHREADS) {
                        const int rr = i >> 5, c8 = (i & 31) * 8, tp = tb - 30 + rr;
                        f32x4 h0 = (f32x4){0.f, 0.f, 0.f, 0.f}, h1 = h0;
                        if (tp >= 0) {
                            const bf16_t* zr = Z + (size_t)(tok0 - 30 + rr) * ZLD + Z_CU + c8;
                            const uint4 au = *(const uint4*)zr, gu = *(const uint4*)(zr + 256);
                            h0[0] = __uint_as_float(au.x << 16) * sigmoidf(__uint_as_float(gu.x << 16)); h0[1] = __uint_as_float(au.x & 0xffff0000u) * sigmoidf(__uint_as_float(gu.x & 0xffff0000u));
                            h0[2] = __uint_as_float(au.y << 16) * sigmoidf(__uint_as_float(gu.y << 16)); h0[3] = __uint_as_float(au.y & 0xffff0000u) * sigmoidf(__uint_as_float(gu.y & 0xffff0000u));
                            h1[0] = __uint_as_float(au.z << 16) * sigmoidf(__uint_as_float(gu.z << 16)); h1[1] = __uint_as_float(au.z & 0xffff0000u) * sigmoidf(__uint_as_float(gu.z & 0xffff0000u));
                            h1[2] = __uint_as_float(au.w << 16) * sigmoidf(__uint_as_float(gu.w << 16)); h1[3] = __uint_as_float(au.w & 0xffff0000u) * sigmoidf(__uint_as_float(gu.w & 0xffff0000u));
                        }
                        *(f32x4*)&hL[rr * 256 + c8] = h0; *(f32x4*)&hL[rr * 256 + c8 + 4] = h1;
                    }
                    __syncthreads();
                    {
                        float hwin[46];
#pragma unroll
                        for (int i = 0; i < 46; ++i) hwin[i] = hL[(half * 16 + i) * 256 + c];
#pragma unroll
                        for (int o = 0; o < 16; ++o) {
                            float a = cbias;
#pragma unroll
                            for (int j = 0; j < CONV_W; ++j) a += hwin[o + j] * wreg[j];
                            ct[(half * 16 + o) * 256 + c] = a;
                        }
                    }
                    __syncthreads();
#pragma unroll
                    for (int i = 0; i < 4; ++i) {
                        const int tt = wave * 4 + i;
                        const f32x4 v = *(const f32x4*)&ct[tt * 256 + lane * 4];
                        const float mu = wave_sum(v[0] + v[1] + v[2] + v[3]) * (1.f / 256.f);
                        const f32x4 dv = v - mu;
                        const float var = wave_sum(dv[0] * dv[0] + dv[1] * dv[1] + dv[2] * dv[2] + dv[3] * dv[3]) * (1.f / 256.f);
                        const float rstd = 1.0f / sqrtf(var + NORM_EPS);
                        const f32x4 gg = *(const f32x4*)(lg + lane * 4), bb = *(const f32x4*)(lb + lane * 4);
                        f32x4 y = dv * rstd * gg + bb;
                        uint2 o; o.x = pk2(siluf(y[0]), siluf(y[1])); o.y = pk2(siluf(y[2]), siluf(y[3]));
                        *(uint2*)(MIX + (size_t)(tok0 + tt) * D_MODEL + MIX_CONV + lane * 4) = o;
                    }
                }
            }
        } else if (k == 3 && PH_ON(3)) {
            if (rep == 0)
            for (int e = bid * NTHREADS + tid; e < BATCH * GLA_HEADS * 4608; e += G * NTHREADS) {
                const int bh = e / 4608, idx = e % 4608, d = idx % 48;
                float state = 0.f;
#pragma unroll 32
                for (int c = 0; c < 64; ++c) {
                    const size_t it = (size_t)bh * 64 + c;
                    const float tmp = SLOC[it * 4608 + idx], dec = DEC[it * 48 + d];
                    SLOC[it * 4608 + idx] = state; state = dec * state + tmp; }
            }
            {
                unsigned* hist32 = (unsigned*)lds_raw;
                constexpr int HSTR = 1028;
                unsigned* rs = (unsigned*)(lds_raw + 32 * HSTR * 4);
                volatile unsigned* qsh = (volatile unsigned*)(lds_raw + LDSCTL_OFF + 64);
                unsigned* qhead = ctl + CW_Q3 + 64 * l + rep;
                const int qc = lane & 15, g4 = lane >> 4, qh = wave >> 2, kg = wave & 3;
                const int row = 16 * qh + qc;
                for (;;) {
                    __syncthreads();
                    if (tid == 0) qsh[0] = atomicAdd(qhead, 1u);
                    __syncthreads();
                    const int it = (int)qsh[0];
                    if (it >= BATCH * 128) break;
                    const int b = it & 3, qt = 127 - (it >> 2);
                    const int tokb = b * SEQ, q0 = qt * 32, tq = q0 + row;
                    bf16x8 qf[9][2];
                    {
                        const bf16_t* zq = Z + (size_t)(tokb + tq) * ZLD + Z_IQ + g4 * 8;
#pragma unroll
                        for (int h = 0; h < 8; ++h)
#pragma unroll
                            for (int ks = 0; ks < 2; ++ks) qf[h][ks] = *(const bf16x8*)(zq + h * 64 + ks * 32);
                        const bf16_t* ql = QL + (size_t)(tokb + tq) * 64 + g4 * 8;
#pragma unroll
                        for (int ks = 0; ks < 2; ++ks) qf[8][ks] = *(const bf16x8*)(ql + ks * 32);
                    }
                    float ch[8];
                    { const f32x4 c0 = *(const f32x4*)(CH + (size_t)(tokb + tq) * 8), c1 = *(const f32x4*)(CH + (size_t)(tokb + tq) * 8 + 4);
                      ch[0] = c0[0]; ch[1] = c0[1]; ch[2] = c0[2]; ch[3] = c0[3]; ch[4] = c1[0]; ch[5] = c1[1]; ch[6] = c1[2]; ch[7] = c1[3]; }
                    if (qt < 8) {
                        if (rep == 0 && kg == 0 && g4 == 0) for (int kt = 0; kt <= qt; ++kt) MASK[((size_t)(b * 128) + kt) * SEQ + tq] = (kt < qt || row == 31) ? 0xffffffffu : ((1u << (row + 1)) - 1u);
                        continue;
                    }
#pragma unroll
                    for (int i = 0; i < 16; ++i) ((uint4*)hist32)[tid + 512 * i] = make_uint4(0u, 0u, 0u, 0u);
                    if (tid < 32) ((uint4*)hist32)[8192 + tid] = make_uint4(0u, 0u, 0u, 0u);
                    if (tid < 32) { rs[tid] = 0u; rs[32 + tid] = TOPK; rs[64 + tid] = 0u; rs[96 + tid] = 0u; }
                    __syncthreads();
#define DSA_SCORE(kt_) \
                        f32x4 sc[2]; \
                        { const bf16_t* kp = IK + (size_t)(tokb + (kt_) * 32 + qc) * 64 + g4 * 8; \
                          bf16x8 kf[2][2]; \
                          _Pragma("unroll") for (int u = 0; u < 2; ++u) _Pragma("unroll") for (int ks = 0; ks < 2; ++ks) kf[u][ks] = *(const bf16x8*)(kp + u * 16 * 64 + ks * 32); \
                          _Pragma("unroll") for (int u = 0; u < 2; ++u) { sc[u] = (f32x4){0.f, 0.f, 0.f, 0.f}; \
                              _Pragma("unroll") for (int ks = 0; ks < 2; ++ks) sc[u] = __builtin_amdgcn_mfma_f32_16x16x32_bf16(kf[u][ks], qf[8][ks], sc[u], 0, 0, 0); } \
                          _Pragma("unroll") for (int h = 0; h < 8; ++h) _Pragma("unroll") for (int u = 0; u < 2; ++u) { f32x4 a = (f32x4){0.f, 0.f, 0.f, 0.f}; \
                              _Pragma("unroll") for (int ks = 0; ks < 2; ++ks) a = __builtin_amdgcn_mfma_f32_16x16x32_bf16(kf[u][ks], qf[h][ks], a, 0, 0, 0); \
                              _Pragma("unroll") for (int i = 0; i < 4; ++i) sc[u][i] = __builtin_fmaf(fabsf(a[i]), ch[h], sc[u][i]); } }
                    for (int pass = 0; pass < 2; ++pass) {
                        const unsigned mmask = (pass == 0) ? 0u : 0xFFE00000u;
                        const int bshift = (pass == 0) ? 21 : 10;
                        const unsigned bmask = 2047u;
                        const unsigned prefm = rs[row];
                        for (int kt = kg; kt <= qt; kt += 4) {
                            DSA_SCORE(kt)
#pragma unroll
                            for (int u = 0; u < 2; ++u)
#pragma unroll
                                for (int i = 0; i < 4; ++i) {
                                    const int sidx = kt * 32 + 16 * u + 4 * g4 + i;
                                    const unsigned key = fkey(sc[u][i]);
                                    if (sidx <= tq && (key & mmask) == prefm) { const unsigned bin = (key >> bshift) & bmask; if (rep < 2) atomicAdd(&hist32[row * HSTR + (bin >> 1)], 1u << ((bin & 1u) * 16u)); else asm volatile("" :: "v"(bin)); }
                                }
                        }
                        __syncthreads();
                        for (int rr = 0; rr < 4; ++rr) {
                            const int R = wave * 4 + rr;
                            const unsigned kremR = rs[32 + R];
                            const uint4* hw = (const uint4*)(hist32 + R * HSTR + lane * 16);
                            unsigned cntl = 0u;
#pragma unroll
                            for (int q4 = 0; q4 < 4; ++q4) { const uint4 w = hw[q4]; cntl += (w.x & 0xffffu) + (w.x >> 16) + (w.y & 0xffffu) + (w.y >> 16) + (w.z & 0xffffu) + (w.z >> 16) + (w.w & 0xffffu) + (w.w >> 16); }
                            unsigned suf = cntl;
#pragma unroll
                            for (int o = 1; o < 64; o <<= 1) { const unsigned tv = __shfl_down(suf, o); if (lane + o < 64) suf += tv; }
                            const unsigned excl = suf - cntl;
                            if (excl < kremR && kremR <= suf) {
                                unsigned above = excl, eq = 0u; int bin = 0;
#pragma unroll 1
                                for (int i = 15; i >= 0; --i) { const unsigned w = hist32[R * HSTR + lane * 16 + i]; const unsigned hi = w >> 16, lo = w & 0xffffu;
                                    if (above + hi >= kremR) { bin = 2 * (lane * 16 + i) + 1; eq = hi; break; } above += hi;
                                    if (above + lo >= kremR) { bin = 2 * (lane * 16 + i); eq = lo; break; } above += lo; }
                                rs[R] = rs[R] | ((unsigned)bin << bshift); rs[32 + R] = kremR - above; rs[64 + R] = eq;
                            }
                        }
                        __syncthreads();
                        if (pass == 0) {
#pragma unroll
                            for (int i = 0; i < 16; ++i) ((uint4*)hist32)[tid + 512 * i] = make_uint4(0u, 0u, 0u, 0u);
                            if (tid < 32) ((uint4*)hist32)[8192 + tid] = make_uint4(0u, 0u, 0u, 0u);
                            __syncthreads();
                        }
                    }
                    {
                        const unsigned tau = rs[row]; const bool tiecrit = rs[64 + row] > rs[32 + row];
                        unsigned* mcol = MASK + (size_t)(b * 128) * SEQ + tq;
                        for (int kt = kg; kt <= qt; kt += 4) {
                            DSA_SCORE(kt)
                            unsigned bits = 0u;
#pragma unroll
                            for (int u = 0; u < 2; ++u)
#pragma unroll
                                for (int i = 0; i < 4; ++i) {
                                    const int sidx = kt * 32 + 16 * u + 4 * g4 + i;
                                    const unsigned key = fkey(sc[u][i]), key22 = key & 0xFFFFFC00u;
                                    const bool valid = sidx <= tq;
                                    if (valid && (key22 > tau || (key22 == tau && !tiecrit))) bits |= 1u << (16 * u + 4 * g4 + i);
                                    if (valid && key22 == tau && tiecrit) { const unsigned idx = atomicAdd(&rs[96 + row], 1u); if (idx < 511u) { hist32[row * HSTR + 2 * idx] = key; hist32[row * HSTR + 2 * idx + 1] = (unsigned)sidx; } }
                                }
                            bits |= (unsigned)__shfl_xor((int)bits, 16);
                            bits |= (unsigned)__shfl_xor((int)bits, 32);
                            if (g4 == 0 && rep == 0) mcol[(size_t)kt * SEQ] = bits;
                        }
                        asm volatile("s_waitcnt vmcnt(0)" ::: "memory");
                        __syncthreads();
                        if (rep == 0 && tid < 32 && rs[64 + tid] > rs[32 + tid]) {
                            int tdx = tid; asm volatile("" : "+v"(tdx));
                            unsigned nl = rs[96 + tid]; if (nl > 511u) nl = 511u;
                            const unsigned need = rs[32 + tid];
                            unsigned* lst = hist32 + tdx * HSTR;
                            for (unsigned q = 0; q < need && q < nl; ++q) {
                                unsigned bk = 0u, bs = 0xffffffffu, bi = 0u;
                                for (unsigned e2 = 0; e2 < nl; ++e2) { const unsigned kv = lst[2 * e2], sv = lst[2 * e2 + 1]; if (sv != 0xffffffffu && (kv > bk || (kv == bk && sv < bs))) { bk = kv; bs = sv; bi = e2; } }
                                lst[2 * bi + 1] = 0xffffffffu;
                                if (bs != 0xffffffffu) atomicOr(MASK + ((size_t)(b * 128) + (bs >> 5)) * SEQ + q0 + tdx, 1u << (bs & 31u));
                            }
                        }
                    }
#undef DSA_SCORE
                }
            }
        } else if (k == 4 && PH_ON(4)) {
            float* qt = ldsf;
            float* kt = qt + 64 * 49;
            float* vs = kt + 64 * 49;
            float* Am = vs + 64 * 97;
            float* Sin = Am + 64 * 65;
            const float* gon = args.in[7] + l * GLA_DV;
            volatile unsigned* qsh = (volatile unsigned*)(lds_raw + LDSCTL_OFF + 64);
            unsigned* qhead = ctl + CW_Q4 + 64 * l + rep;
            float* biasd = (float*)(lds_raw + 131072);
            for (int i = tid; i < 6 * 224; i += NTHREADS) { const int h = i / 224, d = i % 224 - 32; biasd[i] = d < 0 ? 0.f : args.in[2][t5_bucket(d) * DSA_HEADS + h] * 1.4426950408889634f; }
            constexpr int N_ATT = BATCH * 32 * 3;
            for (;;) {
                __syncthreads();
                if (tid == 0) qsh[0] = atomicAdd(qhead, 1u);
                __syncthreads();
                const int qit = (int)qsh[0];
#ifndef MK_GLA2_REP
#define MK_GLA2_REP 1
#endif
                if (qit >= N_ATT + MK_GLA2_REP * BATCH * GLA_HEADS * 64) break;
                if (qit < N_ATT) {
                    const int qt = 31 - qit / 12, rem = qit % 12, b = rem & 3, h0 = 2 * (rem >> 2);
                    const int tokb = b * SEQ, q0 = qt * 128, nkt = 4 * (qt + 1);
                    int tid_a = tid; asm volatile("" : "+v"(tid_a));
                    const int la = tid_a & 63, r = la & 31, hh = la >> 5;
                    const int qg = wave & 3, hd = wave >> 2, h = h0 + hd;
                    const int tq = q0 + 32 * qg + r;
                    LDSAS unsigned char* lb = (LDSAS unsigned char*)lds_raw;
                    LDSAS unsigned* maskl = (LDSAS unsigned*)(lb + 65536);
                    for (int idx0 = tid_a; idx0 < nkt * 128; idx0 += 8 * NTHREADS) {
                        unsigned mv[8];
#pragma unroll
                        for (int u8 = 0; u8 < 8; ++u8) { const int idx = idx0 + u8 * NTHREADS; mv[u8] = (idx < nkt * 128) ? MASK[((size_t)(b * 128) + (idx >> 7)) * SEQ + q0 + (idx & 127)] : 0u; }
#pragma unroll
                        for (int u8 = 0; u8 < 8; ++u8) { const int idx = idx0 + u8 * NTHREADS; if (idx < nkt * 128) maskl[idx] = mv[u8]; }
                    }
                    bf16x8 qf[4];
#pragma unroll
                    for (int ks = 0; ks < 4; ++ks) qf[ks] = *(const bf16x8*)(QN + (size_t)(tokb + tq) * 384 + h * 64 + ks * 16 + hh * 8);
                    f32x16 oacc[2];
#pragma unroll
                    for (int dt = 0; dt < 2; ++dt)
#pragma unroll
                        for (int i = 0; i < 16; ++i) oacc[dt][i] = 0.f;
                    float lsum = 0.f;
                    const int krow = 4 * wave + (la >> 4), kpos = la & 15;
                    const int vrow = 16 * wave + (la >> 2), vpos = la & 3;
                    const char* ksrc = (const char*)KN + ((size_t)(tokb + krow) * 384 + h0 * 64) * 2 + ((kpos ^ (krow & 15)) * 16);
                    const char* vsrc = (const char*)VT + ((size_t)(b * 128) * 384 + h0 * 64 + vrow) * 64 + ((vpos ^ ((vrow >> 2) & 3)) * 16);
                    int koff[4], voff[2][2];
#pragma unroll
                    for (int ks = 0; ks < 4; ++ks) koff[ks] = r * 256 + (((hd * 8 + ks * 2 + hh) ^ (r & 15)) * 16);
#pragma unroll
                    for (int dt = 0; dt < 2; ++dt)
#pragma unroll
                        for (int sst = 0; sst < 2; ++sst) { const int vr = hd * 64 + dt * 32 + r; voff[dt][sst] = 8192 + vr * 64 + (((2 * sst + hh) ^ ((vr >> 2) & 3)) * 16); }
#define ATT_ISSUE(kt_, st_) do { const int ktc = (kt_) < nkt ? (kt_) : nkt - 1; \
                        __builtin_amdgcn_global_load_lds((const unsigned*)(ksrc + (size_t)ktc * (32 * 768)), (LDSAS unsigned*)(lb + (st_) * 16384 + wave * 1024), 16, 0, 0); \
                        __builtin_amdgcn_global_load_lds((const unsigned*)(vsrc + (size_t)ktc * (384 * 64)), (LDSAS unsigned*)(lb + (st_) * 16384 + 8192 + wave * 1024), 16, 0, 0); } while (0)
                    __syncthreads();
                    ATT_ISSUE(0, 0); ATT_ISSUE(1, 1); ATT_ISSUE(2, 2);
                    for (int kt = 0; kt < nkt; ++kt) {
                        asm volatile("s_waitcnt vmcnt(4)" ::: "memory");
                        __builtin_amdgcn_s_barrier();
                        asm volatile("" ::: "memory");
                        ATT_ISSUE(kt + 3, (kt + 3) & 3);
                        if (kt * 32 <= q0 + 32 * qg + 31) {
                            LDSAS unsigned char* st = lb + (kt & 3) * 16384;
                            const unsigned mwh = maskl[kt * 128 + 32 * qg + r] >> (4 * hh);
                            const int mind = (q0 + 32 * qg) - (kt * 32 + 31);
                            f32x16 S;
#pragma unroll
                            for (int i = 0; i < 16; ++i) S[i] = 0.f;
#pragma unroll
                            for (int ks = 0; ks < 4; ++ks) { const bf16x8 a = *(const LDSAS bf16x8*)(st + koff[ks]); S = MFMA32(a, qf[ks], S); }
                            float p[16];
                            if (mind >= 113) {
                                const float bu = biasd[h * 224 + 223];
#pragma unroll
                                for (int i = 0; i < 16; ++i) p[i] = __uint_as_float(__float_as_uint(__builtin_amdgcn_exp2f(S[i] + bu)) & (unsigned)__builtin_amdgcn_sbfe((int)mwh, (i & 3) + 8 * (i >> 2), 1));
                            } else {
                                const float* bp = biasd + h * 224 + (tq - kt * 32 - 4 * hh + 5);
#pragma unroll
                                for (int i = 0; i < 16; ++i) p[i] = __uint_as_float(__float_as_uint(__builtin_amdgcn_exp2f(S[i] + bp[27 - (i & 3) - 8 * (i >> 2)])) & (unsigned)__builtin_amdgcn_sbfe((int)mwh, (i & 3) + 8 * (i >> 2), 1));
                            }
                            float ps = 0.f;
#pragma unroll
                            for (int i = 0; i < 16; ++i) ps += p[i];
                            lsum += ps;
                            uint4 u0, u1;
                            u0.x = pkbf(p[0], p[1]); u0.y = pkbf(p[2], p[3]); u0.z = pkbf(p[4], p[5]); u0.w = pkbf(p[6], p[7]);
                            u1.x = pkbf(p[8], p[9]); u1.y = pkbf(p[10], p[11]); u1.z = pkbf(p[12], p[13]); u1.w = pkbf(p[14], p[15]);
                            const bf16x8 pf0 = __builtin_bit_cast(bf16x8, u0), pf1 = __builtin_bit_cast(bf16x8, u1);
#pragma unroll
                            for (int dt = 0; dt < 2; ++dt) {
                                const bf16x8 a0 = *(const LDSAS bf16x8*)(st + voff[dt][0]);
                                const bf16x8 a1 = *(const LDSAS bf16x8*)(st + voff[dt][1]);
                                oacc[dt] = MFMA32(a0, pf0, oacc[dt]);
                                oacc[dt] = MFMA32(a1, pf1, oacc[dt]);
                            }
                        }
                    }
#undef ATT_ISSUE
                    asm volatile("s_waitcnt vmcnt(0)" ::: "memory");
                    {
                        const float lt = lsum + __shfl_xor(lsum, 32);
                        float inv = 1.f / lt;
                        bf16_t* mo = MIX + (size_t)(tokb + tq) * D_MODEL + MIX_DSA + h * 64;
#pragma unroll
                        for (int dt = 0; dt < 2; ++dt)
#pragma unroll
                            for (int g4 = 0; g4 < 4; ++g4) {
                                uint2 o; o.x = pkbf(oacc[dt][4 * g4] * inv, oacc[dt][4 * g4 + 1] * inv); o.y = pkbf(oacc[dt][4 * g4 + 2] * inv, oacc[dt][4 * g4 + 3] * inv);
                                *(uint2*)(mo + dt * 32 + 8 * g4 + 4 * hh) = o;
                            }
                    }
                    continue;
                }
                const int item = (qit - N_ATT) % (BATCH * GLA_HEADS * 64);
                const int bh = item >> 6, c = item & 63, b = bh >> 2, h = bh & 3, tok0 = b * SEQ + c * 64;
                int tid_g = tid; asm volatile("" : "+v"(tid_g));
                __syncthreads();
                {
                    LDSAS unsigned char* lb = (LDSAS unsigned char*)lds_raw;
                    constexpr int QS_OFF = 0, KS_OFF = 7168, VT_OFF = 14336, ST_OFF = 28160, SQ_OFF = 38912;
                    if (tid_g < 384) {
                        const int t = tid_g / 6, c8 = (tid_g % 6) * 8;
                        const bf16_t* zr = Z + (size_t)(tok0 + t) * ZLD;
                        const uint4 qu = *(const uint4*)(zr + Z_GQ + h * 48 + c8), ku = *(const uint4*)(zr + Z_GK + h * 48 + c8);
                        const f32x4 b0 = *(const f32x4*)(BCUM + (size_t)(tok0 + t) * 192 + h * 48 + c8), b1 = *(const f32x4*)(BCUM + (size_t)(tok0 + t) * 192 + h * 48 + c8 + 4);
                        const float e0 = __expf(b0[0]), e1 = __expf(b0[1]), e2 = __expf(b0[2]), e3 = __expf(b0[3]), e4 = __expf(b1[0]), e5 = __expf(b1[1]), e6 = __expf(b1[2]), e7 = __expf(b1[3]);
                        const float qs = 0.14433756729740643f;
                        u32x4v qo, ko;
                        qo.x = pkbf(__uint_as_float(qu.x << 16) * qs * e0, __uint_as_float(qu.x & 0xffff0000u) * qs * e1); qo.y = pkbf(__uint_as_float(qu.y << 16) * qs * e2, __uint_as_float(qu.y & 0xffff0000u) * qs * e3);
                        qo.z = pkbf(__uint_as_float(qu.z << 16) * qs * e4, __uint_as_float(qu.z & 0xffff0000u) * qs * e5); qo.w = pkbf(__uint_as_float(qu.w << 16) * qs * e6, __uint_as_float(qu.w & 0xffff0000u) * qs * e7);
                        ko.x = pkbf(__uint_as_float(ku.x << 16) / e0, __uint_as_float(ku.x & 0xffff0000u) / e1); ko.y = pkbf(__uint_as_float(ku.y << 16) / e2, __uint_as_float(ku.y & 0xffff0000u) / e3);
                        ko.z = pkbf(__uint_as_float(ku.z << 16) / e4, __uint_as_float(ku.z & 0xffff0000u) / e5); ko.w = pkbf(__uint_as_float(ku.w << 16) / e6, __uint_as_float(ku.w & 0xffff0000u) / e7);
                        *(LDSAS u32x4v*)(lb + QS_OFF + t * 112 + c8 * 2) = qo; *(LDSAS u32x4v*)(lb + KS_OFF + t * 112 + c8 * 2) = ko;
                    }
                    for (int i = tid_g; i < 64 * 12; i += NTHREADS) {
                        const int sidx = i / 12, c8 = (i % 12) * 8;
                        const uint4 vu = *(const uint4*)(Z + (size_t)(tok0 + sidx) * ZLD + Z_GV + h * 96 + c8);
                        const int sl = sidx & 31, pp = (sidx & 32) + (sl & 16) + 8 * ((sl >> 2) & 1) + 4 * ((sl >> 3) & 1) + (sl & 3);
                        LDSAS bf16_t* vp = (LDSAS bf16_t*)(lb + VT_OFF) + c8 * 72 + pp;
                        vp[0] = (bf16_t)(vu.x & 0xffffu); vp[72] = (bf16_t)(vu.x >> 16); vp[144] = (bf16_t)(vu.y & 0xffffu); vp[216] = (bf16_t)(vu.y >> 16);
                        vp[288] = (bf16_t)(vu.z & 0xffffu); vp[360] = (bf16_t)(vu.z >> 16); vp[432] = (bf16_t)(vu.w & 0xffffu); vp[504] = (bf16_t)(vu.w >> 16);
                    }
                    for (int i = tid_g; i < 96 * 6; i += NTHREADS) {
                        const int v = i / 6, c8 = (i % 6) * 8;
                        const f32x4 s0 = *(const f32x4*)(SLOC + (size_t)item * 4608 + v * 48 + c8), s1 = *(const f32x4*)(SLOC + (size_t)item * 4608 + v * 48 + c8 + 4);
                        u32x4v so; so.x = pkbf(s0[0], s0[1]); so.y = pkbf(s0[2], s0[3]); so.z = pkbf(s1[0], s1[1]); so.w = pkbf(s1[2], s1[3]);
                        *(LDSAS u32x4v*)(lb + ST_OFF + v * 112 + c8 * 2) = so;
                    }
                    __syncthreads();
                    const int la = tid_g & 63, r = la & 31, hh = la >> 5;
                    const int wv = (wave < 6) ? wave : 0, vt = wv % 3, tt = wv / 3;
                    f32x16 oT;
#pragma unroll
                    for (int i = 0; i < 16; ++i) oT[i] = 0.f;
                    bf16x8 qB[3];
#pragma unroll
                    for (int ks = 0; ks < 3; ++ks) qB[ks] = *(const LDSAS bf16x8*)(lb + QS_OFF + (32 * tt + r) * 112 + (16 * ks + 8 * hh) * 2);
#pragma unroll
                    for (int st = 0; st < 2; ++st) {
                        if (st <= tt) {
                            f32x16 X;
#pragma unroll
                            for (int i = 0; i < 16; ++i) X[i] = 0.f;
#pragma unroll
                            for (int ks = 0; ks < 3; ++ks) { const bf16x8 kA = *(const LDSAS bf16x8*)(lb + KS_OFF + (32 * st + r) * 112 + (16 * ks + 8 * hh) * 2); X = MFMA32(kA, qB[ks], X); }
                            if (st == tt) {
#pragma unroll
                                for (int i = 0; i < 16; ++i) X[i] = (crow(i, hh) <= r) ? X[i] : 0.f;
                            }
                            u32x4v u0, u1;
                            u0.x = pkbf(X[0], X[1]); u0.y = pkbf(X[2], X[3]); u0.z = pkbf(X[4], X[5]); u0.w = pkbf(X[6], X[7]);
                            u1.x = pkbf(X[8], X[9]); u1.y = pkbf(X[10], X[11]); u1.z = pkbf(X[12], X[13]); u1.w = pkbf(X[14], X[15]);
                            const bf16x8 x0 = __builtin_bit_cast(bf16x8, u0), x1 = __builtin_bit_cast(bf16x8, u1);
                            const bf16x8 v0 = *(const LDSAS bf16x8*)(lb + VT_OFF + (32 * vt + r) * 144 + (32 * st + 8 * hh) * 2);
                            const bf16x8 v1 = *(const LDSAS bf16x8*)(lb + VT_OFF + (32 * vt + r) * 144 + (32 * st + 16 + 8 * hh) * 2);
                            oT = MFMA32(v0, x0, oT); oT = MFMA32(v1, x1, oT);
                        }
                    }
#pragma unroll
                    for (int ks = 0; ks < 3; ++ks) { const bf16x8 sA = *(const LDSAS bf16x8*)(lb + ST_OFF + (32 * vt + r) * 112 + (16 * ks + 8 * hh) * 2); oT = MFMA32(sA, qB[ks], oT); }
                    float ssp = 0.f;
#pragma unroll
                    for (int i = 0; i < 16; ++i) ssp += oT[i] * oT[i];
                    ssp += __shfl_xor(ssp, 32);
                    LDSAS float* sq = (LDSAS float*)(lb + SQ_OFF);
                    if (wave < 6 && hh == 0) sq[(32 * tt + r) * 3 + vt] = ssp;
                    __syncthreads();
                    if (wave < 6) {
                        const int t = 32 * tt + r;
                        const float rinv = 1.0f / sqrtf((sq[t * 3] + sq[t * 3 + 1] + sq[t * 3 + 2]) * (1.f / 96.f) + NORM_EPS);
#pragma unroll
                        for (int g4 = 0; g4 < 4; ++g4) {
                            const int v0i = 32 * vt + 8 * g4 + 4 * hh;
                            const f32x4 gg = *(const f32x4*)(gon + v0i);
                            const uint2 ru = *(const uint2*)(Z + (size_t)(tok0 + t) * ZLD + Z_GR + h * 96 + v0i);
                            uint2 w; w.x = pkbf(oT[4 * g4] * rinv * gg[0] * siluf(__uint_as_float(ru.x << 16)), oT[4 * g4 + 1] * rinv * gg[1] * siluf(__uint_as_float(ru.x & 0xffff0000u)));
                            w.y = pkbf(oT[4 * g4 + 2] * rinv * gg[2] * siluf(__uint_as_float(ru.y << 16)), oT[4 * g4 + 3] * rinv * gg[3] * siluf(__uint_as_float(ru.y & 0xffff0000u)));
                            *(uint2*)(MIX + (size_t)(tok0 + t) * D_MODEL + MIX_GLA + h * 96 + v0i) = w;
                        }
                    }
                }
            }
        } else if (k == 5 && PH_ON(5)) {
            pg8::Gemm g{MIX, WOUT + (size_t)l * D_MODEL * D_MODEL, T, D_MODEL, D_MODEL}; pg8::StaticOrder S; S.init(T, D_MODEL, G, bid);
            pg8::EpiRes E{xin, OUT, D_MODEL};
            pg8::gemm_phase<pg8::EpiRes, pg8::StaticOrder, true, true>(tid, ldsq, g, S, E);
        } else if (k == 6 && PH_ON(6)) {
            const float* g = args.in[15] + l * D_MODEL;
#pragma unroll 4
            for (int r = gw; r < T; r += NGW) rmsnorm_row_bf16(OUT + (size_t)r * D_MODEL, g, XN + (size_t)r * D_MODEL, lane);
            {
                float* scr = ldsf + wave * (64 * 33);
                for (int it = MOEW_P7 + gw; it < N_EXPERTS * MOEW_IE; it += NGW) {
                    const int e = it / MOEW_IE; int r = it % MOEW_IE;
                    const size_t we = (size_t)l * N_EXPERTS + e;
                    if (r < MOEW_IG) { transpose_item(args.in[27] + we * D_MODEL * D_EXPERT, D_MODEL, D_EXPERT, 16, WGU + (size_t)e * 1024 * D_MODEL, 0, 2, 0, scr, r, lane); continue; } r -= MOEW_IG;
                    if (r < MOEW_IG) { transpose_item(args.in[28] + we * D_MODEL * D_EXPERT, D_MODEL, D_EXPERT, 16, WGU + (size_t)e * 1024 * D_MODEL, 0, 2, 1, scr, r, lane); continue; } r -= MOEW_IG;
                    transpose_item(args.in[29] + we * D_EXPERT * D_MODEL, D_EXPERT, D_MODEL, 32, WDN + (size_t)e * D_MODEL * D_EXPERT, 0, 1, 0, scr, r, lane);
                }
            }
        } else if (k == 7 && PH_ON(7)) {
            pg8::Gemm g{XN, WCQ + (size_t)l * XW * D_MODEL, T, XW, D_MODEL}; pg8::StaticOrder S; S.init(T, XW, G, bid);
            pg8::EpiStoreBf16 E{CQ, XW, 0xffff};
            pg8::gemm_phase<pg8::EpiStoreBf16, pg8::StaticOrder, true, true>(tid, ldsq, g, S, E);
            if (bid >= T / 256) {
                float* scr = ldsf + wave * (64 * 33);
                const int nidle = (G - T / 256) * NWAVES;
                for (int it = (bid - T / 256) * NWAVES + wave; it < MOEW_P7; it += nidle) {
                    const int e = it / MOEW_IE; int r = it % MOEW_IE;
                    const size_t we = (size_t)l * N_EXPERTS + e;
                    if (r < MOEW_IG) { transpose_item(args.in[27] + we * D_MODEL * D_EXPERT, D_MODEL, D_EXPERT, 16, WGU + (size_t)e * 1024 * D_MODEL, 0, 2, 0, scr, r, lane); continue; } r -= MOEW_IG;
                    if (r < MOEW_IG) { transpose_item(args.in[28] + we * D_MODEL * D_EXPERT, D_MODEL, D_EXPERT, 16, WGU + (size_t)e * 1024 * D_MODEL, 0, 2, 1, scr, r, lane); continue; } r -= MOEW_IG;
                    transpose_item(args.in[29] + we * D_EXPERT * D_MODEL, D_EXPERT, D_MODEL, 32, WDN + (size_t)e * D_MODEL * D_EXPERT, 0, 1, 0, scr, r, lane);
                }
            }
        } else if (k == 8 && PH_ON(8)) {
            {
                const float* gq = args.in[19] + l * X_DH;
                const int r = lane & 31, hh = lane >> 5;
                for (int item = gw; item < BATCH * X_HEADS * (SEQ / 32); item += NGW) {
                    const int tt = item & 127, h = (item >> 7) & 3, b = item >> 9;
                    const int tok = b * SEQ + tt * 32 + r;
                    bf16x8 qf[4];
                    {
                        float qv[4][8]; float ss = 0.f;
#pragma unroll
                        for (int ks = 0; ks < 4; ++ks) { const uint4 u = *(const uint4*)(CQ + (size_t)tok * XW + h * 64 + ks * 16 + hh * 8);
                            qv[ks][0] = __uint_as_float(u.x << 16); qv[ks][1] = __uint_as_float(u.x & 0xffff0000u); qv[ks][2] = __uint_as_float(u.y << 16); qv[ks][3] = __uint_as_float(u.y & 0xffff0000u);
                            qv[ks][4] = __uint_as_float(u.z << 16); qv[ks][5] = __uint_as_float(u.z & 0xffff0000u); qv[ks][6] = __uint_as_float(u.w << 16); qv[ks][7] = __uint_as_float(u.w & 0xffff0000u);
#pragma unroll
                            for (int e = 0; e < 8; ++e) ss += qv[ks][e] * qv[ks][e]; }
                        ss += __shfl_xor(ss, 32);
                        const float rq = (0.125f * 1.4426950408889634f) / sqrtf(ss * (1.f / 64.f) + NORM_EPS);
#pragma unroll
                        for (int ks = 0; ks < 4; ++ks) { const f32x4 g0 = *(const f32x4*)(gq + ks * 16 + hh * 8), g1 = *(const f32x4*)(gq + ks * 16 + hh * 8 + 4);
                            uint4 u; u.x = pkbf(qv[ks][0] * rq * g0[0], qv[ks][1] * rq * g0[1]); u.y = pkbf(qv[ks][2] * rq * g0[2], qv[ks][3] * rq * g0[3]);
                            u.z = pkbf(qv[ks][4] * rq * g1[0], qv[ks][5] * rq * g1[1]); u.w = pkbf(qv[ks][6] * rq * g1[2], qv[ks][7] * rq * g1[3]);
                            qf[ks] = __builtin_bit_cast(bf16x8, u); }
                    }
                    f32x16 oacc[2];
#pragma unroll
                    for (int dt = 0; dt < 2; ++dt)
#pragma unroll
                        for (int e = 0; e < 16; ++e) oacc[dt][e] = 0.f;
                    float lsm = 0.f;
                    const bf16_t* kb = CKN + ((size_t)l * BATCH * MEM_LEN + (size_t)b * MEM_LEN + r) * 256 + h * 64 + hh * 8;
                    const bf16_t* vb = CVT + ((size_t)((l * BATCH + b) * X_HEADS + h) * 64 + r) * 256 + hh * 8;
#pragma unroll 2
                    for (int kt = 0; kt < 8; ++kt) {
                        f32x16 S;
#pragma unroll
                        for (int e = 0; e < 16; ++e) S[e] = 0.f;
#pragma unroll
                        for (int ks = 0; ks < 4; ++ks) { const bf16x8 a = *(const bf16x8*)(kb + (size_t)kt * 32 * 256 + ks * 16); S = MFMA32(a, qf[ks], S); }
                        float p[16]; float ps = 0.f;
#pragma unroll
                        for (int e = 0; e < 16; ++e) { p[e] = __builtin_amdgcn_exp2f(S[e]); ps += p[e]; }
                        lsm += ps;
                        uint4 u0, u1;
                        u0.x = pkbf(p[0], p[1]); u0.y = pkbf(p[2], p[3]); u0.z = pkbf(p[4], p[5]); u0.w = pkbf(p[6], p[7]);
                        u1.x = pkbf(p[8], p[9]); u1.y = pkbf(p[10], p[11]); u1.z = pkbf(p[12], p[13]); u1.w = pkbf(p[14], p[15]);
                        const bf16x8 pf0 = __builtin_bit_cast(bf16x8, u0), pf1 = __builtin_bit_cast(bf16x8, u1);
#pragma unroll
                        for (int dt = 0; dt < 2; ++dt) {
                            const bf16x8 a0 = *(const bf16x8*)(vb + (size_t)dt * 32 * 256 + kt * 32);
                            const bf16x8 a1 = *(const bf16x8*)(vb + (size_t)dt * 32 * 256 + kt * 32 + 16);
                            oacc[dt] = MFMA32(a0, pf0, oacc[dt]);
                            oacc[dt] = MFMA32(a1, pf1, oacc[dt]);
                        }
                    }
                    const float inv = 1.f / (lsm + __shfl_xor(lsm, 32));
                    bf16_t* op = COIN + (size_t)tok * XW + h * 64;
#pragma unroll
                    for (int dt = 0; dt < 2; ++dt)
#pragma unroll
                        for (int g4 = 0; g4 < 4; ++g4) {
                            uint2 o; o.x = pkbf(oacc[dt][4 * g4] * inv, oacc[dt][4 * g4 + 1] * inv); o.y = pkbf(oacc[dt][4 * g4 + 2] * inv, oacc[dt][4 * g4 + 3] * inv);
                            *(uint2*)(op + dt * 32 + 8 * g4 + 4 * hh) = o;
                        }
                }
            }
        } else if (k == 9 && PH_ON(9)) {
            pg8::Gemm g{COIN, WCO + (size_t)l * D_MODEL * XW, T, D_MODEL, XW}; pg8::StaticOrder S; S.init(T, D_MODEL, G, bid);
            pg8::EpiRes E{OUT, OUT, D_MODEL};
            pg8::gemm_phase<pg8::EpiRes, pg8::StaticOrder, true, true>(tid, ldsq, g, S, E);
        } else if (k == 10 && PH_ON(10)) {
            const float* g = args.in[22] + l * D_MODEL;
            const float* brg = args.in[24] + l * N_GROUPS; const float* bre = args.in[26] + l * N_EXPERTS;
            unsigned* lcnt = (unsigned*)lds_raw;
            unsigned* lbase = lcnt + 16;
            unsigned* ler = lcnt + 32;
            float* rinvs = (float*)lds_raw + 192;
            float* lg = (float*)lds_raw + 256;
            float* red = (float*)lds_raw + 2048;
            const bf16_t* wrt_hi = WRT + (size_t)l * 2 * 32 * D_MODEL; const bf16_t* wrt_lo = wrt_hi + 32 * D_MODEL;
            for (int chunk = bid; chunk < T / 64; chunk += G) {
                __syncthreads();
                if (tid < 16) lcnt[tid] = 0u;
#ifndef MK_RT_A
#define MK_RT_A 1
#endif
#ifndef MK_RT_B
#define MK_RT_B 1
#endif
                for (int rta = 0; rta < MK_RT_A; ++rta)
#pragma unroll 2
                for (int ti = 0; ti < 8; ++ti) {
                    const int r = chunk * 64 + wave * 8 + ti;
                    const float* xrow = OUT + (size_t)r * D_MODEL;
                    f32x4 v[4]; float ss = 0.f;
#pragma unroll
                    for (int jj = 0; jj < 4; ++jj) { v[jj] = *(const f32x4*)(xrow + lane * 4 + 256 * jj); ss += v[jj][0] * v[jj][0] + v[jj][1] * v[jj][1] + v[jj][2] * v[jj][2] + v[jj][3] * v[jj][3]; }
                    const float rinv = 1.0f / sqrtf(wave_sum(ss) * (1.f / 1024.f) + NORM_EPS);
                    if (lane == 0) rinvs[wave * 8 + ti] = rinv;
#pragma unroll
                    for (int jj = 0; jj < 4; ++jj) { const f32x4 gg = *(const f32x4*)(g + lane * 4 + 256 * jj);
                        uint2 o; o.x = pk2(v[jj][0] * rinv * gg[0], v[jj][1] * rinv * gg[1]); o.y = pk2(v[jj][2] * rinv * gg[2], v[jj][3] * rinv * gg[3]);
                        *(uint2*)(XN + (size_t)r * D_MODEL + lane * 4 + 256 * jj) = o; }
                }
                __syncthreads();
                for (int rtb = 0; rtb < MK_RT_B; ++rtb) {
                    const int rr = lane & 31, hh = lane >> 5;
                    f32x16 acc[2];
#pragma unroll
                    for (int mt = 0; mt < 2; ++mt)
#pragma unroll
                        for (int e = 0; e < 16; ++e) acc[mt][e] = 0.f;
                    const float rv0 = rinvs[rr], rv1 = rinvs[32 + rr];
#pragma unroll 4
                    for (int kq = 0; kq < 8; ++kq) {
                        const int k0 = 16 * (8 * wave + kq) + 8 * hh;
                        const bf16x8 bh = *(const bf16x8*)(wrt_hi + (size_t)rr * D_MODEL + k0), bl = *(const bf16x8*)(wrt_lo + (size_t)rr * D_MODEL + k0);
                        const f32x4 g0 = *(const f32x4*)(g + k0), g1 = *(const f32x4*)(g + k0 + 4);
#pragma unroll
                        for (int mt = 0; mt < 2; ++mt) {
                            const float* xp = OUT + (size_t)(chunk * 64 + mt * 32 + rr) * D_MODEL + k0;
                            const f32x4 x0 = *(const f32x4*)xp, x1 = *(const f32x4*)(xp + 4);
                            const float rv = mt ? rv1 : rv0;
                            float xn[8] = {x0[0] * rv * g0[0], x0[1] * rv * g0[1], x0[2] * rv * g0[2], x0[3] * rv * g0[3], x1[0] * rv * g1[0], x1[1] * rv * g1[1], x1[2] * rv * g1[2], x1[3] * rv * g1[3]};
                            u32x4v uh, ul;
                            uh.x = pkbf(xn[0], xn[1]); uh.y = pkbf(xn[2], xn[3]); uh.z = pkbf(xn[4], xn[5]); uh.w = pkbf(xn[6], xn[7]);
                            ul.x = pkbf(xn[0] - __uint_as_float(uh.x << 16), xn[1] - __uint_as_float(uh.x & 0xffff0000u)); ul.y = pkbf(xn[2] - __uint_as_float(uh.y << 16), xn[3] - __uint_as_float(uh.y & 0xffff0000u));
                            ul.z = pkbf(xn[4] - __uint_as_float(uh.z << 16), xn[5] - __uint_as_float(uh.z & 0xffff0000u)); ul.w = pkbf(xn[6] - __uint_as_float(uh.w << 16), xn[7] - __uint_as_float(uh.w & 0xffff0000u));
                            const bf16x8 ah = __builtin_bit_cast(bf16x8, uh), al = __builtin_bit_cast(bf16x8, ul);
                            acc[mt] = MFMA32(ah, bh, acc[mt]); acc[mt] = MFMA32(ah, bl, acc[mt]); acc[mt] = MFMA32(al, bh, acc[mt]);
                        }
                    }
#pragma unroll
                    for (int mt = 0; mt < 2; ++mt)
#pragma unroll
                        for (int e = 0; e < 16; ++e) red[((wave * 2 + mt) * 32 + crow(e, hh)) * 33 + rr] = acc[mt][e];
                }
                __syncthreads();
                for (int idx = tid; idx < 64 * 20; idx += NTHREADS) { const int t = idx / 20, n = idx % 20; float sv = 0.f;
#pragma unroll
                    for (int w = 0; w < 8; ++w) sv += red[((w * 2 + (t >> 5)) * 32 + (t & 31)) * 33 + n];
                    lg[t * 21 + n] = sv; }
                __syncthreads();
                if (tid < 64) {
                    const int r = chunk * 64 + tid;
                    float acc[20];
#pragma unroll
                    for (int jj = 0; jj < 20; ++jj) acc[jj] = lg[tid * 21 + jj];
                    float gl[4]; int gs = 0;
#pragma unroll
                    for (int jj = 0; jj < 4; ++jj) gl[jj] = acc[jj] + brg[jj];
                    float gmax = gl[0];
#pragma unroll
                    for (int jj = 1; jj < 4; ++jj) if (gl[jj] > gmax) { gmax = gl[jj]; gs = jj; }
                    float den = 0.f;
#pragma unroll
                    for (int jj = 0; jj < 4; ++jj) den += __expf(gl[jj] - gmax);
                    const float gwt = 1.f / den;
                    float el[4];
#pragma unroll
                    for (int jj = 0; jj < 4; ++jj) { float vsel = 0.f;
#pragma unroll
                        for (int gg2 = 0; gg2 < 4; ++gg2) vsel = (gg2 == gs) ? (acc[4 + gg2 * 4 + jj] + bre[gg2 * 4 + jj]) : vsel;
                        el[jj] = vsel; }
                    int i1 = 0; float e1v = el[0];
#pragma unroll
                    for (int jj = 1; jj < 4; ++jj) if (el[jj] > e1v) { e1v = el[jj]; i1 = jj; }
                    int i2 = -1; float e2v = -INFINITY;
#pragma unroll
                    for (int jj = 0; jj < 4; ++jj) if (jj != i1 && el[jj] > e2v) { e2v = el[jj]; i2 = jj; }
                    const float e2 = __expf(e2v - e1v);
                    const float w1 = 1.f / (1.f + e2), w2 = e2 / (1.f + e2);
                    const int ex1 = gs * 4 + i1, ex2 = gs * 4 + i2;
                    tok_e[r * 2] = ex1; tok_e[r * 2 + 1] = ex2;
                    tok_g[r * 2] = w1 * gwt; tok_g[r * 2 + 1] = w2 * gwt;
                    const unsigned r1 = atomicAdd(&lcnt[ex1], 1u), r2 = atomicAdd(&lcnt[ex2], 1u);
                    ler[tid * 2] = (unsigned)ex1 | (r1 << 8); ler[tid * 2 + 1] = (unsigned)ex2 | (r2 << 8);
                }
                __syncthreads();
                if (tid < 16) CNTT[((size_t)l * (T / 64) + chunk) * 16 + tid] = (int)lcnt[tid];
                if (tid < 128) tok_r[(chunk * 64) * 2 + tid] = (int)(ler[tid] >> 8);
            }
        } else if (k >= 11 && k <= 14 && PH_ON(11)) {
            int off[N_EXPERTS + 1];
            int* cbt = (int*)lds_raw + 1024;
            if (k == 11) {
                int* segs = (int*)lds_raw;
                int* tot = (int*)lds_raw + 512;
                __syncthreads();
                for (int i = tid; i < (T / 64) * 16; i += NTHREADS) cbt[i] = CNTT[(size_t)l * (T / 64) * 16 + i];
                __syncthreads();
                { const int e = tid & 15, sg = tid >> 4; int sacc = 0;
#pragma unroll
                  for (int c = 0; c < 8; ++c) { const int v = cbt[(sg * 8 + c) * 16 + e]; cbt[(sg * 8 + c) * 16 + e] = sacc; sacc += v; }
                  segs[sg * 16 + e] = sacc; }
                __syncthreads();
                { const int e = tid & 15, sg = tid >> 4; int base = 0;
                  for (int q = 0; q < sg; ++q) base += segs[q * 16 + e];
#pragma unroll
                  for (int c = 0; c < 8; ++c) cbt[(sg * 8 + c) * 16 + e] += base;
                  if (sg == 31) { tot[e] = base + segs[sg * 16 + e]; if (bid == 0) cnt[e] = (unsigned)(base + segs[sg * 16 + e]); } }
                __syncthreads();
                off[0] = 0;
#pragma unroll
                for (int e = 0; e < N_EXPERTS; ++e) off[e + 1] = off[e] + ((tot[e] + PADR - 1) / PADR) * PADR;
            } else {
                off[0] = 0;
#pragma unroll
                for (int e = 0; e < N_EXPERTS; ++e) { const int c = (int)__hip_atomic_load(&cnt[e], __ATOMIC_RELAXED, __HIP_MEMORY_SCOPE_AGENT); off[e + 1] = off[e] + ((c + PADR - 1) / PADR) * PADR; }
            }
            const int total_rows = off[N_EXPERTS];
            if (k == 11) {
                for (int tb8 = gw * 8; tb8 < T; tb8 += NGW * 8) {
                    int pe = 0, pdst = 0;
                    if (lane < 16) { const int i = tb8 * 2 + lane; pe = tok_e[i]; int o = 0;
#pragma unroll
                        for (int q = 0; q < N_EXPERTS; ++q) o = (q == pe) ? off[q] : o;
                        const int grank = cbt[(tb8 >> 6) * 16 + pe] + tok_r[i];
                        tok_r[i] = grank; pdst = o + grank; }
#pragma unroll 4
                    for (int t8 = 0; t8 < 8; ++t8) {
                        const uint4* src = (const uint4*)(XN + (size_t)(tb8 + t8) * D_MODEL);
                        const uint4 w0 = src[lane], w1 = src[lane + 64];
                        const int d0 = __builtin_amdgcn_readfirstlane(__shfl(pdst, t8 * 2)), d1 = __builtin_amdgcn_readfirstlane(__shfl(pdst, t8 * 2 + 1));
                        uint4* dst0 = (uint4*)(XG + (size_t)d0 * D_MODEL); uint4* dst1 = (uint4*)(XG + (size_t)d1 * D_MODEL);
                        dst0[lane] = w0; dst0[lane + 64] = w1; dst1[lane] = w0; dst1[lane + 64] = w1;
                    }
                }
                for (int e = 0; e < N_EXPERTS; ++e) {
                    int oe = 0, oe1 = 0;
#pragma unroll
                    for (int q = 0; q < N_EXPERTS; ++q) { oe = (q == e) ? off[q] : oe; oe1 = (q == e) ? off[q + 1] : oe1; }
                    const int c = ((int*)lds_raw + 512)[e];
                    for (int r = oe + c + gw; r < oe1; r += NGW) { uint4* dst = (uint4*)(XG + (size_t)r * D_MODEL); dst[lane] = make_uint4(0u, 0u, 0u, 0u); dst[lane + 64] = make_uint4(0u, 0u, 0u, 0u); }
                }
            } else if (k == 12) {
                pg8::Gemm g{XG, WGU, total_rows, 1024, D_MODEL};
                pg8::GroupSched S;
#pragma unroll
                for (int q = 0; q < 17; ++q) S.off[q] = off[q];
                S.nunits = (total_rows / 256) * 4; S.G = G; S.c = bid;
                pg8::EpiGateUp E{HB, D_EXPERT};
                pg8::gemm_phase<pg8::EpiGateUp, pg8::GroupSched, true, true>(tid, ldsq, g, S, E);
            } else if (k == 13) {
                pg8::Gemm g{HB, WDN, total_rows, 1024, D_EXPERT};
                pg8::GroupSched S;
#pragma unroll
                for (int q = 0; q < 17; ++q) S.off[q] = off[q];
                S.nunits = (total_rows / 256) * 4; S.G = G; S.c = bid;
                pg8::EpiStoreBf16 E{DB, D_MODEL, 3};
                pg8::gemm_phase<pg8::EpiStoreBf16, pg8::GroupSched, true, true>(tid, ldsq, g, S, E);
            } else {
                const float* gnx = args.in[3] + (l + 1 < DEPTH ? l + 1 : l) * D_MODEL;
                for (int tb8 = gw * 8; tb8 < T; tb8 += NGW * 8) {
                int prow = 0; float pgate = 0.f;
                if (lane < 16) { const int i = tb8 * 2 + lane; const int pe = tok_e[i]; int o = 0;
#pragma unroll
                    for (int q = 0; q < N_EXPERTS; ++q) o = (q == pe) ? off[q] : o;
                    prow = o + tok_r[i]; pgate = tok_g[i]; }
#pragma unroll 2
                for (int t8 = 0; t8 < 8; ++t8) {
                    const int r = tb8 + t8;
                    const size_t r0 = (size_t)__builtin_amdgcn_readfirstlane(__shfl(prow, t8 * 2)), r1 = (size_t)__builtin_amdgcn_readfirstlane(__shfl(prow, t8 * 2 + 1));
                    const float g0 = __shfl(pgate, t8 * 2), g1 = __shfl(pgate, t8 * 2 + 1);
                    f32x4 xv[4]; float ss = 0.f;
#pragma unroll
                    for (int j = 0; j < 4; ++j) {
                        const int c = lane * 4 + 256 * j;
                        const uint2 a = *(const uint2*)(DB + r0 * 1024 + c), bq = *(const uint2*)(DB + r1 * 1024 + c);
                        f32x4 x = *(const f32x4*)(OUT + (size_t)r * D_MODEL + c);
                        x[0] += g0 * __uint_as_float(a.x << 16) + g1 * __uint_as_float(bq.x << 16);
                        x[1] += g0 * __uint_as_float(a.x & 0xffff0000u) + g1 * __uint_as_float(bq.x & 0xffff0000u);
                        x[2] += g0 * __uint_as_float(a.y << 16) + g1 * __uint_as_float(bq.y << 16);
                        x[3] += g0 * __uint_as_float(a.y & 0xffff0000u) + g1 * __uint_as_float(bq.y & 0xffff0000u);
                        *(f32x4*)(OUT + (size_t)r * D_MODEL + c) = x;
                        xv[j] = x; ss += x[0] * x[0] + x[1] * x[1] + x[2] * x[2] + x[3] * x[3];
                    }
                    if (l + 1 < DEPTH) {
                        const float rinv = 1.0f / sqrtf(wave_sum(ss) * (1.f / 1024.f) + NORM_EPS);
#pragma unroll
                        for (int j = 0; j < 4; ++j) { const int c = lane * 4 + 256 * j; const f32x4 gg = *(const f32x4*)(gnx + c);
                            uint2 o; o.x = pk2(xv[j][0] * rinv * gg[0], xv[j][1] * rinv * gg[1]); o.y = pk2(xv[j][2] * rinv * gg[2], xv[j][3] * rinv * gg[3]);
                            *(uint2*)(XN + (size_t)r * D_MODEL + c) = o; }
                    }
                }
                }
            }
        }
    }
#ifdef MK_PROF_A
    if (KSEL < 0) {
        xcd_barrier(bar);
        if (bid == 0 && threadIdx.x == 0) ctl[8192 + DEPTH * NP] = (unsigned)__builtin_amdgcn_s_memrealtime();
        xcd_barrier(bar);
        const float da = (float)(ctl[8192 + MK_PROF_A + 1] - ctl[8192 + MK_PROF_A]) * 0.01f;
        const float db = (MK_PROF_B < 0) ? (float)(ctl[8192 + DEPTH * NP] - ctl[8192]) * 0.01f : (float)(ctl[8192 + MK_PROF_B + 1] - ctl[8192 + MK_PROF_B]) * 0.01f;
        for (size_t i = (size_t)T * D_MODEL / 2 + (size_t)bid * NTHREADS + threadIdx.x; i < (size_t)T * D_MODEL; i += (size_t)G * NTHREADS) OUT[i] = db;
        if (bid == 0 && threadIdx.x == 0) OUT[0] = 100.f * da;
    }
#endif
}

#ifndef MK_SINGLE
#define MK_SINGLE 1
#endif
extern "C" void kernel_launch(void* const* d_in, const int* in_sizes, int n_in, void* d_out, int out_size, void* d_ws, size_t ws_size, hipStream_t stream) {
    static int grid = 0;
    if (grid == 0) {
        if (n_in != 30 || out_size != T * D_MODEL || ws_size < WS_END) { fprintf(stderr, "kernel_launch: unexpected sizes n_in %d out %d ws %zu (need %zu)\n", n_in, out_size, ws_size, (size_t)WS_END); grid = -1; return; }
        int dev = 0, cus = 0;
        if (hipGetDevice(&dev) != hipSuccess || hipDeviceGetAttribute(&cus, hipDeviceAttributeMultiprocessorCount, dev) != hipSuccess) { grid = -1; return; }
        bool okattr = true;
#define SETATTR(K) okattr = okattr && (hipFuncSetAttribute((const void*)mk_fwd<K>, hipFuncAttributeMaxDynamicSharedMemorySize, LDS_BYTES) == hipSuccess)
#if MK_SINGLE
        SETATTR(-1);
#else
        SETATTR(0); SETATTR(1); SETATTR(2); SETATTR(3); SETATTR(4); SETATTR(5); SETATTR(6); SETATTR(7); SETATTR(8); SETATTR(9); SETATTR(10); SETATTR(11); SETATTR(12); SETATTR(13); SETATTR(14);
#endif
        if (!okattr) { fprintf(stderr, "kernel_launch: hipFuncSetAttribute failed\n"); grid = -1; return; }
        (void)hipGetLastError();
        grid = cus > 0 ? cus : 256;
    }
    if (grid < 0) return;
    (void)hipMemsetAsync((char*)d_ws + WS_CTL, 0, CTL_BYTES, stream);
    Args a{};
    for (int i = 0; i < 30; ++i) a.in[i] = (const float*)d_in[i];
    a.out = (float*)d_out; a.ws = (unsigned char*)d_ws;
#if MK_SINGLE
    a.ph_lo = 0; a.ph_hi = DEPTH * NP;
    hipLaunchKernelGGL(mk_fwd<-1>, dim3(grid), dim3(NTHREADS), LDS_BYTES, stream, a);
#else
    for (int ph = 0; ph < DEPTH * NP; ++ph) {
        a.ph_lo = ph; a.ph_hi = ph + 1;
        switch (ph % NP) {
#define LCASE(K) case K: hipLaunchKernelGGL(mk_fwd<K>, dim3(grid), dim3(NTHREADS), LDS_BYTES, stream, a); break
            LCASE(0); LCASE(1); LCASE(2); LCASE(3); LCASE(4); LCASE(5); LCASE(6); LCASE(7); LCASE(8); LCASE(9); LCASE(10); LCASE(11); LCASE(12); LCASE(13); LCASE(14);
        }
    }
#endif
}
```
